# Optimizing an MI355X kernel written in HIP

```python
import math
import jax, jax.numpy as jnp
from jax import lax
import numpy as np

D_MODEL = 1024
BATCH = 4
SEQ = 8192
DEPTH = 1

D_MIX = D_MODEL
D_ATTN = D_MIX // 2
D_POOL = D_MIX - D_ATTN
HEAD_DIM = 64
ATTN_HEADS = D_ATTN // HEAD_DIM
DILATED_PATTERNS = ((128, 1), (512, 4), (2048, 16))
WBLK = 128
POOL_WINDOWS = (2, 4, 8, 16)
N_POOL_GROUPS = len(POOL_WINDOWS)
POOL_GROUP_DIM = D_POOL // N_POOL_GROUPS
PEER_HEADS = 8
N_KEYS = 128
N_EXPERTS = N_KEYS * N_KEYS
PEER_TOPK = 16
PEER_QDIM = 256
PEER_HALF = PEER_QDIM // 2
TOKEN_CHUNK = 128
EPS = 1e-6
NEG = -1e30

kernel_name = "hymba_dilated_pool_peer_block"


def rmsnorm(x, g):
    xf = x.astype(jnp.float32)
    y = xf * lax.rsqrt(jnp.mean(xf * xf, axis=-1, keepdims=True) + EPS)
    return (y * g.astype(jnp.float32)).astype(x.dtype)


def dilated_branch(q, k, v, window, dilation):
    b, s, h, dh = q.shape
    n_steps = window // dilation
    L = s // dilation
    nb = -(-L // WBLK)
    Lp = nb * WBLK

    def to_sub(t):
        t = t.reshape(b, L, dilation, h, dh).transpose(0, 2, 3, 1, 4)
        t = jnp.pad(t, ((0, 0), (0, 0), (0, 0), (0, Lp - L), (0, 0)))
        return t.reshape(b, dilation, h, nb, WBLK, dh)

    def with_prev(t):
        prev = jnp.pad(t, ((0, 0), (0, 0), (0, 0), (1, 0), (0, 0), (0, 0)))[:, :, :, :nb]
        return jnp.concatenate([prev, t], axis=4)

    qb = to_sub(q)
    kx = with_prev(to_sub(k))
    vx = with_prev(to_sub(v))
    scores = jnp.einsum('brhnqd,brhnkd->brhnqk', qb, kx).astype(jnp.float32) * (dh ** -0.5)
    qi = jnp.arange(WBLK)[:, None]
    kj = jnp.arange(2 * WBLK)[None, :]
    dist = qi + WBLK - kj
    kpos = jnp.arange(nb)[:, None, None] * WBLK - WBLK + kj[None]
    mask = (dist >= 0)[None] & (dist <= n_steps)[None] & (kpos >= 0)
    scores = jnp.where(mask[None, None, None], scores, NEG)
    m = jnp.max(scores, axis=-1, keepdims=True)
    p = jnp.exp(scores - m)
    den = jnp.sum(p, axis=-1, keepdims=True)
    o = jnp.einsum('brhnqk,brhnkd->brhnqd', p, vx.astype(jnp.float32)) / den
    lse = (m + jnp.log(den))[..., 0]
    o = o.reshape(b, dilation, h, Lp, dh)[:, :, :, :L].transpose(0, 3, 1, 2, 4).reshape(b, s, h, dh)
    lse = lse.reshape(b, dilation, h, Lp)[..., :L].transpose(0, 3, 1, 2).reshape(b, s, h)
    return o, lse


def dilated_attention(q, k, v):
    outs, lses = [], []
    for window, dilation in DILATED_PATTERNS:
        o, lse = dilated_branch(q, k, v, window, dilation)
        outs.append(o)
        lses.append(lse)
    w = jax.nn.softmax(jnp.stack(lses, axis=0), axis=0)
    o = jnp.sum(w[..., None] * jnp.stack(outs, axis=0), axis=0)
    return o.astype(q.dtype)


def pool_mixer(z, w_pool, pool_scale):
    b, s, c = z.shape
    zg = z.astype(jnp.float32).reshape(b, s, N_POOL_GROUPS, POOL_GROUP_DIM)
    cs = jnp.cumsum(zg, axis=1)
    t = jnp.arange(1, s + 1, dtype=jnp.float32)
    outs = []
    for g, win in enumerate(POOL_WINDOWS):
        csg = cs[:, :, g]
        lag = jnp.pad(csg, ((0, 0), (win, 0), (0, 0)))[:, :s]
        mean = (csg - lag) / jnp.minimum(t, float(win))[None, :, None]
        outs.append(mean - zg[:, :, g])
    pooled = jnp.stack(outs, axis=2)
    mixed = jnp.einsum('bsgc,gcd->bsgd', pooled, w_pool.astype(jnp.float32)).reshape(b, s, c)
    return (mixed * pool_scale.astype(jnp.float32)).astype(z.dtype)


def peer(h, w_query, sub_keys, expert_u, expert_v):
    b, s, d = h.shape
    q = jnp.einsum('bsd,de->bse', h, w_query).reshape(b, s, PEER_HEADS, 2, PEER_HALF)
    sc = jnp.einsum('bshpc,hpkc->bshpk', q, sub_keys).astype(jnp.float32)
    top_s, top_i = lax.top_k(sc, PEER_TOPK)
    cand_s = top_s[..., 0, :, None] + top_s[..., 1, None, :]
    cand_i = top_i[..., 0, :, None] * N_KEYS + top_i[..., 1, None, :]
    kk = PEER_TOPK * PEER_TOPK
    best_s, best_pos = lax.top_k(cand_s.reshape(b, s, PEER_HEADS, kk), PEER_TOPK)
    expert_idx = jnp.take_along_axis(cand_i.reshape(b, s, PEER_HEADS, kk), best_pos, axis=-1)
    gates = jax.nn.softmax(best_s, axis=-1)
    n_chunks = (b * s) // TOKEN_CHUNK
    xc = h.reshape(n_chunks, TOKEN_CHUNK, d)
    ic = expert_idx.reshape(n_chunks, TOKEN_CHUNK, PEER_HEADS, PEER_TOPK)
    gc = gates.reshape(n_chunks, TOKEN_CHUNK, PEER_HEADS, PEER_TOPK)

    def chunk_fn(args):
        xt, it, gt = args
        u = expert_u[it]
        a = jnp.einsum('chkd,cd->chk', u, xt).astype(jnp.float32)
        act = jax.nn.gelu(a, approximate=False) * gt
        vsel = expert_v[it]
        return jnp.einsum('chk,chkd->cd', act, vsel.astype(jnp.float32))

    y = lax.map(chunk_fn, (xc, ic, gc))
    return y.reshape(b, s, d).astype(h.dtype)


def setup_inputs(seed: int = 0) -> dict:
    key = jax.random.key(seed)
    ks = jax.random.split(key, 13)
    f32 = jnp.float32
    x = jax.random.normal(ks[0], (BATCH, SEQ, D_MODEL), f32)
    norm_mix = 1.0 + 0.1 * jax.random.normal(ks[1], (DEPTH, D_MODEL), f32)
    w_in = jax.random.normal(ks[2], (DEPTH, D_MODEL, 3 * D_ATTN + D_POOL), f32) * D_MODEL ** -0.5
    w_pool = jax.random.normal(ks[3], (DEPTH, N_POOL_GROUPS, POOL_GROUP_DIM, POOL_GROUP_DIM), f32) * POOL_GROUP_DIM ** -0.5
    pool_scale = 1.0 + 0.1 * jax.random.normal(ks[4], (DEPTH, D_POOL), f32)
    w_out = jax.random.normal(ks[5], (DEPTH, D_MIX, D_MODEL), f32) * D_MIX ** -0.5
    norm_ffn = 1.0 + 0.1 * jax.random.normal(ks[6], (DEPTH, D_MODEL), f32)
    w_query = jax.random.normal(ks[7], (DEPTH, D_MODEL, PEER_HEADS * PEER_QDIM), f32) * D_MODEL ** -0.5
    sub_keys = jax.random.normal(ks[8], (DEPTH, PEER_HEADS, 2, N_KEYS, PEER_HALF), f32) * PEER_HALF ** -0.5
    expert_u = jax.random.normal(ks[9], (DEPTH, N_EXPERTS, D_MODEL), f32) * D_MODEL ** -0.5
    expert_v = jax.random.normal(ks[10], (DEPTH, N_EXPERTS, D_MODEL), f32) * PEER_TOPK ** -0.5
    norm_final = 1.0 + 0.1 * jax.random.normal(ks[11], (D_MODEL,), f32)
    return {"x": x, "norm_mix": norm_mix, "w_in": w_in, "w_pool": w_pool, "pool_scale": pool_scale,
            "w_out": w_out, "norm_ffn": norm_ffn, "w_query": w_query, "sub_keys": sub_keys,
            "expert_u": expert_u, "expert_v": expert_v, "norm_final": norm_final}


def reference(x, norm_mix, w_in, w_pool, pool_scale, w_out, norm_ffn, w_query, sub_keys,
              expert_u, expert_v, norm_final):
    b, s, _ = x.shape
    for layer in range(DEPTH):
        h = rmsnorm(x, norm_mix[layer])
        z = jnp.einsum('bsd,de->bse', h, w_in[layer])
        q = z[..., :D_ATTN].reshape(b, s, ATTN_HEADS, HEAD_DIM)
        k = z[..., D_ATTN:2 * D_ATTN].reshape(b, s, ATTN_HEADS, HEAD_DIM)
        v = z[..., 2 * D_ATTN:3 * D_ATTN].reshape(b, s, ATTN_HEADS, HEAD_DIM)
        zp = z[..., 3 * D_ATTN:]
        att = dilated_attention(q, k, v).reshape(b, s, D_ATTN)
        pooled = pool_mixer(zp, w_pool[layer], pool_scale[layer])
        mix = jnp.concatenate([att, pooled], axis=-1)
        x = x + jnp.einsum('bse,ed->bsd', mix, w_out[layer])
        hf = rmsnorm(x, norm_ffn[layer])
        x = x + peer(hf, w_query[layer], sub_keys[layer], expert_u[layer], expert_v[layer])
    return rmsnorm(x, norm_final)
```

```cpp
#include <hip/hip_runtime.h>
#include <cstdio>
#include <cstdint>
namespace pg8 {
#define PG8_LAS __attribute__((address_space(3)))
typedef unsigned short bf16_t;
typedef short bf16x8 __attribute__((ext_vector_type(8)));
typedef float f32x4 __attribute__((ext_vector_type(4)));
typedef unsigned u32x4 __attribute__((ext_vector_type(4)));
constexpr int BM = 256, BK = 64, HALF = 128, HTB = HALF * BK * 2  , STAGE_BYTES = 8 * HTB, NXCD = 8, WGM = 8;

__host__ __device__ __forceinline__ int lds_byte(int r, int c) { const int st = (r >> 4) * 2 + (c >> 5), rr = r & 15, cc = c & 31, ob = rr * 64 + cc * 2; return st * 1024 + (ob ^ (((ob >> 9) & 1) << 5)); }
__host__ __device__ __forceinline__ void stage_rc(int b, int& R, int& C) { const int st = b / 1024, sb = b % 1024, swz = sb ^ (((sb >> 9) & 1) << 5); R = (st >> 1) * 16 + swz / 64; C = (st & 1) * 32 + (swz % 64) / 2; }
__host__ __device__ __forceinline__ int perm32(int rho) { const int n = rho >> 4, i = rho & 15; return 8 * (i >> 2) + 4 * n + (i & 3); }

struct Unit { int pm, pn; };
struct Gemm { const bf16_t* A; const bf16_t* Bt; int M, N, K; };

struct StaticOrder {
    int nM, nN, nwg, G, c;
    __host__ __device__ void init(int M, int N, int G_, int c_) { nM = M / BM; nN = N / BM; nwg = nM * nN; G = G_; c = c_; }
    __host__ __device__ bool next(int i, Unit& u) const {
        const long L = (long)i * G + c; if (L >= nwg) return false;
        int wgid = (int)L; { const int q = nwg / NXCD, r = nwg % NXCD, xcd = wgid % NXCD, off = wgid / NXCD; wgid = (xcd < r ? xcd * (q + 1) : r * (q + 1) + (xcd - r) * q) + off; }
        const int nig = WGM * nN, gid = wgid / nig, fm = gid * WGM, gsz = (nM - fm) < WGM ? (nM - fm) : WGM;
        u.pm = fm + ((wgid % nig) % gsz); u.pn = (wgid % nig) / gsz; return true;
    }
    __device__ __forceinline__ void a_ready(const Unit&) const {}
    __device__ __forceinline__ void done(const Unit&) const {}
};

__device__ __forceinline__ unsigned cvt_pk_bf16(float lo, float hi) { unsigned r; asm volatile("v_cvt_pk_bf16_f32 %0, %1, %2" : "=v"(r) : "v"(lo), "v"(hi)); return r; }
struct EpiZ {
    static constexpr bool PERM = true, AFTER_DRAIN = false;
    bf16_t* O; int ldc; const float* rs; int qcols; float qscale;
    __device__ __forceinline__ void operator()(const f32x4 (&acc)[2][2][4][2], const Unit& u, int wr, int wc, int fr, int fq) const {
        const int row0 = u.pm * BM + wr * 64 + fr; const int colt = u.pn * BM;
        const float sc = (colt < qcols) ? qscale : 1.f;
        const int col0 = colt + wc * 32 + 8 * fq;
#pragma unroll
        for (int ai = 0; ai < 2; ++ai)
#pragma unroll
            for (int m = 0; m < 4; ++m) { const int row = row0 + ai * HALF + m * 16; const float s = rs[row] * sc; bf16_t* rowp = O + (size_t)row * ldc + col0;
#pragma unroll
                for (int bj = 0; bj < 2; ++bj) { const f32x4 v0 = acc[ai][bj][m][0] * s, v1 = acc[ai][bj][m][1] * s;
                    u32x4 w; w.x = cvt_pk_bf16(v0[0], v0[1]); w.y = cvt_pk_bf16(v0[2], v0[3]); w.z = cvt_pk_bf16(v1[0], v1[1]); w.w = cvt_pk_bf16(v1[2], v1[3]);
                    *(u32x4*)(rowp + bj * HALF) = w; } }
    }
};
struct EpiRes {
    static constexpr bool PERM = true, AFTER_DRAIN = false;
    const float* X; float* X1; bf16_t* X1b; float* SS; int ldc;
    __device__ __forceinline__ void operator()(const f32x4 (&acc)[2][2][4][2], const Unit& u, int wr, int wc, int fr, int fq) const {
        const int row0 = u.pm * BM + wr * 64 + fr; const int col0 = u.pn * BM + wc * 32 + 8 * fq;
#pragma unroll
        for (int ai = 0; ai < 2; ++ai)
#pragma unroll
            for (int m = 0; m < 4; ++m) { const int row = row0 + ai * HALF + m * 16; const size_t off = (size_t)row * ldc + col0; float ss = 0.f;
#pragma unroll
                for (int bj = 0; bj < 2; ++bj) {
                    const f32x4 x0 = *(const f32x4*)(X + off + bj * HALF), x1 = *(const f32x4*)(X + off + bj * HALF + 4);
                    const f32x4 v0 = acc[ai][bj][m][0] + x0, v1 = acc[ai][bj][m][1] + x1;
                    *(f32x4*)(X1 + off + bj * HALF) = v0; *(f32x4*)(X1 + off + bj * HALF + 4) = v1;
                    ss += (v0[0] * v0[0] + v0[1] * v0[1]) + (v0[2] * v0[2] + v0[3] * v0[3]) + (v1[0] * v1[0] + v1[1] * v1[1]) + (v1[2] * v1[2] + v1[3] * v1[3]);
                    u32x4 w; w.x = cvt_pk_bf16(v0[0], v0[1]); w.y = cvt_pk_bf16(v0[2], v0[3]); w.z = cvt_pk_bf16(v1[0], v1[1]); w.w = cvt_pk_bf16(v1[2], v1[3]);
                    *(u32x4*)(X1b + off + bj * HALF) = w; }
                ss += __shfl_xor(ss, 16); ss += __shfl_xor(ss, 32);
                if (fq == 0) SS[(size_t)row * 16 + u.pn * 4 + wc] = ss;
                if (m & 1) asm volatile("" ::: "memory"); }
    }
};
struct EpiF32 {
    static constexpr bool PERM = true, AFTER_DRAIN = false;
    float* O; int ldc;
    __device__ __forceinline__ void operator()(const f32x4 (&acc)[2][2][4][2], const Unit& u, int wr, int wc, int fr, int fq) const {
        const int row0 = u.pm * BM + wr * 64 + fr; const int col0 = u.pn * BM + wc * 32 + 8 * fq;
#pragma unroll
        for (int ai = 0; ai < 2; ++ai)
#pragma unroll
            for (int m = 0; m < 4; ++m) { float* rowp = O + (size_t)(row0 + ai * HALF + m * 16) * ldc + col0;
#pragma unroll
                for (int bj = 0; bj < 2; ++bj) { *(f32x4*)(rowp + bj * HALF) = acc[ai][bj][m][0]; *(f32x4*)(rowp + bj * HALF + 4) = acc[ai][bj][m][1]; } }
    }
};

template <class Epi, class Sched, bool ALIGN_EPI = false, bool SP2 = false>
__device__ __forceinline__ void gemm_phase(PG8_LAS unsigned char* lds, const Gemm g, const Sched& S, const Epi& E) {
    const int tid = threadIdx.x, wid = __builtin_amdgcn_readfirstlane(tid >> 6), lane = tid & 63, wr = wid >> 2, wc = wid & 3, fr = lane & 15, fq = lane >> 4;
    const int K = g.K, nt = K / BK;
    unsigned voffA[2], voffB[2];
#pragma unroll
    for (int i = 0; i < 2; ++i) { int R, C; stage_rc(tid * 16 + i * 8192, R, C); const int Rb = Epi::PERM ? ((R & ~31) + perm32(R & 31)) : R;
        voffA[i] = (unsigned)(R * K + C) * 2u; voffB[i] = (unsigned)(Rb * K + C) * 2u; }
    const size_t kstep = (size_t)(BK * 2);
    const size_t hstep = (size_t)HALF * K * 2;
    const size_t tstep = 2 * hstep;
    const unsigned ldsw = (unsigned)wid * 1024u;
    const int aoff = lds_byte(wr * 64 + fr, fq * 8), boff = lds_byte(wc * 32 + fr, fq * 8);
#define PG8_SA(b, h) (((b) * 2 + (h)) * HTB)
#define PG8_SB(b, h) ((4 + (b) * 2 + (h)) * HTB)
#define PG8_STAGE(bufoff, gbase, voff) do { _Pragma("unroll") for (int _i = 0; _i < 2; ++_i) \
        __builtin_amdgcn_global_load_lds((const unsigned*)((const char*)(gbase) + (voff)[_i]), (PG8_LAS unsigned*)(lds + (bufoff) + ldsw + _i * 8192), 16, 0, 0); } while (0)
#define PG8_LDA(dst, b, h) do { _Pragma("unroll") for (int m = 0; m < 4; ++m) _Pragma("unroll") for (int k = 0; k < 2; ++k) dst[m][k] = *(const PG8_LAS bf16x8*)(lds + PG8_SA(b, h) + aoff + m * 2048 + k * 1024); } while (0)
#define PG8_LDB(dst, b, h) do { _Pragma("unroll") for (int n = 0; n < 2; ++n) _Pragma("unroll") for (int k = 0; k < 2; ++k) dst[n][k] = *(const PG8_LAS bf16x8*)(lds + PG8_SB(b, h) + boff + n * 2048 + k * 1024); } while (0)
#define PG8_MMA(ai, bj, At, Bt) do { __builtin_amdgcn_s_setprio(1); _Pragma("unroll") for (int m = 0; m < 4; ++m) _Pragma("unroll") for (int n = 0; n < 2; ++n) _Pragma("unroll") for (int k = 0; k < 2; ++k) \
        acc[ai][bj][m][n] = __builtin_amdgcn_mfma_f32_16x16x32_bf16(Bt[n][k], At[m][k], acc[ai][bj][m][n], 0, 0, 0); __builtin_amdgcn_s_setprio(0); } while (0)
#define PG8_WAIT_V(n) asm volatile("s_waitcnt vmcnt(" #n ")" ::: "memory")
#define PG8_WAIT_L(n) asm volatile("s_waitcnt lgkmcnt(" #n ")" ::: "memory")
#define PG8_BAR __builtin_amdgcn_s_barrier()
#define PG8_SCHED __builtin_amdgcn_sched_barrier(0)
    Unit cur, nxt; int ui = 0;
    if (!S.next(0, cur)) return;
    f32x4 acc[2][2][4][2];
#pragma unroll
    for (int a = 0; a < 2; ++a)
#pragma unroll
        for (int b = 0; b < 2; ++b)
#pragma unroll
            for (int m = 0; m < 4; ++m)
#pragma unroll
                for (int n = 0; n < 2; ++n) acc[a][b][m][n] = (f32x4){0.f, 0.f, 0.f, 0.f};
    bf16x8 At[4][2], B0[2][2], B1[2][2];
    const char* cA = (const char*)g.A + (size_t)cur.pm * tstep; const char* cB = (const char*)g.Bt + (size_t)cur.pn * tstep;
    S.a_ready(cur);
    if constexpr (SP2) {
        PG8_STAGE(PG8_SB(0, 0), cB, voffB); PG8_STAGE(PG8_SB(0, 1), cB + hstep, voffB); PG8_STAGE(PG8_SA(0, 0), cA, voffA); PG8_STAGE(PG8_SA(0, 1), cA + hstep, voffA);
        if (wr == 1) PG8_BAR;
        PG8_WAIT_V(2); PG8_BAR;
        PG8_STAGE(PG8_SB(1, 0), cB + kstep, voffB); PG8_STAGE(PG8_SA(1, 0), cA + kstep, voffA); PG8_STAGE(PG8_SB(1, 1), cB + hstep + kstep, voffB);
        PG8_WAIT_V(6); PG8_BAR;
    } else {
        PG8_STAGE(PG8_SB(0, 0), cB, voffB); PG8_STAGE(PG8_SA(0, 0), cA, voffA); PG8_STAGE(PG8_SB(0, 1), cB + hstep, voffB); PG8_STAGE(PG8_SA(0, 1), cA + hstep, voffA);
        if (wr == 1) PG8_BAR;
        PG8_WAIT_V(4); PG8_BAR;
        PG8_STAGE(PG8_SB(1, 0), cB + kstep, voffB); PG8_STAGE(PG8_SA(1, 0), cA + kstep, voffA); PG8_STAGE(PG8_SB(1, 1), cB + hstep + kstep, voffB);
        PG8_WAIT_V(6); PG8_BAR;
    }
    for (;;) {
        const bool has_next = S.next(ui + 1, nxt);
        const char* nA = has_next ? (const char*)g.A + (size_t)nxt.pm * tstep : cA; const char* nB = has_next ? (const char*)g.Bt + (size_t)nxt.pn * tstep : cB;
        for (int t = 0; t < nt; t += 2) {
            const bool last = (t == nt - 2);
            const char* a1 = cA + (size_t)(t + 1) * kstep;
            const char* a2 = last ? nA : cA + (size_t)(t + 2) * kstep; const char* b2 = last ? nB : cB + (size_t)(t + 2) * kstep;
            const char* a3 = a2 + kstep; const char* b3 = b2 + kstep;
            if (last && has_next) S.a_ready(nxt);
            if constexpr (SP2) {
            PG8_LDB(B0, 0, 0); PG8_LDB(B1, 0, 1); PG8_SCHED; PG8_LDA(At, 0, 0); PG8_STAGE(PG8_SA(1, 1), a1 + hstep, voffA);
            PG8_WAIT_V(8); PG8_WAIT_L(0); PG8_BAR; PG8_MMA(0, 0, At, B0); PG8_MMA(0, 1, At, B1); PG8_BAR; PG8_SCHED;
            PG8_LDA(At, 0, 1); PG8_STAGE(PG8_SB(0, 0), b2, voffB); PG8_STAGE(PG8_SB(0, 1), b2 + hstep, voffB); PG8_STAGE(PG8_SA(0, 0), a2, voffA);
            PG8_WAIT_V(8); PG8_WAIT_L(0); PG8_BAR; PG8_MMA(1, 0, At, B0); PG8_MMA(1, 1, At, B1); PG8_BAR; PG8_SCHED;
            PG8_LDB(B0, 1, 0); PG8_LDB(B1, 1, 1); PG8_SCHED; PG8_LDA(At, 1, 0); PG8_STAGE(PG8_SA(0, 1), a2 + hstep, voffA);
            PG8_WAIT_V(8); PG8_WAIT_L(0); PG8_BAR; PG8_MMA(0, 0, At, B0); PG8_MMA(0, 1, At, B1); PG8_BAR; PG8_SCHED;
            PG8_LDA(At, 1, 1); PG8_STAGE(PG8_SB(1, 0), b3, voffB); PG8_STAGE(PG8_SB(1, 1), b3 + hstep, voffB); PG8_STAGE(PG8_SA(1, 0), a3, voffA);
            PG8_WAIT_V(8); PG8_WAIT_L(0); PG8_BAR; PG8_MMA(1, 0, At, B0); PG8_MMA(1, 1, At, B1); PG8_BAR; PG8_SCHED;
            } else {
            PG8_LDB(B0, 0, 0); PG8_SCHED; PG8_LDA(At, 0, 0); PG8_STAGE(PG8_SA(1, 1), a1 + hstep, voffA);
            PG8_WAIT_L(8); PG8_BAR; PG8_WAIT_L(0); PG8_MMA(0, 0, At, B0); PG8_BAR; PG8_SCHED;
            PG8_LDB(B1, 0, 1); PG8_STAGE(PG8_SB(0, 0), b2, voffB);
            PG8_BAR; PG8_WAIT_L(0); PG8_MMA(0, 1, At, B1); PG8_BAR;
            PG8_LDA(At, 0, 1); PG8_STAGE(PG8_SA(0, 0), a2, voffA);
            PG8_BAR; PG8_WAIT_L(0); PG8_MMA(1, 0, At, B0); PG8_BAR; PG8_SCHED;
            PG8_STAGE(PG8_SB(0, 1), b2 + hstep, voffB);
            PG8_WAIT_V(6); PG8_BAR; PG8_MMA(1, 1, At, B1); PG8_BAR;
            PG8_LDB(B0, 1, 0); PG8_SCHED; PG8_LDA(At, 1, 0); PG8_STAGE(PG8_SA(0, 1), a2 + hstep, voffA);
            PG8_WAIT_L(8); PG8_BAR; PG8_WAIT_L(0); PG8_MMA(0, 0, At, B0); PG8_BAR; PG8_SCHED;
            PG8_LDB(B1, 1, 1); PG8_STAGE(PG8_SB(1, 0), b3, voffB);
            PG8_BAR; PG8_WAIT_L(0); PG8_MMA(0, 1, At, B1); PG8_BAR;
            PG8_LDA(At, 1, 1); PG8_STAGE(PG8_SA(1, 0), a3, voffA);
            PG8_BAR; PG8_WAIT_L(0); PG8_MMA(1, 0, At, B0); PG8_BAR; PG8_SCHED;
            PG8_STAGE(PG8_SB(1, 1), b3 + hstep, voffB);
            PG8_WAIT_V(6); PG8_BAR; PG8_MMA(1, 1, At, B1); PG8_BAR;
            }
        }
        if constexpr (ALIGN_EPI) { if (wr == 0) PG8_BAR; }
        if constexpr (!Epi::AFTER_DRAIN) { E(acc, cur, wr, wc, fr, fq); S.done(cur); }
        if (!has_next) break;
#pragma unroll
        for (int a = 0; a < 2; ++a)
#pragma unroll
            for (int b = 0; b < 2; ++b)
#pragma unroll
                for (int m = 0; m < 4; ++m)
#pragma unroll
                    for (int n = 0; n < 2; ++n) acc[a][b][m][n] = (f32x4){0.f, 0.f, 0.f, 0.f};
        cur = nxt; cA = nA; cB = nB; ++ui;
        if constexpr (ALIGN_EPI) { if (wr == 1) PG8_BAR; }
    }
    PG8_WAIT_V(0);
    if constexpr (!ALIGN_EPI) { if (wr == 0) PG8_BAR; }
    PG8_BAR;
    if constexpr (Epi::AFTER_DRAIN) { E.fused(acc, cur, wr, wc, fr, fq, lds, wid, lane); S.done(cur); }
#undef PG8_SA
#undef PG8_SB
#undef PG8_STAGE
#undef PG8_LDA
#undef PG8_LDB
#undef PG8_MMA
#undef PG8_WAIT_V
#undef PG8_WAIT_L
#undef PG8_BAR
#undef PG8_SCHED
}
}
#define PG8_SP2 true
#define PG8_ALIGN true

constexpr int NWAVES = 8;
constexpr int BATCH = 4, SEQ = 8192, D = 1024, M = BATCH * SEQ;
constexpr int NH = 8, HD = 64, DATT = 512, DPOOL = 512, NZ = 3 * DATT + DPOOL;
constexpr int PEER_H = 8, NKEYS = 128, NEXP = NKEYS * NKEYS, TOPK = 16, NSC = PEER_H * 2 * NKEYS;
constexpr float EPS = 1e-6f;
constexpr float QSCALE = 0.125f * 1.4426950408889634f;

constexpr size_t MiB = 1u << 20;
constexpr size_t WS_CTL = 0, CTL_ZERO_BYTES = 64 * 1024;
constexpr size_t WS_R1 = 1 * MiB;
constexpr size_t WS_SS = 2 * MiB;
constexpr size_t WS_LSE = 4 * MiB;
constexpr size_t WS_WIN = 8 * MiB;
constexpr size_t WS_WOUT = 12 * MiB;
constexpr size_t WS_WSC = 14 * MiB;
constexpr size_t WS_EU = 32 * MiB, WS_EV = 64 * MiB;
constexpr size_t WS_XB = 96 * MiB;
constexpr size_t WS_Z = 160 * MiB;
constexpr size_t WS_OB = 288 * MiB;
constexpr size_t WS_MIX = 384 * MiB;
constexpr size_t WS_SC = 160 * MiB;
constexpr size_t WS_IDX = 448 * MiB, WS_GATE = 464 * MiB;
constexpr size_t WS_END = 480 * MiB;
static_assert(WS_SC + (size_t)M * NSC * 4 <= WS_IDX, "ws map");

constexpr int LDS_BYTES = 147456;
constexpr int LDSCTL_OFF = 146432, MISC_OFF = LDSCTL_OFF + 320;
constexpr int RING_OFF = 0;

#define GAS __attribute__((address_space(1)))
#define LAS __attribute__((address_space(3)))
typedef unsigned short bf16;
typedef unsigned v4u __attribute__((ext_vector_type(4)));
typedef unsigned v2u __attribute__((ext_vector_type(2)));
typedef float f32x4 __attribute__((ext_vector_type(4)));
typedef float f32x16 __attribute__((ext_vector_type(16)));
typedef short bf16x8 __attribute__((ext_vector_type(8)));
typedef short s16x4 __attribute__((ext_vector_type(4)));
typedef GAS unsigned gu32;
#define RLX_AGENT __ATOMIC_RELAXED, __HIP_MEMORY_SCOPE_AGENT
#define LDS_WAIT() asm volatile("s_waitcnt lgkmcnt(0)" ::: "memory")
#define VM_WAIT() asm volatile("s_waitcnt vmcnt(0)" ::: "memory")
__device__ __forceinline__ unsigned f2bf(float f) { unsigned u = __builtin_bit_cast(unsigned, f); return (u + 0x7fffu + ((u >> 16) & 1u)) >> 16; }
__device__ __forceinline__ unsigned pk2(float lo, float hi) { return f2bf(lo) | (f2bf(hi) << 16); }
__device__ __forceinline__ float bflo(unsigned w) { return __builtin_bit_cast(float, w << 16); }
__device__ __forceinline__ float bfhi(unsigned w) { return __builtin_bit_cast(float, w & 0xffff0000u); }
#define XB_TMO      128
#define XB_XCNT(j)  (256  + 64 * (j))
#define XB_XSUB(j)  (1280 + 64 * (j))
#define XB_XGEN(j)  (2304 + 64 * (j))
#define XB_TOP      3328
#define XB_TOPGEN   3392
#define XCD_BAR_WORDS 3456
#define XB_SPIN_CAP (1u << 18)

__device__ __forceinline__ unsigned xb_ld(unsigned* p)              { return __hip_atomic_load(p, __ATOMIC_RELAXED, __HIP_MEMORY_SCOPE_AGENT); }
__device__ __forceinline__ unsigned xb_add(unsigned* p, unsigned v) { return __hip_atomic_fetch_add(p, v, __ATOMIC_RELAXED, __HIP_MEMORY_SCOPE_AGENT); }
__device__ __forceinline__ unsigned xb_xcc_id() { return (unsigned)__builtin_amdgcn_s_getreg((3 << 11) | 20) & 0xFu; }
#define XB_SPIN(cond, bar) do { unsigned _sp = 0; while (cond) { __builtin_amdgcn_s_sleep(1); \
    if ((++_sp & 255u) == 0u) { if (xb_ld(&(bar)[XB_TMO])) break; if (_sp > XB_SPIN_CAP) { atomicAdd(&(bar)[XB_TMO], 1u); break; } } } } while (0)

struct XcdBarrier {
    unsigned* bar; unsigned x;
    volatile LAS unsigned* st;
};

__device__ __forceinline__ XcdBarrier xcd_barrier_post(unsigned* bar, volatile LAS unsigned* st) {
    XcdBarrier b; b.bar = bar; b.x = xb_xcc_id(); b.st = st;
    if (threadIdx.x == 0) (void)xb_add(&bar[XB_XCNT(b.x)], 1u);
    return b;
}
__device__ __forceinline__ void xcd_barrier_complete(unsigned* bar, unsigned x, unsigned& nloc, unsigned& nx) {
    const unsigned G = gridDim.x * gridDim.y * gridDim.z;
    unsigned sum, cnt, mine, sp = 0u;
    for (;;) {
        sum = 0u; cnt = 0u; mine = 0u;
#pragma unroll
        for (unsigned j = 0; j < 16; ++j) { const unsigned c = xb_ld(&bar[XB_XCNT(j)]); sum += c; cnt += (c > 0u) ? 1u : 0u; mine = (j == x) ? c : mine; }
        if (sum == G) break;
        __builtin_amdgcn_s_sleep(1);
        if ((++sp & 255u) == 0u) { if (xb_ld(&bar[XB_TMO])) break; if (sp > XB_SPIN_CAP) { atomicAdd(&bar[XB_TMO], 1u); break; } }
    }
    nloc = mine > 0u ? mine : 1u; nx = cnt > 0u ? cnt : 1u;
}

__device__ __forceinline__ void xcd_barrier(const XcdBarrier& b) {
    asm volatile("s_waitcnt vmcnt(0)" ::: "memory");
    __syncthreads();
    if (threadIdx.x == 0) {
        unsigned* bar = b.bar;
        __builtin_amdgcn_s_waitcnt(0);
        unsigned nloc = b.st[0], nx = b.st[1];
        if (nloc == 0u) { xcd_barrier_complete(bar, b.x, nloc, nx); b.st[0] = nloc; b.st[1] = nx; }
        const unsigned old = xb_add(&bar[XB_XSUB(b.x)], 1u);
        const unsigned gen = old / nloc;
        if (old + 1u == (gen + 1u) * nloc) {
            __builtin_amdgcn_fence(__ATOMIC_RELEASE, "agent");
            asm volatile("s_waitcnt vmcnt(0)" ::: "memory");
            const unsigned og = xb_add(&bar[XB_TOP], 1u);
            const unsigned tg = og / nx;
            if (og + 1u == (tg + 1u) * nx) xb_add(&bar[XB_TOPGEN], 1u);
            else XB_SPIN(xb_ld(&bar[XB_TOPGEN]) == tg, bar);
            __builtin_amdgcn_fence(__ATOMIC_ACQUIRE, "agent");
            xb_add(&bar[XB_XGEN(b.x)], 1u);
            asm volatile("s_waitcnt vmcnt(0)" ::: "memory");
        } else {
            XB_SPIN(xb_ld(&bar[XB_XGEN(b.x)]) == gen, bar);
            __builtin_amdgcn_fence(__ATOMIC_ACQUIRE, "agent");
            asm volatile("s_waitcnt vmcnt(0)" ::: "memory");
        }
    }
    __syncthreads();
}

struct Frame {
    LAS unsigned char* lds;
    volatile LAS unsigned* MISC;
    int tid, lane, wave;
    int vcu, G;
    const float *x, *norm_mix, *w_in, *w_pool, *pool_scale, *w_out, *norm_ffn, *w_query, *sub_keys, *expert_u, *expert_v, *norm_final;
    float* out;
    unsigned char* ws;
};

__device__ __forceinline__ float wave_sum(float v) {
#pragma unroll
    for (int o = 1; o < 64; o <<= 1) v += __shfl_xor(v, o);
    return v;
}

__device__ __forceinline__ void p0_transpose_item(const float* W, int N, const float* ks, bf16* WT, int ldo, int col_off, LAS float* scr, int item, int lane) {
    const int nblk = N / 32, kb = item / nblk, nb = item % nblk, k0 = 64 * kb, n0 = 32 * nb;
#pragma unroll 8
    for (int i = 0; i < 32; ++i) { const int kk = 2 * i + (lane >> 5); const float s = ks ? ks[k0 + kk] : 1.f; scr[kk * 33 + (lane & 31)] = W[(size_t)(k0 + kk) * N + n0 + (lane & 31)] * s; }
    LDS_WAIT(); asm volatile("" ::: "memory");
    const int c = lane & 7;
#pragma unroll
    for (int j = 0; j < 4; ++j) { const int n = (lane >> 3) + 8 * j; const LAS float* s = scr + (8 * c) * 33 + n;
        v4u o; o.x = pk2(s[0 * 33], s[1 * 33]); o.y = pk2(s[2 * 33], s[3 * 33]); o.z = pk2(s[4 * 33], s[5 * 33]); o.w = pk2(s[6 * 33], s[7 * 33]);
        *(GAS v4u*)(WT + (size_t)(n0 + n) * ldo + col_off + k0 + 8 * c) = o; }
    LDS_WAIT(); asm volatile("" ::: "memory");
}

__device__ __forceinline__ void p0_prologue(Frame& F) {
    LAS float* scr = (LAS float*)(F.lds + RING_OFF + F.wave * 16384);
    const int gw = F.vcu * NWAVES + F.wave, NGW = F.G * NWAVES;
    bf16* WIN = (bf16*)(F.ws + WS_WIN); bf16* WOUT = (bf16*)(F.ws + WS_WOUT); bf16* WSC = (bf16*)(F.ws + WS_WSC);
    constexpr int I_IN = (D / 64) * (NZ / 32), I_OUT = (DATT / 64) * (D / 32);
    for (int it = gw; it < I_IN + I_OUT; it += NGW) {
        if (it < I_IN) p0_transpose_item(F.w_in, NZ, F.norm_mix, WIN, D, 0, scr, it, F.lane);
        else p0_transpose_item(F.w_out, D, nullptr, WOUT, D, 0, scr, it - I_IN, F.lane);
    }
    const int gt = (F.vcu * NWAVES + F.wave) * 64 + F.lane, NGT = F.G * NWAVES * 64;
    for (int it = gt; it < DPOOL * (D / 4); it += NGT) {
        const int cin = it / (D / 4), n4 = (it % (D / 4)) * 4, g = cin >> 7;
        const float* wp = F.w_pool + (size_t)cin * 128;
        const float* ps = F.pool_scale + g * 128;
        const float* wo = F.w_out + (size_t)(DATT + g * 128) * D + n4;
        f32x4 acc = {0.f, 0.f, 0.f, 0.f};
#pragma unroll 4
        for (int d = 0; d < 128; ++d) { const float a = wp[d] * ps[d]; const f32x4 b = *(const f32x4*)(wo + (size_t)d * D); acc += a * b; }
#pragma unroll
        for (int j = 0; j < 4; ++j) WOUT[(size_t)(n4 + j) * D + DATT + cin] = (bf16)f2bf(acc[j]);
    }
    for (int it = gt; it < 16 * 32 * 256; it += NGT) {
        const int d4 = (it & 255) * 4, k4 = ((it >> 8) & 31) * 4, blk = it >> 13;
        const float* wq = F.w_query + (size_t)d4 * NSC + blk * 128;
        const float* sk = F.sub_keys + (size_t)(blk * 128 + k4) * 128;
        float acc[4][4];
#pragma unroll
        for (int i = 0; i < 4; ++i)
#pragma unroll
            for (int j = 0; j < 4; ++j) acc[i][j] = 0.f;
        for (int c = 0; c < 128; c += 4) {
            f32x4 a[4], b[4];
#pragma unroll
            for (int i = 0; i < 4; ++i) { a[i] = *(const f32x4*)(sk + i * 128 + c); b[i] = *(const f32x4*)(wq + (size_t)i * NSC + c); }
#pragma unroll
            for (int i = 0; i < 4; ++i)
#pragma unroll
                for (int j = 0; j < 4; ++j) acc[i][j] += a[i][0] * b[j][0] + a[i][1] * b[j][1] + a[i][2] * b[j][2] + a[i][3] * b[j][3];
        }
        const f32x4 gf = *(const f32x4*)(F.norm_ffn + d4);
#pragma unroll
        for (int i = 0; i < 4; ++i) { v2u o; o.x = pk2(acc[i][0] * gf[0], acc[i][1] * gf[1]); o.y = pk2(acc[i][2] * gf[2], acc[i][3] * gf[3]);
            *(GAS v2u*)(WSC + (size_t)(blk * 128 + k4 + i) * D + d4) = o; }
    }
    {
        bf16* EU = (bf16*)(F.ws + WS_EU); bf16* EV = (bf16*)(F.ws + WS_EV);
        const size_t n8 = (size_t)NEXP * D / 8;
        for (size_t i = gt; i < 2 * n8; i += NGT) {
            const bool second = i >= n8; const size_t j = second ? i - n8 : i;
            const float* src = (second ? F.expert_v : F.expert_u) + j * 8;
            const f32x4 a = *(const f32x4*)src, b = *(const f32x4*)(src + 4);
            v4u o; o.x = pk2(a[0], a[1]); o.y = pk2(a[2], a[3]); o.z = pk2(b[0], b[1]); o.w = pk2(b[2], b[3]);
            *(GAS v4u*)((second ? EV : EU) + j * 8) = o;
        }
    }
    {
        bf16* XB = (bf16*)(F.ws + WS_XB); float* R1 = (float*)(F.ws + WS_R1);
        for (int m = gw; m < M; m += NGW) {
            const float* xr = F.x + (size_t)m * D + 8 * F.lane; float s = 0.f;
#pragma unroll
            for (int j = 0; j < 2; ++j) { const f32x4 a = *(const f32x4*)(xr + 512 * j), b = *(const f32x4*)(xr + 512 * j + 4);
                s += (a[0] * a[0] + a[1] * a[1]) + (a[2] * a[2] + a[3] * a[3]) + (b[0] * b[0] + b[1] * b[1]) + (b[2] * b[2] + b[3] * b[3]);
                v4u o; o.x = pk2(a[0], a[1]); o.y = pk2(a[2], a[3]); o.z = pk2(b[0], b[1]); o.w = pk2(b[2], b[3]);
                *(GAS v4u*)(XB + (size_t)m * D + 8 * F.lane + 512 * j) = o; }
            s = wave_sum(s);
            if (F.lane == 0) R1[m] = 1.0f / sqrtf(s * (1.0f / D) + EPS);
        }
    }
}

constexpr int ATT_KEYS = 384, ATT_KCH = ATT_KEYS * 16 + 16;
constexpr int ATT_K_OFF = 0, ATT_V_OFF = 8 * ATT_KCH;
constexpr int ATT_VDH = 24 * 1024 + 64;
constexpr int ATT_OST_OFF = ATT_V_OFF + 2 * ATT_VDH;
constexpr int ATT_LDS_END = ATT_OST_OFF + NWAVES * 4096;
static_assert(ATT_V_OFF % 16 == 0 && ATT_OST_OFF % 16 == 0 && ATT_LDS_END <= LDSCTL_OFF, "attention LDS map");
constexpr int ATT_UNITS = BATCH * NH * 96;

__device__ __forceinline__ int crow(int r, int hi) { return (r & 3) + 8 * (r >> 2) + 4 * hi; }
__device__ __forceinline__ s16x4 vtr(const LAS unsigned char* p) { return __builtin_bit_cast(s16x4, __builtin_amdgcn_ds_read_tr16_b64_v4i16((LAS s16x4*)p)); }

__device__ __forceinline__ void attn_unit(Frame& F, int unit) {
    const int tid = F.tid, lane = F.lane, w = F.wave, r32 = lane & 31, hi = lane >> 5;
    const int bh = unit / 96, rem = unit % 96, br = rem >> 5, idx = rem & 31;
    const int b = bh >> 3, h = bh & 7;
    const int dsh = 2 * br, dil = 1 << dsh;
    const int ppr = 32 >> dsh;
    const int res = idx / ppr, pair = idx % ppr;
    const int s0 = pair * 256 - 128;
    const bf16* Z = (const bf16*)(F.ws + WS_Z);
    const size_t tokbase = (size_t)b * SEQ + res;
    {
        v4u kv[6], vv[6];
#pragma unroll
        for (int it = 0; it < 6; ++it) { const int p = tid + 512 * it, key = p >> 3, c = p & 7; int s = s0 + key; s = s < 0 ? 0 : s;
            const bf16* row = Z + (tokbase + ((size_t)s << dsh)) * NZ + h * HD + c * 8;
            kv[it] = *(const GAS v4u*)(row + DATT); vv[it] = *(const GAS v4u*)(row + 2 * DATT); }
#pragma unroll
        for (int it = 0; it < 6; ++it) { const int p = tid + 512 * it, key = p >> 3, c = p & 7;
            *(LAS v4u*)(F.lds + ATT_K_OFF + c * ATT_KCH + key * 16) = kv[it];
            *(LAS v4u*)(F.lds + ATT_V_OFF + (c >> 2) * ATT_VDH + (key >> 4) * 1024 + (key & 15) * 64 + (c & 3) * 16) = vv[it]; }
    }
    const int sq0 = pair * 256 + 32 * w;
    bf16x8 qr[4];
    {
        const bf16* qrow = Z + (tokbase + ((size_t)(sq0 + r32) << dsh)) * NZ + h * HD + hi * 8;
#pragma unroll
        for (int d0 = 0; d0 < 4; ++d0) qr[d0] = *(const GAS bf16x8*)(qrow + d0 * 16);
    }
    __syncthreads();
    f32x16 p[5];
#pragma unroll
    for (int j = 0; j < 5; ++j) {
        p[j] = f32x16{};
        const LAS unsigned char* kb = F.lds + ATT_K_OFF + hi * ATT_KCH + (32 * (w + j) + r32) * 16;
#pragma unroll
        for (int d0 = 0; d0 < 4; ++d0) { const bf16x8 kf = *(const LAS bf16x8*)(kb + 2 * d0 * ATT_KCH); p[j] = __builtin_amdgcn_mfma_f32_32x32x16_bf16(kf, qr[d0], p[j], 0, 0, 0); }
    }
    const float NEGB = -1e30f;
#pragma unroll
    for (int r = 0; r < 16; ++r) { const int kj = crow(r, hi); if (kj < r32) p[0][r] = NEGB; if (kj > r32) p[4][r] = NEGB; }
    if (pair == 0) {
#pragma unroll
        for (int j = 0; j < 4; ++j) if (w + j < 4) {
#pragma unroll
            for (int r = 0; r < 16; ++r) p[j][r] = NEGB; }
    }
    float mx = NEGB;
#pragma unroll
    for (int j = 0; j < 5; ++j)
#pragma unroll
        for (int r = 0; r < 16; ++r) mx = fmaxf(mx, p[j][r]);
    mx = fmaxf(mx, __shfl_xor(mx, 32));
    float l = 0.f;
#pragma unroll
    for (int j = 0; j < 5; ++j)
#pragma unroll
        for (int r = 0; r < 16; ++r) { const float e = __builtin_amdgcn_exp2f(p[j][r] - mx); p[j][r] = e; l += e; }
    l += __shfl_xor(l, 32);
    f32x16 o[2]; o[0] = f32x16{}; o[1] = f32x16{};
    const LAS unsigned char* vb = F.lds + ATT_V_OFF + (4 * hi + ((lane & 15) >> 2)) * 64 + ((lane >> 4) & 1) * 32 + (lane & 3) * 8;
#pragma unroll
    for (int j = 0; j < 5; ++j)
#pragma unroll
        for (int s = 0; s < 2; ++s) {
            v4u pw; pw.x = pk2(p[j][8 * s + 0], p[j][8 * s + 1]); pw.y = pk2(p[j][8 * s + 2], p[j][8 * s + 3]); pw.z = pk2(p[j][8 * s + 4], p[j][8 * s + 5]); pw.w = pk2(p[j][8 * s + 6], p[j][8 * s + 7]);
            const bf16x8 pa = __builtin_bit_cast(bf16x8, pw);
#pragma unroll
            for (int dh = 0; dh < 2; ++dh) {
                const LAS unsigned char* vp = vb + dh * ATT_VDH + (2 * (w + j) + s) * 1024;
                const s16x4 lo = vtr(vp), hh = vtr(vp + 512);
                const bf16x8 vf = (bf16x8){lo[0], lo[1], lo[2], lo[3], hh[0], hh[1], hh[2], hh[3]};
                o[dh] = __builtin_amdgcn_mfma_f32_32x32x16_bf16(pa, vf, o[dh], 0, 0, 0);
            }
        }
    const float rl = 1.0f / l;
    bf16* OB = (bf16*)(F.ws + WS_OB) + (size_t)br * M * DATT;
    float* LSE = (float*)(F.ws + WS_LSE) + (size_t)br * M * NH;
    LAS bf16* stg = (LAS bf16*)(F.lds + ATT_OST_OFF + w * 4096);
#pragma unroll
    for (int r = 0; r < 16; ++r) { const int orow = crow(r, hi); const float rr = __shfl(rl, orow);
#pragma unroll
        for (int dh = 0; dh < 2; ++dh) stg[orow * 64 + dh * 32 + r32] = (bf16)f2bf(o[dh][r] * rr); }
    if (hi == 0) LSE[(tokbase + ((size_t)(sq0 + r32) << dsh)) * NH + h] = mx + __builtin_amdgcn_logf(l);
    LDS_WAIT();
#pragma unroll
    for (int i = 0; i < 4; ++i) { const int row = i * 8 + (lane >> 3), ch = lane & 7; const v4u v = *(const LAS v4u*)(stg + row * 64 + ch * 8);
        *(GAS v4u*)(OB + (tokbase + ((size_t)(sq0 + row) << dsh)) * DATT + h * HD + ch * 8) = v; }
    __syncthreads();
}

__device__ __forceinline__ void pool_rows(Frame& F) {
    const bf16* Z = (const bf16*)(F.ws + WS_Z); bf16* MIX = (bf16*)(F.ws + WS_MIX);
    const int gw = F.vcu * NWAVES + F.wave, NGW = F.G * NWAVES;
    const int win = 2 << (F.lane >> 4);
    constexpr int TPW = 16;
    for (int it = gw; it < M / TPW; it += NGW) {
        for (int i = 0; i < TPW; ++i) {
            const int t = it * TPW + i, s = t & (SEQ - 1);
            const int cnt = (s + 1) < win ? (s + 1) : win;
            const bf16* zr = Z + (size_t)t * NZ + 3 * DATT + 8 * F.lane;
            float acc[8];
#pragma unroll
            for (int e = 0; e < 8; ++e) acc[e] = 0.f;
            v4u z0 = *(const GAS v4u*)zr;
            for (int j = 0; j < cnt; ++j) { const v4u v = *(const GAS v4u*)(zr - (size_t)j * NZ);
                acc[0] += bflo(v.x); acc[1] += bfhi(v.x); acc[2] += bflo(v.y); acc[3] += bfhi(v.y); acc[4] += bflo(v.z); acc[5] += bfhi(v.z); acc[6] += bflo(v.w); acc[7] += bfhi(v.w); }
            const float inv = 1.0f / (float)cnt;
            v4u o; o.x = pk2(acc[0] * inv - bflo(z0.x), acc[1] * inv - bfhi(z0.x)); o.y = pk2(acc[2] * inv - bflo(z0.y), acc[3] * inv - bfhi(z0.y));
            o.z = pk2(acc[4] * inv - bflo(z0.z), acc[5] * inv - bfhi(z0.z)); o.w = pk2(acc[6] * inv - bflo(z0.w), acc[7] * inv - bfhi(z0.w));
            *(GAS v4u*)(MIX + (size_t)t * D + DATT + 8 * F.lane) = o;
        }
    }
}

__device__ __forceinline__ void merge_rows(Frame& F) {
    const bf16* OB = (const bf16*)(F.ws + WS_OB); const float* LSE = (const float*)(F.ws + WS_LSE); bf16* MIX = (bf16*)(F.ws + WS_MIX);
    const int gw = F.vcu * NWAVES + F.wave, NGW = F.G * NWAVES;
    for (int t = gw; t < M; t += NGW) {
        const int h = F.lane >> 3;
        const float l0 = LSE[(size_t)t * NH + h], l1 = LSE[(size_t)(M + t) * NH + h], l2 = LSE[(size_t)(2 * M + t) * NH + h];
        const float mx = fmaxf(l0, fmaxf(l1, l2));
        float w0 = __builtin_amdgcn_exp2f(l0 - mx), w1 = __builtin_amdgcn_exp2f(l1 - mx), w2 = __builtin_amdgcn_exp2f(l2 - mx);
        const float inv = 1.0f / (w0 + w1 + w2); w0 *= inv; w1 *= inv; w2 *= inv;
        const size_t off = (size_t)t * DATT + 8 * F.lane;
        const v4u a = *(const GAS v4u*)(OB + off), b = *(const GAS v4u*)(OB + (size_t)M * DATT + off), c = *(const GAS v4u*)(OB + (size_t)2 * M * DATT + off);
        v4u o;
        o.x = pk2(w0 * bflo(a.x) + w1 * bflo(b.x) + w2 * bflo(c.x), w0 * bfhi(a.x) + w1 * bfhi(b.x) + w2 * bfhi(c.x));
        o.y = pk2(w0 * bflo(a.y) + w1 * bflo(b.y) + w2 * bflo(c.y), w0 * bfhi(a.y) + w1 * bfhi(b.y) + w2 * bfhi(c.y));
        o.z = pk2(w0 * bflo(a.z) + w1 * bflo(b.z) + w2 * bflo(c.z), w0 * bfhi(a.z) + w1 * bfhi(b.z) + w2 * bfhi(c.z));
        o.w = pk2(w0 * bflo(a.w) + w1 * bflo(b.w) + w2 * bflo(c.w), w0 * bfhi(a.w) + w1 * bfhi(b.w) + w2 * bfhi(c.w));
        *(GAS v4u*)(MIX + (size_t)t * D + 8 * F.lane) = o;
    }
}

constexpr int TK_ROW = 68;
constexpr int TK_WAVE_BYTES = 64 * TK_ROW * 4;
static_assert(NWAVES * TK_WAVE_BYTES <= LDSCTL_OFF, "top-k LDS map");

__device__ __forceinline__ unsigned f2ord(float f) { const unsigned u = __builtin_bit_cast(unsigned, f); return (u & 0x80000000u) ? ~u : (u | 0x80000000u); }
__device__ __forceinline__ float ord2f(unsigned k) { const unsigned u = (k & 0x80000000u) ? (k & 0x7fffffffu) : ~k; return __builtin_bit_cast(float, u); }
#define TK_INSERT(L, xin) do { unsigned x_ = (xin); _Pragma("unroll") for (int i_ = 0; i_ < 16; ++i_) { const unsigned hi_ = max(L[i_], x_); x_ = min(L[i_], x_); L[i_] = hi_; } } while (0)

__device__ __forceinline__ void topk_phase(Frame& F) {
    const float* SC = (const float*)(F.ws + WS_SC); const float* SS = (const float*)(F.ws + WS_SS);
    int* IDX = (int*)(F.ws + WS_IDX); float* GATE = (float*)(F.ws + WS_GATE);
    const int gw = F.vcu * NWAVES + F.wave, NGW = F.G * NWAVES, lane = F.lane;
    LAS float* st = (LAS float*)(F.lds + F.wave * TK_WAVE_BYTES);
    for (int it = gw; it < M / 8; it += NGW) {
        const int t0 = it * 8;
        unsigned L0[16], L1[16];
#pragma unroll
        for (int i = 0; i < 16; ++i) { L0[i] = 0u; L1[i] = 0u; }
#pragma unroll
        for (int rnd = 0; rnd < 4; ++rnd) {
            const int p = rnd >> 1, kc = rnd & 1;
#pragma unroll
            for (int i = 0; i < 16; ++i) { const int pr = 4 * i + (lane >> 4), tl = pr >> 3, h = pr & 7;
                const f32x4 v = *(const GAS f32x4*)(SC + (size_t)(t0 + tl) * NSC + h * 256 + p * 128 + kc * 64 + (lane & 15) * 4);
                *(LAS f32x4*)(st + pr * TK_ROW + (lane & 15) * 4) = v; }
            LDS_WAIT(); asm volatile("" ::: "memory");
#pragma unroll 1
            for (int q = 0; q < 16; ++q) {
                const f32x4 v = *(const LAS f32x4*)(st + lane * TK_ROW + q * 4);
#pragma unroll
                for (int e = 0; e < 4; ++e) { const unsigned key = (f2ord(v[e]) & ~127u) | (unsigned)(127 - (kc * 64 + q * 4 + e));
                    if (p == 0) TK_INSERT(L0, key); else TK_INSERT(L1, key); }
            }
            LDS_WAIT(); asm volatile("" ::: "memory");
        }
        LAS float* pv0 = st; LAS float* pv1 = st + 16 * 64; LAS int* pi0 = (LAS int*)(st + 32 * 64); LAS int* pi1 = (LAS int*)(st + 48 * 64);
        float v0[16], v1[16];
#pragma unroll
        for (int i = 0; i < 16; ++i) { v0[i] = ord2f(L0[i] & ~127u); v1[i] = ord2f(L1[i] & ~127u);
            pv0[i * 64 + lane] = v0[i]; pv1[i * 64 + lane] = v1[i]; pi0[i * 64 + lane] = 127 - (int)(L0[i] & 127u); pi1[i * 64 + lane] = 127 - (int)(L1[i] & 127u); }
        unsigned T[16];
#pragma unroll
        for (int i = 0; i < 16; ++i) T[i] = 0u;
#pragma unroll
        for (int i = 0; i < 16; ++i)
#pragma unroll
            for (int j = 0; j < 16; ++j) if ((i + 1) * (j + 1) <= 16) { const unsigned key = (f2ord(v0[i] + v1[j]) & ~255u) | (unsigned)(255 - (i * 16 + j)); TK_INSERT(T, key); }
        LDS_WAIT(); asm volatile("" ::: "memory");
        const int tl = lane >> 3, h = lane & 7, t = t0 + tl;
        float ssum = 0.f;
        { const float* sp = SS + (size_t)t * 16;
#pragma unroll
          for (int i = 0; i < 4; ++i) { const f32x4 v = *(const GAS f32x4*)(sp + 4 * i); ssum += (v[0] + v[1]) + (v[2] + v[3]); } }
        const float r2 = 1.0f / sqrtf(ssum * (1.0f / D) + EPS);
        float bs[16]; int ex[16]; float mxs = -3.0e38f;
#pragma unroll
        for (int k = 0; k < 16; ++k) { const int pos = 255 - (int)(T[k] & 255u), i = pos >> 4, j = pos & 15;
            bs[k] = (pv0[i * 64 + lane] + pv1[j * 64 + lane]) * r2; ex[k] = pi0[i * 64 + lane] * NKEYS + pi1[j * 64 + lane]; mxs = fmaxf(mxs, bs[k]); }
        float den = 0.f;
#pragma unroll
        for (int k = 0; k < 16; ++k) { bs[k] = __expf(bs[k] - mxs); den += bs[k]; }
        const float inv = 1.0f / den;
        int* ip = IDX + ((size_t)t * PEER_H + h) * TOPK; float* gp = GATE + ((size_t)t * PEER_H + h) * TOPK;
#pragma unroll
        for (int k = 0; k < 16; k += 4) { *(GAS v4u*)(ip + k) = (v4u){(unsigned)ex[k], (unsigned)ex[k + 1], (unsigned)ex[k + 2], (unsigned)ex[k + 3]};
            *(GAS f32x4*)(gp + k) = (f32x4){bs[k] * inv, bs[k + 1] * inv, bs[k + 2] * inv, bs[k + 3] * inv}; }
        LDS_WAIT(); asm volatile("" ::: "memory");
    }
}

__device__ __forceinline__ float gelu_erf(float a) { return 0.5f * a * (1.0f + erff(a * 0.70710678118654752f)); }

__device__ __forceinline__ void peer_phase(Frame& F) {
    const float* X1 = F.out; const float* SS = (const float*)(F.ws + WS_SS);
    const int* IDX = (const int*)(F.ws + WS_IDX); const float* GATE = (const float*)(F.ws + WS_GATE);
    const bf16* EU = (const bf16*)(F.ws + WS_EU); const bf16* EV = (const bf16*)(F.ws + WS_EV);
    const int gw = F.vcu * NWAVES + F.wave, NGW = F.G * NWAVES, lane = F.lane;
    for (int t = gw; t < M; t += NGW) {
        float x1[16], hf[16], y[16];
        const float* xr = X1 + (size_t)t * D + 8 * lane;
#pragma unroll
        for (int j = 0; j < 2; ++j) { const f32x4 a = *(const GAS f32x4*)(xr + 512 * j), b = *(const GAS f32x4*)(xr + 512 * j + 4);
#pragma unroll
            for (int e = 0; e < 4; ++e) { x1[8 * j + e] = a[e]; x1[8 * j + 4 + e] = b[e]; } }
        float ssum;
        { const float* sp = SS + (size_t)t * 16; const float v = sp[lane & 15]; float s = v; s += __shfl_xor(s, 1); s += __shfl_xor(s, 2); s += __shfl_xor(s, 4); s += __shfl_xor(s, 8); ssum = s; }
        const float r2 = 1.0f / sqrtf(ssum * (1.0f / D) + EPS);
#pragma unroll
        for (int j = 0; j < 2; ++j) { const f32x4 a = *(const GAS f32x4*)(F.norm_ffn + 8 * lane + 512 * j), b = *(const GAS f32x4*)(F.norm_ffn + 8 * lane + 512 * j + 4);
#pragma unroll
            for (int e = 0; e < 4; ++e) { hf[8 * j + e] = x1[8 * j + e] * r2 * a[e]; hf[8 * j + 4 + e] = x1[8 * j + 4 + e] * r2 * b[e]; } }
#pragma unroll
        for (int e = 0; e < 16; ++e) y[e] = 0.f;
        const int ia = IDX[(size_t)t * 128 + lane], ib = IDX[(size_t)t * 128 + 64 + lane];
        const float ga = GATE[(size_t)t * 128 + lane], gb = GATE[(size_t)t * 128 + 64 + lane];
#pragma unroll 1
        for (int bt = 0; bt < 16; ++bt) {
            const int isel = bt < 8 ? ia : ib; const float gsel = bt < 8 ? ga : gb;
            v4u u[8][2], v[8][2];
#pragma unroll
            for (int k = 0; k < 8; ++k) { const int e = __builtin_amdgcn_readlane(isel, ((bt & 7) * 8 + k));
                const bf16* ur = EU + (size_t)e * D + 8 * lane; const bf16* vr = EV + (size_t)e * D + 8 * lane;
                u[k][0] = *(const GAS v4u*)ur; u[k][1] = *(const GAS v4u*)(ur + 512); v[k][0] = *(const GAS v4u*)vr; v[k][1] = *(const GAS v4u*)(vr + 512); }
            float pa[8];
#pragma unroll
            for (int k = 0; k < 8; ++k) { float s = 0.f;
#pragma unroll
                for (int j = 0; j < 2; ++j) { const v4u w = u[k][j];
                    s += bflo(w.x) * hf[8 * j + 0] + bfhi(w.x) * hf[8 * j + 1] + bflo(w.y) * hf[8 * j + 2] + bfhi(w.y) * hf[8 * j + 3]
                       + bflo(w.z) * hf[8 * j + 4] + bfhi(w.z) * hf[8 * j + 5] + bflo(w.w) * hf[8 * j + 6] + bfhi(w.w) * hf[8 * j + 7]; }
                pa[k] = s; }
            float q4[4], q2[2], q1;
#pragma unroll
            for (int i = 0; i < 4; ++i) { const bool up = (lane & 32) != 0; const float keep = up ? pa[i + 4] : pa[i], send = up ? pa[i] : pa[i + 4]; q4[i] = keep + __shfl_xor(send, 32); }
#pragma unroll
            for (int i = 0; i < 2; ++i) { const bool up = (lane & 16) != 0; const float keep = up ? q4[i + 2] : q4[i], send = up ? q4[i] : q4[i + 2]; q2[i] = keep + __shfl_xor(send, 16); }
            { const bool up = (lane & 8) != 0; const float keep = up ? q2[1] : q2[0], send = up ? q2[0] : q2[1]; q1 = keep + __shfl_xor(send, 8); }
            q1 += __shfl_xor(q1, 4); q1 += __shfl_xor(q1, 2); q1 += __shfl_xor(q1, 1);
            const int kk = ((lane >> 5) & 1) * 4 + ((lane >> 4) & 1) * 2 + ((lane >> 3) & 1);
            const float gk = __shfl(gsel, (bt & 7) * 8 + kk);
            const float act = gelu_erf(q1) * gk;
#pragma unroll
            for (int k = 0; k < 8; ++k) {
                const int src = ((k >> 2) & 1) * 32 + ((k >> 1) & 1) * 16 + (k & 1) * 8;
                const float ak = __builtin_bit_cast(float, __builtin_amdgcn_readlane(__builtin_bit_cast(int, act), src));
#pragma unroll
                for (int j = 0; j < 2; ++j) { const v4u w = v[k][j];
                    y[8 * j + 0] += ak * bflo(w.x); y[8 * j + 1] += ak * bfhi(w.x); y[8 * j + 2] += ak * bflo(w.y); y[8 * j + 3] += ak * bfhi(w.y);
                    y[8 * j + 4] += ak * bflo(w.z); y[8 * j + 5] += ak * bfhi(w.z); y[8 * j + 6] += ak * bflo(w.w); y[8 * j + 7] += ak * bfhi(w.w); }
            }
        }
        float s2 = 0.f;
#pragma unroll
        for (int e = 0; e < 16; ++e) { y[e] += x1[e]; s2 += y[e] * y[e]; }
        s2 = wave_sum(s2);
        const float r3 = 1.0f / sqrtf(s2 * (1.0f / D) + EPS);
        float* orow = F.out + (size_t)t * D + 8 * lane;
#pragma unroll
        for (int j = 0; j < 2; ++j) { const f32x4 a = *(const GAS f32x4*)(F.norm_final + 8 * lane + 512 * j), b = *(const GAS f32x4*)(F.norm_final + 8 * lane + 512 * j + 4);
            *(GAS f32x4*)(orow + 512 * j) = (f32x4){y[8 * j] * r3 * a[0], y[8 * j + 1] * r3 * a[1], y[8 * j + 2] * r3 * a[2], y[8 * j + 3] * r3 * a[3]};
            *(GAS f32x4*)(orow + 512 * j + 4) = (f32x4){y[8 * j + 4] * r3 * b[0], y[8 * j + 5] * r3 * b[1], y[8 * j + 6] * r3 * b[2], y[8 * j + 7] * r3 * b[3]}; }
    }
}

struct Args { const float* in[12]; float* out; unsigned char* ws; };
__global__ void __launch_bounds__(NWAVES * 64, 2) hymba_fwd(Args args) {
    extern __shared__ __attribute__((aligned(16))) unsigned char lds[];
    Frame F;
    F.lds = (LAS unsigned char*)lds;
    F.MISC = (volatile LAS unsigned*)(F.lds + MISC_OFF);
    F.tid = threadIdx.x; F.lane = F.tid & 63; F.wave = __builtin_amdgcn_readfirstlane(F.tid >> 6);
    F.G = gridDim.x; { const int bx = blockIdx.x; F.vcu = (F.G % 8 == 0) ? (bx % 8) * (F.G / 8) + bx / 8 : bx; }
    F.x = args.in[0]; F.norm_mix = args.in[1]; F.w_in = args.in[2]; F.w_pool = args.in[3]; F.pool_scale = args.in[4]; F.w_out = args.in[5];
    F.norm_ffn = args.in[6]; F.w_query = args.in[7]; F.sub_keys = args.in[8]; F.expert_u = args.in[9]; F.expert_v = args.in[10]; F.norm_final = args.in[11];
    F.out = args.out; F.ws = args.ws;
    for (int u = F.tid; u < (LDS_BYTES - LDSCTL_OFF) / 4; u += NWAVES * 64) ((LAS unsigned*)(F.lds + LDSCTL_OFF))[u] = 0u;
    __syncthreads();
    XcdBarrier bar = xcd_barrier_post((unsigned*)(F.ws + WS_CTL), F.MISC + 8);
#define GRID_BAR() xcd_barrier(bar)

    p0_prologue(F);
    GRID_BAR();
    {
        pg8::Gemm g{(const pg8::bf16_t*)(F.ws + WS_XB), (const pg8::bf16_t*)(F.ws + WS_WIN), M, NZ, D}; pg8::StaticOrder S; S.init(M, NZ, F.G, (int)blockIdx.x);
        pg8::EpiZ E{(pg8::bf16_t*)(F.ws + WS_Z), NZ, (const float*)(F.ws + WS_R1), DATT, QSCALE};
        pg8::gemm_phase<pg8::EpiZ, pg8::StaticOrder, PG8_ALIGN, PG8_SP2>(F.lds + RING_OFF, g, S, E);
    }
    GRID_BAR();
    for (int u = F.vcu; u < ATT_UNITS; u += F.G) attn_unit(F, u);
    pool_rows(F);
    GRID_BAR();
    merge_rows(F);
    GRID_BAR();
    {
        pg8::Gemm g{(const pg8::bf16_t*)(F.ws + WS_MIX), (const pg8::bf16_t*)(F.ws + WS_WOUT), M, D, D}; pg8::StaticOrder S; S.init(M, D, F.G, (int)blockIdx.x);
        pg8::EpiRes E{F.x, F.out, (pg8::bf16_t*)(F.ws + WS_XB), (float*)(F.ws + WS_SS), D};
        pg8::gemm_phase<pg8::EpiRes, pg8::StaticOrder, PG8_ALIGN, PG8_SP2>(F.lds + RING_OFF, g, S, E);
    }
    GRID_BAR();
    {
        pg8::Gemm g{(const pg8::bf16_t*)(F.ws + WS_XB), (const pg8::bf16_t*)(F.ws + WS_WSC), M, NSC, D}; pg8::StaticOrder S; S.init(M, NSC, F.G, (int)blockIdx.x);
        pg8::EpiF32 E{(float*)(F.ws + WS_SC), NSC};
        pg8::gemm_phase<pg8::EpiF32, pg8::StaticOrder, PG8_ALIGN, PG8_SP2>(F.lds + RING_OFF, g, S, E);
    }
    GRID_BAR();
    topk_phase(F);
    GRID_BAR();
    peer_phase(F);
}

extern "C" void kernel_launch(void* const* d_in, const int* in_sizes, int n_in, void* d_out, int out_size, void* d_ws, size_t ws_size, hipStream_t stream) {
    static int grid = 0;
    if (grid == 0) {
        if (n_in != 12 || in_sizes[0] != M * D || out_size != M * D || ws_size < WS_END) { fprintf(stderr, "kernel_launch: unexpected shapes (n_in %d, in0 %d, out %d, ws %zu); nothing launched\n", n_in, n_in > 0 ? in_sizes[0] : -1, out_size, ws_size); grid = -1; return; }
        int dev = 0, cus = 0, per_cu = 0;
        if (hipGetDevice(&dev) != hipSuccess || hipDeviceGetAttribute(&cus, hipDeviceAttributeMultiprocessorCount, dev) != hipSuccess) { grid = -1; return; }
        if (hipFuncSetAttribute((const void*)hymba_fwd, hipFuncAttributeMaxDynamicSharedMemorySize, LDS_BYTES) != hipSuccess) { fprintf(stderr, "kernel_launch: hipFuncSetAttribute failed\n"); grid = -1; return; }
        if (hipOccupancyMaxActiveBlocksPerMultiprocessor(&per_cu, (const void*)hymba_fwd, NWAVES * 64, LDS_BYTES) != hipSuccess || per_cu < 1)
            fprintf(stderr, "kernel_launch: note: occupancy query reports %d workgroups per CU\n", per_cu);
        (void)hipGetLastError();
        grid = cus;
    }
    if (grid < 0) return;
    if (hipMemsetAsync((char*)d_ws + WS_CTL, 0, CTL_ZERO_BYTES, stream) != hipSuccess) { fprintf(stderr, "kernel_launch: hipMemsetAsync failed\n"); return; }
    Args a{};
    for (int i = 0; i < 12; ++i) a.in[i] = (const float*)d_in[i];
    a.out = (float*)d_out; a.ws = (unsigned char*)d_ws;
    hipLaunchKernelGGL(hymba_fwd, dim3(grid), dim3(NWAVES * 64), LDS_BYTES, stream, a);
    const hipError_t le = hipPeekAtLastError();
    if (le != hipSuccess) fprintf(stderr, "kernel_launch: launch failed: %s\n", hipGetErrorName(le));
}
```

```cpp
#include <hip/hip_runtime.h>
#include <cstdio>
#include <cstdint>
namespace pg8 {
#define PG8_LAS __attribute__((address_space(3)))
typedef unsigned short bf16_t;
typedef short bf16x8 __attribute__((ext_vector_type(8)));
typedef float f32x4 __attribute__((ext_vector_type(4)));
typedef unsigned u32x4 __attribute__((ext_vector_type(4)));
constexpr int BM = 256, BK = 64, HALF = 128, HTB = HALF * BK * 2  , STAGE_BYTES = 8 * HTB, NXCD = 8, WGM = 8;

__host__ __device__ __forceinline__ int lds_byte(int r, int c) { const int st = (r >> 4) * 2 + (c >> 5), rr = r & 15, cc = c & 31, ob = rr * 64 + cc * 2; return st * 1024 + (ob ^ (((ob >> 9) & 1) << 5)); }
__host__ __device__ __forceinline__ void stage_rc(int b, int& R, int& C) { const int st = b / 1024, sb = b % 1024, swz = sb ^ (((sb >> 9) & 1) << 5); R = (st >> 1) * 16 + swz / 64; C = (st & 1) * 32 + (swz % 64) / 2; }
__host__ __device__ __forceinline__ int perm32(int rho) { const int n = rho >> 4, i = rho & 15; return 8 * (i >> 2) + 4 * n + (i & 3); }

struct Unit { int pm, pn; };
struct Gemm { const bf16_t* A; const bf16_t* Bt; int M, N, K; };

struct StaticOrder {
    int nM, nN, nwg, G, c;
    __host__ __device__ void init(int M, int N, int G_, int c_) { nM = M / BM; nN = N / BM; nwg = nM * nN; G = G_; c = c_; }
    __host__ __device__ bool next(int i, Unit& u) const {
        const long L = (long)i * G + c; if (L >= nwg) return false;
        int wgid = (int)L; { const int q = nwg / NXCD, r = nwg % NXCD, xcd = wgid % NXCD, off = wgid / NXCD; wgid = (xcd < r ? xcd * (q + 1) : r * (q + 1) + (xcd - r) * q) + off; }
        const int nig = WGM * nN, gid = wgid / nig, fm = gid * WGM, gsz = (nM - fm) < WGM ? (nM - fm) : WGM;
        u.pm = fm + ((wgid % nig) % gsz); u.pn = (wgid % nig) / gsz; return true;
    }
    __device__ __forceinline__ void a_ready(const Unit&) const {}
    __device__ __forceinline__ void done(const Unit&) const {}
};

__device__ __forceinline__ unsigned cvt_pk_bf16(float lo, float hi) { unsigned r; asm volatile("v_cvt_pk_bf16_f32 %0, %1, %2" : "=v"(r) : "v"(lo), "v"(hi)); return r; }
struct EpiZ {
    static constexpr bool PERM = true, AFTER_DRAIN = false;
    bf16_t* O; int ldc; const float* rs; int qcols; float qscale;
    __device__ __forceinline__ void operator()(const f32x4 (&acc)[2][2][4][2], const Unit& u, int wr, int wc, int fr, int fq) const {
        const int row0 = u.pm * BM + wr * 64 + fr; const int colt = u.pn * BM;
        const float sc = (colt < qcols) ? qscale : 1.f;
        const int col0 = colt + wc * 32 + 8 * fq;
#pragma unroll
        for (int ai = 0; ai < 2; ++ai)
#pragma unroll
            for (int m = 0; m < 4; ++m) { const int row = row0 + ai * HALF + m * 16; const float s = rs[row] * sc; bf16_t* rowp = O + (size_t)row * ldc + col0;
#pragma unroll
                for (int bj = 0; bj < 2; ++bj) { const f32x4 v0 = acc[ai][bj][m][0] * s, v1 = acc[ai][bj][m][1] * s;
                    u32x4 w; w.x = cvt_pk_bf16(v0[0], v0[1]); w.y = cvt_pk_bf16(v0[2], v0[3]); w.z = cvt_pk_bf16(v1[0], v1[1]); w.w = cvt_pk_bf16(v1[2], v1[3]);
                    *(u32x4*)(rowp + bj * HALF) = w; } }
    }
};
struct EpiRes {
    static constexpr bool PERM = true, AFTER_DRAIN = false;
    const float* X; float* X1; bf16_t* X1b; float* SS; int ldc;
    __device__ __forceinline__ void operator()(const f32x4 (&acc)[2][2][4][2], const Unit& u, int wr, int wc, int fr, int fq) const {
        const int row0 = u.pm * BM + wr * 64 + fr; const int col0 = u.pn * BM + wc * 32 + 8 * fq;
#pragma unroll
        for (int ai = 0; ai < 2; ++ai)
#pragma unroll
            for (int m = 0; m < 4; ++m) { const int row = row0 + ai * HALF + m * 16; const size_t off = (size_t)row * ldc + col0; float ss = 0.f;
#pragma unroll
                for (int bj = 0; bj < 2; ++bj) {
                    const f32x4 x0 = *(const f32x4*)(X + off + bj * HALF), x1 = *(const f32x4*)(X + off + bj * HALF + 4);
                    const f32x4 v0 = acc[ai][bj][m][0] + x0, v1 = acc[ai][bj][m][1] + x1;
                    *(f32x4*)(X1 + off + bj * HALF) = v0; *(f32x4*)(X1 + off + bj * HALF + 4) = v1;
                    ss += (v0[0] * v0[0] + v0[1] * v0[1]) + (v0[2] * v0[2] + v0[3] * v0[3]) + (v1[0] * v1[0] + v1[1] * v1[1]) + (v1[2] * v1[2] + v1[3] * v1[3]);
                    u32x4 w; w.x = cvt_pk_bf16(v0[0], v0[1]); w.y = cvt_pk_bf16(v0[2], v0[3]); w.z = cvt_pk_bf16(v1[0], v1[1]); w.w = cvt_pk_bf16(v1[2], v1[3]);
                    *(u32x4*)(X1b + off + bj * HALF) = w; }
                ss += __shfl_xor(ss, 16); ss += __shfl_xor(ss, 32);
                if (fq == 0) SS[(size_t)row * 16 + u.pn * 4 + wc] = ss;
                if (m & 1) asm volatile("" ::: "memory"); }
    }
};
struct EpiF32 {
    static constexpr bool PERM = true, AFTER_DRAIN = false;
    float* O; int ldc;
    __device__ __forceinline__ void operator()(const f32x4 (&acc)[2][2][4][2], const Unit& u, int wr, int wc, int fr, int fq) const {
        const int row0 = u.pm * BM + wr * 64 + fr; const int col0 = u.pn * BM + wc * 32 + 8 * fq;
#pragma unroll
        for (int ai = 0; ai < 2; ++ai)
#pragma unroll
            for (int m = 0; m < 4; ++m) { float* rowp = O + (size_t)(row0 + ai * HALF + m * 16) * ldc + col0;
#pragma unroll
                for (int bj = 0; bj < 2; ++bj) { *(f32x4*)(rowp + bj * HALF) = acc[ai][bj][m][0]; *(f32x4*)(rowp + bj * HALF + 4) = acc[ai][bj][m][1]; } }
    }
};

template <class Epi, class Sched, bool ALIGN_EPI = false, bool SP2 = false>
__device__ __forceinline__ void gemm_phase(PG8_LAS unsigned char* lds, const Gemm g, const Sched& S, const Epi& E) {
    const int tid = threadIdx.x, wid = __builtin_amdgcn_readfirstlane(tid >> 6), lane = tid & 63, wr = wid >> 2, wc = wid & 3, fr = lane & 15, fq = lane >> 4;
    const int K = g.K, nt = K / BK;
    unsigned voffA[2], voffB[2];
#pragma unroll
    for (int i = 0; i < 2; ++i) { int R, C; stage_rc(tid * 16 + i * 8192, R, C); const int Rb = Epi::PERM ? ((R & ~31) + perm32(R & 31)) : R;
        voffA[i] = (unsigned)(R * K + C) * 2u; voffB[i] = (unsigned)(Rb * K + C) * 2u; }
    const size_t kstep = (size_t)(BK * 2);
    const size_t hstep = (size_t)HALF * K * 2;
    const size_t tstep = 2 * hstep;
    const unsigned ldsw = (unsigned)wid * 1024u;
    const int aoff = lds_byte(wr * 64 + fr, fq * 8), boff = lds_byte(wc * 32 + fr, fq * 8);
#define PG8_SA(b, h) (((b) * 2 + (h)) * HTB)
#define PG8_SB(b, h) ((4 + (b) * 2 + (h)) * HTB)
#define PG8_STAGE(bufoff, gbase, voff) do { _Pragma("unroll") for (int _i = 0; _i < 2; ++_i) \
        __builtin_amdgcn_global_load_lds((const unsigned*)((const char*)(gbase) + (voff)[_i]), (PG8_LAS unsigned*)(lds + (bufoff) + ldsw + _i * 8192), 16, 0, 0); } while (0)
#define PG8_LDA(dst, b, h) do { _Pragma("unroll") for (int m = 0; m < 4; ++m) _Pragma("unroll") for (int k = 0; k < 2; ++k) dst[m][k] = *(const PG8_LAS bf16x8*)(lds + PG8_SA(b, h) + aoff + m * 2048 + k * 1024); } while (0)
#define PG8_LDB(dst, b, h) do { _Pragma("unroll") for (int n = 0; n < 2; ++n) _Pragma("unroll") for (int k = 0; k < 2; ++k) dst[n][k] = *(const PG8_LAS bf16x8*)(lds + PG8_SB(b, h) + boff + n * 2048 + k * 1024); } while (0)
#define PG8_MMA(ai, bj, At, Bt) do { __builtin_amdgcn_s_setprio(1); _Pragma("unroll") for (int m = 0; m < 4; ++m) _Pragma("unroll") for (int n = 0; n < 2; ++n) _Pragma("unroll") for (int k = 0; k < 2; ++k) \
        acc[ai][bj][m][n] = __builtin_amdgcn_mfma_f32_16x16x32_bf16(Bt[n][k], At[m][k], acc[ai][bj][m][n], 0, 0, 0); __builtin_amdgcn_s_setprio(0); } while (0)
#define PG8_WAIT_V(n) asm volatile("s_waitcnt vmcnt(" #n ")" ::: "memory")
#define PG8_WAIT_L(n) asm volatile("s_waitcnt lgkmcnt(" #n ")" ::: "memory")
#define PG8_BAR __builtin_amdgcn_s_barrier()
#define PG8_SCHED __builtin_amdgcn_sched_barrier(0)
    Unit cur, nxt; int ui = 0;
    if (!S.next(0, cur)) return;
    f32x4 acc[2][2][4][2];
#pragma unroll
    for (int a = 0; a < 2; ++a)
#pragma unroll
        for (int b = 0; b < 2; ++b)
#pragma unroll
            for (int m = 0; m < 4; ++m)
#pragma unroll
                for (int n = 0; n < 2; ++n) acc[a][b][m][n] = (f32x4){0.f, 0.f, 0.f, 0.f};
    bf16x8 At[4][2], B0[2][2], B1[2][2];
    const char* cA = (const char*)g.A + (size_t)cur.pm * tstep; const char* cB = (const char*)g.Bt + (size_t)cur.pn * tstep;
    S.a_ready(cur);
    if constexpr (SP2) {
        PG8_STAGE(PG8_SB(0, 0), cB, voffB); PG8_STAGE(PG8_SB(0, 1), cB + hstep, voffB); PG8_STAGE(PG8_SA(0, 0), cA, voffA); PG8_STAGE(PG8_SA(0, 1), cA + hstep, voffA);
        if (wr == 1) PG8_BAR;
        PG8_WAIT_V(2); PG8_BAR;
        PG8_STAGE(PG8_SB(1, 0), cB + kstep, voffB); PG8_STAGE(PG8_SA(1, 0), cA + kstep, voffA); PG8_STAGE(PG8_SB(1, 1), cB + hstep + kstep, voffB);
        PG8_WAIT_V(6); PG8_BAR;
    } else {
        PG8_STAGE(PG8_SB(0, 0), cB, voffB); PG8_STAGE(PG8_SA(0, 0), cA, voffA); PG8_STAGE(PG8_SB(0, 1), cB + hstep, voffB); PG8_STAGE(PG8_SA(0, 1), cA + hstep, voffA);
        if (wr == 1) PG8_BAR;
        PG8_WAIT_V(4); PG8_BAR;
        PG8_STAGE(PG8_SB(1, 0), cB + kstep, voffB); PG8_STAGE(PG8_SA(1, 0), cA + kstep, voffA); PG8_STAGE(PG8_SB(1, 1), cB + hstep + kstep, voffB);
        PG8_WAIT_V(6); PG8_BAR;
    }
    for (;;) {
        const bool has_next = S.next(ui + 1, nxt);
        const char* nA = has_next ? (const char*)g.A + (size_t)nxt.pm * tstep : cA; const char* nB = has_next ? (const char*)g.Bt + (size_t)nxt.pn * tstep : cB;
        for (int t = 0; t < nt; t += 2) {
            const bool last = (t == nt - 2);
            const char* a1 = cA + (size_t)(t + 1) * kstep;
            const char* a2 = last ? nA : cA + (size_t)(t + 2) * kstep; const char* b2 = last ? nB : cB + (size_t)(t + 2) * kstep;
            const char* a3 = a2 + kstep; const char* b3 = b2 + kstep;
            if (last && has_next) S.a_ready(nxt);
            if constexpr (SP2) {
            PG8_LDB(B0, 0, 0); PG8_LDB(B1, 0, 1); PG8_SCHED; PG8_LDA(At, 0, 0); PG8_STAGE(PG8_SA(1, 1), a1 + hstep, voffA);
            PG8_WAIT_V(8); PG8_WAIT_L(0); PG8_BAR; PG8_MMA(0, 0, At, B0); PG8_MMA(0, 1, At, B1); PG8_BAR; PG8_SCHED;
            PG8_LDA(At, 0, 1); PG8_STAGE(PG8_SB(0, 0), b2, voffB); PG8_STAGE(PG8_SB(0, 1), b2 + hstep, voffB); PG8_STAGE(PG8_SA(0, 0), a2, voffA);
            PG8_WAIT_V(8); PG8_WAIT_L(0); PG8_BAR; PG8_MMA(1, 0, At, B0); PG8_MMA(1, 1, At, B1); PG8_BAR; PG8_SCHED;
            PG8_LDB(B0, 1, 0); PG8_LDB(B1, 1, 1); PG8_SCHED; PG8_LDA(At, 1, 0); PG8_STAGE(PG8_SA(0, 1), a2 + hstep, voffA);
            PG8_WAIT_V(8); PG8_WAIT_L(0); PG8_BAR; PG8_MMA(0, 0, At, B0); PG8_MMA(0, 1, At, B1); PG8_BAR; PG8_SCHED;
            PG8_LDA(At, 1, 1); PG8_STAGE(PG8_SB(1, 0), b3, voffB); PG8_STAGE(PG8_SB(1, 1), b3 + hstep, voffB); PG8_STAGE(PG8_SA(1, 0), a3, voffA);
            PG8_WAIT_V(8); PG8_WAIT_L(0); PG8_BAR; PG8_MMA(1, 0, At, B0); PG8_MMA(1, 1, At, B1); PG8_BAR; PG8_SCHED;
            } else {
            PG8_LDB(B0, 0, 0); PG8_SCHED; PG8_LDA(At, 0, 0); PG8_STAGE(PG8_SA(1, 1), a1 + hstep, voffA);
            PG8_WAIT_L(8); PG8_BAR; PG8_WAIT_L(0); PG8_MMA(0, 0, At, B0); PG8_BAR; PG8_SCHED;
            PG8_LDB(B1, 0, 1); PG8_STAGE(PG8_SB(0, 0), b2, voffB);
            PG8_BAR; PG8_WAIT_L(0); PG8_MMA(0, 1, At, B1); PG8_BAR;
            PG8_LDA(At, 0, 1); PG8_STAGE(PG8_SA(0, 0), a2, voffA);
            PG8_BAR; PG8_WAIT_L(0); PG8_MMA(1, 0, At, B0); PG8_BAR; PG8_SCHED;
            PG8_STAGE(PG8_SB(0, 1), b2 + hstep, voffB);
            PG8_WAIT_V(6); PG8_BAR; PG8_MMA(1, 1, At, B1); PG8_BAR;
            PG8_LDB(B0, 1, 0); PG8_SCHED; PG8_LDA(At, 1, 0); PG8_STAGE(PG8_SA(0, 1), a2 + hstep, voffA);
            PG8_WAIT_L(8); PG8_BAR; PG8_WAIT_L(0); PG8_MMA(0, 0, At, B0); PG8_BAR; PG8_SCHED;
            PG8_LDB(B1, 1, 1); PG8_STAGE(PG8_SB(1, 0), b3, voffB);
            PG8_BAR; PG8_WAIT_L(0); PG8_MMA(0, 1, At, B1); PG8_BAR;
            PG8_LDA(At, 1, 1); PG8_STAGE(PG8_SA(1, 0), a3, voffA);
            PG8_BAR; PG8_WAIT_L(0); PG8_MMA(1, 0, At, B0); PG8_BAR; PG8_SCHED;
            PG8_STAGE(PG8_SB(1, 1), b3 + hstep, voffB);
            PG8_WAIT_V(6); PG8_BAR; PG8_MMA(1, 1, At, B1); PG8_BAR;
            }
        }
        if constexpr (ALIGN_EPI) { if (wr == 0) PG8_BAR; }
        if constexpr (!Epi::AFTER_DRAIN) { E(acc, cur, wr, wc, fr, fq); S.done(cur); }
        if (!has_next) break;
#pragma unroll
        for (int a = 0; a < 2; ++a)
#pragma unroll
            for (int b = 0; b < 2; ++b)
#pragma unroll
                for (int m = 0; m < 4; ++m)
#pragma unroll
                    for (int n = 0; n < 2; ++n) acc[a][b][m][n] = (f32x4){0.f, 0.f, 0.f, 0.f};
        cur = nxt; cA = nA; cB = nB; ++ui;
        if constexpr (ALIGN_EPI) { if (wr == 1) PG8_BAR; }
    }
    PG8_WAIT_V(0);
    if constexpr (!ALIGN_EPI) { if (wr == 0) PG8_BAR; }
    PG8_BAR;
    if constexpr (Epi::AFTER_DRAIN) { E.fused(acc, cur, wr, wc, fr, fq, lds, wid, lane); S.done(cur); }
#undef PG8_SA
#undef PG8_SB
#undef PG8_STAGE
#undef PG8_LDA
#undef PG8_LDB
#undef PG8_MMA
#undef PG8_WAIT_V
#undef PG8_WAIT_L
#undef PG8_BAR
#undef PG8_SCHED
}
}
#define PG8_SP2 true
#define PG8_ALIGN true

constexpr int NWAVES = 8;
constexpr int BATCH = 4, SEQ = 8192, D = 1024, M = BATCH * SEQ;
constexpr int NH = 8, HD = 64, DATT = 512, DPOOL = 512, NZ = 3 * DATT + DPOOL;
constexpr int PEER_H = 8, NKEYS = 128, NEXP = NKEYS * NKEYS, TOPK = 16, NSC = PEER_H * 2 * NKEYS;
constexpr float EPS = 1e-6f;
constexpr float QSCALE = 0.125f * 1.4426950408889634f;

constexpr size_t MiB = 1u << 20;
constexpr size_t WS_CTL = 0, CTL_ZERO_BYTES = 64 * 1024;
constexpr size_t WS_R1 = 1 * MiB;
constexpr size_t WS_SS = 2 * MiB;
constexpr size_t WS_LSE = 4 * MiB;
constexpr size_t WS_WIN = 8 * MiB;
constexpr size_t WS_WOUT = 12 * MiB;
constexpr size_t WS_WSC = 14 * MiB;
constexpr size_t WS_EU = 32 * MiB, WS_EV = 64 * MiB;
constexpr size_t WS_XB = 96 * MiB;
constexpr size_t WS_Z = 160 * MiB;
constexpr size_t WS_OB = 288 * MiB;
constexpr size_t WS_MIX = 384 * MiB;
constexpr size_t WS_SC = 160 * MiB;
constexpr size_t WS_IDX = 448 * MiB, WS_GATE = 464 * MiB;
constexpr size_t WS_END = 480 * MiB;
static_assert(WS_SC + (size_t)M * NSC * 4 <= WS_IDX, "ws map");

constexpr int LDS_BYTES = 147456;
constexpr int LDSCTL_OFF = 146432, MISC_OFF = LDSCTL_OFF + 320;
constexpr int RING_OFF = 0;

#define GAS __attribute__((address_space(1)))
#define LAS __attribute__((address_space(3)))
typedef unsigned short bf16;
typedef unsigned v4u __attribute__((ext_vector_type(4)));
typedef unsigned v2u __attribute__((ext_vector_type(2)));
typedef float f32x4 __attribute__((ext_vector_type(4)));
typedef float f32x16 __attribute__((ext_vector_type(16)));
typedef short bf16x8 __attribute__((ext_vector_type(8)));
typedef short s16x4 __attribute__((ext_vector_type(4)));
typedef GAS unsigned gu32;
#define RLX_AGENT __ATOMIC_RELAXED, __HIP_MEMORY_SCOPE_AGENT
#define LDS_WAIT() asm volatile("s_waitcnt lgkmcnt(0)" ::: "memory")
#define VM_WAIT() asm volatile("s_waitcnt vmcnt(0)" ::: "memory")
__device__ __forceinline__ unsigned f2bf(float f) { unsigned u = __builtin_bit_cast(unsigned, f); return (u + 0x7fffu + ((u >> 16) & 1u)) >> 16; }
__device__ __forceinline__ unsigned pk2(float lo, float hi) { return f2bf(lo) | (f2bf(hi) << 16); }
__device__ __forceinline__ float bflo(unsigned w) { return __builtin_bit_cast(float, w << 16); }
__device__ __forceinline__ float bfhi(unsigned w) { return __builtin_bit_cast(float, w & 0xffff0000u); }
#define XB_TMO      128
#define XB_XCNT(j)  (256  + 64 * (j))
#define XB_XSUB(j)  (1280 + 64 * (j))
#define XB_XGEN(j)  (2304 + 64 * (j))
#define XB_TOP      3328
#define XB_TOPGEN   3392
#define XCD_BAR_WORDS 3456
#define XB_SPIN_CAP (1u << 18)

__device__ __forceinline__ unsigned xb_ld(unsigned* p)              { return __hip_atomic_load(p, __ATOMIC_RELAXED, __HIP_MEMORY_SCOPE_AGENT); }
__device__ __forceinline__ unsigned xb_add(unsigned* p, unsigned v) { return __hip_atomic_fetch_add(p, v, __ATOMIC_RELAXED, __HIP_MEMORY_SCOPE_AGENT); }
__device__ __forceinline__ unsigned xb_xcc_id() { return (unsigned)__builtin_amdgcn_s_getreg((3 << 11) | 20) & 0xFu; }
#define XB_SPIN(cond, bar) do { unsigned _sp = 0; while (cond) { __builtin_amdgcn_s_sleep(1); \
    if ((++_sp & 255u) == 0u) { if (xb_ld(&(bar)[XB_TMO])) break; if (_sp > XB_SPIN_CAP) { atomicAdd(&(bar)[XB_TMO], 1u); break; } } } } while (0)

struct XcdBarrier {
    unsigned* bar; unsigned x;
    volatile LAS unsigned* st;
};

__device__ __forceinline__ XcdBarrier xcd_barrier_post(unsigned* bar, volatile LAS unsigned* st) {
    XcdBarrier b; b.bar = bar; b.x = xb_xcc_id(); b.st = st;
    if (threadIdx.x == 0) (void)xb_add(&bar[XB_XCNT(b.x)], 1u);
    return b;
}
__device__ __forceinline__ void xcd_barrier_complete(unsigned* bar, unsigned x, unsigned& nloc, unsigned& nx) {
    const unsigned G = gridDim.x * gridDim.y * gridDim.z;
    unsigned sum, cnt, mine, sp = 0u;
    for (;;) {
        sum = 0u; cnt = 0u; mine = 0u;
#pragma unroll
        for (unsigned j = 0; j < 16; ++j) { const unsigned c = xb_ld(&bar[XB_XCNT(j)]); sum += c; cnt += (c > 0u) ? 1u : 0u; mine = (j == x) ? c : mine; }
        if (sum == G) break;
        __builtin_amdgcn_s_sleep(1);
        if ((++sp & 255u) == 0u) { if (xb_ld(&bar[XB_TMO])) break; if (sp > XB_SPIN_CAP) { atomicAdd(&bar[XB_TMO], 1u); break; } }
    }
    nloc = mine > 0u ? mine : 1u; nx = cnt > 0u ? cnt : 1u;
}

__device__ __forceinline__ void xcd_barrier(const XcdBarrier& b) {
    asm volatile("s_waitcnt vmcnt(0)" ::: "memory");
    __syncthreads();
    if (threadIdx.x == 0) {
        unsigned* bar = b.bar;
        __builtin_amdgcn_s_waitcnt(0);
        unsigned nloc = b.st[0], nx = b.st[1];
        if (nloc == 0u) { xcd_barrier_complete(bar, b.x, nloc, nx); b.st[0] = nloc; b.st[1] = nx; }
        const unsigned old = xb_add(&bar[XB_XSUB(b.x)], 1u);
        const unsigned gen = old / nloc;
        if (old + 1u == (gen + 1u) * nloc) {
            __builtin_amdgcn_fence(__ATOMIC_RELEASE, "agent");
            asm volatile("s_waitcnt vmcnt(0)" ::: "memory");
            const unsigned og = xb_add(&bar[XB_TOP], 1u);
            const unsigned tg = og / nx;
            if (og + 1u == (tg + 1u) * nx) xb_add(&bar[XB_TOPGEN], 1u);
            else XB_SPIN(xb_ld(&bar[XB_TOPGEN]) == tg, bar);
            __builtin_amdgcn_fence(__ATOMIC_ACQUIRE, "agent");
            xb_add(&bar[XB_XGEN(b.x)], 1u);
            asm volatile("s_waitcnt vmcnt(0)" ::: "memory");
        } else {
            XB_SPIN(xb_ld(&bar[XB_XGEN(b.x)]) == gen, bar);
            __builtin_amdgcn_fence(__ATOMIC_ACQUIRE, "agent");
            asm volatile("s_waitcnt vmcnt(0)" ::: "memory");
        }
    }
    __syncthreads();
}

struct Frame {
    LAS unsigned char* lds;
    volatile LAS unsigned* MISC;
    int tid, lane, wave;
    int vcu, G;
    const float *x, *norm_mix, *w_in, *w_pool, *pool_scale, *w_out, *norm_ffn, *w_query, *sub_keys, *expert_u, *expert_v, *norm_final;
    float* out;
    unsigned char* ws;
};

__device__ __forceinline__ float wave_sum(float v) {
#pragma unroll
    for (int o = 1; o < 64; o <<= 1) v += __shfl_xor(v, o);
    return v;
}

__device__ __forceinline__ void p0_transpose_item(const float* W, int N, const float* ks, bf16* WT, int ldo, int col_off, LAS float* scr, int item, int lane) {
    const int nblk = N / 32, kb = item / nblk, nb = item % nblk, k0 = 64 * kb, n0 = 32 * nb;
#pragma unroll 8
    for (int i = 0; i < 32; ++i) { const int kk = 2 * i + (lane >> 5); const float s = ks ? ks[k0 + kk] : 1.f; scr[kk * 33 + (lane & 31)] = W[(size_t)(k0 + kk) * N + n0 + (lane & 31)] * s; }
    LDS_WAIT(); asm volatile("" ::: "memory");
    const int c = lane & 7;
#pragma unroll
    for (int j = 0; j < 4; ++j) { const int n = (lane >> 3) + 8 * j; const LAS float* s = scr + (8 * c) * 33 + n;
        v4u o; o.x = pk2(s[0 * 33], s[1 * 33]); o.y = pk2(s[2 * 33], s[3 * 33]); o.z = pk2(s[4 * 33], s[5 * 33]); o.w = pk2(s[6 * 33], s[7 * 33]);
        *(GAS v4u*)(WT + (size_t)(n0 + n) * ldo + col_off + k0 + 8 * c) = o; }
    LDS_WAIT(); asm volatile("" ::: "memory");
}

__device__ __forceinline__ void p0_prologue(Frame& F) {
    LAS float* scr = (LAS float*)(F.lds + RING_OFF + F.wave * 16384);
    const int gw = F.vcu * NWAVES + F.wave, NGW = F.G * NWAVES;
    bf16* WIN = (bf16*)(F.ws + WS_WIN); bf16* WOUT = (bf16*)(F.ws + WS_WOUT); bf16* WSC = (bf16*)(F.ws + WS_WSC);
    constexpr int I_IN = (D / 64) * (NZ / 32), I_OUT = (DATT / 64) * (D / 32);
    for (int it = gw; it < I_IN + I_OUT; it += NGW) {
        if (it < I_IN) p0_transpose_item(F.w_in, NZ, F.norm_mix, WIN, D, 0, scr, it, F.lane);
        else p0_transpose_item(F.w_out, D, nullptr, WOUT, D, 0, scr, it - I_IN, F.lane);
    }
    const int gt = (F.vcu * NWAVES + F.wave) * 64 + F.lane, NGT = F.G * NWAVES * 64;
    for (int it = gt; it < DPOOL * (D / 4); it += NGT) {
        const int cin = it / (D / 4), n4 = (it % (D / 4)) * 4, g = cin >> 7;
        const float* wp = F.w_pool + (size_t)cin * 128;
        const float* ps = F.pool_scale + g * 128;
        const float* wo = F.w_out + (size_t)(DATT + g * 128) * D + n4;
        f32x4 acc = {0.f, 0.f, 0.f, 0.f};
#pragma unroll 4
        for (int d = 0; d < 128; ++d) { const float a = wp[d] * ps[d]; const f32x4 b = *(const f32x4*)(wo + (size_t)d * D); acc += a * b; }
#pragma unroll
        for (int j = 0; j < 4; ++j) WOUT[(size_t)(n4 + j) * D + DATT + cin] = (bf16)f2bf(acc[j]);
    }
    for (int it = gt; it < 16 * 32 * 256; it += NGT) {
        const int d4 = (it & 255) * 4, k4 = ((it >> 8) & 31) * 4, blk = it >> 13;
        const float* wq = F.w_query + (size_t)d4 * NSC + blk * 128;
        const float* sk = F.sub_keys + (size_t)(blk * 128 + k4) * 128;
        float acc[4][4];
#pragma unroll
        for (int i = 0; i < 4; ++i)
#pragma unroll
            for (int j = 0; j < 4; ++j) acc[i][j] = 0.f;
        for (int c = 0; c < 128; c += 4) {
            f32x4 a[4], b[4];
#pragma unroll
            for (int i = 0; i < 4; ++i) { a[i] = *(const f32x4*)(sk + i * 128 + c); b[i] = *(const f32x4*)(wq + (size_t)i * NSC + c); }
#pragma unroll
            for (int i = 0; i < 4; ++i)
#pragma unroll
                for (int j = 0; j < 4; ++j) acc[i][j] += a[i][0] * b[j][0] + a[i][1] * b[j][1] + a[i][2] * b[j][2] + a[i][3] * b[j][3];
        }
        const f32x4 gf = *(const f32x4*)(F.norm_ffn + d4);
#pragma unroll
        for (int i = 0; i < 4; ++i) { v2u o; o.x = pk2(acc[i][0] * gf[0], acc[i][1] * gf[1]); o.y = pk2(acc[i][2] * gf[2], acc[i][3] * gf[3]);
            *(GAS v2u*)(WSC + (size_t)(blk * 128 + k4 + i) * D + d4) = o; }
    }
    {
        unsigned char* EU = F.ws + WS_EU; unsigned char* EV = F.ws + WS_EV;
        const size_t n16 = (size_t)NEXP * D / 16;
        for (size_t i = gt; i < 2 * n16; i += NGT) {
            const bool second = i >= n16; const size_t j = second ? i - n16 : i;
            const float* src = (second ? F.expert_v : F.expert_u) + j * 16; const float sc = second ? 4.0f : 32.0f;
            v4u o;
#pragma unroll
            for (int q = 0; q < 4; ++q) { const f32x4 a = *(const f32x4*)(src + 4 * q) * sc;
                int w = __builtin_amdgcn_cvt_pk_fp8_f32(a[0], a[1], 0, false); w = __builtin_amdgcn_cvt_pk_fp8_f32(a[2], a[3], w, true); o[q] = (unsigned)w; }
            *(GAS v4u*)((second ? EV : EU) + j * 16) = o;
        }
    }
    {
        bf16* XB = (bf16*)(F.ws + WS_XB); float* R1 = (float*)(F.ws + WS_R1);
        for (int m = gw; m < M; m += NGW) {
            const float* xr = F.x + (size_t)m * D + 8 * F.lane; float s = 0.f;
#pragma unroll
            for (int j = 0; j < 2; ++j) { const f32x4 a = *(const f32x4*)(xr + 512 * j), b = *(const f32x4*)(xr + 512 * j + 4);
                s += (a[0] * a[0] + a[1] * a[1]) + (a[2] * a[2] + a[3] * a[3]) + (b[0] * b[0] + b[1] * b[1]) + (b[2] * b[2] + b[3] * b[3]);
                v4u o; o.x = pk2(a[0], a[1]); o.y = pk2(a[2], a[3]); o.z = pk2(b[0], b[1]); o.w = pk2(b[2], b[3]);
                *(GAS v4u*)(XB + (size_t)m * D + 8 * F.lane + 512 * j) = o; }
            s = wave_sum(s);
            if (F.lane == 0) R1[m] = 1.0f / sqrtf(s * (1.0f / D) + EPS);
        }
    }
}

constexpr int ATT_KEYS = 384, ATT_KCH = ATT_KEYS * 16 + 16;
constexpr int ATT_K_OFF = 0, ATT_V_OFF = 8 * ATT_KCH;
constexpr int ATT_VDH = 24 * 1024 + 64;
constexpr int ATT_OST_OFF = ATT_V_OFF + 2 * ATT_VDH;
constexpr int ATT_LDS_END = ATT_OST_OFF + NWAVES * 4096;
static_assert(ATT_V_OFF % 16 == 0 && ATT_OST_OFF % 16 == 0 && ATT_LDS_END <= LDSCTL_OFF, "attention LDS map");
constexpr int ATT_UNITS = BATCH * NH * 96;

__device__ __forceinline__ int crow(int r, int hi) { return (r & 3) + 8 * (r >> 2) + 4 * hi; }
__device__ __forceinline__ s16x4 vtr(const LAS unsigned char* p) { return __builtin_bit_cast(s16x4, __builtin_amdgcn_ds_read_tr16_b64_v4i16((LAS s16x4*)p)); }

__device__ __forceinline__ void attn_unit(Frame& F, int unit) {
    const int tid = F.tid, lane = F.lane, w = F.wave, r32 = lane & 31, hi = lane >> 5;
    const int bh = unit / 96, rem = unit % 96, br = rem >> 5, idx = rem & 31;
    const int b = bh >> 3, h = bh & 7;
    const int dsh = 2 * br, dil = 1 << dsh;
    const int ppr = 32 >> dsh;
    const int res = idx / ppr, pair = idx % ppr;
    const int s0 = pair * 256 - 128;
    const bf16* Z = (const bf16*)(F.ws + WS_Z);
    const size_t tokbase = (size_t)b * SEQ + res;
    {
        v4u kv[6], vv[6];
#pragma unroll
        for (int it = 0; it < 6; ++it) { const int p = tid + 512 * it, key = p >> 3, c = p & 7; int s = s0 + key; s = s < 0 ? 0 : s;
            const bf16* row = Z + (tokbase + ((size_t)s << dsh)) * NZ + h * HD + c * 8;
            kv[it] = *(const GAS v4u*)(row + DATT); vv[it] = *(const GAS v4u*)(row + 2 * DATT); }
#pragma unroll
        for (int it = 0; it < 6; ++it) { const int p = tid + 512 * it, key = p >> 3, c = p & 7;
            *(LAS v4u*)(F.lds + ATT_K_OFF + c * ATT_KCH + key * 16) = kv[it];
            *(LAS v4u*)(F.lds + ATT_V_OFF + (c >> 2) * ATT_VDH + (key >> 4) * 1024 + (key & 15) * 64 + (c & 3) * 16) = vv[it]; }
    }
    const int sq0 = pair * 256 + 32 * w;
    bf16x8 qr[4];
    {
        const bf16* qrow = Z + (tokbase + ((size_t)(sq0 + r32) << dsh)) * NZ + h * HD + hi * 8;
#pragma unroll
        for (int d0 = 0; d0 < 4; ++d0) qr[d0] = *(const GAS bf16x8*)(qrow + d0 * 16);
    }
    __syncthreads();
    f32x16 p[5];
#pragma unroll
    for (int j = 0; j < 5; ++j) {
        p[j] = f32x16{};
        const LAS unsigned char* kb = F.lds + ATT_K_OFF + hi * ATT_KCH + (32 * (w + j) + r32) * 16;
#pragma unroll
        for (int d0 = 0; d0 < 4; ++d0) { const bf16x8 kf = *(const LAS bf16x8*)(kb + 2 * d0 * ATT_KCH); p[j] = __builtin_amdgcn_mfma_f32_32x32x16_bf16(kf, qr[d0], p[j], 0, 0, 0); }
    }
    const float NEGB = -1e30f;
#pragma unroll
    for (int r = 0; r < 16; ++r) { const int kj = crow(r, hi); if (kj < r32) p[0][r] = NEGB; if (kj > r32) p[4][r] = NEGB; }
    if (pair == 0) {
#pragma unroll
        for (int j = 0; j < 4; ++j) if (w + j < 4) {
#pragma unroll
            for (int r = 0; r < 16; ++r) p[j][r] = NEGB; }
    }
    float mx = NEGB;
#pragma unroll
    for (int j = 0; j < 5; ++j)
#pragma unroll
        for (int r = 0; r < 16; ++r) mx = fmaxf(mx, p[j][r]);
    mx = fmaxf(mx, __shfl_xor(mx, 32));
    float l = 0.f;
#pragma unroll
    for (int j = 0; j < 5; ++j)
#pragma unroll
        for (int r = 0; r < 16; ++r) { const float e = __builtin_amdgcn_exp2f(p[j][r] - mx); p[j][r] = e; l += e; }
    l += __shfl_xor(l, 32);
    f32x16 o[2]; o[0] = f32x16{}; o[1] = f32x16{};
    const LAS unsigned char* vb = F.lds + ATT_V_OFF + (4 * hi + ((lane & 15) >> 2)) * 64 + ((lane >> 4) & 1) * 32 + (lane & 3) * 8;
#pragma unroll
    for (int j = 0; j < 5; ++j)
#pragma unroll
        for (int s = 0; s < 2; ++s) {
            v4u pw; pw.x = pk2(p[j][8 * s + 0], p[j][8 * s + 1]); pw.y = pk2(p[j][8 * s + 2], p[j][8 * s + 3]); pw.z = pk2(p[j][8 * s + 4], p[j][8 * s + 5]); pw.w = pk2(p[j][8 * s + 6], p[j][8 * s + 7]);
            const bf16x8 pa = __builtin_bit_cast(bf16x8, pw);
#pragma unroll
            for (int dh = 0; dh < 2; ++dh) {
                const LAS unsigned char* vp = vb + dh * ATT_VDH + (2 * (w + j) + s) * 1024;
                const s16x4 lo = vtr(vp), hh = vtr(vp + 512);
                const bf16x8 vf = (bf16x8){lo[0], lo[1], lo[2], lo[3], hh[0], hh[1], hh[2], hh[3]};
                o[dh] = __builtin_amdgcn_mfma_f32_32x32x16_bf16(pa, vf, o[dh], 0, 0, 0);
            }
        }
    const float rl = 1.0f / l;
    bf16* OB = (bf16*)(F.ws + WS_OB) + (size_t)br * M * DATT;
    float* LSE = (float*)(F.ws + WS_LSE) + (size_t)br * M * NH;
    LAS bf16* stg = (LAS bf16*)(F.lds + ATT_OST_OFF + w * 4096);
#pragma unroll
    for (int r = 0; r < 16; ++r) { const int orow = crow(r, hi); const float rr = __shfl(rl, orow);
#pragma unroll
        for (int dh = 0; dh < 2; ++dh) stg[orow * 64 + dh * 32 + r32] = (bf16)f2bf(o[dh][r] * rr); }
    if (hi == 0) LSE[(tokbase + ((size_t)(sq0 + r32) << dsh)) * NH + h] = mx + __builtin_amdgcn_logf(l);
    LDS_WAIT();
#pragma unroll
    for (int i = 0; i < 4; ++i) { const int row = i * 8 + (lane >> 3), ch = lane & 7; const v4u v = *(const LAS v4u*)(stg + row * 64 + ch * 8);
        *(GAS v4u*)(OB + (tokbase + ((size_t)(sq0 + row) << dsh)) * DATT + h * HD + ch * 8) = v; }
    __syncthreads();
}

__device__ __forceinline__ void pool_rows(Frame& F) {
    const bf16* Z = (const bf16*)(F.ws + WS_Z); bf16* MIX = (bf16*)(F.ws + WS_MIX);
    const int gw = F.vcu * NWAVES + F.wave, NGW = F.G * NWAVES;
    const int win = 2 << (F.lane >> 4);
    constexpr int TPW = 16;
    for (int it = gw; it < M / TPW; it += NGW) {
        for (int i = 0; i < TPW; ++i) {
            const int t = it * TPW + i, s = t & (SEQ - 1);
            const int cnt = (s + 1) < win ? (s + 1) : win;
            const bf16* zr = Z + (size_t)t * NZ + 3 * DATT + 8 * F.lane;
            float acc[8];
#pragma unroll
            for (int e = 0; e < 8; ++e) acc[e] = 0.f;
            v4u z0 = *(const GAS v4u*)zr;
            for (int j = 0; j < cnt; ++j) { const v4u v = *(const GAS v4u*)(zr - (size_t)j * NZ);
                acc[0] += bflo(v.x); acc[1] += bfhi(v.x); acc[2] += bflo(v.y); acc[3] += bfhi(v.y); acc[4] += bflo(v.z); acc[5] += bfhi(v.z); acc[6] += bflo(v.w); acc[7] += bfhi(v.w); }
            const float inv = 1.0f / (float)cnt;
            v4u o; o.x = pk2(acc[0] * inv - bflo(z0.x), acc[1] * inv - bfhi(z0.x)); o.y = pk2(acc[2] * inv - bflo(z0.y), acc[3] * inv - bfhi(z0.y));
            o.z = pk2(acc[4] * inv - bflo(z0.z), acc[5] * inv - bfhi(z0.z)); o.w = pk2(acc[6] * inv - bflo(z0.w), acc[7] * inv - bfhi(z0.w));
            *(GAS v4u*)(MIX + (size_t)t * D + DATT + 8 * F.lane) = o;
        }
    }
}

__device__ __forceinline__ void merge_rows(Frame& F) {
    const bf16* OB = (const bf16*)(F.ws + WS_OB); const float* LSE = (const float*)(F.ws + WS_LSE); bf16* MIX = (bf16*)(F.ws + WS_MIX);
    const int gw = F.vcu * NWAVES + F.wave, NGW = F.G * NWAVES;
    for (int t = gw; t < M; t += NGW) {
        const int h = F.lane >> 3;
        const float l0 = LSE[(size_t)t * NH + h], l1 = LSE[(size_t)(M + t) * NH + h], l2 = LSE[(size_t)(2 * M + t) * NH + h];
        const float mx = fmaxf(l0, fmaxf(l1, l2));
        float w0 = __builtin_amdgcn_exp2f(l0 - mx), w1 = __builtin_amdgcn_exp2f(l1 - mx), w2 = __builtin_amdgcn_exp2f(l2 - mx);
        const float inv = 1.0f / (w0 + w1 + w2); w0 *= inv; w1 *= inv; w2 *= inv;
        const size_t off = (size_t)t * DATT + 8 * F.lane;
        const v4u a = *(const GAS v4u*)(OB + off), b = *(const GAS v4u*)(OB + (size_t)M * DATT + off), c = *(const GAS v4u*)(OB + (size_t)2 * M * DATT + off);
        v4u o;
        o.x = pk2(w0 * bflo(a.x) + w1 * bflo(b.x) + w2 * bflo(c.x), w0 * bfhi(a.x) + w1 * bfhi(b.x) + w2 * bfhi(c.x));
        o.y = pk2(w0 * bflo(a.y) + w1 * bflo(b.y) + w2 * bflo(c.y), w0 * bfhi(a.y) + w1 * bfhi(b.y) + w2 * bfhi(c.y));
        o.z = pk2(w0 * bflo(a.z) + w1 * bflo(b.z) + w2 * bflo(c.z), w0 * bfhi(a.z) + w1 * bfhi(b.z) + w2 * bfhi(c.z));
        o.w = pk2(w0 * bflo(a.w) + w1 * bflo(b.w) + w2 * bflo(c.w), w0 * bfhi(a.w) + w1 * bfhi(b.w) + w2 * bfhi(c.w));
        *(GAS v4u*)(MIX + (size_t)t * D + 8 * F.lane) = o;
    }
}

constexpr int TK_ROW = 68;
constexpr int TK_WAVE_BYTES = 64 * TK_ROW * 4;
static_assert(NWAVES * TK_WAVE_BYTES <= LDSCTL_OFF, "top-k LDS map");

__device__ __forceinline__ unsigned f2ord(float f) { const unsigned u = __builtin_bit_cast(unsigned, f); return (u & 0x80000000u) ? ~u : (u | 0x80000000u); }
__device__ __forceinline__ float ord2f(unsigned k) { const unsigned u = (k & 0x80000000u) ? (k & 0x7fffffffu) : ~k; return __builtin_bit_cast(float, u); }
#define TK_INSERT(L, xin) do { unsigned x_ = (xin); _Pragma("unroll") for (int i_ = 0; i_ < 16; ++i_) { const unsigned hi_ = max(L[i_], x_); x_ = min(L[i_], x_); L[i_] = hi_; } } while (0)

__device__ __forceinline__ void topk_phase(Frame& F) {
    const float* SC = (const float*)(F.ws + WS_SC); const float* SS = (const float*)(F.ws + WS_SS);
    int* IDX = (int*)(F.ws + WS_IDX); float* GATE = (float*)(F.ws + WS_GATE);
    const int gw = F.vcu * NWAVES + F.wave, NGW = F.G * NWAVES, lane = F.lane;
    LAS float* st = (LAS float*)(F.lds + F.wave * TK_WAVE_BYTES);
    for (int it = gw; it < M / 8; it += NGW) {
        const int t0 = it * 8;
        unsigned L0[16], L1[16];
#pragma unroll
        for (int i = 0; i < 16; ++i) { L0[i] = 0u; L1[i] = 0u; }
#pragma unroll
        for (int rnd = 0; rnd < 4; ++rnd) {
            const int p = rnd >> 1, kc = rnd & 1;
#pragma unroll
            for (int i = 0; i < 16; ++i) { const int pr = 4 * i + (lane >> 4), tl = pr >> 3, h = pr & 7;
                const f32x4 v = *(const GAS f32x4*)(SC + (size_t)(t0 + tl) * NSC + h * 256 + p * 128 + kc * 64 + (lane & 15) * 4);
                *(LAS f32x4*)(st + pr * TK_ROW + (lane & 15) * 4) = v; }
            LDS_WAIT(); asm volatile("" ::: "memory");
#pragma unroll 1
            for (int q = 0; q < 16; ++q) {
                const f32x4 v = *(const LAS f32x4*)(st + lane * TK_ROW + q * 4);
#pragma unroll
                for (int e = 0; e < 4; ++e) { const unsigned key = (f2ord(v[e]) & ~127u) | (unsigned)(127 - (kc * 64 + q * 4 + e));
                    if (p == 0) TK_INSERT(L0, key); else TK_INSERT(L1, key); }
            }
            LDS_WAIT(); asm volatile("" ::: "memory");
        }
        LAS float* pv0 = st; LAS float* pv1 = st + 16 * 64; LAS int* pi0 = (LAS int*)(st + 32 * 64); LAS int* pi1 = (LAS int*)(st + 48 * 64);
        float v0[16], v1[16];
#pragma unroll
        for (int i = 0; i < 16; ++i) { v0[i] = ord2f(L0[i] & ~127u); v1[i] = ord2f(L1[i] & ~127u);
            pv0[i * 64 + lane] = v0[i]; pv1[i * 64 + lane] = v1[i]; pi0[i * 64 + lane] = 127 - (int)(L0[i] & 127u); pi1[i * 64 + lane] = 127 - (int)(L1[i] & 127u); }
        unsigned T[16];
#pragma unroll
        for (int i = 0; i < 16; ++i) T[i] = 0u;
#pragma unroll
        for (int i = 0; i < 16; ++i)
#pragma unroll
            for (int j = 0; j < 16; ++j) if ((i + 1) * (j + 1) <= 16) { const unsigned key = (f2ord(v0[i] + v1[j]) & ~255u) | (unsigned)(255 - (i * 16 + j)); TK_INSERT(T, key); }
        LDS_WAIT(); asm volatile("" ::: "memory");
        const int tl = lane >> 3, h = lane & 7, t = t0 + tl;
        float ssum = 0.f;
        { const float* sp = SS + (size_t)t * 16;
#pragma unroll
          for (int i = 0; i < 4; ++i) { const f32x4 v = *(const GAS f32x4*)(sp + 4 * i); ssum += (v[0] + v[1]) + (v[2] + v[3]); } }
        const float r2 = 1.0f / sqrtf(ssum * (1.0f / D) + EPS);
        float bs[16]; int ex[16]; float mxs = -3.0e38f;
#pragma unroll
        for (int k = 0; k < 16; ++k) { const int pos = 255 - (int)(T[k] & 255u), i = pos >> 4, j = pos & 15;
            bs[k] = (pv0[i * 64 + lane] + pv1[j * 64 + lane]) * r2; ex[k] = pi0[i * 64 + lane] * NKEYS + pi1[j * 64 + lane]; mxs = fmaxf(mxs, bs[k]); }
        float den = 0.f;
#pragma unroll
        for (int k = 0; k < 16; ++k) { bs[k] = __expf(bs[k] - mxs); den += bs[k]; }
        const float inv = 1.0f / den;
        int* ip = IDX + ((size_t)t * PEER_H + h) * TOPK; float* gp = GATE + ((size_t)t * PEER_H + h) * TOPK;
#pragma unroll
        for (int k = 0; k < 16; k += 4) { *(GAS v4u*)(ip + k) = (v4u){(unsigned)ex[k], (unsigned)ex[k + 1], (unsigned)ex[k + 2], (unsigned)ex[k + 3]};
            *(GAS f32x4*)(gp + k) = (f32x4){bs[k] * inv, bs[k + 1] * inv, bs[k + 2] * inv, bs[k + 3] * inv}; }
        LDS_WAIT(); asm volatile("" ::: "memory");
    }
}

typedef float f32x2 __attribute__((ext_vector_type(2)));
constexpr float EU_SCALE = 32.0f, EV_SCALE = 4.0f;
__device__ __forceinline__ float gelu_erf(float a) { return 0.5f * a * (1.0f + erff(a * 0.70710678118654752f)); }

__device__ __forceinline__ void peer_load(v4u (&u)[8], v4u (&v)[8], const unsigned char* EU, const unsigned char* EV, int isel, int base, int lane) {
#pragma unroll
    for (int k = 0; k < 8; ++k) { const int e = __builtin_amdgcn_readlane(isel, base + k);
        u[k] = *(const GAS v4u*)(EU + (size_t)e * D + 16 * lane); v[k] = *(const GAS v4u*)(EV + (size_t)e * D + 16 * lane); }
}
__device__ __forceinline__ void peer_compute(const v4u (&u)[8], const v4u (&v)[8], const f32x2 (&hf)[8], f32x2 (&y)[8], float gsel, int base, int lane) {
    float pa[8];
#pragma unroll
    for (int k = 0; k < 8; ++k) { f32x2 s = {0.f, 0.f};
#pragma unroll
        for (int d = 0; d < 4; ++d) { const int w = (int)u[k][d];
            s += __builtin_amdgcn_cvt_pk_f32_fp8(w, false) * hf[2 * d]; s += __builtin_amdgcn_cvt_pk_f32_fp8(w, true) * hf[2 * d + 1]; }
        pa[k] = s.x + s.y; }
    float q4[4], q2[2], q1;
#pragma unroll
    for (int i = 0; i < 4; ++i) { const bool up = (lane & 32) != 0; const float keep = up ? pa[i + 4] : pa[i], send = up ? pa[i] : pa[i + 4]; q4[i] = keep + __shfl_xor(send, 32); }
#pragma unroll
    for (int i = 0; i < 2; ++i) { const bool up = (lane & 16) != 0; const float keep = up ? q4[i + 2] : q4[i], send = up ? q4[i] : q4[i + 2]; q2[i] = keep + __shfl_xor(send, 16); }
    { const bool up = (lane & 8) != 0; const float keep = up ? q2[1] : q2[0], send = up ? q2[0] : q2[1]; q1 = keep + __shfl_xor(send, 8); }
    q1 += __shfl_xor(q1, 4); q1 += __shfl_xor(q1, 2); q1 += __shfl_xor(q1, 1);
    const int kk = ((lane >> 5) & 1) * 4 + ((lane >> 4) & 1) * 2 + ((lane >> 3) & 1);
    const float gk = __shfl(gsel, base + kk);
    const float act = gelu_erf(q1 * (1.0f / EU_SCALE)) * gk * (1.0f / EV_SCALE);
#pragma unroll
    for (int k = 0; k < 8; ++k) {
        const int src = ((k >> 2) & 1) * 32 + ((k >> 1) & 1) * 16 + (k & 1) * 8;
        const float ak = __builtin_bit_cast(float, __builtin_amdgcn_readlane(__builtin_bit_cast(int, act), src));
        const f32x2 ak2 = {ak, ak};
#pragma unroll
        for (int d = 0; d < 4; ++d) { const int w = (int)v[k][d];
            y[2 * d] += ak2 * __builtin_amdgcn_cvt_pk_f32_fp8(w, false); y[2 * d + 1] += ak2 * __builtin_amdgcn_cvt_pk_f32_fp8(w, true); }
    }
}

__device__ __forceinline__ void peer_phase(Frame& F) {
    const float* X1 = F.out; const float* SS = (const float*)(F.ws + WS_SS);
    const int* IDX = (const int*)(F.ws + WS_IDX); const float* GATE = (const float*)(F.ws + WS_GATE);
    const unsigned char* EU = F.ws + WS_EU; const unsigned char* EV = F.ws + WS_EV;
    const int gw = F.vcu * NWAVES + F.wave, NGW = F.G * NWAVES, lane = F.lane;
    for (int t = gw; t < M; t += NGW) {
        f32x2 x1[8], hf[8], y[8];
        const float* xr = X1 + (size_t)t * D + 16 * lane;
#pragma unroll
        for (int j = 0; j < 4; ++j) { const f32x4 a = *(const GAS f32x4*)(xr + 4 * j); x1[2 * j] = (f32x2){a[0], a[1]}; x1[2 * j + 1] = (f32x2){a[2], a[3]}; }
        float ssum;
        { const float* sp = SS + (size_t)t * 16; float s = sp[lane & 15]; s += __shfl_xor(s, 1); s += __shfl_xor(s, 2); s += __shfl_xor(s, 4); s += __shfl_xor(s, 8); ssum = s; }
        const float r2 = 1.0f / sqrtf(ssum * (1.0f / D) + EPS);
#pragma unroll
        for (int j = 0; j < 4; ++j) { const f32x4 g = *(const GAS f32x4*)(F.norm_ffn + 16 * lane + 4 * j);
            hf[2 * j] = x1[2 * j] * r2 * (f32x2){g[0], g[1]}; hf[2 * j + 1] = x1[2 * j + 1] * r2 * (f32x2){g[2], g[3]}; }
#pragma unroll
        for (int e = 0; e < 8; ++e) y[e] = (f32x2){0.f, 0.f};
        const int ia = IDX[(size_t)t * 128 + lane], ib = IDX[(size_t)t * 128 + 64 + lane];
        const float ga = GATE[(size_t)t * 128 + lane], gb = GATE[(size_t)t * 128 + 64 + lane];
        v4u uA[8], vA[8], uB[8], vB[8];
        peer_load(uA, vA, EU, EV, ia, 0, lane);
#pragma unroll 1
        for (int bt = 0; bt < 16; bt += 2) {
            const int isel = bt < 8 ? ia : ib; const float gsel = bt < 8 ? ga : gb; const int base = (bt & 7) * 8;
            peer_load(uB, vB, EU, EV, isel, base + 8, lane);
            peer_compute(uA, vA, hf, y, gsel, base, lane);
            if (bt + 2 < 16) { const int isel2 = (bt + 2) < 8 ? ia : ib; peer_load(uA, vA, EU, EV, isel2, ((bt + 2) & 7) * 8, lane); }
            peer_compute(uB, vB, hf, y, gsel, base + 8, lane);
        }
        float s2 = 0.f;
#pragma unroll
        for (int e = 0; e < 8; ++e) { y[e] += x1[e]; s2 += y[e].x * y[e].x + y[e].y * y[e].y; }
        s2 = wave_sum(s2);
        const float r3 = 1.0f / sqrtf(s2 * (1.0f / D) + EPS);
        float* orow = F.out + (size_t)t * D + 16 * lane;
#pragma unroll
        for (int j = 0; j < 4; ++j) { const f32x4 g = *(const GAS f32x4*)(F.norm_final + 16 * lane + 4 * j);
            *(GAS f32x4*)(orow + 4 * j) = (f32x4){y[2 * j].x * r3 * g[0], y[2 * j].y * r3 * g[1], y[2 * j + 1].x * r3 * g[2], y[2 * j + 1].y * r3 * g[3]}; }
    }
}

struct Args { const float* in[12]; float* out; unsigned char* ws; };
__global__ void __launch_bounds__(NWAVES * 64, 2) hymba_fwd(Args args) {
    extern __shared__ __attribute__((aligned(16))) unsigned char lds[];
    Frame F;
    F.lds = (LAS unsigned char*)lds;
    F.MISC = (volatile LAS unsigned*)(F.lds + MISC_OFF);
    F.tid = threadIdx.x; F.lane = F.tid & 63; F.wave = __builtin_amdgcn_readfirstlane(F.tid >> 6);
    F.G = gridDim.x; { const int bx = blockIdx.x; F.vcu = (F.G % 8 == 0) ? (bx % 8) * (F.G / 8) + bx / 8 : bx; }
    F.x = args.in[0]; F.norm_mix = args.in[1]; F.w_in = args.in[2]; F.w_pool = args.in[3]; F.pool_scale = args.in[4]; F.w_out = args.in[5];
    F.norm_ffn = args.in[6]; F.w_query = args.in[7]; F.sub_keys = args.in[8]; F.expert_u = args.in[9]; F.expert_v = args.in[10]; F.norm_final = args.in[11];
    F.out = args.out; F.ws = args.ws;
    for (int u = F.tid; u < (LDS_BYTES - LDSCTL_OFF) / 4; u += NWAVES * 64) ((LAS unsigned*)(F.lds + LDSCTL_OFF))[u] = 0u;
    __syncthreads();
    XcdBarrier bar = xcd_barrier_post((unsigned*)(F.ws + WS_CTL), F.MISC + 8);
#define GRID_BAR() xcd_barrier(bar)

    p0_prologue(F);
    GRID_BAR();
    {
        pg8::Gemm g{(const pg8::bf16_t*)(F.ws + WS_XB), (const pg8::bf16_t*)(F.ws + WS_WIN), M, NZ, D}; pg8::StaticOrder S; S.init(M, NZ, F.G, (int)blockIdx.x);
        pg8::EpiZ E{(pg8::bf16_t*)(F.ws + WS_Z), NZ, (const float*)(F.ws + WS_R1), DATT, QSCALE};
        pg8::gemm_phase<pg8::EpiZ, pg8::StaticOrder, PG8_ALIGN, PG8_SP2>(F.lds + RING_OFF, g, S, E);
    }
    GRID_BAR();
    for (int u = F.vcu; u < ATT_UNITS; u += F.G) attn_unit(F, u);
    pool_rows(F);
    GRID_BAR();
    merge_rows(F);
    GRID_BAR();
    {
        pg8::Gemm g{(const pg8::bf16_t*)(F.ws + WS_MIX), (const pg8::bf16_t*)(F.ws + WS_WOUT), M, D, D}; pg8::StaticOrder S; S.init(M, D, F.G, (int)blockIdx.x);
        pg8::EpiRes E{F.x, F.out, (pg8::bf16_t*)(F.ws + WS_XB), (float*)(F.ws + WS_SS), D};
        pg8::gemm_phase<pg8::EpiRes, pg8::StaticOrder, PG8_ALIGN, PG8_SP2>(F.lds + RING_OFF, g, S, E);
    }
    GRID_BAR();
    {
        pg8::Gemm g{(const pg8::bf16_t*)(F.ws + WS_XB), (const pg8::bf16_t*)(F.ws + WS_WSC), M, NSC, D}; pg8::StaticOrder S; S.init(M, NSC, F.G, (int)blockIdx.x);
        pg8::EpiF32 E{(float*)(F.ws + WS_SC), NSC};
        pg8::gemm_phase<pg8::EpiF32, pg8::StaticOrder, PG8_ALIGN, PG8_SP2>(F.lds + RING_OFF, g, S, E);
    }
    GRID_BAR();
    topk_phase(F);
    GRID_BAR();
    peer_phase(F);
}

extern "C" void kernel_launch(void* const* d_in, const int* in_sizes, int n_in, void* d_out, int out_size, void* d_ws, size_t ws_size, hipStream_t stream) {
    static int grid = 0;
    if (grid == 0) {
        if (n_in != 12 || in_sizes[0] != M * D || out_size != M * D || ws_size < WS_END) { fprintf(stderr, "kernel_launch: unexpected shapes (n_in %d, in0 %d, out %d, ws %zu); nothing launched\n", n_in, n_in > 0 ? in_sizes[0] : -1, out_size, ws_size); grid = -1; return; }
        int dev = 0, cus = 0, per_cu = 0;
        if (hipGetDevice(&dev) != hipSuccess || hipDeviceGetAttribute(&cus, hipDeviceAttributeMultiprocessorCount, dev) != hipSuccess) { grid = -1; return; }
        if (hipFuncSetAttribute((const void*)hymba_fwd, hipFuncAttributeMaxDynamicSharedMemorySize, LDS_BYTES) != hipSuccess) { fprintf(stderr, "kernel_launch: hipFuncSetAttribute failed\n"); grid = -1; return; }
        if (hipOccupancyMaxActiveBlocksPerMultiprocessor(&per_cu, (const void*)hymba_fwd, NWAVES * 64, LDS_BYTES) != hipSuccess || per_cu < 1)
            fprintf(stderr, "kernel_launch: note: occupancy query reports %d workgroups per CU\n", per_cu);
        (void)hipGetLastError();
        grid = cus;
    }
    if (grid < 0) return;
    if (hipMemsetAsync((char*)d_ws + WS_CTL, 0, CTL_ZERO_BYTES, stream) != hipSuccess) { fprintf(stderr, "kernel_launch: hipMemsetAsync failed\n"); return; }
    Args a{};
    for (int i = 0; i < 12; ++i) a.in[i] = (const float*)d_in[i];
    a.out = (float*)d_out; a.ws = (unsigned char*)d_ws;
    hipLaunchKernelGGL(hymba_fwd, dim3(grid), dim3(NWAVES * 64), LDS_BYTES, stream, a);
    const hipError_t le = hipPeekAtLastError();
    if (le != hipSuccess) fprintf(stderr, "kernel_launch: launch failed: %s\n", hipGetErrorName(le));
}
```

```cpp
#include <hip/hip_runtime.h>
#include <cstdio>
#include <cstdint>
namespace pg8 {
#define PG8_LAS __attribute__((address_space(3)))
typedef unsigned short bf16_t;
typedef short bf16x8 __attribute__((ext_vector_type(8)));
typedef float f32x4 __attribute__((ext_vector_type(4)));
typedef unsigned u32x4 __attribute__((ext_vector_type(4)));
constexpr int BM = 256, BK = 64, HALF = 128, HTB = HALF * BK * 2  , STAGE_BYTES = 8 * HTB, NXCD = 8, WGM = 8;

__host__ __device__ __forceinline__ int lds_byte(int r, int c) { const int st = (r >> 4) * 2 + (c >> 5), rr = r & 15, cc = c & 31, ob = rr * 64 + cc * 2; return st * 1024 + (ob ^ (((ob >> 9) & 1) << 5)); }
__host__ __device__ __forceinline__ void stage_rc(int b, int& R, int& C) { const int st = b / 1024, sb = b % 1024, swz = sb ^ (((sb >> 9) & 1) << 5); R = (st >> 1) * 16 + swz / 64; C = (st & 1) * 32 + (swz % 64) / 2; }
__host__ __device__ __forceinline__ int perm32(int rho) { const int n = rho >> 4, i = rho & 15; return 8 * (i >> 2) + 4 * n + (i & 3); }

struct Unit { int pm, pn; };
struct Gemm { const bf16_t* A; const bf16_t* Bt; int M, N, K; };

struct StaticOrder {
    int nM, nN, nwg, G, c;
    __host__ __device__ void init(int M, int N, int G_, int c_) { nM = M / BM; nN = N / BM; nwg = nM * nN; G = G_; c = c_; }
    __host__ __device__ bool next(int i, Unit& u) const {
        const long L = (long)i * G + c; if (L >= nwg) return false;
        int wgid = (int)L; { const int q = nwg / NXCD, r = nwg % NXCD, xcd = wgid % NXCD, off = wgid / NXCD; wgid = (xcd < r ? xcd * (q + 1) : r * (q + 1) + (xcd - r) * q) + off; }
        const int nig = WGM * nN, gid = wgid / nig, fm = gid * WGM, gsz = (nM - fm) < WGM ? (nM - fm) : WGM;
        u.pm = fm + ((wgid % nig) % gsz); u.pn = (wgid % nig) / gsz; return true;
    }
    __device__ __forceinline__ void a_ready(const Unit&) const {}
    __device__ __forceinline__ void done(const Unit&) const {}
};

__device__ __forceinline__ unsigned cvt_pk_bf16(float lo, float hi) { unsigned r; asm volatile("v_cvt_pk_bf16_f32 %0, %1, %2" : "=v"(r) : "v"(lo), "v"(hi)); return r; }
struct EpiZ {
    static constexpr bool PERM = true, AFTER_DRAIN = false;
    bf16_t* O; int ldc; const float* rs; int qcols; float qscale;
    __device__ __forceinline__ void operator()(const f32x4 (&acc)[2][2][4][2], const Unit& u, int wr, int wc, int fr, int fq) const {
        const int row0 = u.pm * BM + wr * 64 + fr; const int colt = u.pn * BM;
        const float sc = (colt < qcols) ? qscale : 1.f;
        const int col0 = colt + wc * 32 + 8 * fq;
#pragma unroll
        for (int ai = 0; ai < 2; ++ai)
#pragma unroll
            for (int m = 0; m < 4; ++m) { const int row = row0 + ai * HALF + m * 16; const float s = rs[row] * sc; bf16_t* rowp = O + (size_t)row * ldc + col0;
#pragma unroll
                for (int bj = 0; bj < 2; ++bj) { const f32x4 v0 = acc[ai][bj][m][0] * s, v1 = acc[ai][bj][m][1] * s;
                    u32x4 w; w.x = cvt_pk_bf16(v0[0], v0[1]); w.y = cvt_pk_bf16(v0[2], v0[3]); w.z = cvt_pk_bf16(v1[0], v1[1]); w.w = cvt_pk_bf16(v1[2], v1[3]);
                    *(u32x4*)(rowp + bj * HALF) = w; } }
    }
};
struct EpiRes {
    static constexpr bool PERM = true, AFTER_DRAIN = false;
    const float* X; float* X1; bf16_t* X1b; float* SS; int ldc;
    __device__ __forceinline__ void operator()(const f32x4 (&acc)[2][2][4][2], const Unit& u, int wr, int wc, int fr, int fq) const {
        const int row0 = u.pm * BM + wr * 64 + fr; const int col0 = u.pn * BM + wc * 32 + 8 * fq;
#pragma unroll
        for (int ai = 0; ai < 2; ++ai)
#pragma unroll
            for (int m = 0; m < 4; ++m) { const int row = row0 + ai * HALF + m * 16; const size_t off = (size_t)row * ldc + col0; float ss = 0.f;
#pragma unroll
                for (int bj = 0; bj < 2; ++bj) {
                    const f32x4 x0 = *(const f32x4*)(X + off + bj * HALF), x1 = *(const f32x4*)(X + off + bj * HALF + 4);
                    const f32x4 v0 = acc[ai][bj][m][0] + x0, v1 = acc[ai][bj][m][1] + x1;
                    *(f32x4*)(X1 + off + bj * HALF) = v0; *(f32x4*)(X1 + off + bj * HALF + 4) = v1;
                    ss += (v0[0] * v0[0] + v0[1] * v0[1]) + (v0[2] * v0[2] + v0[3] * v0[3]) + (v1[0] * v1[0] + v1[1] * v1[1]) + (v1[2] * v1[2] + v1[3] * v1[3]);
                    u32x4 w; w.x = cvt_pk_bf16(v0[0], v0[1]); w.y = cvt_pk_bf16(v0[2], v0[3]); w.z = cvt_pk_bf16(v1[0], v1[1]); w.w = cvt_pk_bf16(v1[2], v1[3]);
                    *(u32x4*)(X1b + off + bj * HALF) = w; }
                ss += __shfl_xor(ss, 16); ss += __shfl_xor(ss, 32);
                if (fq == 0) SS[(size_t)row * 16 + u.pn * 4 + wc] = ss;
                if (m & 1) asm volatile("" ::: "memory"); }
    }
};
struct EpiF32 {
    static constexpr bool PERM = true, AFTER_DRAIN = false;
    float* O; int ldc;
    __device__ __forceinline__ void operator()(const f32x4 (&acc)[2][2][4][2], const Unit& u, int wr, int wc, int fr, int fq) const {
        const int row0 = u.pm * BM + wr * 64 + fr; const int col0 = u.pn * BM + wc * 32 + 8 * fq;
#pragma unroll
        for (int ai = 0; ai < 2; ++ai)
#pragma unroll
            for (int m = 0; m < 4; ++m) { float* rowp = O + (size_t)(row0 + ai * HALF + m * 16) * ldc + col0;
#pragma unroll
                for (int bj = 0; bj < 2; ++bj) { *(f32x4*)(rowp + bj * HALF) = acc[ai][bj][m][0]; *(f32x4*)(rowp + bj * HALF + 4) = acc[ai][bj][m][1]; } }
    }
};

template <class Epi, class Sched, bool ALIGN_EPI = false, bool SP2 = false>
__device__ __forceinline__ void gemm_phase(PG8_LAS unsigned char* lds, const Gemm g, const Sched& S, const Epi& E) {
    const int tid = threadIdx.x, wid = __builtin_amdgcn_readfirstlane(tid >> 6), lane = tid & 63, wr = wid >> 2, wc = wid & 3, fr = lane & 15, fq = lane >> 4;
    const int K = g.K, nt = K / BK;
    unsigned voffA[2], voffB[2];
#pragma unroll
    for (int i = 0; i < 2; ++i) { int R, C; stage_rc(tid * 16 + i * 8192, R, C); const int Rb = Epi::PERM ? ((R & ~31) + perm32(R & 31)) : R;
        voffA[i] = (unsigned)(R * K + C) * 2u; voffB[i] = (unsigned)(Rb * K + C) * 2u; }
    const size_t kstep = (size_t)(BK * 2);
    const size_t hstep = (size_t)HALF * K * 2;
    const size_t tstep = 2 * hstep;
    const unsigned ldsw = (unsigned)wid * 1024u;
    const int aoff = lds_byte(wr * 64 + fr, fq * 8), boff = lds_byte(wc * 32 + fr, fq * 8);
#define PG8_SA(b, h) (((b) * 2 + (h)) * HTB)
#define PG8_SB(b, h) ((4 + (b) * 2 + (h)) * HTB)
#define PG8_STAGE(bufoff, gbase, voff) do { _Pragma("unroll") for (int _i = 0; _i < 2; ++_i) \
        __builtin_amdgcn_global_load_lds((const unsigned*)((const char*)(gbase) + (voff)[_i]), (PG8_LAS unsigned*)(lds + (bufoff) + ldsw + _i * 8192), 16, 0, 0); } while (0)
#define PG8_LDA(dst, b, h) do { _Pragma("unroll") for (int m = 0; m < 4; ++m) _Pragma("unroll") for (int k = 0; k < 2; ++k) dst[m][k] = *(const PG8_LAS bf16x8*)(lds + PG8_SA(b, h) + aoff + m * 2048 + k * 1024); } while (0)
#define PG8_LDB(dst, b, h) do { _Pragma("unroll") for (int n = 0; n < 2; ++n) _Pragma("unroll") for (int k = 0; k < 2; ++k) dst[n][k] = *(const PG8_LAS bf16x8*)(lds + PG8_SB(b, h) + boff + n * 2048 + k * 1024); } while (0)
#define PG8_MMA(ai, bj, At, Bt) do { __builtin_amdgcn_s_setprio(1); _Pragma("unroll") for (int m = 0; m < 4; ++m) _Pragma("unroll") for (int n = 0; n < 2; ++n) _Pragma("unroll") for (int k = 0; k < 2; ++k) \
        acc[ai][bj][m][n] = __builtin_amdgcn_mfma_f32_16x16x32_bf16(Bt[n][k], At[m][k], acc[ai][bj][m][n], 0, 0, 0); __builtin_amdgcn_s_setprio(0); } while (0)
#define PG8_WAIT_V(n) asm volatile("s_waitcnt vmcnt(" #n ")" ::: "memory")
#define PG8_WAIT_L(n) asm volatile("s_waitcnt lgkmcnt(" #n ")" ::: "memory")
#define PG8_BAR __builtin_amdgcn_s_barrier()
#define PG8_SCHED __builtin_amdgcn_sched_barrier(0)
    Unit cur, nxt; int ui = 0;
    if (!S.next(0, cur)) return;
    f32x4 acc[2][2][4][2];
#pragma unroll
    for (int a = 0; a < 2; ++a)
#pragma unroll
        for (int b = 0; b < 2; ++b)
#pragma unroll
            for (int m = 0; m < 4; ++m)
#pragma unroll
                for (int n = 0; n < 2; ++n) acc[a][b][m][n] = (f32x4){0.f, 0.f, 0.f, 0.f};
    bf16x8 At[4][2], B0[2][2], B1[2][2];
    const char* cA = (const char*)g.A + (size_t)cur.pm * tstep; const char* cB = (const char*)g.Bt + (size_t)cur.pn * tstep;
    S.a_ready(cur);
    if constexpr (SP2) {
        PG8_STAGE(PG8_SB(0, 0), cB, voffB); PG8_STAGE(PG8_SB(0, 1), cB + hstep, voffB); PG8_STAGE(PG8_SA(0, 0), cA, voffA); PG8_STAGE(PG8_SA(0, 1), cA + hstep, voffA);
        if (wr == 1) PG8_BAR;
        PG8_WAIT_V(2); PG8_BAR;
        PG8_STAGE(PG8_SB(1, 0), cB + kstep, voffB); PG8_STAGE(PG8_SA(1, 0), cA + kstep, voffA); PG8_STAGE(PG8_SB(1, 1), cB + hstep + kstep, voffB);
        PG8_WAIT_V(6); PG8_BAR;
    } else {
        PG8_STAGE(PG8_SB(0, 0), cB, voffB); PG8_STAGE(PG8_SA(0, 0), cA, voffA); PG8_STAGE(PG8_SB(0, 1), cB + hstep, voffB); PG8_STAGE(PG8_SA(0, 1), cA + hstep, voffA);
        if (wr == 1) PG8_BAR;
        PG8_WAIT_V(4); PG8_BAR;
        PG8_STAGE(PG8_SB(1, 0), cB + kstep, voffB); PG8_STAGE(PG8_SA(1, 0), cA + kstep, voffA); PG8_STAGE(PG8_SB(1, 1), cB + hstep + kstep, voffB);
        PG8_WAIT_V(6); PG8_BAR;
    }
    for (;;) {
        const bool has_next = S.next(ui + 1, nxt);
        const char* nA = has_next ? (const char*)g.A + (size_t)nxt.pm * tstep : cA; const char* nB = has_next ? (const char*)g.Bt + (size_t)nxt.pn * tstep : cB;
        for (int t = 0; t < nt; t += 2) {
            const bool last = (t == nt - 2);
            const char* a1 = cA + (size_t)(t + 1) * kstep;
            const char* a2 = last ? nA : cA + (size_t)(t + 2) * kstep; const char* b2 = last ? nB : cB + (size_t)(t + 2) * kstep;
            const char* a3 = a2 + kstep; const char* b3 = b2 + kstep;
            if (last && has_next) S.a_ready(nxt);
            if constexpr (SP2) {
            PG8_LDB(B0, 0, 0); PG8_LDB(B1, 0, 1); PG8_SCHED; PG8_LDA(At, 0, 0); PG8_STAGE(PG8_SA(1, 1), a1 + hstep, voffA);
            PG8_WAIT_V(8); PG8_WAIT_L(0); PG8_BAR; PG8_MMA(0, 0, At, B0); PG8_MMA(0, 1, At, B1); PG8_BAR; PG8_SCHED;
            PG8_LDA(At, 0, 1); PG8_STAGE(PG8_SB(0, 0), b2, voffB); PG8_STAGE(PG8_SB(0, 1), b2 + hstep, voffB); PG8_STAGE(PG8_SA(0, 0), a2, voffA);
            PG8_WAIT_V(8); PG8_WAIT_L(0); PG8_BAR; PG8_MMA(1, 0, At, B0); PG8_MMA(1, 1, At, B1); PG8_BAR; PG8_SCHED;
            PG8_LDB(B0, 1, 0); PG8_LDB(B1, 1, 1); PG8_SCHED; PG8_LDA(At, 1, 0); PG8_STAGE(PG8_SA(0, 1), a2 + hstep, voffA);
            PG8_WAIT_V(8); PG8_WAIT_L(0); PG8_BAR; PG8_MMA(0, 0, At, B0); PG8_MMA(0, 1, At, B1); PG8_BAR; PG8_SCHED;
            PG8_LDA(At, 1, 1); PG8_STAGE(PG8_SB(1, 0), b3, voffB); PG8_STAGE(PG8_SB(1, 1), b3 + hstep, voffB); PG8_STAGE(PG8_SA(1, 0), a3, voffA);
            PG8_WAIT_V(8); PG8_WAIT_L(0); PG8_BAR; PG8_MMA(1, 0, At, B0); PG8_MMA(1, 1, At, B1); PG8_BAR; PG8_SCHED;
            } else {
            PG8_LDB(B0, 0, 0); PG8_SCHED; PG8_LDA(At, 0, 0); PG8_STAGE(PG8_SA(1, 1), a1 + hstep, voffA);
            PG8_WAIT_L(8); PG8_BAR; PG8_WAIT_L(0); PG8_MMA(0, 0, At, B0); PG8_BAR; PG8_SCHED;
            PG8_LDB(B1, 0, 1); PG8_STAGE(PG8_SB(0, 0), b2, voffB);
            PG8_BAR; PG8_WAIT_L(0); PG8_MMA(0, 1, At, B1); PG8_BAR;
            PG8_LDA(At, 0, 1); PG8_STAGE(PG8_SA(0, 0), a2, voffA);
            PG8_BAR; PG8_WAIT_L(0); PG8_MMA(1, 0, At, B0); PG8_BAR; PG8_SCHED;
            PG8_STAGE(PG8_SB(0, 1), b2 + hstep, voffB);
            PG8_WAIT_V(6); PG8_BAR; PG8_MMA(1, 1, At, B1); PG8_BAR;
            PG8_LDB(B0, 1, 0); PG8_SCHED; PG8_LDA(At, 1, 0); PG8_STAGE(PG8_SA(0, 1), a2 + hstep, voffA);
            PG8_WAIT_L(8); PG8_BAR; PG8_WAIT_L(0); PG8_MMA(0, 0, At, B0); PG8_BAR; PG8_SCHED;
            PG8_LDB(B1, 1, 1); PG8_STAGE(PG8_SB(1, 0), b3, voffB);
            PG8_BAR; PG8_WAIT_L(0); PG8_MMA(0, 1, At, B1); PG8_BAR;
            PG8_LDA(At, 1, 1); PG8_STAGE(PG8_SA(1, 0), a3, voffA);
            PG8_BAR; PG8_WAIT_L(0); PG8_MMA(1, 0, At, B0); PG8_BAR; PG8_SCHED;
            PG8_STAGE(PG8_SB(1, 1), b3 + hstep, voffB);
            PG8_WAIT_V(6); PG8_BAR; PG8_MMA(1, 1, At, B1); PG8_BAR;
            }
        }
        if constexpr (ALIGN_EPI) { if (wr == 0) PG8_BAR; }
        if constexpr (!Epi::AFTER_DRAIN) { E(acc, cur, wr, wc, fr, fq); S.done(cur); }
        if (!has_next) break;
#pragma unroll
        for (int a = 0; a < 2; ++a)
#pragma unroll
            for (int b = 0; b < 2; ++b)
#pragma unroll
                for (int m = 0; m < 4; ++m)
#pragma unroll
                    for (int n = 0; n < 2; ++n) acc[a][b][m][n] = (f32x4){0.f, 0.f, 0.f, 0.f};
        cur = nxt; cA = nA; cB = nB; ++ui;
        if constexpr (ALIGN_EPI) { if (wr == 1) PG8_BAR; }
    }
    PG8_WAIT_V(0);
    if constexpr (!ALIGN_EPI) { if (wr == 0) PG8_BAR; }
    PG8_BAR;
    if constexpr (Epi::AFTER_DRAIN) { E.fused(acc, cur, wr, wc, fr, fq, lds, wid, lane); S.done(cur); }
#undef PG8_SA
#undef PG8_SB
#undef PG8_STAGE
#undef PG8_LDA
#undef PG8_LDB
#undef PG8_MMA
#undef PG8_WAIT_V
#undef PG8_WAIT_L
#undef PG8_BAR
#undef PG8_SCHED
}
}
#define PG8_SP2 true
#define PG8_ALIGN true

constexpr int NWAVES = 8;
constexpr int BATCH = 4, SEQ = 8192, D = 1024, M = BATCH * SEQ;
constexpr int NH = 8, HD = 64, DATT = 512, DPOOL = 512, NZ = 3 * DATT + DPOOL;
constexpr int PEER_H = 8, NKEYS = 128, NEXP = NKEYS * NKEYS, TOPK = 16, NSC = PEER_H * 2 * NKEYS;
constexpr float EPS = 1e-6f;
constexpr float QSCALE = 0.125f * 1.4426950408889634f;

constexpr size_t MiB = 1u << 20;
constexpr size_t WS_CTL = 0, CTL_ZERO_BYTES = 64 * 1024;
constexpr size_t WS_R1 = 1 * MiB;
constexpr size_t WS_SS = 2 * MiB;
constexpr size_t WS_LSE = 4 * MiB;
constexpr size_t WS_WIN = 8 * MiB;
constexpr size_t WS_WOUT = 12 * MiB;
constexpr size_t WS_WSC = 14 * MiB;
constexpr size_t WS_EU = 32 * MiB, WS_EV = 64 * MiB;
constexpr size_t WS_XB = 96 * MiB;
constexpr size_t WS_Z = 160 * MiB;
constexpr size_t WS_OB = 288 * MiB;
constexpr size_t WS_MIX = 384 * MiB;
constexpr size_t WS_SC = 160 * MiB;
constexpr size_t WS_IDX = 448 * MiB, WS_GATE = 464 * MiB;
constexpr size_t WS_END = 480 * MiB;
static_assert(WS_SC + (size_t)M * NSC * 4 <= WS_IDX, "ws map");

constexpr int LDS_BYTES = 147456;
constexpr int LDSCTL_OFF = 146432, MISC_OFF = LDSCTL_OFF + 320;
constexpr int RING_OFF = 0;

#define GAS __attribute__((address_space(1)))
#define LAS __attribute__((address_space(3)))
typedef unsigned short bf16;
typedef unsigned v4u __attribute__((ext_vector_type(4)));
typedef unsigned v2u __attribute__((ext_vector_type(2)));
typedef float f32x4 __attribute__((ext_vector_type(4)));
typedef float f32x16 __attribute__((ext_vector_type(16)));
typedef short bf16x8 __attribute__((ext_vector_type(8)));
typedef short s16x4 __attribute__((ext_vector_type(4)));
typedef GAS unsigned gu32;
#define RLX_AGENT __ATOMIC_RELAXED, __HIP_MEMORY_SCOPE_AGENT
#define LDS_WAIT() asm volatile("s_waitcnt lgkmcnt(0)" ::: "memory")
#define VM_WAIT() asm volatile("s_waitcnt vmcnt(0)" ::: "memory")
__device__ __forceinline__ unsigned f2bf(float f) { unsigned u = __builtin_bit_cast(unsigned, f); return (u + 0x7fffu + ((u >> 16) & 1u)) >> 16; }
__device__ __forceinline__ unsigned pk2(float lo, float hi) { return f2bf(lo) | (f2bf(hi) << 16); }
__device__ __forceinline__ float bflo(unsigned w) { return __builtin_bit_cast(float, w << 16); }
__device__ __forceinline__ float bfhi(unsigned w) { return __builtin_bit_cast(float, w & 0xffff0000u); }
#define XB_TMO      128
#define XB_XCNT(j)  (256  + 64 * (j))
#define XB_XSUB(j)  (1280 + 64 * (j))
#define XB_XGEN(j)  (2304 + 64 * (j))
#define XB_TOP      3328
#define XB_TOPGEN   3392
#define XCD_BAR_WORDS 3456
#define XB_SPIN_CAP (1u << 18)

__device__ __forceinline__ unsigned xb_ld(unsigned* p)              { return __hip_atomic_load(p, __ATOMIC_RELAXED, __HIP_MEMORY_SCOPE_AGENT); }
__device__ __forceinline__ unsigned xb_add(unsigned* p, unsigned v) { return __hip_atomic_fetch_add(p, v, __ATOMIC_RELAXED, __HIP_MEMORY_SCOPE_AGENT); }
__device__ __forceinline__ unsigned xb_xcc_id() { return (unsigned)__builtin_amdgcn_s_getreg((3 << 11) | 20) & 0xFu; }
#define XB_SPIN(cond, bar) do { unsigned _sp = 0; while (cond) { __builtin_amdgcn_s_sleep(1); \
    if ((++_sp & 255u) == 0u) { if (xb_ld(&(bar)[XB_TMO])) break; if (_sp > XB_SPIN_CAP) { atomicAdd(&(bar)[XB_TMO], 1u); break; } } } } while (0)

struct XcdBarrier {
    unsigned* bar; unsigned x;
    volatile LAS unsigned* st;
};

__device__ __forceinline__ XcdBarrier xcd_barrier_post(unsigned* bar, volatile LAS unsigned* st) {
    XcdBarrier b; b.bar = bar; b.x = xb_xcc_id(); b.st = st;
    if (threadIdx.x == 0) (void)xb_add(&bar[XB_XCNT(b.x)], 1u);
    return b;
}
__device__ __forceinline__ void xcd_barrier_complete(unsigned* bar, unsigned x, unsigned& nloc, unsigned& nx) {
    const unsigned G = gridDim.x * gridDim.y * gridDim.z;
    unsigned sum, cnt, mine, sp = 0u;
    for (;;) {
        sum = 0u; cnt = 0u; mine = 0u;
#pragma unroll
        for (unsigned j = 0; j < 16; ++j) { const unsigned c = xb_ld(&bar[XB_XCNT(j)]); sum += c; cnt += (c > 0u) ? 1u : 0u; mine = (j == x) ? c : mine; }
        if (sum == G) break;
        __builtin_amdgcn_s_sleep(1);
        if ((++sp & 255u) == 0u) { if (xb_ld(&bar[XB_TMO])) break; if (sp > XB_SPIN_CAP) { atomicAdd(&bar[XB_TMO], 1u); break; } }
    }
    nloc = mine > 0u ? mine : 1u; nx = cnt > 0u ? cnt : 1u;
}

__device__ __forceinline__ void xcd_barrier(const XcdBarrier& b) {
    asm volatile("s_waitcnt vmcnt(0)" ::: "memory");
    __syncthreads();
    if (threadIdx.x == 0) {
        unsigned* bar = b.bar;
        __builtin_amdgcn_s_waitcnt(0);
        unsigned nloc = b.st[0], nx = b.st[1];
        if (nloc == 0u) { xcd_barrier_complete(bar, b.x, nloc, nx); b.st[0] = nloc; b.st[1] = nx; }
        const unsigned old = xb_add(&bar[XB_XSUB(b.x)], 1u);
        const unsigned gen = old / nloc;
        if (old + 1u == (gen + 1u) * nloc) {
            __builtin_amdgcn_fence(__ATOMIC_RELEASE, "agent");
            asm volatile("s_waitcnt vmcnt(0)" ::: "memory");
            const unsigned og = xb_add(&bar[XB_TOP], 1u);
            const unsigned tg = og / nx;
            if (og + 1u == (tg + 1u) * nx) xb_add(&bar[XB_TOPGEN], 1u);
            else XB_SPIN(xb_ld(&bar[XB_TOPGEN]) == tg, bar);
            __builtin_amdgcn_fence(__ATOMIC_ACQUIRE, "agent");
            xb_add(&bar[XB_XGEN(b.x)], 1u);
            asm volatile("s_waitcnt vmcnt(0)" ::: "memory");
        } else {
            XB_SPIN(xb_ld(&bar[XB_XGEN(b.x)]) == gen, bar);
            __builtin_amdgcn_fence(__ATOMIC_ACQUIRE, "agent");
            asm volatile("s_waitcnt vmcnt(0)" ::: "memory");
        }
    }
    __syncthreads();
}

struct Frame {
    LAS unsigned char* lds;
    volatile LAS unsigned* MISC;
    int tid, lane, wave;
    int vcu, G;
    const float *x, *norm_mix, *w_in, *w_pool, *pool_scale, *w_out, *norm_ffn, *w_query, *sub_keys, *expert_u, *expert_v, *norm_final;
    float* out;
    unsigned char* ws;
};

__device__ __forceinline__ float wave_sum(float v) {
#pragma unroll
    for (int o = 1; o < 64; o <<= 1) v += __shfl_xor(v, o);
    return v;
}

__device__ __forceinline__ void p0_transpose_item(const float* W, int N, const float* ks, bf16* WT, int ldo, int col_off, LAS float* scr, int item, int lane) {
    const int nblk = N / 32, kb = item / nblk, nb = item % nblk, k0 = 64 * kb, n0 = 32 * nb;
#pragma unroll 8
    for (int i = 0; i < 32; ++i) { const int kk = 2 * i + (lane >> 5); const float s = ks ? ks[k0 + kk] : 1.f; scr[kk * 33 + (lane & 31)] = W[(size_t)(k0 + kk) * N + n0 + (lane & 31)] * s; }
    LDS_WAIT(); asm volatile("" ::: "memory");
    const int c = lane & 7;
#pragma unroll
    for (int j = 0; j < 4; ++j) { const int n = (lane >> 3) + 8 * j; const LAS float* s = scr + (8 * c) * 33 + n;
        v4u o; o.x = pk2(s[0 * 33], s[1 * 33]); o.y = pk2(s[2 * 33], s[3 * 33]); o.z = pk2(s[4 * 33], s[5 * 33]); o.w = pk2(s[6 * 33], s[7 * 33]);
        *(GAS v4u*)(WT + (size_t)(n0 + n) * ldo + col_off + k0 + 8 * c) = o; }
    LDS_WAIT(); asm volatile("" ::: "memory");
}

__device__ __forceinline__ void p0_prologue(Frame& F) {
    LAS float* scr = (LAS float*)(F.lds + RING_OFF + F.wave * 16384);
    const int gw = F.vcu * NWAVES + F.wave, NGW = F.G * NWAVES;
    bf16* WIN = (bf16*)(F.ws + WS_WIN); bf16* WOUT = (bf16*)(F.ws + WS_WOUT); bf16* WSC = (bf16*)(F.ws + WS_WSC);
    constexpr int I_IN = (D / 64) * (NZ / 32), I_OUT = (DATT / 64) * (D / 32);
    for (int it = gw; it < I_IN + I_OUT; it += NGW) {
        if (it < I_IN) p0_transpose_item(F.w_in, NZ, F.norm_mix, WIN, D, 0, scr, it, F.lane);
        else p0_transpose_item(F.w_out, D, nullptr, WOUT, D, 0, scr, it - I_IN, F.lane);
    }
    const int gt = (F.vcu * NWAVES + F.wave) * 64 + F.lane, NGT = F.G * NWAVES * 64;
    for (int it = gt; it < DPOOL * (D / 4); it += NGT) {
        const int cin = it / (D / 4), n4 = (it % (D / 4)) * 4, g = cin >> 7;
        const float* wp = F.w_pool + (size_t)cin * 128;
        const float* ps = F.pool_scale + g * 128;
        const float* wo = F.w_out + (size_t)(DATT + g * 128) * D + n4;
        f32x4 acc = {0.f, 0.f, 0.f, 0.f};
#pragma unroll 4
        for (int d = 0; d < 128; ++d) { const float a = wp[d] * ps[d]; const f32x4 b = *(const f32x4*)(wo + (size_t)d * D); acc += a * b; }
#pragma unroll
        for (int j = 0; j < 4; ++j) WOUT[(size_t)(n4 + j) * D + DATT + cin] = (bf16)f2bf(acc[j]);
    }
    for (int it = gt; it < 16 * 32 * 256; it += NGT) {
        const int d4 = (it & 255) * 4, k4 = ((it >> 8) & 31) * 4, blk = it >> 13;
        const float* wq = F.w_query + (size_t)d4 * NSC + blk * 128;
        const float* sk = F.sub_keys + (size_t)(blk * 128 + k4) * 128;
        float acc[4][4];
#pragma unroll
        for (int i = 0; i < 4; ++i)
#pragma unroll
            for (int j = 0; j < 4; ++j) acc[i][j] = 0.f;
        for (int c = 0; c < 128; c += 4) {
            f32x4 a[4], b[4];
#pragma unroll
            for (int i = 0; i < 4; ++i) { a[i] = *(const f32x4*)(sk + i * 128 + c); b[i] = *(const f32x4*)(wq + (size_t)i * NSC + c); }
#pragma unroll
            for (int i = 0; i < 4; ++i)
#pragma unroll
                for (int j = 0; j < 4; ++j) acc[i][j] += a[i][0] * b[j][0] + a[i][1] * b[j][1] + a[i][2] * b[j][2] + a[i][3] * b[j][3];
        }
        const f32x4 gf = *(const f32x4*)(F.norm_ffn + d4);
#pragma unroll
        for (int i = 0; i < 4; ++i) { v2u o; o.x = pk2(acc[i][0] * gf[0], acc[i][1] * gf[1]); o.y = pk2(acc[i][2] * gf[2], acc[i][3] * gf[3]);
            *(GAS v2u*)(WSC + (size_t)(blk * 128 + k4 + i) * D + d4) = o; }
    }
    {
        unsigned char* EU = F.ws + WS_EU; unsigned char* EV = F.ws + WS_EV;
        const size_t n16 = (size_t)NEXP * D / 16;
        for (size_t i0 = gt; i0 < 2 * n16; i0 += (size_t)4 * NGT) {
            f32x4 a[4][4];
#pragma unroll
            for (int r = 0; r < 4; ++r) { const size_t i = i0 + (size_t)r * NGT; if (i < 2 * n16) { const bool second = i >= n16; const size_t j = second ? i - n16 : i;
                const float* src = (second ? F.expert_v : F.expert_u) + j * 16;
#pragma unroll
                for (int q = 0; q < 4; ++q) a[r][q] = *(const f32x4*)(src + 4 * q); } }
#pragma unroll
            for (int r = 0; r < 4; ++r) { const size_t i = i0 + (size_t)r * NGT; if (i < 2 * n16) { const bool second = i >= n16; const size_t j = second ? i - n16 : i; const float sc = second ? 4.0f : 32.0f;
                v4u o;
#pragma unroll
                for (int q = 0; q < 4; ++q) { const f32x4 v = a[r][q] * sc; int w = __builtin_amdgcn_cvt_pk_fp8_f32(v[0], v[1], 0, false); w = __builtin_amdgcn_cvt_pk_fp8_f32(v[2], v[3], w, true); o[q] = (unsigned)w; }
                *(GAS v4u*)((second ? EV : EU) + j * 16) = o; } }
        }
    }
    {
        bf16* XB = (bf16*)(F.ws + WS_XB); float* R1 = (float*)(F.ws + WS_R1);
        for (int m0 = gw * 4; m0 < M; m0 += NGW * 4) {
            f32x4 a[4][4];
#pragma unroll
            for (int r = 0; r < 4; ++r) { const float* xr = F.x + (size_t)(m0 + r) * D + 8 * F.lane;
                a[r][0] = *(const f32x4*)(xr); a[r][1] = *(const f32x4*)(xr + 4); a[r][2] = *(const f32x4*)(xr + 512); a[r][3] = *(const f32x4*)(xr + 516); }
#pragma unroll
            for (int r = 0; r < 4; ++r) { float s = 0.f;
#pragma unroll
                for (int q = 0; q < 4; ++q) s += (a[r][q][0] * a[r][q][0] + a[r][q][1] * a[r][q][1]) + (a[r][q][2] * a[r][q][2] + a[r][q][3] * a[r][q][3]);
#pragma unroll
                for (int j = 0; j < 2; ++j) { v4u o; o.x = pk2(a[r][2 * j][0], a[r][2 * j][1]); o.y = pk2(a[r][2 * j][2], a[r][2 * j][3]); o.z = pk2(a[r][2 * j + 1][0], a[r][2 * j + 1][1]); o.w = pk2(a[r][2 * j + 1][2], a[r][2 * j + 1][3]);
                    *(GAS v4u*)(XB + (size_t)(m0 + r) * D + 8 * F.lane + 512 * j) = o; }
                s = wave_sum(s);
                if (F.lane == 0) R1[m0 + r] = 1.0f / sqrtf(s * (1.0f / D) + EPS); }
        }
    }
}

constexpr int ATT_KEYS = 384, ATT_KCH = ATT_KEYS * 16 + 16;
constexpr int ATT_K_OFF = 0, ATT_V_OFF = 8 * ATT_KCH;
constexpr int ATT_VDH = 24 * 1024 + 64;
constexpr int ATT_OST_OFF = ATT_V_OFF + 2 * ATT_VDH;
constexpr int ATT_LDS_END = ATT_OST_OFF + NWAVES * 4096;
static_assert(ATT_V_OFF % 16 == 0 && ATT_OST_OFF % 16 == 0 && ATT_LDS_END <= LDSCTL_OFF, "attention LDS map");
constexpr int ATT_UNITS = BATCH * NH * 96;

__device__ __forceinline__ int crow(int r, int hi) { return (r & 3) + 8 * (r >> 2) + 4 * hi; }
__device__ __forceinline__ s16x4 vtr(const LAS unsigned char* p) { return __builtin_bit_cast(s16x4, __builtin_amdgcn_ds_read_tr16_b64_v4i16((LAS s16x4*)p)); }

__device__ __forceinline__ void attn_unit(Frame& F, int unit) {
    const int tid = F.tid, lane = F.lane, w = F.wave, r32 = lane & 31, hi = lane >> 5;
    const int bh = unit / 96, rem = unit % 96, br = rem >> 5, idx = rem & 31;
    const int b = bh >> 3, h = bh & 7;
    const int dsh = 2 * br, dil = 1 << dsh;
    const int ppr = 32 >> dsh;
    const int res = idx / ppr, pair = idx % ppr;
    const int s0 = pair * 256 - 128;
    const bf16* Z = (const bf16*)(F.ws + WS_Z);
    const size_t tokbase = (size_t)b * SEQ + res;
    {
        v4u kv[6], vv[6];
#pragma unroll
        for (int it = 0; it < 6; ++it) { const int p = tid + 512 * it, key = p >> 3, c = p & 7; int s = s0 + key; s = s < 0 ? 0 : s;
            const bf16* row = Z + (tokbase + ((size_t)s << dsh)) * NZ + h * HD + c * 8;
            kv[it] = *(const GAS v4u*)(row + DATT); vv[it] = *(const GAS v4u*)(row + 2 * DATT); }
#pragma unroll
        for (int it = 0; it < 6; ++it) { const int p = tid + 512 * it, key = p >> 3, c = p & 7;
            *(LAS v4u*)(F.lds + ATT_K_OFF + c * ATT_KCH + key * 16) = kv[it];
            *(LAS v4u*)(F.lds + ATT_V_OFF + (c >> 2) * ATT_VDH + (key >> 4) * 1024 + (key & 15) * 64 + (c & 3) * 16) = vv[it]; }
    }
    const int sq0 = pair * 256 + 32 * w;
    bf16x8 qr[4];
    {
        const bf16* qrow = Z + (tokbase + ((size_t)(sq0 + r32) << dsh)) * NZ + h * HD + hi * 8;
#pragma unroll
        for (int d0 = 0; d0 < 4; ++d0) qr[d0] = *(const GAS bf16x8*)(qrow + d0 * 16);
    }
    __syncthreads();
    f32x16 p[5];
#pragma unroll
    for (int j = 0; j < 5; ++j) {
        p[j] = f32x16{};
        const LAS unsigned char* kb = F.lds + ATT_K_OFF + hi * ATT_KCH + (32 * (w + j) + r32) * 16;
#pragma unroll
        for (int d0 = 0; d0 < 4; ++d0) { const bf16x8 kf = *(const LAS bf16x8*)(kb + 2 * d0 * ATT_KCH); p[j] = __builtin_amdgcn_mfma_f32_32x32x16_bf16(kf, qr[d0], p[j], 0, 0, 0); }
    }
    const float NEGB = -1e30f;
#pragma unroll
    for (int r = 0; r < 16; ++r) { const int kj = crow(r, hi); if (kj < r32) p[0][r] = NEGB; if (kj > r32) p[4][r] = NEGB; }
    if (pair == 0) {
#pragma unroll
        for (int j = 0; j < 4; ++j) if (w + j < 4) {
#pragma unroll
            for (int r = 0; r < 16; ++r) p[j][r] = NEGB; }
    }
    float mx = NEGB;
#pragma unroll
    for (int j = 0; j < 5; ++j)
#pragma unroll
        for (int r = 0; r < 16; ++r) mx = fmaxf(mx, p[j][r]);
    mx = fmaxf(mx, __shfl_xor(mx, 32));
    float l = 0.f;
#pragma unroll
    for (int j = 0; j < 5; ++j)
#pragma unroll
        for (int r = 0; r < 16; ++r) { const float e = __builtin_amdgcn_exp2f(p[j][r] - mx); p[j][r] = e; l += e; }
    l += __shfl_xor(l, 32);
    f32x16 o[2]; o[0] = f32x16{}; o[1] = f32x16{};
    const LAS unsigned char* vb = F.lds + ATT_V_OFF + (4 * hi + ((lane & 15) >> 2)) * 64 + ((lane >> 4) & 1) * 32 + (lane & 3) * 8;
#pragma unroll
    for (int j = 0; j < 5; ++j)
#pragma unroll
        for (int s = 0; s < 2; ++s) {
            v4u pw; pw.x = pk2(p[j][8 * s + 0], p[j][8 * s + 1]); pw.y = pk2(p[j][8 * s + 2], p[j][8 * s + 3]); pw.z = pk2(p[j][8 * s + 4], p[j][8 * s + 5]); pw.w = pk2(p[j][8 * s + 6], p[j][8 * s + 7]);
            const bf16x8 pa = __builtin_bit_cast(bf16x8, pw);
#pragma unroll
            for (int dh = 0; dh < 2; ++dh) {
                const LAS unsigned char* vp = vb + dh * ATT_VDH + (2 * (w + j) + s) * 1024;
                const s16x4 lo = vtr(vp), hh = vtr(vp + 512);
                const bf16x8 vf = (bf16x8){lo[0], lo[1], lo[2], lo[3], hh[0], hh[1], hh[2], hh[3]};
                o[dh] = __builtin_amdgcn_mfma_f32_32x32x16_bf16(pa, vf, o[dh], 0, 0, 0);
            }
        }
    const float rl = 1.0f / l;
    bf16* OB = (bf16*)(F.ws + WS_OB) + (size_t)br * M * DATT;
    float* LSE = (float*)(F.ws + WS_LSE) + (size_t)br * M * NH;
    LAS bf16* stg = (LAS bf16*)(F.lds + ATT_OST_OFF + w * 4096);
#pragma unroll
    for (int r = 0; r < 16; ++r) { const int orow = crow(r, hi); const float rr = __shfl(rl, orow);
#pragma unroll
        for (int dh = 0; dh < 2; ++dh) stg[orow * 64 + dh * 32 + r32] = (bf16)f2bf(o[dh][r] * rr); }
    if (hi == 0) LSE[(tokbase + ((size_t)(sq0 + r32) << dsh)) * NH + h] = mx + __builtin_amdgcn_logf(l);
    LDS_WAIT();
#pragma unroll
    for (int i = 0; i < 4; ++i) { const int row = i * 8 + (lane >> 3), ch = lane & 7; const v4u v = *(const LAS v4u*)(stg + row * 64 + ch * 8);
        *(GAS v4u*)(OB + (tokbase + ((size_t)(sq0 + row) << dsh)) * DATT + h * HD + ch * 8) = v; }
    __syncthreads();
}

__device__ __forceinline__ void pool_rows(Frame& F) {
    const bf16* Z = (const bf16*)(F.ws + WS_Z); bf16* MIX = (bf16*)(F.ws + WS_MIX);
    const int gw = F.vcu * NWAVES + F.wave, NGW = F.G * NWAVES;
    const int win = 2 << (F.lane >> 4);
    constexpr int TPW = 16;
    for (int it = gw; it < M / TPW; it += NGW) {
        const int tb = it * TPW, sb = tb & (SEQ - 1);
        const bf16* zc = Z + (size_t)tb * NZ + 3 * DATT + 8 * F.lane;
        float acc[8];
#pragma unroll
        for (int e = 0; e < 8; ++e) acc[e] = 0.f;
        for (int j = 1; j < win; ++j) if (sb - j >= 0) { const v4u v = *(const GAS v4u*)(zc - (long)j * NZ);
            acc[0] += bflo(v.x); acc[1] += bfhi(v.x); acc[2] += bflo(v.y); acc[3] += bfhi(v.y); acc[4] += bflo(v.z); acc[5] += bfhi(v.z); acc[6] += bflo(v.w); acc[7] += bfhi(v.w); }
#pragma unroll 4
        for (int i = 0; i < TPW; ++i) {
            const int s = sb + i; const v4u z0 = *(const GAS v4u*)(zc + (size_t)i * NZ);
            acc[0] += bflo(z0.x); acc[1] += bfhi(z0.x); acc[2] += bflo(z0.y); acc[3] += bfhi(z0.y); acc[4] += bflo(z0.z); acc[5] += bfhi(z0.z); acc[6] += bflo(z0.w); acc[7] += bfhi(z0.w);
            const int cnt = (s + 1) < win ? (s + 1) : win; const float inv = 1.0f / (float)cnt;
            v4u o; o.x = pk2(acc[0] * inv - bflo(z0.x), acc[1] * inv - bfhi(z0.x)); o.y = pk2(acc[2] * inv - bflo(z0.y), acc[3] * inv - bfhi(z0.y));
            o.z = pk2(acc[4] * inv - bflo(z0.z), acc[5] * inv - bfhi(z0.z)); o.w = pk2(acc[6] * inv - bflo(z0.w), acc[7] * inv - bfhi(z0.w));
            *(GAS v4u*)(MIX + (size_t)(tb + i) * D + DATT + 8 * F.lane) = o;
            if (s - (win - 1) >= 0) { const v4u v = *(const GAS v4u*)(zc + (long)(i - (win - 1)) * NZ);
                acc[0] -= bflo(v.x); acc[1] -= bfhi(v.x); acc[2] -= bflo(v.y); acc[3] -= bfhi(v.y); acc[4] -= bflo(v.z); acc[5] -= bfhi(v.z); acc[6] -= bflo(v.w); acc[7] -= bfhi(v.w); }
        }
    }
}

__device__ __forceinline__ void merge_rows(Frame& F) {
    const bf16* OB = (const bf16*)(F.ws + WS_OB); const float* LSE = (const float*)(F.ws + WS_LSE); bf16* MIX = (bf16*)(F.ws + WS_MIX);
    const int gw = F.vcu * NWAVES + F.wave, NGW = F.G * NWAVES;
    for (int t = gw; t < M; t += NGW) {
        const int h = F.lane >> 3;
        const float l0 = LSE[(size_t)t * NH + h], l1 = LSE[(size_t)(M + t) * NH + h], l2 = LSE[(size_t)(2 * M + t) * NH + h];
        const float mx = fmaxf(l0, fmaxf(l1, l2));
        float w0 = __builtin_amdgcn_exp2f(l0 - mx), w1 = __builtin_amdgcn_exp2f(l1 - mx), w2 = __builtin_amdgcn_exp2f(l2 - mx);
        const float inv = 1.0f / (w0 + w1 + w2); w0 *= inv; w1 *= inv; w2 *= inv;
        const size_t off = (size_t)t * DATT + 8 * F.lane;
        const v4u a = *(const GAS v4u*)(OB + off), b = *(const GAS v4u*)(OB + (size_t)M * DATT + off), c = *(const GAS v4u*)(OB + (size_t)2 * M * DATT + off);
        v4u o;
        o.x = pk2(w0 * bflo(a.x) + w1 * bflo(b.x) + w2 * bflo(c.x), w0 * bfhi(a.x) + w1 * bfhi(b.x) + w2 * bfhi(c.x));
        o.y = pk2(w0 * bflo(a.y) + w1 * bflo(b.y) + w2 * bflo(c.y), w0 * bfhi(a.y) + w1 * bfhi(b.y) + w2 * bfhi(c.y));
        o.z = pk2(w0 * bflo(a.z) + w1 * bflo(b.z) + w2 * bflo(c.z), w0 * bfhi(a.z) + w1 * bfhi(b.z) + w2 * bfhi(c.z));
        o.w = pk2(w0 * bflo(a.w) + w1 * bflo(b.w) + w2 * bflo(c.w), w0 * bfhi(a.w) + w1 * bfhi(b.w) + w2 * bfhi(c.w));
        *(GAS v4u*)(MIX + (size_t)t * D + 8 * F.lane) = o;
    }
}

constexpr int TK_ROW = 68;
constexpr int TK_WAVE_BYTES = 64 * TK_ROW * 4;
static_assert(NWAVES * TK_WAVE_BYTES <= LDSCTL_OFF, "top-k LDS map");

__device__ __forceinline__ unsigned f2ord(float f) { const unsigned u = __builtin_bit_cast(unsigned, f); return (u & 0x80000000u) ? ~u : (u | 0x80000000u); }
__device__ __forceinline__ float ord2f(unsigned k) { const unsigned u = (k & 0x80000000u) ? (k & 0x7fffffffu) : ~k; return __builtin_bit_cast(float, u); }
#define TK_INSERT(L, xin) do { unsigned x_ = (xin); _Pragma("unroll") for (int i_ = 0; i_ < 16; ++i_) { const unsigned hi_ = max(L[i_], x_); x_ = min(L[i_], x_); L[i_] = hi_; } } while (0)

__device__ __forceinline__ void topk_phase(Frame& F) {
    const float* SC = (const float*)(F.ws + WS_SC); const float* SS = (const float*)(F.ws + WS_SS);
    int* IDX = (int*)(F.ws + WS_IDX); float* GATE = (float*)(F.ws + WS_GATE);
    const int gw = F.vcu * NWAVES + F.wave, NGW = F.G * NWAVES, lane = F.lane;
    LAS float* st = (LAS float*)(F.lds + F.wave * TK_WAVE_BYTES);
    for (int it = gw; it < M / 8; it += NGW) {
        const int t0 = it * 8;
        unsigned L0[16], L1[16];
#pragma unroll
        for (int i = 0; i < 16; ++i) { L0[i] = 0u; L1[i] = 0u; }
#pragma unroll
        for (int rnd = 0; rnd < 4; ++rnd) {
            const int p = rnd >> 1, kc = rnd & 1;
#pragma unroll
            for (int i = 0; i < 16; ++i) { const int pr = 4 * i + (lane >> 4), tl = pr >> 3, h = pr & 7;
                const f32x4 v = *(const GAS f32x4*)(SC + (size_t)(t0 + tl) * NSC + h * 256 + p * 128 + kc * 64 + (lane & 15) * 4);
                *(LAS f32x4*)(st + pr * TK_ROW + (lane & 15) * 4) = v; }
            LDS_WAIT(); asm volatile("" ::: "memory");
#pragma unroll 1
            for (int q = 0; q < 16; ++q) {
                const f32x4 v = *(const LAS f32x4*)(st + lane * TK_ROW + q * 4);
#pragma unroll
                for (int e = 0; e < 4; ++e) { const unsigned key = (f2ord(v[e]) & ~127u) | (unsigned)(127 - (kc * 64 + q * 4 + e));
                    if (p == 0) TK_INSERT(L0, key); else TK_INSERT(L1, key); }
            }
            LDS_WAIT(); asm volatile("" ::: "memory");
        }
        LAS float* pv0 = st; LAS float* pv1 = st + 16 * 64; LAS int* pi0 = (LAS int*)(st + 32 * 64); LAS int* pi1 = (LAS int*)(st + 48 * 64);
        float v0[16], v1[16];
#pragma unroll
        for (int i = 0; i < 16; ++i) { v0[i] = ord2f(L0[i] & ~127u); v1[i] = ord2f(L1[i] & ~127u);
            pv0[i * 64 + lane] = v0[i]; pv1[i * 64 + lane] = v1[i]; pi0[i * 64 + lane] = 127 - (int)(L0[i] & 127u); pi1[i * 64 + lane] = 127 - (int)(L1[i] & 127u); }
        unsigned T[16];
#pragma unroll
        for (int i = 0; i < 16; ++i) T[i] = 0u;
#pragma unroll
        for (int i = 0; i < 16; ++i)
#pragma unroll
            for (int j = 0; j < 16; ++j) if ((i + 1) * (j + 1) <= 16) { const unsigned key = (f2ord(v0[i] + v1[j]) & ~255u) | (unsigned)(255 - (i * 16 + j)); TK_INSERT(T, key); }
        LDS_WAIT(); asm volatile("" ::: "memory");
        const int tl = lane >> 3, h = lane & 7, t = t0 + tl;
        float ssum = 0.f;
        { const float* sp = SS + (size_t)t * 16;
#pragma unroll
          for (int i = 0; i < 4; ++i) { const f32x4 v = *(const GAS f32x4*)(sp + 4 * i); ssum += (v[0] + v[1]) + (v[2] + v[3]); } }
        const float r2 = 1.0f / sqrtf(ssum * (1.0f / D) + EPS);
        float bs[16]; int ex[16]; float mxs = -3.0e38f;
#pragma unroll
        for (int k = 0; k < 16; ++k) { const int pos = 255 - (int)(T[k] & 255u), i = pos >> 4, j = pos & 15;
            bs[k] = (pv0[i * 64 + lane] + pv1[j * 64 + lane]) * r2; ex[k] = pi0[i * 64 + lane] * NKEYS + pi1[j * 64 + lane]; mxs = fmaxf(mxs, bs[k]); }
        float den = 0.f;
#pragma unroll
        for (int k = 0; k < 16; ++k) { bs[k] = __expf(bs[k] - mxs); den += bs[k]; }
        const float inv = 1.0f / den;
        int* ip = IDX + ((size_t)t * PEER_H + h) * TOPK; float* gp = GATE + ((size_t)t * PEER_H + h) * TOPK;
#pragma unroll
        for (int k = 0; k < 16; k += 4) { *(GAS v4u*)(ip + k) = (v4u){(unsigned)ex[k], (unsigned)ex[k + 1], (unsigned)ex[k + 2], (unsigned)ex[k + 3]};
            *(GAS f32x4*)(gp + k) = (f32x4){bs[k] * inv, bs[k + 1] * inv, bs[k + 2] * inv, bs[k + 3] * inv}; }
        LDS_WAIT(); asm volatile("" ::: "memory");
    }
}

typedef float f32x2 __attribute__((ext_vector_type(2)));
constexpr float EU_SCALE = 32.0f, EV_SCALE = 4.0f;
__device__ __forceinline__ float gelu_erf(float v) {
    const float av = __builtin_fabsf(v), t = __builtin_amdgcn_rcpf(av * 0.2316418882f + 1.0f);
    float q = t * 0.5307027145f + (-0.7265760135f); q = q * t + 0.7107068705f; q = q * t + (-0.142248368f); q = q * t + 0.127414796f; q = q * t;
    const float e = __builtin_amdgcn_exp2f((v * v) * (-0.72134752044f));
    const float m = v * (q * e);
    return v < 0.f ? m : v - m;
}

constexpr int PEER_WAVE_LDS = 3072;
__device__ __forceinline__ float peer_dot(const v4u& u, const f32x2 (&hf)[8]) {
    f32x2 s = {0.f, 0.f};
#pragma unroll
    for (int d = 0; d < 4; ++d) { const int w = (int)u[d]; s += __builtin_amdgcn_cvt_pk_f32_fp8(w, false) * hf[2 * d]; s += __builtin_amdgcn_cvt_pk_f32_fp8(w, true) * hf[2 * d + 1]; }
    return s.x + s.y;
}
__device__ __forceinline__ void peer_axpy(f32x2 (&y)[8], float ak, const v4u& v) {
    const f32x2 ak2 = {ak, ak};
#pragma unroll
    for (int d = 0; d < 4; ++d) { const int w = (int)v[d]; y[2 * d] += ak2 * __builtin_amdgcn_cvt_pk_f32_fp8(w, false); y[2 * d + 1] += ak2 * __builtin_amdgcn_cvt_pk_f32_fp8(w, true); }
}
__device__ __forceinline__ void peer_load2(v4u (&u)[8], v4u (&v)[8], unsigned (&it)[8], const unsigned char* EU, const unsigned char* EV, const LAS unsigned* sck, int base, int lane) {
#pragma unroll
    for (int k = 0; k < 8; ++k) { const unsigned c = (unsigned)__builtin_amdgcn_readfirstlane((int)sck[base + k]); it[k] = c; const unsigned e = c >> 8;
        const unsigned loff = 16u * (unsigned)lane; const GAS unsigned char* ub = (const GAS unsigned char*)EU + (size_t)e * D; const GAS unsigned char* vb = (const GAS unsigned char*)EV + (size_t)e * D;
        u[k] = *(const GAS v4u*)(ub + loff); v[k] = *(const GAS v4u*)(vb + loff); }
}
__device__ __forceinline__ void peer_compute2(const v4u (&u)[8], const v4u (&v)[8], const unsigned (&it)[8], const f32x2 (&hf0)[8], const f32x2 (&hf1)[8], f32x2 (&y0)[8], f32x2 (&y1)[8],
                                              const LAS float* sgate, int base, int lane) {
    float pa[8];
#pragma unroll
    for (int k = 0; k < 8; ++k) { if (it[k] & 128u) pa[k] = peer_dot(u[k], hf1); else pa[k] = peer_dot(u[k], hf0); }
    float q4[4], q2[2], q1;
#pragma unroll
    for (int i = 0; i < 4; ++i) { const bool up = (lane & 32) != 0; const float keep = up ? pa[i + 4] : pa[i], send = up ? pa[i] : pa[i + 4]; q4[i] = keep + __shfl_xor(send, 32); }
#pragma unroll
    for (int i = 0; i < 2; ++i) { const bool up = (lane & 16) != 0; const float keep = up ? q4[i + 2] : q4[i], send = up ? q4[i] : q4[i + 2]; q2[i] = keep + __shfl_xor(send, 16); }
    { const bool up = (lane & 8) != 0; const float keep = up ? q2[1] : q2[0], send = up ? q2[0] : q2[1]; q1 = keep + __shfl_xor(send, 8); }
    q1 += __shfl_xor(q1, 4); q1 += __shfl_xor(q1, 2); q1 += __shfl_xor(q1, 1);
    const int kk = ((lane >> 5) & 1) * 4 + ((lane >> 4) & 1) * 2 + ((lane >> 3) & 1);
    const float gk = sgate[base + kk];
    const float act = gelu_erf(q1 * (1.0f / EU_SCALE)) * gk * (1.0f / EV_SCALE);
#pragma unroll
    for (int k = 0; k < 8; ++k) {
        const int src = ((k >> 2) & 1) * 32 + ((k >> 1) & 1) * 16 + (k & 1) * 8;
        const float ak = __builtin_bit_cast(float, __builtin_amdgcn_readlane(__builtin_bit_cast(int, act), src));
        if (it[k] & 128u) peer_axpy(y1, ak, v[k]); else peer_axpy(y0, ak, v[k]);
    }
}
__device__ __forceinline__ void peer_load_hf(Frame& F, int t, f32x2 (&hf)[8], int lane) {
    const float* SS = (const float*)(F.ws + WS_SS);
    const float* xr = F.out + (size_t)t * D + 16 * lane;
    float s = SS[(size_t)t * 16 + (lane & 15)]; s += __shfl_xor(s, 1); s += __shfl_xor(s, 2); s += __shfl_xor(s, 4); s += __shfl_xor(s, 8);
    const float r2 = 1.0f / sqrtf(s * (1.0f / D) + EPS);
#pragma unroll
    for (int j = 0; j < 4; ++j) { const f32x4 a = *(const GAS f32x4*)(xr + 4 * j), g = *(const GAS f32x4*)(F.norm_ffn + 16 * lane + 4 * j);
        hf[2 * j] = (f32x2){a[0] * r2 * g[0], a[1] * r2 * g[1]}; hf[2 * j + 1] = (f32x2){a[2] * r2 * g[2], a[3] * r2 * g[3]}; }
}
__device__ __forceinline__ void peer_finish(Frame& F, int t, f32x2 (&y)[8], int lane) {
    float* orow = F.out + (size_t)t * D + 16 * lane; float s2 = 0.f;
#pragma unroll
    for (int j = 0; j < 4; ++j) { const f32x4 a = *(const GAS f32x4*)(orow + 4 * j); y[2 * j] += (f32x2){a[0], a[1]}; y[2 * j + 1] += (f32x2){a[2], a[3]}; }
#pragma unroll
    for (int e = 0; e < 8; ++e) s2 += y[e].x * y[e].x + y[e].y * y[e].y;
    s2 = wave_sum(s2);
    const float r3 = 1.0f / sqrtf(s2 * (1.0f / D) + EPS);
#pragma unroll
    for (int j = 0; j < 4; ++j) { const f32x4 g = *(const GAS f32x4*)(F.norm_final + 16 * lane + 4 * j);
        *(GAS f32x4*)(orow + 4 * j) = (f32x4){y[2 * j].x * r3 * g[0], y[2 * j].y * r3 * g[1], y[2 * j + 1].x * r3 * g[2], y[2 * j + 1].y * r3 * g[3]}; }
}

template <bool SYNC, class Bar> __device__ __forceinline__ void peer_phase(Frame& F, const Bar& bar) {
    const int* IDX = (const int*)(F.ws + WS_IDX); const float* GATE = (const float*)(F.ws + WS_GATE);
    const unsigned char* EU = F.ws + WS_EU; const unsigned char* EV = F.ws + WS_EV;
    const int gw = F.vcu * NWAVES + F.wave, NGW = F.G * NWAVES;
    LAS unsigned* ck = (LAS unsigned*)(F.lds + F.wave * PEER_WAVE_LDS); LAS unsigned* sck = ck + 256; LAS float* sgate = (LAS float*)(ck + 512);
    const int npairs = M / 2, nrounds = (npairs + NGW - 1) / NGW;
    for (int rd = 0; rd < nrounds; ++rd) {
        if (SYNC && rd > 0) xcd_barrier(bar);
        const int pi = gw + rd * NGW;
        if (pi >= npairs) continue;
        int lane = F.lane; asm volatile("" : "+v"(lane));
        const int t0 = 2 * pi;
        unsigned myk[4]; float myg[4];
#pragma unroll
        for (int q = 0; q < 4; ++q) { const int p = q * 64 + lane; myk[q] = ((unsigned)IDX[(size_t)t0 * 128 + p] << 8) | (unsigned)p; myg[q] = GATE[(size_t)t0 * 128 + p]; ck[p] = myk[q]; }
        LDS_WAIT(); asm volatile("" ::: "memory");
        int rk[4] = {0, 0, 0, 0};
#pragma unroll 2
        for (int j = 0; j < 256; j += 4) { const v4u o = *(const LAS v4u*)(ck + j);
#pragma unroll
            for (int q = 0; q < 4; ++q) rk[q] += (int)(o.x < myk[q]) + (int)(o.y < myk[q]) + (int)(o.z < myk[q]) + (int)(o.w < myk[q]); }
#pragma unroll
        for (int q = 0; q < 4; ++q) { sck[rk[q]] = myk[q]; sgate[rk[q]] = myg[q]; }
        LDS_WAIT(); asm volatile("" ::: "memory");
        f32x2 hf0[8], hf1[8], y0[8], y1[8];
        peer_load_hf(F, t0, hf0, lane); peer_load_hf(F, t0 + 1, hf1, lane);
#pragma unroll
        for (int e = 0; e < 8; ++e) { y0[e] = (f32x2){0.f, 0.f}; y1[e] = (f32x2){0.f, 0.f}; }
        v4u uA[8], vA[8]; unsigned itA[8];
#pragma unroll 1
        for (int bt = 0; bt < 32; ++bt) {
            peer_load2(uA, vA, itA, EU, EV, sck, bt * 8, lane);
            peer_compute2(uA, vA, itA, hf0, hf1, y0, y1, sgate, bt * 8, lane);
        }
        peer_finish(F, t0, y0, lane); peer_finish(F, t0 + 1, y1, lane);
        LDS_WAIT(); asm volatile("" ::: "memory");
    }
}

struct Args { const float* in[12]; float* out; unsigned char* ws; };
__global__ void __launch_bounds__(NWAVES * 64, 2) hymba_fwd(Args args) {
    extern __shared__ __attribute__((aligned(16))) unsigned char lds[];
    Frame F;
    F.lds = (LAS unsigned char*)lds;
    F.MISC = (volatile LAS unsigned*)(F.lds + MISC_OFF);
    F.tid = threadIdx.x; F.lane = F.tid & 63; F.wave = __builtin_amdgcn_readfirstlane(F.tid >> 6);
    F.G = gridDim.x; { const int bx = blockIdx.x; F.vcu = (F.G % 8 == 0) ? (bx % 8) * (F.G / 8) + bx / 8 : bx; }
    F.x = args.in[0]; F.norm_mix = args.in[1]; F.w_in = args.in[2]; F.w_pool = args.in[3]; F.pool_scale = args.in[4]; F.w_out = args.in[5];
    F.norm_ffn = args.in[6]; F.w_query = args.in[7]; F.sub_keys = args.in[8]; F.expert_u = args.in[9]; F.expert_v = args.in[10]; F.norm_final = args.in[11];
    F.out = args.out; F.ws = args.ws;
    for (int u = F.tid; u < (LDS_BYTES - LDSCTL_OFF) / 4; u += NWAVES * 64) ((LAS unsigned*)(F.lds + LDSCTL_OFF))[u] = 0u;
    __syncthreads();
    XcdBarrier bar = xcd_barrier_post((unsigned*)(F.ws + WS_CTL), F.MISC + 8);
#define GRID_BAR() xcd_barrier(bar)

#ifndef PROBE_DUP
#define PROBE_DUP -1
#endif
    p0_prologue(F);
    if (PROBE_DUP == 0) { GRID_BAR(); p0_prologue(F); }
    GRID_BAR();
    {
        pg8::Gemm g{(const pg8::bf16_t*)(F.ws + WS_XB), (const pg8::bf16_t*)(F.ws + WS_WIN), M, NZ, D}; pg8::StaticOrder S; S.init(M, NZ, F.G, (int)blockIdx.x);
        pg8::EpiZ E{(pg8::bf16_t*)(F.ws + WS_Z), NZ, (const float*)(F.ws + WS_R1), DATT, QSCALE};
        pg8::gemm_phase<pg8::EpiZ, pg8::StaticOrder, PG8_ALIGN, PG8_SP2>(F.lds + RING_OFF, g, S, E);
        if (PROBE_DUP == 1) { GRID_BAR(); pg8::gemm_phase<pg8::EpiZ, pg8::StaticOrder, PG8_ALIGN, PG8_SP2>(F.lds + RING_OFF, g, S, E); }
    }
    GRID_BAR();
    for (int u = F.vcu; u < ATT_UNITS; u += F.G) attn_unit(F, u);
    if (PROBE_DUP == 2) { GRID_BAR(); for (int u = F.vcu; u < ATT_UNITS; u += F.G) attn_unit(F, u); }
    pool_rows(F);
    if (PROBE_DUP == 3) { GRID_BAR(); pool_rows(F); }
    GRID_BAR();
    merge_rows(F);
    if (PROBE_DUP == 4) { GRID_BAR(); merge_rows(F); }
    GRID_BAR();
    {
        pg8::Gemm g{(const pg8::bf16_t*)(F.ws + WS_MIX), (const pg8::bf16_t*)(F.ws + WS_WOUT), M, D, D}; pg8::StaticOrder S; S.init(M, D, F.G, (int)blockIdx.x);
        pg8::EpiRes E{F.x, F.out, (pg8::bf16_t*)(F.ws + WS_XB), (float*)(F.ws + WS_SS), D};
        pg8::gemm_phase<pg8::EpiRes, pg8::StaticOrder, PG8_ALIGN, PG8_SP2>(F.lds + RING_OFF, g, S, E);
        if (PROBE_DUP == 5) { GRID_BAR(); pg8::gemm_phase<pg8::EpiRes, pg8::StaticOrder, PG8_ALIGN, PG8_SP2>(F.lds + RING_OFF, g, S, E); }
    }
    GRID_BAR();
    {
        pg8::Gemm g{(const pg8::bf16_t*)(F.ws + WS_XB), (const pg8::bf16_t*)(F.ws + WS_WSC), M, NSC, D}; pg8::StaticOrder S; S.init(M, NSC, F.G, (int)blockIdx.x);
        pg8::EpiF32 E{(float*)(F.ws + WS_SC), NSC};
        pg8::gemm_phase<pg8::EpiF32, pg8::StaticOrder, PG8_ALIGN, PG8_SP2>(F.lds + RING_OFF, g, S, E);
        if (PROBE_DUP == 6) { GRID_BAR(); pg8::gemm_phase<pg8::EpiF32, pg8::StaticOrder, PG8_ALIGN, PG8_SP2>(F.lds + RING_OFF, g, S, E); }
    }
    GRID_BAR();
    topk_phase(F);
    if (PROBE_DUP == 7) { GRID_BAR(); topk_phase(F); }
    GRID_BAR();
#ifndef PEER_SYNC
#define PEER_SYNC false
#endif
    peer_phase<PEER_SYNC>(F, bar);
}

extern "C" void kernel_launch(void* const* d_in, const int* in_sizes, int n_in, void* d_out, int out_size, void* d_ws, size_t ws_size, hipStream_t stream) {
    static int grid = 0;
    if (grid == 0) {
        if (n_in != 12 || in_sizes[0] != M * D || out_size != M * D || ws_size < WS_END) { fprintf(stderr, "kernel_launch: unexpected shapes (n_in %d, in0 %d, out %d, ws %zu); nothing launched\n", n_in, n_in > 0 ? in_sizes[0] : -1, out_size, ws_size); grid = -1; return; }
        int dev = 0, cus = 0, per_cu = 0;
        if (hipGetDevice(&dev) != hipSuccess || hipDeviceGetAttribute(&cus, hipDeviceAttributeMultiprocessorCount, dev) != hipSuccess) { grid = -1; return; }
        if (hipFuncSetAttribute((const void*)hymba_fwd, hipFuncAttributeMaxDynamicSharedMemorySize, LDS_BYTES) != hipSuccess) { fprintf(stderr, "kernel_launch: hipFuncSetAttribute failed\n"); grid = -1; return; }
        if (hipOccupancyMaxActiveBlocksPerMultiprocessor(&per_cu, (const void*)hymba_fwd, NWAVES * 64, LDS_BYTES) != hipSuccess || per_cu < 1)
            fprintf(stderr, "kernel_launch: note: occupancy query reports %d workgroups per CU\n", per_cu);
        (void)hipGetLastError();
        grid = cus;
    }
    if (grid < 0) return;
    if (hipMemsetAsync((char*)d_ws + WS_CTL, 0, CTL_ZERO_BYTES, stream) != hipSuccess) { fprintf(stderr, "kernel_launch: hipMemsetAsync failed\n"); return; }
    Args a{};
    for (int i = 0; i < 12; ++i) a.in[i] = (const float*)d_in[i];
    a.out = (float*)d_out; a.ws = (unsigned char*)d_ws;
    hipLaunchKernelGGL(hymba_fwd, dim3(grid), dim3(NWAVES * 64), LDS_BYTES, stream, a);
    const hipError_t le = hipPeekAtLastError();
    if (le != hipSuccess) fprintf(stderr, "kernel_launch: launch failed: %s\n", hipGetErrorName(le));
}
```

```cpp
#include <hip/hip_runtime.h>
#include <cstdio>
#include <cstdint>
namespace pg8 {
#define PG8_LAS __attribute__((address_space(3)))
typedef unsigned short bf16_t;
typedef short bf16x8 __attribute__((ext_vector_type(8)));
typedef float f32x4 __attribute__((ext_vector_type(4)));
typedef unsigned u32x4 __attribute__((ext_vector_type(4)));
constexpr int BM = 256, BK = 64, HALF = 128, HTB = HALF * BK * 2  , STAGE_BYTES = 8 * HTB, NXCD = 8, WGM = 8;

__host__ __device__ __forceinline__ int lds_byte(int r, int c) { const int st = (r >> 4) * 2 + (c >> 5), rr = r & 15, cc = c & 31, ob = rr * 64 + cc * 2; return st * 1024 + (ob ^ (((ob >> 9) & 1) << 5)); }
__host__ __device__ __forceinline__ void stage_rc(int b, int& R, int& C) { const int st = b / 1024, sb = b % 1024, swz = sb ^ (((sb >> 9) & 1) << 5); R = (st >> 1) * 16 + swz / 64; C = (st & 1) * 32 + (swz % 64) / 2; }
__host__ __device__ __forceinline__ int perm32(int rho) { const int n = rho >> 4, i = rho & 15; return 8 * (i >> 2) + 4 * n + (i & 3); }

struct Unit { int pm, pn; };
struct Gemm { const bf16_t* A; const bf16_t* Bt; int M, N, K; };

struct StaticOrder {
    int nM, nN, nwg, G, c;
    __host__ __device__ void init(int M, int N, int G_, int c_) { nM = M / BM; nN = N / BM; nwg = nM * nN; G = G_; c = c_; }
    __host__ __device__ bool next(int i, Unit& u) const {
        const long L = (long)i * G + c; if (L >= nwg) return false;
        int wgid = (int)L; { const int q = nwg / NXCD, r = nwg % NXCD, xcd = wgid % NXCD, off = wgid / NXCD; wgid = (xcd < r ? xcd * (q + 1) : r * (q + 1) + (xcd - r) * q) + off; }
        const int nig = WGM * nN, gid = wgid / nig, fm = gid * WGM, gsz = (nM - fm) < WGM ? (nM - fm) : WGM;
        u.pm = fm + ((wgid % nig) % gsz); u.pn = (wgid % nig) / gsz; return true;
    }
    __device__ __forceinline__ void a_ready(const Unit&) const {}
    __device__ __forceinline__ void done(const Unit&) const {}
};

__device__ __forceinline__ unsigned cvt_pk_bf16(float lo, float hi) { unsigned r; asm volatile("v_cvt_pk_bf16_f32 %0, %1, %2" : "=v"(r) : "v"(lo), "v"(hi)); return r; }
struct EpiZ {
    static constexpr bool PERM = true, AFTER_DRAIN = false;
    bf16_t* O; int ldc; const float* rs; int qcols; float qscale;
    __device__ __forceinline__ void operator()(const f32x4 (&acc)[2][2][4][2], const Unit& u, int wr, int wc, int fr, int fq) const {
        const int row0 = u.pm * BM + wr * 64 + fr; const int colt = u.pn * BM;
        const float sc = (colt < qcols) ? qscale : 1.f;
        const int col0 = colt + wc * 32 + 8 * fq;
#pragma unroll
        for (int ai = 0; ai < 2; ++ai)
#pragma unroll
            for (int m = 0; m < 4; ++m) { const int row = row0 + ai * HALF + m * 16; const float s = rs[row] * sc; bf16_t* rowp = O + (size_t)row * ldc + col0;
#pragma unroll
                for (int bj = 0; bj < 2; ++bj) { const f32x4 v0 = acc[ai][bj][m][0] * s, v1 = acc[ai][bj][m][1] * s;
                    u32x4 w; w.x = cvt_pk_bf16(v0[0], v0[1]); w.y = cvt_pk_bf16(v0[2], v0[3]); w.z = cvt_pk_bf16(v1[0], v1[1]); w.w = cvt_pk_bf16(v1[2], v1[3]);
                    *(u32x4*)(rowp + bj * HALF) = w; } }
    }
};
struct EpiRes {
    static constexpr bool PERM = true, AFTER_DRAIN = false;
    const float* X; float* X1; bf16_t* X1b; float* SS; int ldc;
    __device__ __forceinline__ void operator()(const f32x4 (&acc)[2][2][4][2], const Unit& u, int wr, int wc, int fr, int fq) const {
        const int row0 = u.pm * BM + wr * 64 + fr; const int col0 = u.pn * BM + wc * 32 + 8 * fq;
#pragma unroll
        for (int ai = 0; ai < 2; ++ai)
#pragma unroll
            for (int m = 0; m < 4; ++m) { const int row = row0 + ai * HALF + m * 16; const size_t off = (size_t)row * ldc + col0; float ss = 0.f;
#pragma unroll
                for (int bj = 0; bj < 2; ++bj) {
                    const f32x4 x0 = *(const f32x4*)(X + off + bj * HALF), x1 = *(const f32x4*)(X + off + bj * HALF + 4);
                    const f32x4 v0 = acc[ai][bj][m][0] + x0, v1 = acc[ai][bj][m][1] + x1;
                    *(f32x4*)(X1 + off + bj * HALF) = v0; *(f32x4*)(X1 + off + bj * HALF + 4) = v1;
                    ss += (v0[0] * v0[0] + v0[1] * v0[1]) + (v0[2] * v0[2] + v0[3] * v0[3]) + (v1[0] * v1[0] + v1[1] * v1[1]) + (v1[2] * v1[2] + v1[3] * v1[3]);
                    u32x4 w; w.x = cvt_pk_bf16(v0[0], v0[1]); w.y = cvt_pk_bf16(v0[2], v0[3]); w.z = cvt_pk_bf16(v1[0], v1[1]); w.w = cvt_pk_bf16(v1[2], v1[3]);
                    *(u32x4*)(X1b + off + bj * HALF) = w; }
                ss += __shfl_xor(ss, 16); ss += __shfl_xor(ss, 32);
                if (fq == 0) SS[(size_t)row * 16 + u.pn * 4 + wc] = ss;
                if (m & 1) asm volatile("" ::: "memory"); }
    }
};
struct EpiF32 {
    static constexpr bool PERM = true, AFTER_DRAIN = false;
    float* O; int ldc;
    __device__ __forceinline__ void operator()(const f32x4 (&acc)[2][2][4][2], const Unit& u, int wr, int wc, int fr, int fq) const {
        const int row0 = u.pm * BM + wr * 64 + fr; const int col0 = u.pn * BM + wc * 32 + 8 * fq;
#pragma unroll
        for (int ai = 0; ai < 2; ++ai)
#pragma unroll
            for (int m = 0; m < 4; ++m) { float* rowp = O + (size_t)(row0 + ai * HALF + m * 16) * ldc + col0;
#pragma unroll
                for (int bj = 0; bj < 2; ++bj) { *(f32x4*)(rowp + bj * HALF) = acc[ai][bj][m][0]; *(f32x4*)(rowp + bj * HALF + 4) = acc[ai][bj][m][1]; } }
    }
};

template <class Epi, class Sched, bool ALIGN_EPI = false, bool SP2 = false>
__device__ __forceinline__ void gemm_phase(PG8_LAS unsigned char* lds, const Gemm g, const Sched& S, const Epi& E) {
    const int tid = threadIdx.x, wid = __builtin_amdgcn_readfirstlane(tid >> 6), lane = tid & 63, wr = wid >> 2, wc = wid & 3, fr = lane & 15, fq = lane >> 4;
    const int K = g.K, nt = K / BK;
    unsigned voffA[2], voffB[2];
#pragma unroll
    for (int i = 0; i < 2; ++i) { int R, C; stage_rc(tid * 16 + i * 8192, R, C); const int Rb = Epi::PERM ? ((R & ~31) + perm32(R & 31)) : R;
        voffA[i] = (unsigned)(R * K + C) * 2u; voffB[i] = (unsigned)(Rb * K + C) * 2u; }
    const size_t kstep = (size_t)(BK * 2);
    const size_t hstep = (size_t)HALF * K * 2;
    const size_t tstep = 2 * hstep;
    const unsigned ldsw = (unsigned)wid * 1024u;
    const int aoff = lds_byte(wr * 64 + fr, fq * 8), boff = lds_byte(wc * 32 + fr, fq * 8);
#define PG8_SA(b, h) (((b) * 2 + (h)) * HTB)
#define PG8_SB(b, h) ((4 + (b) * 2 + (h)) * HTB)
#define PG8_STAGE(bufoff, gbase, voff) do { _Pragma("unroll") for (int _i = 0; _i < 2; ++_i) \
        __builtin_amdgcn_global_load_lds((const unsigned*)((const char*)(gbase) + (voff)[_i]), (PG8_LAS unsigned*)(lds + (bufoff) + ldsw + _i * 8192), 16, 0, 0); } while (0)
#define PG8_LDA(dst, b, h) do { _Pragma("unroll") for (int m = 0; m < 4; ++m) _Pragma("unroll") for (int k = 0; k < 2; ++k) dst[m][k] = *(const PG8_LAS bf16x8*)(lds + PG8_SA(b, h) + aoff + m * 2048 + k * 1024); } while (0)
#define PG8_LDB(dst, b, h) do { _Pragma("unroll") for (int n = 0; n < 2; ++n) _Pragma("unroll") for (int k = 0; k < 2; ++k) dst[n][k] = *(const PG8_LAS bf16x8*)(lds + PG8_SB(b, h) + boff + n * 2048 + k * 1024); } while (0)
#define PG8_MMA(ai, bj, At, Bt) do { __builtin_amdgcn_s_setprio(1); _Pragma("unroll") for (int m = 0; m < 4; ++m) _Pragma("unroll") for (int n = 0; n < 2; ++n) _Pragma("unroll") for (int k = 0; k < 2; ++k) \
        acc[ai][bj][m][n] = __builtin_amdgcn_mfma_f32_16x16x32_bf16(Bt[n][k], At[m][k], acc[ai][bj][m][n], 0, 0, 0); __builtin_amdgcn_s_setprio(0); } while (0)
#define PG8_WAIT_V(n) asm volatile("s_waitcnt vmcnt(" #n ")" ::: "memory")
#define PG8_WAIT_L(n) asm volatile("s_waitcnt lgkmcnt(" #n ")" ::: "memory")
#define PG8_BAR __builtin_amdgcn_s_barrier()
#define PG8_SCHED __builtin_amdgcn_sched_barrier(0)
    Unit cur, nxt; int ui = 0;
    if (!S.next(0, cur)) return;
    f32x4 acc[2][2][4][2];
#pragma unroll
    for (int a = 0; a < 2; ++a)
#pragma unroll
        for (int b = 0; b < 2; ++b)
#pragma unroll
            for (int m = 0; m < 4; ++m)
#pragma unroll
                for (int n = 0; n < 2; ++n) acc[a][b][m][n] = (f32x4){0.f, 0.f, 0.f, 0.f};
    bf16x8 At[4][2], B0[2][2], B1[2][2];
    const char* cA = (const char*)g.A + (size_t)cur.pm * tstep; const char* cB = (const char*)g.Bt + (size_t)cur.pn * tstep;
    S.a_ready(cur);
    if constexpr (SP2) {
        PG8_STAGE(PG8_SB(0, 0), cB, voffB); PG8_STAGE(PG8_SB(0, 1), cB + hstep, voffB); PG8_STAGE(PG8_SA(0, 0), cA, voffA); PG8_STAGE(PG8_SA(0, 1), cA + hstep, voffA);
        if (wr == 1) PG8_BAR;
        PG8_WAIT_V(2); PG8_BAR;
        PG8_STAGE(PG8_SB(1, 0), cB + kstep, voffB); PG8_STAGE(PG8_SA(1, 0), cA + kstep, voffA); PG8_STAGE(PG8_SB(1, 1), cB + hstep + kstep, voffB);
        PG8_WAIT_V(6); PG8_BAR;
    } else {
        PG8_STAGE(PG8_SB(0, 0), cB, voffB); PG8_STAGE(PG8_SA(0, 0), cA, voffA); PG8_STAGE(PG8_SB(0, 1), cB + hstep, voffB); PG8_STAGE(PG8_SA(0, 1), cA + hstep, voffA);
        if (wr == 1) PG8_BAR;
        PG8_WAIT_V(4); PG8_BAR;
        PG8_STAGE(PG8_SB(1, 0), cB + kstep, voffB); PG8_STAGE(PG8_SA(1, 0), cA + kstep, voffA); PG8_STAGE(PG8_SB(1, 1), cB + hstep + kstep, voffB);
        PG8_WAIT_V(6); PG8_BAR;
    }
    for (;;) {
        const bool has_next = S.next(ui + 1, nxt);
        const char* nA = has_next ? (const char*)g.A + (size_t)nxt.pm * tstep : cA; const char* nB = has_next ? (const char*)g.Bt + (size_t)nxt.pn * tstep : cB;
        for (int t = 0; t < nt; t += 2) {
            const bool last = (t == nt - 2);
            const char* a1 = cA + (size_t)(t + 1) * kstep;
            const char* a2 = last ? nA : cA + (size_t)(t + 2) * kstep; const char* b2 = last ? nB : cB + (size_t)(t + 2) * kstep;
            const char* a3 = a2 + kstep; const char* b3 = b2 + kstep;
            if (last && has_next) S.a_ready(nxt);
            if constexpr (SP2) {
            PG8_LDB(B0, 0, 0); PG8_LDB(B1, 0, 1); PG8_SCHED; PG8_LDA(At, 0, 0); PG8_STAGE(PG8_SA(1, 1), a1 + hstep, voffA);
            PG8_WAIT_V(8); PG8_WAIT_L(0); PG8_BAR; PG8_MMA(0, 0, At, B0); PG8_MMA(0, 1, At, B1); PG8_BAR; PG8_SCHED;
            PG8_LDA(At, 0, 1); PG8_STAGE(PG8_SB(0, 0), b2, voffB); PG8_STAGE(PG8_SB(0, 1), b2 + hstep, voffB); PG8_STAGE(PG8_SA(0, 0), a2, voffA);
            PG8_WAIT_V(8); PG8_WAIT_L(0); PG8_BAR; PG8_MMA(1, 0, At, B0); PG8_MMA(1, 1, At, B1); PG8_BAR; PG8_SCHED;
            PG8_LDB(B0, 1, 0); PG8_LDB(B1, 1, 1); PG8_SCHED; PG8_LDA(At, 1, 0); PG8_STAGE(PG8_SA(0, 1), a2 + hstep, voffA);
            PG8_WAIT_V(8); PG8_WAIT_L(0); PG8_BAR; PG8_MMA(0, 0, At, B0); PG8_MMA(0, 1, At, B1); PG8_BAR; PG8_SCHED;
            PG8_LDA(At, 1, 1); PG8_STAGE(PG8_SB(1, 0), b3, voffB); PG8_STAGE(PG8_SB(1, 1), b3 + hstep, voffB); PG8_STAGE(PG8_SA(1, 0), a3, voffA);
            PG8_WAIT_V(8); PG8_WAIT_L(0); PG8_BAR; PG8_MMA(1, 0, At, B0); PG8_MMA(1, 1, At, B1); PG8_BAR; PG8_SCHED;
            } else {
            PG8_LDB(B0, 0, 0); PG8_SCHED; PG8_LDA(At, 0, 0); PG8_STAGE(PG8_SA(1, 1), a1 + hstep, voffA);
            PG8_WAIT_L(8); PG8_BAR; PG8_WAIT_L(0); PG8_MMA(0, 0, At, B0); PG8_BAR; PG8_SCHED;
            PG8_LDB(B1, 0, 1); PG8_STAGE(PG8_SB(0, 0), b2, voffB);
            PG8_BAR; PG8_WAIT_L(0); PG8_MMA(0, 1, At, B1); PG8_BAR;
            PG8_LDA(At, 0, 1); PG8_STAGE(PG8_SA(0, 0), a2, voffA);
            PG8_BAR; PG8_WAIT_L(0); PG8_MMA(1, 0, At, B0); PG8_BAR; PG8_SCHED;
            PG8_STAGE(PG8_SB(0, 1), b2 + hstep, voffB);
            PG8_WAIT_V(6); PG8_BAR; PG8_MMA(1, 1, At, B1); PG8_BAR;
            PG8_LDB(B0, 1, 0); PG8_SCHED; PG8_LDA(At, 1, 0); PG8_STAGE(PG8_SA(0, 1), a2 + hstep, voffA);
            PG8_WAIT_L(8); PG8_BAR; PG8_WAIT_L(0); PG8_MMA(0, 0, At, B0); PG8_BAR; PG8_SCHED;
            PG8_LDB(B1, 1, 1); PG8_STAGE(PG8_SB(1, 0), b3, voffB);
            PG8_BAR; PG8_WAIT_L(0); PG8_MMA(0, 1, At, B1); PG8_BAR;
            PG8_LDA(At, 1, 1); PG8_STAGE(PG8_SA(1, 0), a3, voffA);
            PG8_BAR; PG8_WAIT_L(0); PG8_MMA(1, 0, At, B0); PG8_BAR; PG8_SCHED;
            PG8_STAGE(PG8_SB(1, 1), b3 + hstep, voffB);
            PG8_WAIT_V(6); PG8_BAR; PG8_MMA(1, 1, At, B1); PG8_BAR;
            }
        }
        if constexpr (ALIGN_EPI) { if (wr == 0) PG8_BAR; }
        if constexpr (!Epi::AFTER_DRAIN) { E(acc, cur, wr, wc, fr, fq); S.done(cur); }
        if (!has_next) break;
#pragma unroll
        for (int a = 0; a < 2; ++a)
#pragma unroll
            for (int b = 0; b < 2; ++b)
#pragma unroll
                for (int m = 0; m < 4; ++m)
#pragma unroll
                    for (int n = 0; n < 2; ++n) acc[a][b][m][n] = (f32x4){0.f, 0.f, 0.f, 0.f};
        cur = nxt; cA = nA; cB = nB; ++ui;
        if constexpr (ALIGN_EPI) { if (wr == 1) PG8_BAR; }
    }
    PG8_WAIT_V(0);
    if constexpr (!ALIGN_EPI) { if (wr == 0) PG8_BAR; }
    PG8_BAR;
    if constexpr (Epi::AFTER_DRAIN) { E.fused(acc, cur, wr, wc, fr, fq, lds, wid, lane); S.done(cur); }
#undef PG8_SA
#undef PG8_SB
#undef PG8_STAGE
#undef PG8_LDA
#undef PG8_LDB
#undef PG8_MMA
#undef PG8_WAIT_V
#undef PG8_WAIT_L
#undef PG8_BAR
#undef PG8_SCHED
}
}
#define PG8_SP2 true
#define PG8_ALIGN true

constexpr int NWAVES = 8;
constexpr int BATCH = 4, SEQ = 8192, D = 1024, M = BATCH * SEQ;
constexpr int NH = 8, HD = 64, DATT = 512, DPOOL = 512, NZ = 3 * DATT + DPOOL;
constexpr int PEER_H = 8, NKEYS = 128, NEXP = NKEYS * NKEYS, TOPK = 16, NSC = PEER_H * 2 * NKEYS;
constexpr float EPS = 1e-6f;
constexpr float QSCALE = 0.125f * 1.4426950408889634f;

constexpr size_t MiB = 1u << 20;
constexpr size_t WS_CTL = 0, CTL_ZERO_BYTES = 64 * 1024;
constexpr size_t WS_R1 = 1 * MiB;
constexpr size_t WS_SS = 2 * MiB;
constexpr size_t WS_LSE = 4 * MiB;
constexpr size_t WS_WIN = 8 * MiB;
constexpr size_t WS_WOUT = 12 * MiB;
constexpr size_t WS_WSC = 14 * MiB;
constexpr size_t WS_EU = 32 * MiB, WS_EV = 64 * MiB;
constexpr size_t WS_XB = 96 * MiB;
constexpr size_t WS_Z = 160 * MiB;
constexpr size_t WS_OB = 288 * MiB;
constexpr size_t WS_MIX = 384 * MiB;
constexpr size_t WS_SC = 160 * MiB;
constexpr size_t WS_IDX = 448 * MiB, WS_GATE = 464 * MiB;
constexpr size_t WS_END = 480 * MiB;
static_assert(WS_SC + (size_t)M * NSC * 4 <= WS_IDX, "ws map");

constexpr int LDS_BYTES = 147456;
constexpr int LDSCTL_OFF = 146432, MISC_OFF = LDSCTL_OFF + 320;
constexpr int RING_OFF = 0;

#define GAS __attribute__((address_space(1)))
#define LAS __attribute__((address_space(3)))
typedef unsigned short bf16;
typedef unsigned v4u __attribute__((ext_vector_type(4)));
typedef unsigned v2u __attribute__((ext_vector_type(2)));
typedef float f32x4 __attribute__((ext_vector_type(4)));
typedef float f32x16 __attribute__((ext_vector_type(16)));
typedef short bf16x8 __attribute__((ext_vector_type(8)));
typedef short s16x4 __attribute__((ext_vector_type(4)));
typedef GAS unsigned gu32;
#define RLX_AGENT __ATOMIC_RELAXED, __HIP_MEMORY_SCOPE_AGENT
#define LDS_WAIT() asm volatile("s_waitcnt lgkmcnt(0)" ::: "memory")
#define VM_WAIT() asm volatile("s_waitcnt vmcnt(0)" ::: "memory")
__device__ __forceinline__ unsigned f2bf(float f) { unsigned u = __builtin_bit_cast(unsigned, f); return (u + 0x7fffu + ((u >> 16) & 1u)) >> 16; }
__device__ __forceinline__ unsigned pk2(float lo, float hi) { return f2bf(lo) | (f2bf(hi) << 16); }
__device__ __forceinline__ float bflo(unsigned w) { return __builtin_bit_cast(float, w << 16); }
__device__ __forceinline__ float bfhi(unsigned w) { return __builtin_bit_cast(float, w & 0xffff0000u); }
#define XB_TMO      128
#define XB_XCNT(j)  (256  + 64 * (j))
#define XB_XSUB(j)  (1280 + 64 * (j))
#define XB_XGEN(j)  (2304 + 64 * (j))
#define XB_TOP      3328
#define XB_TOPGEN   3392
#define XCD_BAR_WORDS 3456
#define XB_SPIN_CAP (1u << 18)

__device__ __forceinline__ unsigned xb_ld(unsigned* p)              { return __hip_atomic_load(p, __ATOMIC_RELAXED, __HIP_MEMORY_SCOPE_AGENT); }
__device__ __forceinline__ unsigned xb_add(unsigned* p, unsigned v) { return __hip_atomic_fetch_add(p, v, __ATOMIC_RELAXED, __HIP_MEMORY_SCOPE_AGENT); }
__device__ __forceinline__ unsigned xb_xcc_id() { return (unsigned)__builtin_amdgcn_s_getreg((3 << 11) | 20) & 0xFu; }
#define XB_SPIN(cond, bar) do { unsigned _sp = 0; while (cond) { __builtin_amdgcn_s_sleep(1); \
    if ((++_sp & 255u) == 0u) { if (xb_ld(&(bar)[XB_TMO])) break; if (_sp > XB_SPIN_CAP) { atomicAdd(&(bar)[XB_TMO], 1u); break; } } } } while (0)

struct XcdBarrier {
    unsigned* bar; unsigned x;
    volatile LAS unsigned* st;
};

__device__ __forceinline__ XcdBarrier xcd_barrier_post(unsigned* bar, volatile LAS unsigned* st) {
    XcdBarrier b; b.bar = bar; b.x = xb_xcc_id(); b.st = st;
    if (threadIdx.x == 0) (void)xb_add(&bar[XB_XCNT(b.x)], 1u);
    return b;
}
__device__ __forceinline__ void xcd_barrier_complete(unsigned* bar, unsigned x, unsigned& nloc, unsigned& nx) {
    const unsigned G = gridDim.x * gridDim.y * gridDim.z;
    unsigned sum, cnt, mine, sp = 0u;
    for (;;) {
        sum = 0u; cnt = 0u; mine = 0u;
#pragma unroll
        for (unsigned j = 0; j < 16; ++j) { const unsigned c = xb_ld(&bar[XB_XCNT(j)]); sum += c; cnt += (c > 0u) ? 1u : 0u; mine = (j == x) ? c : mine; }
        if (sum == G) break;
        __builtin_amdgcn_s_sleep(1);
        if ((++sp & 255u) == 0u) { if (xb_ld(&bar[XB_TMO])) break; if (sp > XB_SPIN_CAP) { atomicAdd(&bar[XB_TMO], 1u); break; } }
    }
    nloc = mine > 0u ? mine : 1u; nx = cnt > 0u ? cnt : 1u;
}

__device__ __forceinline__ void xcd_barrier(const XcdBarrier& b) {
    asm volatile("s_waitcnt vmcnt(0)" ::: "memory");
    __syncthreads();
    if (threadIdx.x == 0) {
        unsigned* bar = b.bar;
        __builtin_amdgcn_s_waitcnt(0);
        unsigned nloc = b.st[0], nx = b.st[1];
        if (nloc == 0u) { xcd_barrier_complete(bar, b.x, nloc, nx); b.st[0] = nloc; b.st[1] = nx; }
        const unsigned old = xb_add(&bar[XB_XSUB(b.x)], 1u);
        const unsigned gen = old / nloc;
        if (old + 1u == (gen + 1u) * nloc) {
            __builtin_amdgcn_fence(__ATOMIC_RELEASE, "agent");
            asm volatile("s_waitcnt vmcnt(0)" ::: "memory");
            const unsigned og = xb_add(&bar[XB_TOP], 1u);
            const unsigned tg = og / nx;
            if (og + 1u == (tg + 1u) * nx) xb_add(&bar[XB_TOPGEN], 1u);
            else XB_SPIN(xb_ld(&bar[XB_TOPGEN]) == tg, bar);
            __builtin_amdgcn_fence(__ATOMIC_ACQUIRE, "agent");
            xb_add(&bar[XB_XGEN(b.x)], 1u);
            asm volatile("s_waitcnt vmcnt(0)" ::: "memory");
        } else {
            XB_SPIN(xb_ld(&bar[XB_XGEN(b.x)]) == gen, bar);
            __builtin_amdgcn_fence(__ATOMIC_ACQUIRE, "agent");
            asm volatile("s_waitcnt vmcnt(0)" ::: "memory");
        }
    }
    __syncthreads();
}

struct Frame {
    LAS unsigned char* lds;
    volatile LAS unsigned* MISC;
    int tid, lane, wave;
    int vcu, G;
    const float *x, *norm_mix, *w_in, *w_pool, *pool_scale, *w_out, *norm_ffn, *w_query, *sub_keys, *expert_u, *expert_v, *norm_final;
    float* out;
    unsigned char* ws;
};

__device__ __forceinline__ float wave_sum(float v) {
#pragma unroll
    for (int o = 1; o < 64; o <<= 1) v += __shfl_xor(v, o);
    return v;
}

__device__ __forceinline__ void p0_transpose_item(const float* W, int N, const float* ks, bf16* WT, int ldo, int col_off, LAS float* scr, int item, int lane) {
    const int nblk = N / 32, kb = item / nblk, nb = item % nblk, k0 = 64 * kb, n0 = 32 * nb;
#pragma unroll 8
    for (int i = 0; i < 32; ++i) { const int kk = 2 * i + (lane >> 5); const float s = ks ? ks[k0 + kk] : 1.f; scr[kk * 33 + (lane & 31)] = W[(size_t)(k0 + kk) * N + n0 + (lane & 31)] * s; }
    LDS_WAIT(); asm volatile("" ::: "memory");
    const int c = lane & 7;
#pragma unroll
    for (int j = 0; j < 4; ++j) { const int n = (lane >> 3) + 8 * j; const LAS float* s = scr + (8 * c) * 33 + n;
        v4u o; o.x = pk2(s[0 * 33], s[1 * 33]); o.y = pk2(s[2 * 33], s[3 * 33]); o.z = pk2(s[4 * 33], s[5 * 33]); o.w = pk2(s[6 * 33], s[7 * 33]);
        *(GAS v4u*)(WT + (size_t)(n0 + n) * ldo + col_off + k0 + 8 * c) = o; }
    LDS_WAIT(); asm volatile("" ::: "memory");
}

__device__ __forceinline__ void p0_prologue(Frame& F) {
    LAS float* scr = (LAS float*)(F.lds + RING_OFF + F.wave * 16384);
    const int gw = F.vcu * NWAVES + F.wave, NGW = F.G * NWAVES;
    bf16* WIN = (bf16*)(F.ws + WS_WIN); bf16* WOUT = (bf16*)(F.ws + WS_WOUT); bf16* WSC = (bf16*)(F.ws + WS_WSC);
    constexpr int I_IN = (D / 64) * (NZ / 32), I_OUT = (DATT / 64) * (D / 32);
    for (int it = gw; it < I_IN + I_OUT; it += NGW) {
        if (it < I_IN) p0_transpose_item(F.w_in, NZ, F.norm_mix, WIN, D, 0, scr, it, F.lane);
        else p0_transpose_item(F.w_out, D, nullptr, WOUT, D, 0, scr, it - I_IN, F.lane);
    }
    const int gt = (F.vcu * NWAVES + F.wave) * 64 + F.lane, NGT = F.G * NWAVES * 64;
    for (int it = gt; it < DPOOL * (D / 4); it += NGT) {
        const int cin = it / (D / 4), n4 = (it % (D / 4)) * 4, g = cin >> 7;
        const float* wp = F.w_pool + (size_t)cin * 128;
        const float* ps = F.pool_scale + g * 128;
        const float* wo = F.w_out + (size_t)(DATT + g * 128) * D + n4;
        f32x4 acc = {0.f, 0.f, 0.f, 0.f};
#pragma unroll 4
        for (int d = 0; d < 128; ++d) { const float a = wp[d] * ps[d]; const f32x4 b = *(const f32x4*)(wo + (size_t)d * D); acc += a * b; }
#pragma unroll
        for (int j = 0; j < 4; ++j) WOUT[(size_t)(n4 + j) * D + DATT + cin] = (bf16)f2bf(acc[j]);
    }
    for (int it = gt; it < 16 * 32 * 256; it += NGT) {
        const int d4 = (it & 255) * 4, k4 = ((it >> 8) & 31) * 4, blk = it >> 13;
        const float* wq = F.w_query + (size_t)d4 * NSC + blk * 128;
        const float* sk = F.sub_keys + (size_t)(blk * 128 + k4) * 128;
        float acc[4][4];
#pragma unroll
        for (int i = 0; i < 4; ++i)
#pragma unroll
            for (int j = 0; j < 4; ++j) acc[i][j] = 0.f;
        for (int c = 0; c < 128; c += 4) {
            f32x4 a[4], b[4];
#pragma unroll
            for (int i = 0; i < 4; ++i) { a[i] = *(const f32x4*)(sk + i * 128 + c); b[i] = *(const f32x4*)(wq + (size_t)i * NSC + c); }
#pragma unroll
            for (int i = 0; i < 4; ++i)
#pragma unroll
                for (int j = 0; j < 4; ++j) acc[i][j] += a[i][0] * b[j][0] + a[i][1] * b[j][1] + a[i][2] * b[j][2] + a[i][3] * b[j][3];
        }
        const f32x4 gf = *(const f32x4*)(F.norm_ffn + d4);
#pragma unroll
        for (int i = 0; i < 4; ++i) { v2u o; o.x = pk2(acc[i][0] * gf[0], acc[i][1] * gf[1]); o.y = pk2(acc[i][2] * gf[2], acc[i][3] * gf[3]);
            *(GAS v2u*)(WSC + (size_t)(blk * 128 + k4 + i) * D + d4) = o; }
    }
    {
        unsigned char* EU = F.ws + WS_EU; unsigned char* EV = F.ws + WS_EV;
        const size_t n16 = (size_t)NEXP * D / 16;
        for (size_t i0 = gt; i0 < 2 * n16; i0 += (size_t)4 * NGT) {
            f32x4 a[4][4];
#pragma unroll
            for (int r = 0; r < 4; ++r) { const size_t i = i0 + (size_t)r * NGT; if (i < 2 * n16) { const bool second = i >= n16; const size_t j = second ? i - n16 : i;
                const float* src = (second ? F.expert_v : F.expert_u) + j * 16;
#pragma unroll
                for (int q = 0; q < 4; ++q) a[r][q] = *(const f32x4*)(src + 4 * q); } }
#pragma unroll
            for (int r = 0; r < 4; ++r) { const size_t i = i0 + (size_t)r * NGT; if (i < 2 * n16) { const bool second = i >= n16; const size_t j = second ? i - n16 : i; const float sc = second ? 4.0f : 32.0f;
                v4u o;
#pragma unroll
                for (int q = 0; q < 4; ++q) { f32x4 v = a[r][q] * sc; if (!second) v = v * *(const f32x4*)(F.norm_ffn + ((j * 16) & (D - 1)) + 4 * q); int w = __builtin_amdgcn_cvt_pk_fp8_f32(v[0], v[1], 0, false); w = __builtin_amdgcn_cvt_pk_fp8_f32(v[2], v[3], w, true); o[q] = (unsigned)w; }
                *(GAS v4u*)((second ? EV : EU) + j * 16) = o; } }
        }
    }
    {
        bf16* XB = (bf16*)(F.ws + WS_XB); float* R1 = (float*)(F.ws + WS_R1);
        for (int m0 = gw * 4; m0 < M; m0 += NGW * 4) {
            f32x4 a[4][4];
#pragma unroll
            for (int r = 0; r < 4; ++r) { const float* xr = F.x + (size_t)(m0 + r) * D + 8 * F.lane;
                a[r][0] = *(const f32x4*)(xr); a[r][1] = *(const f32x4*)(xr + 4); a[r][2] = *(const f32x4*)(xr + 512); a[r][3] = *(const f32x4*)(xr + 516); }
#pragma unroll
            for (int r = 0; r < 4; ++r) { float s = 0.f;
#pragma unroll
                for (int q = 0; q < 4; ++q) s += (a[r][q][0] * a[r][q][0] + a[r][q][1] * a[r][q][1]) + (a[r][q][2] * a[r][q][2] + a[r][q][3] * a[r][q][3]);
#pragma unroll
                for (int j = 0; j < 2; ++j) { v4u o; o.x = pk2(a[r][2 * j][0], a[r][2 * j][1]); o.y = pk2(a[r][2 * j][2], a[r][2 * j][3]); o.z = pk2(a[r][2 * j + 1][0], a[r][2 * j + 1][1]); o.w = pk2(a[r][2 * j + 1][2], a[r][2 * j + 1][3]);
                    *(GAS v4u*)(XB + (size_t)(m0 + r) * D + 8 * F.lane + 512 * j) = o; }
                s = wave_sum(s);
                if (F.lane == 0) R1[m0 + r] = 1.0f / sqrtf(s * (1.0f / D) + EPS); }
        }
    }
}

constexpr int ATT_KEYS = 384, ATT_KCH = ATT_KEYS * 16 + 16;
constexpr int ATT_K_OFF = 0, ATT_V_OFF = 8 * ATT_KCH;
constexpr int ATT_VDH = 24 * 1024 + 64;
constexpr int ATT_OST_OFF = ATT_V_OFF + 2 * ATT_VDH;
constexpr int ATT_LDS_END = ATT_OST_OFF + NWAVES * 4096;
static_assert(ATT_V_OFF % 16 == 0 && ATT_OST_OFF % 16 == 0 && ATT_LDS_END <= LDSCTL_OFF, "attention LDS map");
constexpr int ATT_UNITS = BATCH * NH * 96;

__device__ __forceinline__ int crow(int r, int hi) { return (r & 3) + 8 * (r >> 2) + 4 * hi; }
__device__ __forceinline__ s16x4 vtr(const LAS unsigned char* p) { return __builtin_bit_cast(s16x4, __builtin_amdgcn_ds_read_tr16_b64_v4i16((LAS s16x4*)p)); }

__device__ __forceinline__ void attn_unit(Frame& F, int unit) {
    const int tid = F.tid, lane = F.lane, w = F.wave, r32 = lane & 31, hi = lane >> 5;
    const int bh = unit / 96, rem = unit % 96, br = rem >> 5, idx = rem & 31;
    const int b = bh >> 3, h = bh & 7;
    const int dsh = 2 * br, dil = 1 << dsh;
    const int ppr = 32 >> dsh;
    const int res = idx / ppr, pair = idx % ppr;
    const int s0 = pair * 256 - 128;
    const bf16* Z = (const bf16*)(F.ws + WS_Z);
    const size_t tokbase = (size_t)b * SEQ + res;
    {
        v4u kv[6], vv[6];
#pragma unroll
        for (int it = 0; it < 6; ++it) { const int p = tid + 512 * it, key = p >> 3, c = p & 7; int s = s0 + key; s = s < 0 ? 0 : s;
            const bf16* row = Z + (tokbase + ((size_t)s << dsh)) * NZ + h * HD + c * 8;
            kv[it] = *(const GAS v4u*)(row + DATT); vv[it] = *(const GAS v4u*)(row + 2 * DATT); }
#pragma unroll
        for (int it = 0; it < 6; ++it) { const int p = tid + 512 * it, key = p >> 3, c = p & 7;
            *(LAS v4u*)(F.lds + ATT_K_OFF + c * ATT_KCH + key * 16) = kv[it];
            *(LAS v4u*)(F.lds + ATT_V_OFF + (c >> 2) * ATT_VDH + (key >> 4) * 1024 + (key & 15) * 64 + (c & 3) * 16) = vv[it]; }
    }
    const int sq0 = pair * 256 + 32 * w;
    bf16x8 qr[4];
    {
        const bf16* qrow = Z + (tokbase + ((size_t)(sq0 + r32) << dsh)) * NZ + h * HD + hi * 8;
#pragma unroll
        for (int d0 = 0; d0 < 4; ++d0) qr[d0] = *(const GAS bf16x8*)(qrow + d0 * 16);
    }
    __syncthreads();
    f32x16 p[5];
#pragma unroll
    for (int j = 0; j < 5; ++j) {
        p[j] = f32x16{};
        const LAS unsigned char* kb = F.lds + ATT_K_OFF + hi * ATT_KCH + (32 * (w + j) + r32) * 16;
#pragma unroll
        for (int d0 = 0; d0 < 4; ++d0) { const bf16x8 kf = *(const LAS bf16x8*)(kb + 2 * d0 * ATT_KCH); p[j] = __builtin_amdgcn_mfma_f32_32x32x16_bf16(kf, qr[d0], p[j], 0, 0, 0); }
    }
    const float NEGB = -1e30f;
#pragma unroll
    for (int r = 0; r < 16; ++r) { const int kj = crow(r, hi); if (kj < r32) p[0][r] = NEGB; if (kj > r32) p[4][r] = NEGB; }
    if (pair == 0) {
#pragma unroll
        for (int j = 0; j < 4; ++j) if (w + j < 4) {
#pragma unroll
            for (int r = 0; r < 16; ++r) p[j][r] = NEGB; }
    }
    float mx = NEGB;
#pragma unroll
    for (int j = 0; j < 5; ++j)
#pragma unroll
        for (int r = 0; r < 16; ++r) mx = fmaxf(mx, p[j][r]);
    mx = fmaxf(mx, __shfl_xor(mx, 32));
    float l = 0.f;
#pragma unroll
    for (int j = 0; j < 5; ++j)
#pragma unroll
        for (int r = 0; r < 16; ++r) { const float e = __builtin_amdgcn_exp2f(p[j][r] - mx); p[j][r] = e; l += e; }
    l += __shfl_xor(l, 32);
    f32x16 o[2]; o[0] = f32x16{}; o[1] = f32x16{};
    const LAS unsigned char* vb = F.lds + ATT_V_OFF + (4 * hi + ((lane & 15) >> 2)) * 64 + ((lane >> 4) & 1) * 32 + (lane & 3) * 8;
#pragma unroll
    for (int j = 0; j < 5; ++j)
#pragma unroll
        for (int s = 0; s < 2; ++s) {
            v4u pw; pw.x = pk2(p[j][8 * s + 0], p[j][8 * s + 1]); pw.y = pk2(p[j][8 * s + 2], p[j][8 * s + 3]); pw.z = pk2(p[j][8 * s + 4], p[j][8 * s + 5]); pw.w = pk2(p[j][8 * s + 6], p[j][8 * s + 7]);
            const bf16x8 pa = __builtin_bit_cast(bf16x8, pw);
#pragma unroll
            for (int dh = 0; dh < 2; ++dh) {
                const LAS unsigned char* vp = vb + dh * ATT_VDH + (2 * (w + j) + s) * 1024;
                const s16x4 lo = vtr(vp), hh = vtr(vp + 512);
                const bf16x8 vf = (bf16x8){lo[0], lo[1], lo[2], lo[3], hh[0], hh[1], hh[2], hh[3]};
                o[dh] = __builtin_amdgcn_mfma_f32_32x32x16_bf16(pa, vf, o[dh], 0, 0, 0);
            }
        }
    const float rl = 1.0f / l;
    bf16* OB = (bf16*)(F.ws + WS_OB) + (size_t)br * M * DATT;
    float* LSE = (float*)(F.ws + WS_LSE) + (size_t)br * M * NH;
    LAS bf16* stg = (LAS bf16*)(F.lds + ATT_OST_OFF + w * 4096);
#pragma unroll
    for (int r = 0; r < 16; ++r) { const int orow = crow(r, hi); const float rr = __shfl(rl, orow);
#pragma unroll
        for (int dh = 0; dh < 2; ++dh) stg[orow * 64 + dh * 32 + r32] = (bf16)f2bf(o[dh][r] * rr); }
    if (hi == 0) LSE[(tokbase + ((size_t)(sq0 + r32) << dsh)) * NH + h] = mx + __builtin_amdgcn_logf(l);
    LDS_WAIT();
#pragma unroll
    for (int i = 0; i < 4; ++i) { const int row = i * 8 + (lane >> 3), ch = lane & 7; const v4u v = *(const LAS v4u*)(stg + row * 64 + ch * 8);
        *(GAS v4u*)(OB + (tokbase + ((size_t)(sq0 + row) << dsh)) * DATT + h * HD + ch * 8) = v; }
    __syncthreads();
}

__device__ __forceinline__ void pool_rows(Frame& F) {
    const bf16* Z = (const bf16*)(F.ws + WS_Z); bf16* MIX = (bf16*)(F.ws + WS_MIX);
    const int gw = F.vcu * NWAVES + F.wave, NGW = F.G * NWAVES;
    const int win = 2 << (F.lane >> 4);
    constexpr int TPW = 16;
    for (int it = gw; it < M / TPW; it += NGW) {
        const int tb = it * TPW, sb = tb & (SEQ - 1);
        const bf16* zc = Z + (size_t)tb * NZ + 3 * DATT + 8 * F.lane;
        float acc[8];
#pragma unroll
        for (int e = 0; e < 8; ++e) acc[e] = 0.f;
        for (int j = 1; j < win; ++j) if (sb - j >= 0) { const v4u v = *(const GAS v4u*)(zc - (long)j * NZ);
            acc[0] += bflo(v.x); acc[1] += bfhi(v.x); acc[2] += bflo(v.y); acc[3] += bfhi(v.y); acc[4] += bflo(v.z); acc[5] += bfhi(v.z); acc[6] += bflo(v.w); acc[7] += bfhi(v.w); }
#pragma unroll 4
        for (int i = 0; i < TPW; ++i) {
            const int s = sb + i; const v4u z0 = *(const GAS v4u*)(zc + (size_t)i * NZ);
            acc[0] += bflo(z0.x); acc[1] += bfhi(z0.x); acc[2] += bflo(z0.y); acc[3] += bfhi(z0.y); acc[4] += bflo(z0.z); acc[5] += bfhi(z0.z); acc[6] += bflo(z0.w); acc[7] += bfhi(z0.w);
            const int cnt = (s + 1) < win ? (s + 1) : win; const float inv = 1.0f / (float)cnt;
            v4u o; o.x = pk2(acc[0] * inv - bflo(z0.x), acc[1] * inv - bfhi(z0.x)); o.y = pk2(acc[2] * inv - bflo(z0.y), acc[3] * inv - bfhi(z0.y));
            o.z = pk2(acc[4] * inv - bflo(z0.z), acc[5] * inv - bfhi(z0.z)); o.w = pk2(acc[6] * inv - bflo(z0.w), acc[7] * inv - bfhi(z0.w));
            *(GAS v4u*)(MIX + (size_t)(tb + i) * D + DATT + 8 * F.lane) = o;
            if (s - (win - 1) >= 0) { const v4u v = *(const GAS v4u*)(zc + (long)(i - (win - 1)) * NZ);
                acc[0] -= bflo(v.x); acc[1] -= bfhi(v.x); acc[2] -= bflo(v.y); acc[3] -= bfhi(v.y); acc[4] -= bflo(v.z); acc[5] -= bfhi(v.z); acc[6] -= bflo(v.w); acc[7] -= bfhi(v.w); }
        }
    }
}

__device__ __forceinline__ void merge_rows(Frame& F) {
    const bf16* OB = (const bf16*)(F.ws + WS_OB); const float* LSE = (const float*)(F.ws + WS_LSE); bf16* MIX = (bf16*)(F.ws + WS_MIX);
    const int gw = F.vcu * NWAVES + F.wave, NGW = F.G * NWAVES;
    for (int t = gw; t < M; t += NGW) {
        const int h = F.lane >> 3;
        const float l0 = LSE[(size_t)t * NH + h], l1 = LSE[(size_t)(M + t) * NH + h], l2 = LSE[(size_t)(2 * M + t) * NH + h];
        const float mx = fmaxf(l0, fmaxf(l1, l2));
        float w0 = __builtin_amdgcn_exp2f(l0 - mx), w1 = __builtin_amdgcn_exp2f(l1 - mx), w2 = __builtin_amdgcn_exp2f(l2 - mx);
        const float inv = 1.0f / (w0 + w1 + w2); w0 *= inv; w1 *= inv; w2 *= inv;
        const size_t off = (size_t)t * DATT + 8 * F.lane;
        const v4u a = *(const GAS v4u*)(OB + off), b = *(const GAS v4u*)(OB + (size_t)M * DATT + off), c = *(const GAS v4u*)(OB + (size_t)2 * M * DATT + off);
        v4u o;
        o.x = pk2(w0 * bflo(a.x) + w1 * bflo(b.x) + w2 * bflo(c.x), w0 * bfhi(a.x) + w1 * bfhi(b.x) + w2 * bfhi(c.x));
        o.y = pk2(w0 * bflo(a.y) + w1 * bflo(b.y) + w2 * bflo(c.y), w0 * bfhi(a.y) + w1 * bfhi(b.y) + w2 * bfhi(c.y));
        o.z = pk2(w0 * bflo(a.z) + w1 * bflo(b.z) + w2 * bflo(c.z), w0 * bfhi(a.z) + w1 * bfhi(b.z) + w2 * bfhi(c.z));
        o.w = pk2(w0 * bflo(a.w) + w1 * bflo(b.w) + w2 * bflo(c.w), w0 * bfhi(a.w) + w1 * bfhi(b.w) + w2 * bfhi(c.w));
        *(GAS v4u*)(MIX + (size_t)t * D + 8 * F.lane) = o;
    }
}

constexpr int TK_ROW = 68;
constexpr int TK_WAVE_BYTES = 64 * TK_ROW * 4;
static_assert(NWAVES * TK_WAVE_BYTES <= LDSCTL_OFF, "top-k LDS map");

__device__ __forceinline__ unsigned f2ord(float f) { const unsigned u = __builtin_bit_cast(unsigned, f); return (u & 0x80000000u) ? ~u : (u | 0x80000000u); }
__device__ __forceinline__ float ord2f(unsigned k) { const unsigned u = (k & 0x80000000u) ? (k & 0x7fffffffu) : ~k; return __builtin_bit_cast(float, u); }
#define TK_INSERT(L, xin) do { unsigned x_ = (xin); _Pragma("unroll") for (int i_ = 0; i_ < 16; ++i_) { const unsigned hi_ = max(L[i_], x_); x_ = min(L[i_], x_); L[i_] = hi_; } } while (0)

__device__ __forceinline__ void topk_phase(Frame& F) {
    const float* SC = (const float*)(F.ws + WS_SC); const float* SS = (const float*)(F.ws + WS_SS);
    int* IDX = (int*)(F.ws + WS_IDX); float* GATE = (float*)(F.ws + WS_GATE);
    const int gw = F.vcu * NWAVES + F.wave, NGW = F.G * NWAVES, lane = F.lane;
    LAS float* st = (LAS float*)(F.lds + F.wave * TK_WAVE_BYTES);
    for (int it = gw; it < M / 8; it += NGW) {
        const int t0 = it * 8;
        unsigned L0[16], L1[16];
#pragma unroll
        for (int i = 0; i < 16; ++i) { L0[i] = 0u; L1[i] = 0u; }
#pragma unroll
        for (int rnd = 0; rnd < 4; ++rnd) {
            const int p = rnd >> 1, kc = rnd & 1;
#pragma unroll
            for (int i = 0; i < 16; ++i) { const int pr = 4 * i + (lane >> 4), tl = pr >> 3, h = pr & 7;
                const f32x4 v = *(const GAS f32x4*)(SC + (size_t)(t0 + tl) * NSC + h * 256 + p * 128 + kc * 64 + (lane & 15) * 4);
                *(LAS f32x4*)(st + pr * TK_ROW + (lane & 15) * 4) = v; }
            LDS_WAIT(); asm volatile("" ::: "memory");
#pragma unroll 1
            for (int q = 0; q < 16; ++q) {
                const f32x4 v = *(const LAS f32x4*)(st + lane * TK_ROW + q * 4);
#pragma unroll
                for (int e = 0; e < 4; ++e) { const unsigned key = (f2ord(v[e]) & ~127u) | (unsigned)(127 - (kc * 64 + q * 4 + e));
                    if (p == 0) TK_INSERT(L0, key); else TK_INSERT(L1, key); }
            }
            LDS_WAIT(); asm volatile("" ::: "memory");
        }
        LAS float* pv0 = st; LAS float* pv1 = st + 16 * 64; LAS int* pi0 = (LAS int*)(st + 32 * 64); LAS int* pi1 = (LAS int*)(st + 48 * 64);
        float v0[16], v1[16];
#pragma unroll
        for (int i = 0; i < 16; ++i) { v0[i] = ord2f(L0[i] & ~127u); v1[i] = ord2f(L1[i] & ~127u);
            pv0[i * 64 + lane] = v0[i]; pv1[i * 64 + lane] = v1[i]; pi0[i * 64 + lane] = 127 - (int)(L0[i] & 127u); pi1[i * 64 + lane] = 127 - (int)(L1[i] & 127u); }
        unsigned T[16];
#pragma unroll
        for (int i = 0; i < 16; ++i) T[i] = 0u;
#pragma unroll
        for (int i = 0; i < 16; ++i)
#pragma unroll
            for (int j = 0; j < 16; ++j) if ((i + 1) * (j + 1) <= 16) { const unsigned key = (f2ord(v0[i] + v1[j]) & ~255u) | (unsigned)(255 - (i * 16 + j)); TK_INSERT(T, key); }
        LDS_WAIT(); asm volatile("" ::: "memory");
        const int tl = lane >> 3, h = lane & 7, t = t0 + tl;
        float ssum = 0.f;
        { const float* sp = SS + (size_t)t * 16;
#pragma unroll
          for (int i = 0; i < 4; ++i) { const f32x4 v = *(const GAS f32x4*)(sp + 4 * i); ssum += (v[0] + v[1]) + (v[2] + v[3]); } }
        const float r2 = 1.0f / sqrtf(ssum * (1.0f / D) + EPS);
        float bs[16]; int ex[16]; float mxs = -3.0e38f;
#pragma unroll
        for (int k = 0; k < 16; ++k) { const int pos = 255 - (int)(T[k] & 255u), i = pos >> 4, j = pos & 15;
            bs[k] = (pv0[i * 64 + lane] + pv1[j * 64 + lane]) * r2; ex[k] = pi0[i * 64 + lane] * NKEYS + pi1[j * 64 + lane]; mxs = fmaxf(mxs, bs[k]); }
        float den = 0.f;
#pragma unroll
        for (int k = 0; k < 16; ++k) { bs[k] = __expf(bs[k] - mxs); den += bs[k]; }
        const float inv = 1.0f / den;
        int* ip = IDX + ((size_t)t * PEER_H + h) * TOPK; float* gp = GATE + ((size_t)t * PEER_H + h) * TOPK;
#pragma unroll
        for (int k = 0; k < 16; k += 4) { *(GAS v4u*)(ip + k) = (v4u){(unsigned)ex[k], (unsigned)ex[k + 1], (unsigned)ex[k + 2], (unsigned)ex[k + 3]};
            *(GAS f32x4*)(gp + k) = (f32x4){bs[k] * inv, bs[k + 1] * inv, bs[k + 2] * inv, bs[k + 3] * inv}; }
        LDS_WAIT(); asm volatile("" ::: "memory");
    }
}

typedef float f32x2 __attribute__((ext_vector_type(2)));
typedef long l64x2 __attribute__((ext_vector_type(2)));
constexpr float EU_SCALE = 32.0f, EV_SCALE = 4.0f;
__device__ __forceinline__ float gelu_erf(float v) {
    const float av = __builtin_fabsf(v), t = __builtin_amdgcn_rcpf(av * 0.2316418882f + 1.0f);
    float q = t * 0.5307027145f + (-0.7265760135f); q = q * t + 0.7107068705f; q = q * t + (-0.142248368f); q = q * t + 0.127414796f; q = q * t;
    const float e = __builtin_amdgcn_exp2f((v * v) * (-0.72134752044f));
    const float m = v * (q * e);
    return v < 0.f ? m : v - m;
}
constexpr int PU_WAVE_LDS = 10496;
constexpr int PU_SL = 0, PU_HIST = 8192, PU_DSCR = 9216, PU_CNT = 10240;
static_assert(NWAVES * PU_WAVE_LDS <= LDSCTL_OFF, "PEER U LDS map");
#ifndef PEER_UACT_EXPR
#define PEER_UACT_EXPR gelu_erf(a * (1.0f / EU_SCALE)) * gt * (1.0f / EV_SCALE)
#endif
#ifndef PEER_ACT_EXPR
#define PEER_ACT_EXPR __builtin_bit_cast(float, itv.y)
#endif
#ifndef PEER_V_ITEMS
#define PEER_V_ITEMS 128
#endif
constexpr int PV_LIST = 0, PV_SSP = 32768;

__device__ __forceinline__ void peer_u_loadA(v4u (&A)[16], const unsigned char* EU, unsigned e, int lane) {
    const GAS unsigned char* rowp = (const GAS unsigned char*)EU + (size_t)e * D + 16 * (lane & 3);
#pragma unroll
    for (int i = 0; i < 16; ++i) A[i] = *(const GAS v4u*)(rowp + 64 * i);
}
template <unsigned EMASK, bool DUMMY> __device__ __forceinline__ void peer_u_phase(Frame& F, int blk) {
    const int* IDX = (const int*)(F.ws + WS_IDX); const float* GATE = (const float*)(F.ws + WS_GATE); const float* SS = (const float*)(F.ws + WS_SS);
    const unsigned char* EU = F.ws + WS_EU; unsigned* VE = (unsigned*)(F.ws + WS_SC); float* VA = (float*)(F.ws + WS_SC + (size_t)M * 128 * 4);
    const int lane = F.lane, c = lane & 15, g = lane >> 4;
    const int T0 = blk * 128 + F.wave * 16;
    LAS unsigned char* wl = F.lds + F.wave * PU_WAVE_LDS;
    LAS unsigned* SL = (LAS unsigned*)(wl + PU_SL); LAS unsigned* HIST = (LAS unsigned*)(wl + PU_HIST); LAS float* DSCR = (LAS float*)(wl + PU_DSCR); LAS unsigned* CNT = (LAS unsigned*)(wl + PU_CNT);
    l64x2 Bop[16];
    {
        const int tB = T0 + c; float s = 0.f;
#pragma unroll
        for (int i = 0; i < 4; ++i) { const f32x4 v = *(const GAS f32x4*)(SS + (size_t)tB * 16 + 4 * i); s += (v[0] + v[1]) + (v[2] + v[3]); }
        const float r2 = 1.0f / sqrtf(s * (1.0f / D) + EPS);
        const float* xp = F.out + (size_t)tB * D + 16 * g;
#pragma unroll
        for (int i = 0; i < 16; ++i) { v4u o;
#pragma unroll
            for (int q = 0; q < 4; ++q) { const f32x4 a = *(const GAS f32x4*)(xp + 64 * i + 4 * q) * r2;
                int w = __builtin_amdgcn_cvt_pk_fp8_f32(a[0], a[1], 0, false); w = __builtin_amdgcn_cvt_pk_fp8_f32(a[2], a[3], w, true); o[q] = (unsigned)w; }
            Bop[i] = __builtin_bit_cast(l64x2, o); asm volatile("" : "+v"(Bop[i]) :: "memory"); }
    }
    *(LAS v4u*)(HIST + 4 * lane) = (v4u){0u, 0u, 0u, 0u};
    if (lane < 16) CNT[lane] = 0u;
    LDS_WAIT(); asm volatile("" ::: "memory");
#pragma unroll 4
    for (int q = 0; q < 32; ++q) { const unsigned e = (unsigned)IDX[(size_t)T0 * 128 + q * 64 + lane]; __hip_atomic_fetch_add(HIST + (e >> 6), 1u, __ATOMIC_RELAXED, __HIP_MEMORY_SCOPE_WAVEFRONT); }
    LDS_WAIT(); asm volatile("" ::: "memory");
    {
        const v4u hv = *(const LAS v4u*)(HIST + 4 * lane); const unsigned tot = hv.x + hv.y + hv.z + hv.w; unsigned inc = tot;
#pragma unroll
        for (int o = 1; o < 64; o <<= 1) { const unsigned n = (unsigned)__shfl_up((int)inc, o); if (lane >= o) inc += n; }
        const unsigned ex = inc - tot;
        LDS_WAIT(); asm volatile("" ::: "memory");
        *(LAS v4u*)(HIST + 4 * lane) = (v4u){ex, ex + hv.x, ex + hv.x + hv.y, ex + hv.x + hv.y + hv.z};
    }
    LDS_WAIT(); asm volatile("" ::: "memory");
#pragma unroll 4
    for (int q = 0; q < 32; ++q) { const unsigned p = (unsigned)(q * 64 + lane); const unsigned e = (unsigned)IDX[(size_t)T0 * 128 + p];
        const unsigned pos = __hip_atomic_fetch_add(HIST + (e >> 6), 1u, __ATOMIC_RELAXED, __HIP_MEMORY_SCOPE_WAVEFRONT); SL[pos] = (e << 11) | p; }
    LDS_WAIT(); asm volatile("" ::: "memory");
    v4u A[16];
    const int psrc = (4 * c + g) * 4;
    unsigned itl = SL[lane >> 2];
    peer_u_loadA(A, EU, (itl >> 11) & EMASK, lane);
#pragma unroll 1
    for (int b = 0; b < 128; ++b) {
        f32x4 acc = {0.f, 0.f, 0.f, 0.f};
#pragma unroll
        for (int i = 0; i < 16; ++i) { v4u t;
#pragma unroll
            for (int w = 0; w < 4; ++w) t[w] = (unsigned)__builtin_amdgcn_ds_bpermute(psrc, (int)A[i][w]);
            const l64x2 a2 = __builtin_bit_cast(l64x2, t);
            acc = __builtin_amdgcn_mfma_f32_16x16x32_fp8_fp8(a2.x, Bop[i].x, acc, 0, 0, 0); acc = __builtin_amdgcn_mfma_f32_16x16x32_fp8_fp8(a2.y, Bop[i].y, acc, 0, 0, 0); }
        const unsigned itcur = SL[16 * b + c];
        if (b + 1 < 128) { itl = SL[16 * (b + 1) + (lane >> 2)]; peer_u_loadA(A, EU, (itl >> 11) & EMASK, lane); }
        *(LAS f32x4*)(DSCR + 4 * lane) = acc;
        LDS_WAIT(); asm volatile("" ::: "memory");
        if (lane < 16) { const unsigned p = itcur & 2047u, cr = p >> 7, e = itcur >> 11;
            const float a = DSCR[((lane >> 2) * 16 + cr) * 4 + (lane & 3)];
            const float gt = GATE[(size_t)T0 * 128 + p];
            const float act = PEER_UACT_EXPR;
            const unsigned pos = __hip_atomic_fetch_add(CNT + cr, 1u, __ATOMIC_RELAXED, __HIP_MEMORY_SCOPE_WAVEFRONT);
            if (!DUMMY) { VE[(size_t)(T0 + cr) * 128 + pos] = e; VA[(size_t)(T0 + cr) * 128 + pos] = act; } else if (act == 123.456f) VA[0] = act; }
        LDS_WAIT(); asm volatile("" ::: "memory");
    }
}

__device__ __forceinline__ void peer_v_phase(Frame& F, int blk) {
    const unsigned char* EV = F.ws + WS_EV; const unsigned* VE = (const unsigned*)(F.ws + WS_SC); const float* VA = (const float*)(F.ws + WS_SC + (size_t)M * 128 * 4);
    const int lane = F.lane, q = lane >> 3, c = lane & 7, w = F.wave;
    const int CB = blk * 128;
    const LAS unsigned* LE = (const LAS unsigned*)(F.lds + PV_LIST); const LAS float* LA = (const LAS float*)(F.lds + PV_LIST + 16384); LAS float* SSP = (LAS float*)(F.lds + PV_SSP);
    const unsigned voff = 128u * (unsigned)w + 16u * (unsigned)c;
#pragma unroll 1
    for (int rd = 0; rd < 4; ++rd) {
        const int TB = CB + 32 * rd;
        __syncthreads();
        {
            const GAS v4u* se = (const GAS v4u*)(VE + (size_t)TB * 128) + F.tid * 2; const GAS v4u* sa = (const GAS v4u*)(VA + (size_t)TB * 128) + F.tid * 2;
            LAS v4u* de = (LAS v4u*)(F.lds + PV_LIST) + F.tid * 2; LAS v4u* da = (LAS v4u*)(F.lds + PV_LIST + 16384) + F.tid * 2;
            const v4u a0 = se[0], a1 = se[1], a2 = sa[0], a3 = sa[1]; de[0] = a0; de[1] = a1; da[0] = a2; da[1] = a3;
        }
        __syncthreads();
        f32x2 y[4][8];
#pragma unroll
        for (int gI = 0; gI < 4; ++gI)
#pragma unroll
            for (int e = 0; e < 8; ++e) y[gI][e] = (f32x2){0.f, 0.f};
#pragma unroll 1
        for (int i0 = 0; i0 < PEER_V_ITEMS; i0 += 4) {
            v4u vv[4][4]; float ac[4][4];
#pragma unroll
            for (int ii = 0; ii < 4; ++ii)
#pragma unroll
                for (int gI = 0; gI < 4; ++gI) { const int li = (8 * gI + q) * 128 + i0 + ii; ac[ii][gI] = LA[li];
                    vv[ii][gI] = *(const GAS v4u*)((const GAS unsigned char*)EV + (size_t)LE[li] * D + voff); }
#pragma unroll
            for (int ii = 0; ii < 4; ++ii)
#pragma unroll
                for (int gI = 0; gI < 4; ++gI) { const f32x2 a2 = {ac[ii][gI], ac[ii][gI]};
#pragma unroll
                    for (int d = 0; d < 4; ++d) { const int wd = (int)vv[ii][gI][d];
                        y[gI][2 * d] += a2 * __builtin_amdgcn_cvt_pk_f32_fp8(wd, false); y[gI][2 * d + 1] += a2 * __builtin_amdgcn_cvt_pk_f32_fp8(wd, true); } }
        }
#pragma unroll
        for (int gI = 0; gI < 4; ++gI) { const float* xr = F.out + (size_t)(TB + 8 * gI + q) * D + voff; float ss = 0.f;
#pragma unroll
            for (int j = 0; j < 4; ++j) { const f32x4 a = *(const GAS f32x4*)(xr + 4 * j); y[gI][2 * j] += (f32x2){a[0], a[1]}; y[gI][2 * j + 1] += (f32x2){a[2], a[3]};
                ss += (y[gI][2 * j].x * y[gI][2 * j].x + y[gI][2 * j].y * y[gI][2 * j].y) + (y[gI][2 * j + 1].x * y[gI][2 * j + 1].x + y[gI][2 * j + 1].y * y[gI][2 * j + 1].y); }
            ss += __shfl_xor(ss, 1); ss += __shfl_xor(ss, 2); ss += __shfl_xor(ss, 4);
            if (c == 0) SSP[(8 * gI + q) * 8 + w] = ss; }
        __syncthreads();
#pragma unroll
        for (int gI = 0; gI < 4; ++gI) { const LAS f32x4* sp = (const LAS f32x4*)(SSP + (8 * gI + q) * 8); const f32x4 s0 = sp[0], s1 = sp[1];
            const float tot = ((s0[0] + s0[1]) + (s0[2] + s0[3])) + ((s1[0] + s1[1]) + (s1[2] + s1[3]));
            const float r3 = 1.0f / sqrtf(tot * (1.0f / D) + EPS);
            float* orow = F.out + (size_t)(TB + 8 * gI + q) * D + voff;
#pragma unroll
            for (int j = 0; j < 4; ++j) { const f32x4 gn = *(const GAS f32x4*)(F.norm_final + voff + 4 * j);
                *(GAS f32x4*)(orow + 4 * j) = (f32x4){y[gI][2 * j].x * r3 * gn[0], y[gI][2 * j].y * r3 * gn[1], y[gI][2 * j + 1].x * r3 * gn[2], y[gI][2 * j + 1].y * r3 * gn[3]}; } }
    }
}

struct Args { const float* in[12]; float* out; unsigned char* ws; };
__global__ void __launch_bounds__(NWAVES * 64, 2) hymba_fwd(Args args) {
    extern __shared__ __attribute__((aligned(16))) unsigned char lds[];
    Frame F;
    F.lds = (LAS unsigned char*)lds;
    F.MISC = (volatile LAS unsigned*)(F.lds + MISC_OFF);
    F.tid = threadIdx.x; F.lane = F.tid & 63; F.wave = __builtin_amdgcn_readfirstlane(F.tid >> 6);
    F.G = gridDim.x; { const int bx = blockIdx.x; F.vcu = (F.G % 8 == 0) ? (bx % 8) * (F.G / 8) + bx / 8 : bx; }
    F.x = args.in[0]; F.norm_mix = args.in[1]; F.w_in = args.in[2]; F.w_pool = args.in[3]; F.pool_scale = args.in[4]; F.w_out = args.in[5];
    F.norm_ffn = args.in[6]; F.w_query = args.in[7]; F.sub_keys = args.in[8]; F.expert_u = args.in[9]; F.expert_v = args.in[10]; F.norm_final = args.in[11];
    F.out = args.out; F.ws = args.ws;
    for (int u = F.tid; u < (LDS_BYTES - LDSCTL_OFF) / 4; u += NWAVES * 64) ((LAS unsigned*)(F.lds + LDSCTL_OFF))[u] = 0u;
    __syncthreads();
    XcdBarrier bar = xcd_barrier_post((unsigned*)(F.ws + WS_CTL), F.MISC + 8);
#define GRID_BAR() xcd_barrier(bar)

#ifndef PROBE_DUP
#define PROBE_DUP -1
#endif
#ifdef UBENCH
    {
        unsigned r0 = F.tid, r1 = F.tid * 3, r2 = F.tid * 5, r3 = F.tid * 7; float f0 = 1.f, f1 = 2.f, f2 = 3.f, f3 = 4.f; f32x2 p0 = {1.f, 2.f}, p1 = {3.f, 4.f}, q0 = {0.f, 0.f}, q1 = {0.f, 0.f}, q2 = {0.f, 0.f}, q3 = {0.f, 0.f};
        for (int it = 0; it < 20000; ++it) {
#pragma unroll
            for (int k = 0; k < 4; ++k) {
#if UBENCH == 1
                asm volatile("v_cvt_pk_f32_fp8_e32 %0, %4\n v_cvt_pk_f32_fp8_e32 %1, %5\n v_cvt_pk_f32_fp8_e32 %2, %6\n v_cvt_pk_f32_fp8_e32 %3, %7" : "=v"(q0), "=v"(q1), "=v"(q2), "=v"(q3) : "v"(r0), "v"(r1), "v"(r2), "v"(r3));
#elif UBENCH == 2
                asm volatile("v_cvt_f32_ubyte0_e32 %0, %4\n v_cvt_f32_ubyte1_e32 %1, %5\n v_cvt_f32_ubyte2_e32 %2, %6\n v_cvt_f32_ubyte3_e32 %3, %7" : "=v"(f0), "=v"(f1), "=v"(f2), "=v"(f3) : "v"(r0), "v"(r1), "v"(r2), "v"(r3));
#elif UBENCH == 3
                asm volatile("v_pk_fma_f32 %0, %4, %5, %0\n v_pk_fma_f32 %1, %4, %5, %1\n v_pk_fma_f32 %2, %4, %5, %2\n v_pk_fma_f32 %3, %4, %5, %3" : "+v"(q0), "+v"(q1), "+v"(q2), "+v"(q3) : "v"(p0), "v"(p1));
#elif UBENCH == 4
                asm volatile("v_dot2_f32_f16 %0, %4, %5, %0\n v_dot2_f32_f16 %1, %4, %6, %1\n v_dot2_f32_f16 %2, %5, %6, %2\n v_dot2_f32_f16 %3, %6, %7, %3" : "+v"(f0), "+v"(f1), "+v"(f2), "+v"(f3) : "v"(r0), "v"(r1), "v"(r2), "v"(r3));
#elif UBENCH == 5
                asm volatile("v_perm_b32 %0, %4, %5, %6\n v_perm_b32 %1, %5, %6, %7\n v_perm_b32 %2, %4, %6, %7\n v_perm_b32 %3, %4, %5, %7" : "=v"(f0), "=v"(f1), "=v"(f2), "=v"(f3) : "v"(r0), "v"(r1), "v"(r2), "v"(r3));
#elif UBENCH == 6
                asm volatile("v_fma_f32 %0, %4, %5, %0\n v_fma_f32 %1, %4, %5, %1\n v_fma_f32 %2, %4, %5, %2\n v_fma_f32 %3, %4, %5, %3" : "+v"(f0), "+v"(f1), "+v"(f2), "+v"(f3) : "v"(p0.x), "v"(p1.y));
#elif UBENCH == 7
                asm volatile("v_dot4_i32_i8 %0, %4, %5, %0\n v_dot4_i32_i8 %1, %4, %6, %1\n v_dot4_i32_i8 %2, %5, %6, %2\n v_dot4_i32_i8 %3, %6, %7, %3" : "+v"(f0), "+v"(f1), "+v"(f2), "+v"(f3) : "v"(r0), "v"(r1), "v"(r2), "v"(r3));
#endif
            }
        }
        float* dump = (float*)(F.ws + WS_Z);
        dump[(size_t)blockIdx.x * 512 + F.tid] = f0 + f1 + f2 + f3 + q0.x + q1.y + q2.x + q3.y;
    }
#endif
    p0_prologue(F);
    if (PROBE_DUP == 0) { GRID_BAR(); p0_prologue(F); }
    GRID_BAR();
    {
        pg8::Gemm g{(const pg8::bf16_t*)(F.ws + WS_XB), (const pg8::bf16_t*)(F.ws + WS_WIN), M, NZ, D}; pg8::StaticOrder S; S.init(M, NZ, F.G, (int)blockIdx.x);
        pg8::EpiZ E{(pg8::bf16_t*)(F.ws + WS_Z), NZ, (const float*)(F.ws + WS_R1), DATT, QSCALE};
        pg8::gemm_phase<pg8::EpiZ, pg8::StaticOrder, PG8_ALIGN, PG8_SP2>(F.lds + RING_OFF, g, S, E);
        if (PROBE_DUP == 1) { GRID_BAR(); pg8::gemm_phase<pg8::EpiZ, pg8::StaticOrder, PG8_ALIGN, PG8_SP2>(F.lds + RING_OFF, g, S, E); }
    }
    GRID_BAR();
    for (int u = F.vcu; u < ATT_UNITS; u += F.G) attn_unit(F, u);
    if (PROBE_DUP == 2) { GRID_BAR(); for (int u = F.vcu; u < ATT_UNITS; u += F.G) attn_unit(F, u); }
    pool_rows(F);
    if (PROBE_DUP == 3) { GRID_BAR(); pool_rows(F); }
    GRID_BAR();
    merge_rows(F);
    if (PROBE_DUP == 4) { GRID_BAR(); merge_rows(F); }
    GRID_BAR();
    {
        pg8::Gemm g{(const pg8::bf16_t*)(F.ws + WS_MIX), (const pg8::bf16_t*)(F.ws + WS_WOUT), M, D, D}; pg8::StaticOrder S; S.init(M, D, F.G, (int)blockIdx.x);
        pg8::EpiRes E{F.x, F.out, (pg8::bf16_t*)(F.ws + WS_XB), (float*)(F.ws + WS_SS), D};
        pg8::gemm_phase<pg8::EpiRes, pg8::StaticOrder, PG8_ALIGN, PG8_SP2>(F.lds + RING_OFF, g, S, E);
        if (PROBE_DUP == 5) { GRID_BAR(); pg8::gemm_phase<pg8::EpiRes, pg8::StaticOrder, PG8_ALIGN, PG8_SP2>(F.lds + RING_OFF, g, S, E); }
    }
    GRID_BAR();
    {
        pg8::Gemm g{(const pg8::bf16_t*)(F.ws + WS_XB), (const pg8::bf16_t*)(F.ws + WS_WSC), M, NSC, D}; pg8::StaticOrder S; S.init(M, NSC, F.G, (int)blockIdx.x);
        pg8::EpiF32 E{(float*)(F.ws + WS_SC), NSC};
        pg8::gemm_phase<pg8::EpiF32, pg8::StaticOrder, PG8_ALIGN, PG8_SP2>(F.lds + RING_OFF, g, S, E);
        if (PROBE_DUP == 6) { GRID_BAR(); pg8::gemm_phase<pg8::EpiF32, pg8::StaticOrder, PG8_ALIGN, PG8_SP2>(F.lds + RING_OFF, g, S, E); }
    }
    GRID_BAR();
    topk_phase(F);
    if (PROBE_DUP == 7) { GRID_BAR(); topk_phase(F); }
    GRID_BAR();
#ifndef PROBE_U2
#define PROBE_U2 0
#endif
#ifndef PROBE_UMASK
#define PROBE_UMASK 0x3fffu
#endif
    for (int blk = F.vcu; blk < M / 128; blk += F.G) { if (PROBE_U2) { peer_u_phase<PROBE_UMASK, true>(F, blk); __syncthreads(); } peer_u_phase<0x3fffu, false>(F, blk); peer_v_phase(F, blk); __syncthreads(); }
}

extern "C" void kernel_launch(void* const* d_in, const int* in_sizes, int n_in, void* d_out, int out_size, void* d_ws, size_t ws_size, hipStream_t stream) {
    static int grid = 0;
    if (grid == 0) {
        if (n_in != 12 || in_sizes[0] != M * D || out_size != M * D || ws_size < WS_END) { fprintf(stderr, "kernel_launch: unexpected shapes (n_in %d, in0 %d, out %d, ws %zu); nothing launched\n", n_in, n_in > 0 ? in_sizes[0] : -1, out_size, ws_size); grid = -1; return; }
        int dev = 0, cus = 0, per_cu = 0;
        if (hipGetDevice(&dev) != hipSuccess || hipDeviceGetAttribute(&cus, hipDeviceAttributeMultiprocessorCount, dev) != hipSuccess) { grid = -1; return; }
        if (hipFuncSetAttribute((const void*)hymba_fwd, hipFuncAttributeMaxDynamicSharedMemorySize, LDS_BYTES) != hipSuccess) { fprintf(stderr, "kernel_launch: hipFuncSetAttribute failed\n"); grid = -1; return; }
        if (hipOccupancyMaxActiveBlocksPerMultiprocessor(&per_cu, (const void*)hymba_fwd, NWAVES * 64, LDS_BYTES) != hipSuccess || per_cu < 1)
            fprintf(stderr, "kernel_launch: note: occupancy query reports %d workgroups per CU\n", per_cu);
        (void)hipGetLastError();
        grid = cus;
    }
    if (grid < 0) return;
    if (hipMemsetAsync((char*)d_ws + WS_CTL, 0, CTL_ZERO_BYTES, stream) != hipSuccess) { fprintf(stderr, "kernel_launch: hipMemsetAsync failed\n"); return; }
    Args a{};
    for (int i = 0; i < 12; ++i) a.in[i] = (const float*)d_in[i];
    a.out = (float*)d_out; a.ws = (unsigned char*)d_ws;
    hipLaunchKernelGGL(hymba_fwd, dim3(grid), dim3(NWAVES * 64), LDS_BYTES, stream, a);
    const hipError_t le = hipPeekAtLastError();
    if (le != hipSuccess) fprintf(stderr, "kernel_launch: launch failed: %s\n", hipGetErrorName(le));
}
```

```cpp
#include <hip/hip_runtime.h>
#include <cstdio>
#include <cstdint>
namespace pg8 {
#define PG8_LAS __attribute__((address_space(3)))
typedef unsigned short bf16_t;
typedef short bf16x8 __attribute__((ext_vector_type(8)));
typedef float f32x4 __attribute__((ext_vector_type(4)));
typedef unsigned u32x4 __attribute__((ext_vector_type(4)));
constexpr int BM = 256, BK = 64, HALF = 128, HTB = HALF * BK * 2  , STAGE_BYTES = 8 * HTB, NXCD = 8, WGM = 8;

__host__ __device__ __forceinline__ int lds_byte(int r, int c) { const int st = (r >> 4) * 2 + (c >> 5), rr = r & 15, cc = c & 31, ob = rr * 64 + cc * 2; return st * 1024 + (ob ^ (((ob >> 9) & 1) << 5)); }
__host__ __device__ __forceinline__ void stage_rc(int b, int& R, int& C) { const int st = b / 1024, sb = b % 1024, swz = sb ^ (((sb >> 9) & 1) << 5); R = (st >> 1) * 16 + swz / 64; C = (st & 1) * 32 + (swz % 64) / 2; }
__host__ __device__ __forceinline__ int perm32(int rho) { const int n = rho >> 4, i = rho & 15; return 8 * (i >> 2) + 4 * n + (i & 3); }

struct Unit { int pm, pn; };
struct Gemm { const bf16_t* A; const bf16_t* Bt; int M, N, K; };

struct StaticOrder {
    int nM, nN, nwg, G, c;
    __host__ __device__ void init(int M, int N, int G_, int c_) { nM = M / BM; nN = N / BM; nwg = nM * nN; G = G_; c = c_; }
    __host__ __device__ bool next(int i, Unit& u) const {
        const long L = (long)i * G + c; if (L >= nwg) return false;
        int wgid = (int)L; { const int q = nwg / NXCD, r = nwg % NXCD, xcd = wgid % NXCD, off = wgid / NXCD; wgid = (xcd < r ? xcd * (q + 1) : r * (q + 1) + (xcd - r) * q) + off; }
        const int nig = WGM * nN, gid = wgid / nig, fm = gid * WGM, gsz = (nM - fm) < WGM ? (nM - fm) : WGM;
        u.pm = fm + ((wgid % nig) % gsz); u.pn = (wgid % nig) / gsz; return true;
    }
    __device__ __forceinline__ void a_ready(const Unit&) const {}
    __device__ __forceinline__ void done(const Unit&) const {}
};

__device__ __forceinline__ unsigned cvt_pk_bf16(float lo, float hi) { unsigned r; asm volatile("v_cvt_pk_bf16_f32 %0, %1, %2" : "=v"(r) : "v"(lo), "v"(hi)); return r; }
struct EpiZ {
    static constexpr bool PERM = true, AFTER_DRAIN = false;
    bf16_t* O; int ldc; const float* rs; int qcols; float qscale;
    __device__ __forceinline__ void operator()(const f32x4 (&acc)[2][2][4][2], const Unit& u, int wr, int wc, int fr, int fq) const {
        const int row0 = u.pm * BM + wr * 64 + fr; const int colt = u.pn * BM;
        const float sc = (colt < qcols) ? qscale : 1.f;
        const int col0 = colt + wc * 32 + 8 * fq;
#pragma unroll
        for (int ai = 0; ai < 2; ++ai)
#pragma unroll
            for (int m = 0; m < 4; ++m) { const int row = row0 + ai * HALF + m * 16; const float s = rs[row] * sc; bf16_t* rowp = O + (size_t)row * ldc + col0;
#pragma unroll
                for (int bj = 0; bj < 2; ++bj) { const f32x4 v0 = acc[ai][bj][m][0] * s, v1 = acc[ai][bj][m][1] * s;
                    u32x4 w; w.x = cvt_pk_bf16(v0[0], v0[1]); w.y = cvt_pk_bf16(v0[2], v0[3]); w.z = cvt_pk_bf16(v1[0], v1[1]); w.w = cvt_pk_bf16(v1[2], v1[3]);
                    *(u32x4*)(rowp + bj * HALF) = w; } }
    }
};
struct EpiRes {
    static constexpr bool PERM = true, AFTER_DRAIN = false;
    const float* X; float* X1; bf16_t* X1b; float* SS; int ldc;
    __device__ __forceinline__ void operator()(const f32x4 (&acc)[2][2][4][2], const Unit& u, int wr, int wc, int fr, int fq) const {
        const int row0 = u.pm * BM + wr * 64 + fr; const int col0 = u.pn * BM + wc * 32 + 8 * fq;
#pragma unroll
        for (int ai = 0; ai < 2; ++ai)
#pragma unroll
            for (int m = 0; m < 4; ++m) { const int row = row0 + ai * HALF + m * 16; const size_t off = (size_t)row * ldc + col0; float ss = 0.f;
#pragma unroll
                for (int bj = 0; bj < 2; ++bj) {
                    const f32x4 x0 = *(const f32x4*)(X + off + bj * HALF), x1 = *(const f32x4*)(X + off + bj * HALF + 4);
                    const f32x4 v0 = acc[ai][bj][m][0] + x0, v1 = acc[ai][bj][m][1] + x1;
                    *(f32x4*)(X1 + off + bj * HALF) = v0; *(f32x4*)(X1 + off + bj * HALF + 4) = v1;
                    ss += (v0[0] * v0[0] + v0[1] * v0[1]) + (v0[2] * v0[2] + v0[3] * v0[3]) + (v1[0] * v1[0] + v1[1] * v1[1]) + (v1[2] * v1[2] + v1[3] * v1[3]);
                    u32x4 w; w.x = cvt_pk_bf16(v0[0], v0[1]); w.y = cvt_pk_bf16(v0[2], v0[3]); w.z = cvt_pk_bf16(v1[0], v1[1]); w.w = cvt_pk_bf16(v1[2], v1[3]);
                    *(u32x4*)(X1b + off + bj * HALF) = w; }
                ss += __shfl_xor(ss, 16); ss += __shfl_xor(ss, 32);
                if (fq == 0) SS[(size_t)row * 16 + u.pn * 4 + wc] = ss;
                if (m & 1) asm volatile("" ::: "memory"); }
    }
};
typedef _Float16 f16x2_t __attribute__((ext_vector_type(2)));
__device__ __forceinline__ unsigned cvt_pk_f16(float lo, float hi) { const f16x2_t h = {(_Float16)lo, (_Float16)hi}; return __builtin_bit_cast(unsigned, h); }
struct EpiF16 {
    static constexpr bool PERM = true, AFTER_DRAIN = false;
    unsigned short* O; int ldc;
    __device__ __forceinline__ void operator()(const f32x4 (&acc)[2][2][4][2], const Unit& u, int wr, int wc, int fr, int fq) const {
        const int row0 = u.pm * BM + wr * 64 + fr; const int col0 = u.pn * BM + wc * 32 + 8 * fq;
#pragma unroll
        for (int ai = 0; ai < 2; ++ai)
#pragma unroll
            for (int m = 0; m < 4; ++m) { unsigned short* rowp = O + (size_t)(row0 + ai * HALF + m * 16) * ldc + col0;
#pragma unroll
                for (int bj = 0; bj < 2; ++bj) { const f32x4 v0 = acc[ai][bj][m][0], v1 = acc[ai][bj][m][1];
                    u32x4 w; w.x = cvt_pk_f16(v0[0], v0[1]); w.y = cvt_pk_f16(v0[2], v0[3]); w.z = cvt_pk_f16(v1[0], v1[1]); w.w = cvt_pk_f16(v1[2], v1[3]);
                    *(u32x4*)(rowp + bj * HALF) = w; } }
    }
};

template <class Epi, class Sched, bool ALIGN_EPI = false, bool SP2 = false>
__device__ __forceinline__ void gemm_phase(PG8_LAS unsigned char* lds, const Gemm g, const Sched& S, const Epi& E) {
    const int tid = threadIdx.x, wid = __builtin_amdgcn_readfirstlane(tid >> 6), lane = tid & 63, wr = wid >> 2, wc = wid & 3, fr = lane & 15, fq = lane >> 4;
    const int K = g.K, nt = K / BK;
    unsigned voffA[2], voffB[2];
#pragma unroll
    for (int i = 0; i < 2; ++i) { int R, C; stage_rc(tid * 16 + i * 8192, R, C); const int Rb = Epi::PERM ? ((R & ~31) + perm32(R & 31)) : R;
        voffA[i] = (unsigned)(R * K + C) * 2u; voffB[i] = (unsigned)(Rb * K + C) * 2u; }
    const size_t kstep = (size_t)(BK * 2);
    const size_t hstep = (size_t)HALF * K * 2;
    const size_t tstep = 2 * hstep;
    const unsigned ldsw = (unsigned)wid * 1024u;
    const int aoff = lds_byte(wr * 64 + fr, fq * 8), boff = lds_byte(wc * 32 + fr, fq * 8);
#define PG8_SA(b, h) (((b) * 2 + (h)) * HTB)
#define PG8_SB(b, h) ((4 + (b) * 2 + (h)) * HTB)
#define PG8_STAGE(bufoff, gbase, voff) do { _Pragma("unroll") for (int _i = 0; _i < 2; ++_i) \
        __builtin_amdgcn_global_load_lds((const unsigned*)((const char*)(gbase) + (voff)[_i]), (PG8_LAS unsigned*)(lds + (bufoff) + ldsw + _i * 8192), 16, 0, 0); } while (0)
#define PG8_LDA(dst, b, h) do { _Pragma("unroll") for (int m = 0; m < 4; ++m) _Pragma("unroll") for (int k = 0; k < 2; ++k) dst[m][k] = *(const PG8_LAS bf16x8*)(lds + PG8_SA(b, h) + aoff + m * 2048 + k * 1024); } while (0)
#define PG8_LDB(dst, b, h) do { _Pragma("unroll") for (int n = 0; n < 2; ++n) _Pragma("unroll") for (int k = 0; k < 2; ++k) dst[n][k] = *(const PG8_LAS bf16x8*)(lds + PG8_SB(b, h) + boff + n * 2048 + k * 1024); } while (0)
#define PG8_MMA(ai, bj, At, Bt) do { __builtin_amdgcn_s_setprio(1); _Pragma("unroll") for (int m = 0; m < 4; ++m) _Pragma("unroll") for (int n = 0; n < 2; ++n) _Pragma("unroll") for (int k = 0; k < 2; ++k) \
        acc[ai][bj][m][n] = __builtin_amdgcn_mfma_f32_16x16x32_bf16(Bt[n][k], At[m][k], acc[ai][bj][m][n], 0, 0, 0); __builtin_amdgcn_s_setprio(0); } while (0)
#define PG8_WAIT_V(n) asm volatile("s_waitcnt vmcnt(" #n ")" ::: "memory")
#define PG8_WAIT_L(n) asm volatile("s_waitcnt lgkmcnt(" #n ")" ::: "memory")
#define PG8_BAR __builtin_amdgcn_s_barrier()
#define PG8_SCHED __builtin_amdgcn_sched_barrier(0)
    Unit cur, nxt; int ui = 0;
    if (!S.next(0, cur)) return;
    f32x4 acc[2][2][4][2];
#pragma unroll
    for (int a = 0; a < 2; ++a)
#pragma unroll
        for (int b = 0; b < 2; ++b)
#pragma unroll
            for (int m = 0; m < 4; ++m)
#pragma unroll
                for (int n = 0; n < 2; ++n) acc[a][b][m][n] = (f32x4){0.f, 0.f, 0.f, 0.f};
    bf16x8 At[4][2], B0[2][2], B1[2][2];
    const char* cA = (const char*)g.A + (size_t)cur.pm * tstep; const char* cB = (const char*)g.Bt + (size_t)cur.pn * tstep;
    S.a_ready(cur);
    if constexpr (SP2) {
        PG8_STAGE(PG8_SB(0, 0), cB, voffB); PG8_STAGE(PG8_SB(0, 1), cB + hstep, voffB); PG8_STAGE(PG8_SA(0, 0), cA, voffA); PG8_STAGE(PG8_SA(0, 1), cA + hstep, voffA);
        if (wr == 1) PG8_BAR;
        PG8_WAIT_V(2); PG8_BAR;
        PG8_STAGE(PG8_SB(1, 0), cB + kstep, voffB); PG8_STAGE(PG8_SA(1, 0), cA + kstep, voffA); PG8_STAGE(PG8_SB(1, 1), cB + hstep + kstep, voffB);
        PG8_WAIT_V(6); PG8_BAR;
    } else {
        PG8_STAGE(PG8_SB(0, 0), cB, voffB); PG8_STAGE(PG8_SA(0, 0), cA, voffA); PG8_STAGE(PG8_SB(0, 1), cB + hstep, voffB); PG8_STAGE(PG8_SA(0, 1), cA + hstep, voffA);
        if (wr == 1) PG8_BAR;
        PG8_WAIT_V(4); PG8_BAR;
        PG8_STAGE(PG8_SB(1, 0), cB + kstep, voffB); PG8_STAGE(PG8_SA(1, 0), cA + kstep, voffA); PG8_STAGE(PG8_SB(1, 1), cB + hstep + kstep, voffB);
        PG8_WAIT_V(6); PG8_BAR;
    }
    for (;;) {
        const bool has_next = S.next(ui + 1, nxt);
        const char* nA = has_next ? (const char*)g.A + (size_t)nxt.pm * tstep : cA; const char* nB = has_next ? (const char*)g.Bt + (size_t)nxt.pn * tstep : cB;
        for (int t = 0; t < nt; t += 2) {
            const bool last = (t == nt - 2);
            const char* a1 = cA + (size_t)(t + 1) * kstep;
            const char* a2 = last ? nA : cA + (size_t)(t + 2) * kstep; const char* b2 = last ? nB : cB + (size_t)(t + 2) * kstep;
            const char* a3 = a2 + kstep; const char* b3 = b2 + kstep;
            if (last && has_next) S.a_ready(nxt);
            if constexpr (SP2) {
            PG8_LDB(B0, 0, 0); PG8_LDB(B1, 0, 1); PG8_SCHED; PG8_LDA(At, 0, 0); PG8_STAGE(PG8_SA(1, 1), a1 + hstep, voffA);
            PG8_WAIT_V(8); PG8_WAIT_L(0); PG8_BAR; PG8_MMA(0, 0, At, B0); PG8_MMA(0, 1, At, B1); PG8_BAR; PG8_SCHED;
            PG8_LDA(At, 0, 1); PG8_STAGE(PG8_SB(0, 0), b2, voffB); PG8_STAGE(PG8_SB(0, 1), b2 + hstep, voffB); PG8_STAGE(PG8_SA(0, 0), a2, voffA);
            PG8_WAIT_V(8); PG8_WAIT_L(0); PG8_BAR; PG8_MMA(1, 0, At, B0); PG8_MMA(1, 1, At, B1); PG8_BAR; PG8_SCHED;
            PG8_LDB(B0, 1, 0); PG8_LDB(B1, 1, 1); PG8_SCHED; PG8_LDA(At, 1, 0); PG8_STAGE(PG8_SA(0, 1), a2 + hstep, voffA);
            PG8_WAIT_V(8); PG8_WAIT_L(0); PG8_BAR; PG8_MMA(0, 0, At, B0); PG8_MMA(0, 1, At, B1); PG8_BAR; PG8_SCHED;
            PG8_LDA(At, 1, 1); PG8_STAGE(PG8_SB(1, 0), b3, voffB); PG8_STAGE(PG8_SB(1, 1), b3 + hstep, voffB); PG8_STAGE(PG8_SA(1, 0), a3, voffA);
            PG8_WAIT_V(8); PG8_WAIT_L(0); PG8_BAR; PG8_MMA(1, 0, At, B0); PG8_MMA(1, 1, At, B1); PG8_BAR; PG8_SCHED;
            } else {
            PG8_LDB(B0, 0, 0); PG8_SCHED; PG8_LDA(At, 0, 0); PG8_STAGE(PG8_SA(1, 1), a1 + hstep, voffA);
            PG8_WAIT_L(8); PG8_BAR; PG8_WAIT_L(0); PG8_MMA(0, 0, At, B0); PG8_BAR; PG8_SCHED;
            PG8_LDB(B1, 0, 1); PG8_STAGE(PG8_SB(0, 0), b2, voffB);
            PG8_BAR; PG8_WAIT_L(0); PG8_MMA(0, 1, At, B1); PG8_BAR;
            PG8_LDA(At, 0, 1); PG8_STAGE(PG8_SA(0, 0), a2, voffA);
            PG8_BAR; PG8_WAIT_L(0); PG8_MMA(1, 0, At, B0); PG8_BAR; PG8_SCHED;
            PG8_STAGE(PG8_SB(0, 1), b2 + hstep, voffB);
            PG8_WAIT_V(6); PG8_BAR; PG8_MMA(1, 1, At, B1); PG8_BAR;
            PG8_LDB(B0, 1, 0); PG8_SCHED; PG8_LDA(At, 1, 0); PG8_STAGE(PG8_SA(0, 1), a2 + hstep, voffA);
            PG8_WAIT_L(8); PG8_BAR; PG8_WAIT_L(0); PG8_MMA(0, 0, At, B0); PG8_BAR; PG8_SCHED;
            PG8_LDB(B1, 1, 1); PG8_STAGE(PG8_SB(1, 0), b3, voffB);
            PG8_BAR; PG8_WAIT_L(0); PG8_MMA(0, 1, At, B1); PG8_BAR;
            PG8_LDA(At, 1, 1); PG8_STAGE(PG8_SA(1, 0), a3, voffA);
            PG8_BAR; PG8_WAIT_L(0); PG8_MMA(1, 0, At, B0); PG8_BAR; PG8_SCHED;
            PG8_STAGE(PG8_SB(1, 1), b3 + hstep, voffB);
            PG8_WAIT_V(6); PG8_BAR; PG8_MMA(1, 1, At, B1); PG8_BAR;
            }
        }
        if constexpr (ALIGN_EPI) { if (wr == 0) PG8_BAR; }
        if constexpr (!Epi::AFTER_DRAIN) { E(acc, cur, wr, wc, fr, fq); S.done(cur); }
        if (!has_next) break;
#pragma unroll
        for (int a = 0; a < 2; ++a)
#pragma unroll
            for (int b = 0; b < 2; ++b)
#pragma unroll
                for (int m = 0; m < 4; ++m)
#pragma unroll
                    for (int n = 0; n < 2; ++n) acc[a][b][m][n] = (f32x4){0.f, 0.f, 0.f, 0.f};
        cur = nxt; cA = nA; cB = nB; ++ui;
        if constexpr (ALIGN_EPI) { if (wr == 1) PG8_BAR; }
    }
    PG8_WAIT_V(0);
    if constexpr (!ALIGN_EPI) { if (wr == 0) PG8_BAR; }
    PG8_BAR;
    if constexpr (Epi::AFTER_DRAIN) { E.fused(acc, cur, wr, wc, fr, fq, lds, wid, lane); S.done(cur); }
#undef PG8_SA
#undef PG8_SB
#undef PG8_STAGE
#undef PG8_LDA
#undef PG8_LDB
#undef PG8_MMA
#undef PG8_WAIT_V
#undef PG8_WAIT_L
#undef PG8_BAR
#undef PG8_SCHED
}
}
#define PG8_SP2 true
#define PG8_ALIGN true

constexpr int NWAVES = 8;
constexpr int BATCH = 4, SEQ = 8192, D = 1024, M = BATCH * SEQ;
constexpr int NH = 8, HD = 64, DATT = 512, DPOOL = 512, NZ = 3 * DATT + DPOOL;
constexpr int PEER_H = 8, NKEYS = 128, NEXP = NKEYS * NKEYS, TOPK = 16, NSC = PEER_H * 2 * NKEYS;
constexpr float EPS = 1e-6f;
constexpr float QSCALE = 0.125f * 1.4426950408889634f;

constexpr size_t MiB = 1u << 20;
constexpr size_t WS_CTL = 0, CTL_ZERO_BYTES = 64 * 1024;
constexpr size_t WS_R1 = 1 * MiB;
constexpr size_t WS_SS = 2 * MiB;
constexpr size_t WS_LSE = 4 * MiB;
constexpr size_t WS_WIN = 8 * MiB;
constexpr size_t WS_WOUT = 12 * MiB;
constexpr size_t WS_WSC = 14 * MiB;
constexpr size_t WS_EU = 32 * MiB, WS_EV = 64 * MiB;
constexpr size_t WS_XB = 96 * MiB;
constexpr size_t WS_Z = 160 * MiB;
constexpr size_t WS_OB = 288 * MiB;
constexpr size_t WS_MIX = 384 * MiB;
constexpr size_t WS_SC = 160 * MiB;
constexpr size_t WS_SCH = 224 * MiB;
constexpr size_t WS_IDX = 448 * MiB, WS_GATE = 464 * MiB;
constexpr size_t WS_END = 480 * MiB;
static_assert(WS_SC + (size_t)M * NSC * 4 <= WS_IDX, "ws map");

constexpr int LDS_BYTES = 147456;
constexpr int LDSCTL_OFF = 146432, MISC_OFF = LDSCTL_OFF + 320;
constexpr int RING_OFF = 0;

#define GAS __attribute__((address_space(1)))
#define LAS __attribute__((address_space(3)))
typedef unsigned short bf16;
typedef unsigned v4u __attribute__((ext_vector_type(4)));
typedef unsigned v2u __attribute__((ext_vector_type(2)));
typedef float f32x4 __attribute__((ext_vector_type(4)));
typedef float f32x16 __attribute__((ext_vector_type(16)));
typedef short bf16x8 __attribute__((ext_vector_type(8)));
typedef short s16x4 __attribute__((ext_vector_type(4)));
typedef GAS unsigned gu32;
#define RLX_AGENT __ATOMIC_RELAXED, __HIP_MEMORY_SCOPE_AGENT
#define LDS_WAIT() asm volatile("s_waitcnt lgkmcnt(0)" ::: "memory")
#define VM_WAIT() asm volatile("s_waitcnt vmcnt(0)" ::: "memory")
__device__ __forceinline__ unsigned f2bf(float f) { unsigned u = __builtin_bit_cast(unsigned, f); return (u + 0x7fffu + ((u >> 16) & 1u)) >> 16; }
__device__ __forceinline__ unsigned pk2(float lo, float hi) { return f2bf(lo) | (f2bf(hi) << 16); }
__device__ __forceinline__ float bflo(unsigned w) { return __builtin_bit_cast(float, w << 16); }
__device__ __forceinline__ float bfhi(unsigned w) { return __builtin_bit_cast(float, w & 0xffff0000u); }
#define XB_TMO      128
#define XB_XCNT(j)  (256  + 64 * (j))
#define XB_XSUB(j)  (1280 + 64 * (j))
#define XB_XGEN(j)  (2304 + 64 * (j))
#define XB_TOP      3328
#define XB_TOPGEN   3392
#define XCD_BAR_WORDS 3456
#define XB_SPIN_CAP (1u << 18)

__device__ __forceinline__ unsigned xb_ld(unsigned* p)              { return __hip_atomic_load(p, __ATOMIC_RELAXED, __HIP_MEMORY_SCOPE_AGENT); }
__device__ __forceinline__ unsigned xb_add(unsigned* p, unsigned v) { return __hip_atomic_fetch_add(p, v, __ATOMIC_RELAXED, __HIP_MEMORY_SCOPE_AGENT); }
__device__ __forceinline__ unsigned xb_xcc_id() { return (unsigned)__builtin_amdgcn_s_getreg((3 << 11) | 20) & 0xFu; }
#define XB_SPIN(cond, bar) do { unsigned _sp = 0; while (cond) { __builtin_amdgcn_s_sleep(1); \
    if ((++_sp & 255u) == 0u) { if (xb_ld(&(bar)[XB_TMO])) break; if (_sp > XB_SPIN_CAP) { atomicAdd(&(bar)[XB_TMO], 1u); break; } } } } while (0)

struct XcdBarrier {
    unsigned* bar; unsigned x;
    volatile LAS unsigned* st;
};

__device__ __forceinline__ XcdBarrier xcd_barrier_post(unsigned* bar, volatile LAS unsigned* st) {
    XcdBarrier b; b.bar = bar; b.x = xb_xcc_id(); b.st = st;
    if (threadIdx.x == 0) (void)xb_add(&bar[XB_XCNT(b.x)], 1u);
    return b;
}
__device__ __forceinline__ void xcd_barrier_complete(unsigned* bar, unsigned x, unsigned& nloc, unsigned& nx) {
    const unsigned G = gridDim.x * gridDim.y * gridDim.z;
    unsigned sum, cnt, mine, sp = 0u;
    for (;;) {
        sum = 0u; cnt = 0u; mine = 0u;
#pragma unroll
        for (unsigned j = 0; j < 16; ++j) { const unsigned c = xb_ld(&bar[XB_XCNT(j)]); sum += c; cnt += (c > 0u) ? 1u : 0u; mine = (j == x) ? c : mine; }
        if (sum == G) break;
        __builtin_amdgcn_s_sleep(1);
        if ((++sp & 255u) == 0u) { if (xb_ld(&bar[XB_TMO])) break; if (sp > XB_SPIN_CAP) { atomicAdd(&bar[XB_TMO], 1u); break; } }
    }
    nloc = mine > 0u ? mine : 1u; nx = cnt > 0u ? cnt : 1u;
}

__device__ __forceinline__ void xcd_barrier(const XcdBarrier& b) {
    asm volatile("s_waitcnt vmcnt(0)" ::: "memory");
    __syncthreads();
    if (threadIdx.x == 0) {
        unsigned* bar = b.bar;
        __builtin_amdgcn_s_waitcnt(0);
        unsigned nloc = b.st[0], nx = b.st[1];
        if (nloc == 0u) { xcd_barrier_complete(bar, b.x, nloc, nx); b.st[0] = nloc; b.st[1] = nx; }
        const unsigned old = xb_add(&bar[XB_XSUB(b.x)], 1u);
        const unsigned gen = old / nloc;
        if (old + 1u == (gen + 1u) * nloc) {
            __builtin_amdgcn_fence(__ATOMIC_RELEASE, "agent");
            asm volatile("s_waitcnt vmcnt(0)" ::: "memory");
            const unsigned og = xb_add(&bar[XB_TOP], 1u);
            const unsigned tg = og / nx;
            if (og + 1u == (tg + 1u) * nx) xb_add(&bar[XB_TOPGEN], 1u);
            else XB_SPIN(xb_ld(&bar[XB_TOPGEN]) == tg, bar);
            __builtin_amdgcn_fence(__ATOMIC_ACQUIRE, "agent");
            xb_add(&bar[XB_XGEN(b.x)], 1u);
            asm volatile("s_waitcnt vmcnt(0)" ::: "memory");
        } else {
            XB_SPIN(xb_ld(&bar[XB_XGEN(b.x)]) == gen, bar);
            __builtin_amdgcn_fence(__ATOMIC_ACQUIRE, "agent");
            asm volatile("s_waitcnt vmcnt(0)" ::: "memory");
        }
    }
    __syncthreads();
}

struct Frame {
    LAS unsigned char* lds;
    volatile LAS unsigned* MISC;
    int tid, lane, wave;
    int vcu, G;
    const float *x, *norm_mix, *w_in, *w_pool, *pool_scale, *w_out, *norm_ffn, *w_query, *sub_keys, *expert_u, *expert_v, *norm_final;
    float* out;
    unsigned char* ws;
};

__device__ __forceinline__ float wave_sum(float v) {
#pragma unroll
    for (int o = 1; o < 64; o <<= 1) v += __shfl_xor(v, o);
    return v;
}

__device__ __forceinline__ void p0_transpose_item(const float* W, int N, const float* ks, bf16* WT, int ldo, int col_off, LAS float* scr, int item, int lane) {
    const int nblk = N / 32, kb = item / nblk, nb = item % nblk, k0 = 64 * kb, n0 = 32 * nb;
#pragma unroll 8
    for (int i = 0; i < 32; ++i) { const int kk = 2 * i + (lane >> 5); const float s = ks ? ks[k0 + kk] : 1.f; scr[kk * 33 + (lane & 31)] = W[(size_t)(k0 + kk) * N + n0 + (lane & 31)] * s; }
    LDS_WAIT(); asm volatile("" ::: "memory");
    const int c = lane & 7;
#pragma unroll
    for (int j = 0; j < 4; ++j) { const int n = (lane >> 3) + 8 * j; const LAS float* s = scr + (8 * c) * 33 + n;
        v4u o; o.x = pk2(s[0 * 33], s[1 * 33]); o.y = pk2(s[2 * 33], s[3 * 33]); o.z = pk2(s[4 * 33], s[5 * 33]); o.w = pk2(s[6 * 33], s[7 * 33]);
        *(GAS v4u*)(WT + (size_t)(n0 + n) * ldo + col_off + k0 + 8 * c) = o; }
    LDS_WAIT(); asm volatile("" ::: "memory");
}

__device__ __forceinline__ void p0_prologue(Frame& F) {
    LAS float* scr = (LAS float*)(F.lds + RING_OFF + F.wave * 16384);
    const int gw = F.vcu * NWAVES + F.wave, NGW = F.G * NWAVES;
    bf16* WIN = (bf16*)(F.ws + WS_WIN); bf16* WOUT = (bf16*)(F.ws + WS_WOUT); bf16* WSC = (bf16*)(F.ws + WS_WSC);
    constexpr int I_IN = (D / 64) * (NZ / 32), I_OUT = (DATT / 64) * (D / 32);
    for (int it = gw; it < I_IN + I_OUT; it += NGW) {
        if (it < I_IN) p0_transpose_item(F.w_in, NZ, F.norm_mix, WIN, D, 0, scr, it, F.lane);
        else p0_transpose_item(F.w_out, D, nullptr, WOUT, D, 0, scr, it - I_IN, F.lane);
    }
    const int gt = (F.vcu * NWAVES + F.wave) * 64 + F.lane, NGT = F.G * NWAVES * 64;
    for (int it = gt; it < DPOOL * (D / 4); it += NGT) {
        const int cin = it / (D / 4), n4 = (it % (D / 4)) * 4, g = cin >> 7;
        const float* wp = F.w_pool + (size_t)cin * 128;
        const float* ps = F.pool_scale + g * 128;
        const float* wo = F.w_out + (size_t)(DATT + g * 128) * D + n4;
        f32x4 acc = {0.f, 0.f, 0.f, 0.f};
#pragma unroll 16
        for (int d = 0; d < 128; ++d) { const float a = wp[d] * ps[d]; const f32x4 b = *(const f32x4*)(wo + (size_t)d * D); acc += a * b; }
#pragma unroll
        for (int j = 0; j < 4; ++j) WOUT[(size_t)(n4 + j) * D + DATT + cin] = (bf16)f2bf(acc[j]);
    }
    for (int it = gt; it < 16 * 32 * 256; it += NGT) {
        const int d4 = (it & 255) * 4, k4 = ((it >> 8) & 31) * 4, blk = it >> 13;
        const float* wq = F.w_query + (size_t)d4 * NSC + blk * 128;
        const float* sk = F.sub_keys + (size_t)(blk * 128 + k4) * 128;
        float acc[4][4];
#pragma unroll
        for (int i = 0; i < 4; ++i)
#pragma unroll
            for (int j = 0; j < 4; ++j) acc[i][j] = 0.f;
#pragma unroll 4
        for (int c = 0; c < 128; c += 4) {
            f32x4 a[4], b[4];
#pragma unroll
            for (int i = 0; i < 4; ++i) { a[i] = *(const f32x4*)(sk + i * 128 + c); b[i] = *(const f32x4*)(wq + (size_t)i * NSC + c); }
#pragma unroll
            for (int i = 0; i < 4; ++i)
#pragma unroll
                for (int j = 0; j < 4; ++j) acc[i][j] += a[i][0] * b[j][0] + a[i][1] * b[j][1] + a[i][2] * b[j][2] + a[i][3] * b[j][3];
        }
        const f32x4 gf = *(const f32x4*)(F.norm_ffn + d4);
#pragma unroll
        for (int i = 0; i < 4; ++i) { v2u o; o.x = pk2(acc[i][0] * gf[0], acc[i][1] * gf[1]); o.y = pk2(acc[i][2] * gf[2], acc[i][3] * gf[3]);
            *(GAS v2u*)(WSC + (size_t)(blk * 128 + k4 + i) * D + d4) = o; }
    }
    {
        unsigned char* EU = F.ws + WS_EU; unsigned char* EV = F.ws + WS_EV;
        const size_t n16 = (size_t)NEXP * D / 16;
        for (size_t i0 = gt; i0 < 2 * n16; i0 += (size_t)4 * NGT) {
            f32x4 a[4][4];
#pragma unroll
            for (int r = 0; r < 4; ++r) { const size_t i = i0 + (size_t)r * NGT; if (i < 2 * n16) { const bool second = i >= n16; const size_t j = second ? i - n16 : i;
                const float* src = (second ? F.expert_v : F.expert_u) + j * 16;
#pragma unroll
                for (int q = 0; q < 4; ++q) a[r][q] = *(const f32x4*)(src + 4 * q); } }
#pragma unroll
            for (int r = 0; r < 4; ++r) { const size_t i = i0 + (size_t)r * NGT; if (i < 2 * n16) { const bool second = i >= n16; const size_t j = second ? i - n16 : i; const float sc = second ? 4.0f : 32.0f;
                v4u o;
#pragma unroll
                for (int q = 0; q < 4; ++q) { f32x4 v = a[r][q] * sc; if (!second) v = v * *(const f32x4*)(F.norm_ffn + ((j * 16) & (D - 1)) + 4 * q); int w = __builtin_amdgcn_cvt_pk_fp8_f32(v[0], v[1], 0, false); w = __builtin_amdgcn_cvt_pk_fp8_f32(v[2], v[3], w, true); o[q] = (unsigned)w; }
                *(GAS v4u*)((second ? EV : EU) + j * 16) = o; } }
        }
    }
    {
        bf16* XB = (bf16*)(F.ws + WS_XB); float* R1 = (float*)(F.ws + WS_R1);
        for (int m0 = gw * 4; m0 < M; m0 += NGW * 4) {
            f32x4 a[4][4];
#pragma unroll
            for (int r = 0; r < 4; ++r) { const float* xr = F.x + (size_t)(m0 + r) * D + 8 * F.lane;
                a[r][0] = *(const f32x4*)(xr); a[r][1] = *(const f32x4*)(xr + 4); a[r][2] = *(const f32x4*)(xr + 512); a[r][3] = *(const f32x4*)(xr + 516); }
#pragma unroll
            for (int r = 0; r < 4; ++r) { float s = 0.f;
#pragma unroll
                for (int q = 0; q < 4; ++q) s += (a[r][q][0] * a[r][q][0] + a[r][q][1] * a[r][q][1]) + (a[r][q][2] * a[r][q][2] + a[r][q][3] * a[r][q][3]);
#pragma unroll
                for (int j = 0; j < 2; ++j) { v4u o; o.x = pk2(a[r][2 * j][0], a[r][2 * j][1]); o.y = pk2(a[r][2 * j][2], a[r][2 * j][3]); o.z = pk2(a[r][2 * j + 1][0], a[r][2 * j + 1][1]); o.w = pk2(a[r][2 * j + 1][2], a[r][2 * j + 1][3]);
                    *(GAS v4u*)(XB + (size_t)(m0 + r) * D + 8 * F.lane + 512 * j) = o; }
                s = wave_sum(s);
                if (F.lane == 0) R1[m0 + r] = 1.0f / sqrtf(s * (1.0f / D) + EPS); }
        }
    }
}

constexpr int ATT_KEYS = 384, ATT_KCH = ATT_KEYS * 16 + 16;
constexpr int ATT_K_OFF = 0, ATT_V_OFF = 8 * ATT_KCH;
constexpr int ATT_VDH = 24 * 1024 + 64;
constexpr int ATT_OST_OFF = ATT_V_OFF + 2 * ATT_VDH;
constexpr int ATT_LDS_END = ATT_OST_OFF + NWAVES * 4096;
static_assert(ATT_V_OFF % 16 == 0 && ATT_OST_OFF % 16 == 0 && ATT_LDS_END <= LDSCTL_OFF, "attention LDS map");
constexpr int ATT_UNITS = BATCH * NH * 96;

__device__ __forceinline__ int crow(int r, int hi) { return (r & 3) + 8 * (r >> 2) + 4 * hi; }
__device__ __forceinline__ s16x4 vtr(const LAS unsigned char* p) { return __builtin_bit_cast(s16x4, __builtin_amdgcn_ds_read_tr16_b64_v4i16((LAS s16x4*)p)); }

__device__ __forceinline__ void attn_unit(Frame& F, int unit) {
    const int tid = F.tid, lane = F.lane, w = F.wave, r32 = lane & 31, hi = lane >> 5;
    const int bh = unit / 96, rem = unit % 96, br = rem >> 5, idx = rem & 31;
    const int b = bh >> 3, h = bh & 7;
    const int dsh = 2 * br, dil = 1 << dsh;
    const int ppr = 32 >> dsh;
    const int res = idx / ppr, pair = idx % ppr;
    const int s0 = pair * 256 - 128;
    const bf16* Z = (const bf16*)(F.ws + WS_Z);
    const size_t tokbase = (size_t)b * SEQ + res;
    {
        v4u kv[6], vv[6];
#pragma unroll
        for (int it = 0; it < 6; ++it) { const int p = tid + 512 * it, key = p >> 3, c = p & 7; int s = s0 + key; s = s < 0 ? 0 : s;
            const bf16* row = Z + (tokbase + ((size_t)s << dsh)) * NZ + h * HD + c * 8;
            kv[it] = *(const GAS v4u*)(row + DATT); vv[it] = *(const GAS v4u*)(row + 2 * DATT); }
#pragma unroll
        for (int it = 0; it < 6; ++it) { const int p = tid + 512 * it, key = p >> 3, c = p & 7;
            *(LAS v4u*)(F.lds + ATT_K_OFF + c * ATT_KCH + key * 16) = kv[it];
            *(LAS v4u*)(F.lds + ATT_V_OFF + (c >> 2) * ATT_VDH + (key >> 4) * 1024 + (key & 15) * 64 + (c & 3) * 16) = vv[it]; }
    }
    const int sq0 = pair * 256 + 32 * w;
    bf16x8 qr[4];
    {
        const bf16* qrow = Z + (tokbase + ((size_t)(sq0 + r32) << dsh)) * NZ + h * HD + hi * 8;
#pragma unroll
        for (int d0 = 0; d0 < 4; ++d0) qr[d0] = *(const GAS bf16x8*)(qrow + d0 * 16);
    }
    __syncthreads();
    f32x16 p[5];
#pragma unroll
    for (int j = 0; j < 5; ++j) {
        p[j] = f32x16{};
        const LAS unsigned char* kb = F.lds + ATT_K_OFF + hi * ATT_KCH + (32 * (w + j) + r32) * 16;
#pragma unroll
        for (int d0 = 0; d0 < 4; ++d0) { const bf16x8 kf = *(const LAS bf16x8*)(kb + 2 * d0 * ATT_KCH); p[j] = __builtin_amdgcn_mfma_f32_32x32x16_bf16(kf, qr[d0], p[j], 0, 0, 0); }
    }
    const float NEGB = -1e30f;
#pragma unroll
    for (int r = 0; r < 16; ++r) { const int kj = crow(r, hi); if (kj < r32) p[0][r] = NEGB; if (kj > r32) p[4][r] = NEGB; }
    if (pair == 0) {
#pragma unroll
        for (int j = 0; j < 4; ++j) if (w + j < 4) {
#pragma unroll
            for (int r = 0; r < 16; ++r) p[j][r] = NEGB; }
    }
    float mx = NEGB;
#pragma unroll
    for (int j = 0; j < 5; ++j)
#pragma unroll
        for (int r = 0; r < 16; ++r) mx = fmaxf(mx, p[j][r]);
    mx = fmaxf(mx, __shfl_xor(mx, 32));
    float l = 0.f;
#pragma unroll
    for (int j = 0; j < 5; ++j)
#pragma unroll
        for (int r = 0; r < 16; ++r) { const float e = __builtin_amdgcn_exp2f(p[j][r] - mx); p[j][r] = e; l += e; }
    l += __shfl_xor(l, 32);
    f32x16 o[2]; o[0] = f32x16{}; o[1] = f32x16{};
    const LAS unsigned char* vb = F.lds + ATT_V_OFF + (4 * hi + ((lane & 15) >> 2)) * 64 + ((lane >> 4) & 1) * 32 + (lane & 3) * 8;
#pragma unroll
    for (int j = 0; j < 5; ++j)
#pragma unroll
        for (int s = 0; s < 2; ++s) {
            v4u pw; pw.x = pk2(p[j][8 * s + 0], p[j][8 * s + 1]); pw.y = pk2(p[j][8 * s + 2], p[j][8 * s + 3]); pw.z = pk2(p[j][8 * s + 4], p[j][8 * s + 5]); pw.w = pk2(p[j][8 * s + 6], p[j][8 * s + 7]);
            const bf16x8 pa = __builtin_bit_cast(bf16x8, pw);
#pragma unroll
            for (int dh = 0; dh < 2; ++dh) {
                const LAS unsigned char* vp = vb + dh * ATT_VDH + (2 * (w + j) + s) * 1024;
                const s16x4 lo = vtr(vp), hh = vtr(vp + 512);
                const bf16x8 vf = (bf16x8){lo[0], lo[1], lo[2], lo[3], hh[0], hh[1], hh[2], hh[3]};
                o[dh] = __builtin_amdgcn_mfma_f32_32x32x16_bf16(pa, vf, o[dh], 0, 0, 0);
            }
        }
    const float rl = 1.0f / l;
    bf16* OB = (bf16*)(F.ws + WS_OB) + (size_t)br * M * DATT;
    float* LSE = (float*)(F.ws + WS_LSE) + (size_t)br * M * NH;
    LAS bf16* stg = (LAS bf16*)(F.lds + ATT_OST_OFF + w * 4096);
#pragma unroll
    for (int r = 0; r < 16; ++r) { const int orow = crow(r, hi); const float rr = __shfl(rl, orow);
#pragma unroll
        for (int dh = 0; dh < 2; ++dh) stg[orow * 64 + dh * 32 + r32] = (bf16)f2bf(o[dh][r] * rr); }
    if (hi == 0) LSE[(tokbase + ((size_t)(sq0 + r32) << dsh)) * NH + h] = mx + __builtin_amdgcn_logf(l);
    LDS_WAIT();
#pragma unroll
    for (int i = 0; i < 4; ++i) { const int row = i * 8 + (lane >> 3), ch = lane & 7; const v4u v = *(const LAS v4u*)(stg + row * 64 + ch * 8);
        *(GAS v4u*)(OB + (tokbase + ((size_t)(sq0 + row) << dsh)) * DATT + h * HD + ch * 8) = v; }
    __syncthreads();
}

__device__ __forceinline__ void pool_rows(Frame& F) {
    const bf16* Z = (const bf16*)(F.ws + WS_Z); bf16* MIX = (bf16*)(F.ws + WS_MIX);
    const int gw = F.vcu * NWAVES + F.wave, NGW = F.G * NWAVES;
    const int win = 2 << (F.lane >> 4);
    constexpr int TPW = 16;
    for (int it = gw; it < M / TPW; it += NGW) {
        const int tb = it * TPW, sb = tb & (SEQ - 1);
        const bf16* zc = Z + (size_t)tb * NZ + 3 * DATT + 8 * F.lane;
        float acc[8];
#pragma unroll
        for (int e = 0; e < 8; ++e) acc[e] = 0.f;
        for (int j = 1; j < win; ++j) if (sb - j >= 0) { const v4u v = *(const GAS v4u*)(zc - (long)j * NZ);
            acc[0] += bflo(v.x); acc[1] += bfhi(v.x); acc[2] += bflo(v.y); acc[3] += bfhi(v.y); acc[4] += bflo(v.z); acc[5] += bfhi(v.z); acc[6] += bflo(v.w); acc[7] += bfhi(v.w); }
#pragma unroll 4
        for (int i = 0; i < TPW; ++i) {
            const int s = sb + i; const v4u z0 = *(const GAS v4u*)(zc + (size_t)i * NZ);
            acc[0] += bflo(z0.x); acc[1] += bfhi(z0.x); acc[2] += bflo(z0.y); acc[3] += bfhi(z0.y); acc[4] += bflo(z0.z); acc[5] += bfhi(z0.z); acc[6] += bflo(z0.w); acc[7] += bfhi(z0.w);
            const int cnt = (s + 1) < win ? (s + 1) : win; const float inv = 1.0f / (float)cnt;
            v4u o; o.x = pk2(acc[0] * inv - bflo(z0.x), acc[1] * inv - bfhi(z0.x)); o.y = pk2(acc[2] * inv - bflo(z0.y), acc[3] * inv - bfhi(z0.y));
            o.z = pk2(acc[4] * inv - bflo(z0.z), acc[5] * inv - bfhi(z0.z)); o.w = pk2(acc[6] * inv - bflo(z0.w), acc[7] * inv - bfhi(z0.w));
            *(GAS v4u*)(MIX + (size_t)(tb + i) * D + DATT + 8 * F.lane) = o;
            if (s - (win - 1) >= 0) { const v4u v = *(const GAS v4u*)(zc + (long)(i - (win - 1)) * NZ);
                acc[0] -= bflo(v.x); acc[1] -= bfhi(v.x); acc[2] -= bflo(v.y); acc[3] -= bfhi(v.y); acc[4] -= bflo(v.z); acc[5] -= bfhi(v.z); acc[6] -= bflo(v.w); acc[7] -= bfhi(v.w); }
        }
    }
}

__device__ __forceinline__ void merge_rows(Frame& F) {
    const bf16* OB = (const bf16*)(F.ws + WS_OB); const float* LSE = (const float*)(F.ws + WS_LSE); bf16* MIX = (bf16*)(F.ws + WS_MIX);
    const int gw = F.vcu * NWAVES + F.wave, NGW = F.G * NWAVES;
    for (int t = gw; t < M; t += NGW) {
        const int h = F.lane >> 3;
        const float l0 = LSE[(size_t)t * NH + h], l1 = LSE[(size_t)(M + t) * NH + h], l2 = LSE[(size_t)(2 * M + t) * NH + h];
        const float mx = fmaxf(l0, fmaxf(l1, l2));
        float w0 = __builtin_amdgcn_exp2f(l0 - mx), w1 = __builtin_amdgcn_exp2f(l1 - mx), w2 = __builtin_amdgcn_exp2f(l2 - mx);
        const float inv = 1.0f / (w0 + w1 + w2); w0 *= inv; w1 *= inv; w2 *= inv;
        const size_t off = (size_t)t * DATT + 8 * F.lane;
        const v4u a = *(const GAS v4u*)(OB + off), b = *(const GAS v4u*)(OB + (size_t)M * DATT + off), c = *(const GAS v4u*)(OB + (size_t)2 * M * DATT + off);
        v4u o;
        o.x = pk2(w0 * bflo(a.x) + w1 * bflo(b.x) + w2 * bflo(c.x), w0 * bfhi(a.x) + w1 * bfhi(b.x) + w2 * bfhi(c.x));
        o.y = pk2(w0 * bflo(a.y) + w1 * bflo(b.y) + w2 * bflo(c.y), w0 * bfhi(a.y) + w1 * bfhi(b.y) + w2 * bfhi(c.y));
        o.z = pk2(w0 * bflo(a.z) + w1 * bflo(b.z) + w2 * bflo(c.z), w0 * bfhi(a.z) + w1 * bfhi(b.z) + w2 * bfhi(c.z));
        o.w = pk2(w0 * bflo(a.w) + w1 * bflo(b.w) + w2 * bflo(c.w), w0 * bfhi(a.w) + w1 * bfhi(b.w) + w2 * bfhi(c.w));
        *(GAS v4u*)(MIX + (size_t)t * D + 8 * F.lane) = o;
    }
}

constexpr int TK_ROW = 68;
constexpr int TK_WAVE_BYTES = 64 * TK_ROW * 4;
static_assert(NWAVES * TK_WAVE_BYTES <= LDSCTL_OFF, "top-k LDS map");

__device__ __forceinline__ unsigned f2ord(float f) { const unsigned u = __builtin_bit_cast(unsigned, f); return (u & 0x80000000u) ? ~u : (u | 0x80000000u); }
__device__ __forceinline__ float ord2f(unsigned k) { const unsigned u = (k & 0x80000000u) ? (k & 0x7fffffffu) : ~k; return __builtin_bit_cast(float, u); }
#define TK_INSERT(L, xin) do { unsigned x_ = (xin); _Pragma("unroll") for (int i_ = 0; i_ < 16; ++i_) { const unsigned hi_ = max(L[i_], x_); x_ = min(L[i_], x_); L[i_] = hi_; } } while (0)

__device__ __forceinline__ void topk_phase(Frame& F) {
    const unsigned short* SCH = (const unsigned short*)(F.ws + WS_SCH); const float* SS = (const float*)(F.ws + WS_SS);
    int* IDX = (int*)(F.ws + WS_IDX); float* GATE = (float*)(F.ws + WS_GATE);
    const int gw = F.vcu * NWAVES + F.wave, NGW = F.G * NWAVES, lane = F.lane;
    LAS float* st = (LAS float*)(F.lds + F.wave * TK_WAVE_BYTES);
    for (int it = gw; it < M / 8; it += NGW) {
        const int t0 = it * 8;
        unsigned L0[16], L1[16];
#pragma unroll
        for (int i = 0; i < 16; ++i) { L0[i] = 0u; L1[i] = 0u; }
#pragma unroll
        for (int rnd = 0; rnd < 4; ++rnd) {
            const int p = rnd >> 1, kc = rnd & 1;
#pragma unroll
            for (int i = 0; i < 8; ++i) { const int pr = 8 * i + (lane >> 3), tl = pr >> 3, h = pr & 7;
                const v4u v = *(const GAS v4u*)(SCH + (size_t)(t0 + tl) * NSC + h * 256 + p * 128 + kc * 64 + (lane & 7) * 8);
                f32x4 lo, hi;
#pragma unroll
                for (int e = 0; e < 2; ++e) { const unsigned wa = v[e], wb = v[2 + e];
                    const pg8::f16x2_t a = __builtin_bit_cast(pg8::f16x2_t, wa), b = __builtin_bit_cast(pg8::f16x2_t, wb);
                    lo[2 * e] = (float)a.x; lo[2 * e + 1] = (float)a.y; hi[2 * e] = (float)b.x; hi[2 * e + 1] = (float)b.y; }
                *(LAS f32x4*)(st + pr * TK_ROW + (lane & 7) * 8) = lo; *(LAS f32x4*)(st + pr * TK_ROW + (lane & 7) * 8 + 4) = hi; }
            LDS_WAIT(); asm volatile("" ::: "memory");
#pragma unroll 1
            for (int q = 0; q < 16; ++q) {
                const f32x4 v = *(const LAS f32x4*)(st + lane * TK_ROW + q * 4);
#pragma unroll
                for (int e = 0; e < 4; ++e) { const unsigned key = (f2ord(v[e]) & ~127u) | (unsigned)(127 - (kc * 64 + q * 4 + e));
                    if (p == 0) TK_INSERT(L0, key); else TK_INSERT(L1, key); }
            }
            LDS_WAIT(); asm volatile("" ::: "memory");
        }
        LAS float* pv0 = st; LAS float* pv1 = st + 16 * 64; LAS int* pi0 = (LAS int*)(st + 32 * 64); LAS int* pi1 = (LAS int*)(st + 48 * 64);
        float v0[16], v1[16];
#pragma unroll
        for (int i = 0; i < 16; ++i) { v0[i] = ord2f(L0[i] & ~127u); v1[i] = ord2f(L1[i] & ~127u);
            pv0[i * 64 + lane] = v0[i]; pv1[i * 64 + lane] = v1[i]; pi0[i * 64 + lane] = 127 - (int)(L0[i] & 127u); pi1[i * 64 + lane] = 127 - (int)(L1[i] & 127u); }
        unsigned T[16];
#pragma unroll
        for (int i = 0; i < 16; ++i) T[i] = 0u;
#pragma unroll
        for (int i = 0; i < 16; ++i)
#pragma unroll
            for (int j = 0; j < 16; ++j) if ((i + 1) * (j + 1) <= 16) { const unsigned key = (f2ord(v0[i] + v1[j]) & ~255u) | (unsigned)(255 - (i * 16 + j)); TK_INSERT(T, key); }
        LDS_WAIT(); asm volatile("" ::: "memory");
        const int tl = lane >> 3, h = lane & 7, t = t0 + tl;
        float ssum = 0.f;
        { const float* sp = SS + (size_t)t * 16;
#pragma unroll
          for (int i = 0; i < 4; ++i) { const f32x4 v = *(const GAS f32x4*)(sp + 4 * i); ssum += (v[0] + v[1]) + (v[2] + v[3]); } }
        const float r2 = 1.0f / sqrtf(ssum * (1.0f / D) + EPS);
        float bs[16]; int ex[16]; float mxs = -3.0e38f;
#pragma unroll
        for (int k = 0; k < 16; ++k) { const int pos = 255 - (int)(T[k] & 255u), i = pos >> 4, j = pos & 15;
            bs[k] = (pv0[i * 64 + lane] + pv1[j * 64 + lane]) * r2; ex[k] = pi0[i * 64 + lane] * NKEYS + pi1[j * 64 + lane]; mxs = fmaxf(mxs, bs[k]); }
        float den = 0.f;
#pragma unroll
        for (int k = 0; k < 16; ++k) { bs[k] = __expf(bs[k] - mxs); den += bs[k]; }
        const float inv = 1.0f / den;
        int* ip = IDX + ((size_t)t * PEER_H + h) * TOPK; float* gp = GATE + ((size_t)t * PEER_H + h) * TOPK;
#pragma unroll
        for (int k = 0; k < 16; k += 4) { *(GAS v4u*)(ip + k) = (v4u){(unsigned)ex[k], (unsigned)ex[k + 1], (unsigned)ex[k + 2], (unsigned)ex[k + 3]};
            *(GAS f32x4*)(gp + k) = (f32x4){bs[k] * inv, bs[k + 1] * inv, bs[k + 2] * inv, bs[k + 3] * inv}; }
        LDS_WAIT(); asm volatile("" ::: "memory");
    }
}

typedef float f32x2 __attribute__((ext_vector_type(2)));
typedef long l64x2 __attribute__((ext_vector_type(2)));
constexpr float EU_SCALE = 32.0f, EV_SCALE = 4.0f;
__device__ __forceinline__ float gelu_erf(float v) {
    const float av = __builtin_fabsf(v), t = __builtin_amdgcn_rcpf(av * 0.2316418882f + 1.0f);
    float q = t * 0.5307027145f + (-0.7265760135f); q = q * t + 0.7107068705f; q = q * t + (-0.142248368f); q = q * t + 0.127414796f; q = q * t;
    const float e = __builtin_amdgcn_exp2f((v * v) * (-0.72134752044f));
    const float m = v * (q * e);
    return v < 0.f ? m : v - m;
}
constexpr int PU_WAVE_LDS = 10496;
constexpr int PU_SL = 0, PU_HIST = 8192, PU_DSCR = 9216, PU_CNT = 10240;
static_assert(NWAVES * PU_WAVE_LDS <= LDSCTL_OFF, "PEER U LDS map");
#ifndef PEER_UACT_EXPR
#define PEER_UACT_EXPR gelu_erf(a * (1.0f / EU_SCALE)) * gt * (1.0f / EV_SCALE)
#endif
#ifndef PEER_ACT_EXPR
#define PEER_ACT_EXPR __builtin_bit_cast(float, itv.y)
#endif
#ifndef PEER_V_ITEMS
#define PEER_V_ITEMS 128
#endif
constexpr int PV_LIST = 0, PV_SSP = 32768;

__device__ __forceinline__ void peer_u_loadA(v4u (&A)[16], const unsigned char* EU, unsigned e, int lane) {
    const GAS unsigned char* rowp = (const GAS unsigned char*)EU + (size_t)e * D + 16 * (lane & 3);
#pragma unroll
    for (int i = 0; i < 16; ++i) A[i] = *(const GAS v4u*)(rowp + 64 * i);
}
template <unsigned EMASK, bool DUMMY> __device__ __forceinline__ void peer_u_phase(Frame& F, int blk) {
    const int* IDX = (const int*)(F.ws + WS_IDX); const float* GATE = (const float*)(F.ws + WS_GATE); const float* SS = (const float*)(F.ws + WS_SS);
    const unsigned char* EU = F.ws + WS_EU; unsigned* VE = (unsigned*)(F.ws + WS_SC); float* VA = (float*)(F.ws + WS_SC + (size_t)M * 128 * 4);
    const int lane = F.lane, c = lane & 15, g = lane >> 4;
    const int T0 = blk * 128 + F.wave * 16;
    LAS unsigned char* wl = F.lds + F.wave * PU_WAVE_LDS;
    LAS unsigned* SL = (LAS unsigned*)(wl + PU_SL); LAS unsigned* HIST = (LAS unsigned*)(wl + PU_HIST); LAS float* DSCR = (LAS float*)(wl + PU_DSCR); LAS unsigned* CNT = (LAS unsigned*)(wl + PU_CNT);
    l64x2 Bop[16];
    {
        const int tB = T0 + c; float s = 0.f;
#pragma unroll
        for (int i = 0; i < 4; ++i) { const f32x4 v = *(const GAS f32x4*)(SS + (size_t)tB * 16 + 4 * i); s += (v[0] + v[1]) + (v[2] + v[3]); }
        const float r2 = 1.0f / sqrtf(s * (1.0f / D) + EPS);
        const float* xp = F.out + (size_t)tB * D + 16 * g;
#pragma unroll
        for (int i = 0; i < 16; ++i) { v4u o;
#pragma unroll
            for (int q = 0; q < 4; ++q) { const f32x4 a = *(const GAS f32x4*)(xp + 64 * i + 4 * q) * r2;
                int w = __builtin_amdgcn_cvt_pk_fp8_f32(a[0], a[1], 0, false); w = __builtin_amdgcn_cvt_pk_fp8_f32(a[2], a[3], w, true); o[q] = (unsigned)w; }
            Bop[i] = __builtin_bit_cast(l64x2, o); asm volatile("" : "+v"(Bop[i]) :: "memory"); }
    }
    *(LAS v4u*)(HIST + 4 * lane) = (v4u){0u, 0u, 0u, 0u};
    if (lane < 16) CNT[lane] = 0u;
    LDS_WAIT(); asm volatile("" ::: "memory");
#pragma unroll 4
    for (int q = 0; q < 32; ++q) { const unsigned e = (unsigned)IDX[(size_t)T0 * 128 + q * 64 + lane]; __hip_atomic_fetch_add(HIST + (e >> 6), 1u, __ATOMIC_RELAXED, __HIP_MEMORY_SCOPE_WAVEFRONT); }
    LDS_WAIT(); asm volatile("" ::: "memory");
    {
        const v4u hv = *(const LAS v4u*)(HIST + 4 * lane); const unsigned tot = hv.x + hv.y + hv.z + hv.w; unsigned inc = tot;
#pragma unroll
        for (int o = 1; o < 64; o <<= 1) { const unsigned n = (unsigned)__shfl_up((int)inc, o); if (lane >= o) inc += n; }
        const unsigned ex = inc - tot;
        LDS_WAIT(); asm volatile("" ::: "memory");
        *(LAS v4u*)(HIST + 4 * lane) = (v4u){ex, ex + hv.x, ex + hv.x + hv.y, ex + hv.x + hv.y + hv.z};
    }
    LDS_WAIT(); asm volatile("" ::: "memory");
#pragma unroll 4
    for (int q = 0; q < 32; ++q) { const unsigned p = (unsigned)(q * 64 + lane); const unsigned e = (unsigned)IDX[(size_t)T0 * 128 + p];
        const unsigned pos = __hip_atomic_fetch_add(HIST + (e >> 6), 1u, __ATOMIC_RELAXED, __HIP_MEMORY_SCOPE_WAVEFRONT); SL[pos] = (e << 11) | p; }
    LDS_WAIT(); asm volatile("" ::: "memory");
    v4u A[16];
    const int psrc = (4 * c + g) * 4;
    unsigned itl = SL[lane >> 2];
    peer_u_loadA(A, EU, (itl >> 11) & EMASK, lane);
#pragma unroll 1
    for (int b = 0; b < 128; ++b) {
        const unsigned itcur = SL[16 * b + c];
        float gt = 0.f; if (lane < 16) gt = GATE[(size_t)T0 * 128 + (itcur & 2047u)];
        const int bn = (b + 1 < 128) ? b + 1 : b;
        itl = SL[16 * bn + (lane >> 2)];
        const GAS unsigned char* nrow = (const GAS unsigned char*)EU + (size_t)((itl >> 11) & EMASK) * D + 16 * (lane & 3);
        f32x4 acc = {0.f, 0.f, 0.f, 0.f};
#pragma unroll
        for (int i = 0; i < 16; ++i) { v4u t;
#pragma unroll
            for (int w = 0; w < 4; ++w) t[w] = (unsigned)__builtin_amdgcn_ds_bpermute(psrc, (int)A[i][w]);
            A[i] = *(const GAS v4u*)(nrow + 64 * i);
            const l64x2 a2 = __builtin_bit_cast(l64x2, t);
            acc = __builtin_amdgcn_mfma_f32_16x16x32_fp8_fp8(a2.x, Bop[i].x, acc, 0, 0, 0); acc = __builtin_amdgcn_mfma_f32_16x16x32_fp8_fp8(a2.y, Bop[i].y, acc, 0, 0, 0); }
        *(LAS f32x4*)(DSCR + 4 * lane) = acc;
        LDS_WAIT(); asm volatile("" ::: "memory");
        if (lane < 16) { const unsigned p = itcur & 2047u, cr = p >> 7, e = itcur >> 11;
            const float a = DSCR[((lane >> 2) * 16 + cr) * 4 + (lane & 3)];
            const float act = PEER_UACT_EXPR;
            const unsigned pos = __hip_atomic_fetch_add(CNT + cr, 1u, __ATOMIC_RELAXED, __HIP_MEMORY_SCOPE_WAVEFRONT);
            if (!DUMMY) { VE[(size_t)(T0 + cr) * 128 + pos] = e; VA[(size_t)(T0 + cr) * 128 + pos] = act; } else if (act == 123.456f) VA[0] = act; }
        LDS_WAIT(); asm volatile("" ::: "memory");
    }
}

template <unsigned EMASK, bool DUMMY> __device__ __forceinline__ void peer_v_phase(Frame& F, int blk) {
    const unsigned char* EV = F.ws + WS_EV; const unsigned* VE = (const unsigned*)(F.ws + WS_SC); const float* VA = (const float*)(F.ws + WS_SC + (size_t)M * 128 * 4);
    const int lane = F.lane, q = lane >> 3, c = lane & 7, w = F.wave;
    const int CB = blk * 128;
    const LAS unsigned* LE = (const LAS unsigned*)(F.lds + PV_LIST); const LAS float* LA = (const LAS float*)(F.lds + PV_LIST + 16384); LAS float* SSP = (LAS float*)(F.lds + PV_SSP);
    const unsigned voff = 128u * (unsigned)w + 16u * (unsigned)c;
#pragma unroll 1
    for (int rd = 0; rd < 4; ++rd) {
        const int TB = CB + 32 * rd;
        __syncthreads();
        {
            const GAS v4u* se = (const GAS v4u*)(VE + (size_t)TB * 128) + F.tid * 2; const GAS v4u* sa = (const GAS v4u*)(VA + (size_t)TB * 128) + F.tid * 2;
            LAS v4u* de = (LAS v4u*)(F.lds + PV_LIST) + F.tid * 2; LAS v4u* da = (LAS v4u*)(F.lds + PV_LIST + 16384) + F.tid * 2;
            const v4u a0 = se[0], a1 = se[1], a2 = sa[0], a3 = sa[1]; de[0] = a0; de[1] = a1; da[0] = a2; da[1] = a3;
        }
        __syncthreads();
        f32x2 y[4][8];
#pragma unroll
        for (int gI = 0; gI < 4; ++gI)
#pragma unroll
            for (int e = 0; e < 8; ++e) y[gI][e] = (f32x2){0.f, 0.f};
        v4u vv[4][4]; float ac[4][4];
#pragma unroll
        for (int ii = 0; ii < 4; ++ii)
#pragma unroll
            for (int gI = 0; gI < 4; ++gI) { const int li = (8 * gI + q) * 128 + ii; ac[ii][gI] = LA[li];
                vv[ii][gI] = *(const GAS v4u*)((const GAS unsigned char*)EV + (size_t)(LE[li] & EMASK) * D + voff); }
#pragma unroll 1
        for (int i0 = 0; i0 < 128; i0 += 4) {
            const int inx = (i0 + 4 < 128) ? i0 + 4 : i0;
#pragma unroll
            for (int ii = 0; ii < 4; ++ii)
#pragma unroll
                for (int gI = 0; gI < 4; ++gI) { const f32x2 a2 = {ac[ii][gI], ac[ii][gI]}; const v4u cur = vv[ii][gI];
                    const int li = (8 * gI + q) * 128 + inx + ii; ac[ii][gI] = LA[li];
                    vv[ii][gI] = *(const GAS v4u*)((const GAS unsigned char*)EV + (size_t)(LE[li] & EMASK) * D + voff);
#pragma unroll
                    for (int d = 0; d < 4; ++d) { const int wd = (int)cur[d];
                        y[gI][2 * d] += a2 * __builtin_amdgcn_cvt_pk_f32_fp8(wd, false); y[gI][2 * d + 1] += a2 * __builtin_amdgcn_cvt_pk_f32_fp8(wd, true); } }
        }
#pragma unroll
        for (int gI = 0; gI < 4; ++gI) { const float* xr = F.out + (size_t)(TB + 8 * gI + q) * D + voff; float ss = 0.f;
#pragma unroll
            for (int j = 0; j < 4; ++j) { const f32x4 a = *(const GAS f32x4*)(xr + 4 * j); y[gI][2 * j] += (f32x2){a[0], a[1]}; y[gI][2 * j + 1] += (f32x2){a[2], a[3]};
                ss += (y[gI][2 * j].x * y[gI][2 * j].x + y[gI][2 * j].y * y[gI][2 * j].y) + (y[gI][2 * j + 1].x * y[gI][2 * j + 1].x + y[gI][2 * j + 1].y * y[gI][2 * j + 1].y); }
            ss += __shfl_xor(ss, 1); ss += __shfl_xor(ss, 2); ss += __shfl_xor(ss, 4);
            if (c == 0) SSP[(8 * gI + q) * 8 + w] = ss; }
        __syncthreads();
#pragma unroll
        for (int gI = 0; gI < 4; ++gI) { const LAS f32x4* sp = (const LAS f32x4*)(SSP + (8 * gI + q) * 8); const f32x4 s0 = sp[0], s1 = sp[1];
            const float tot = ((s0[0] + s0[1]) + (s0[2] + s0[3])) + ((s1[0] + s1[1]) + (s1[2] + s1[3]));
            const float r3 = 1.0f / sqrtf(tot * (1.0f / D) + EPS);
            float* orow = (DUMMY ? (float*)(F.ws + 192 * MiB) : F.out) + (size_t)(TB + 8 * gI + q) * D + voff;
#pragma unroll
            for (int j = 0; j < 4; ++j) { const f32x4 gn = *(const GAS f32x4*)(F.norm_final + voff + 4 * j);
                *(GAS f32x4*)(orow + 4 * j) = (f32x4){y[gI][2 * j].x * r3 * gn[0], y[gI][2 * j].y * r3 * gn[1], y[gI][2 * j + 1].x * r3 * gn[2], y[gI][2 * j + 1].y * r3 * gn[3]}; } }
    }
}

struct Args { const float* in[12]; float* out; unsigned char* ws; };
__global__ void __launch_bounds__(NWAVES * 64, 2) hymba_fwd(Args args) {
    extern __shared__ __attribute__((aligned(16))) unsigned char lds[];
    Frame F;
    F.lds = (LAS unsigned char*)lds;
    F.MISC = (volatile LAS unsigned*)(F.lds + MISC_OFF);
    F.tid = threadIdx.x; F.lane = F.tid & 63; F.wave = __builtin_amdgcn_readfirstlane(F.tid >> 6);
    F.G = gridDim.x; { const int bx = blockIdx.x; F.vcu = (F.G % 8 == 0) ? (bx % 8) * (F.G / 8) + bx / 8 : bx; }
    F.x = args.in[0]; F.norm_mix = args.in[1]; F.w_in = args.in[2]; F.w_pool = args.in[3]; F.pool_scale = args.in[4]; F.w_out = args.in[5];
    F.norm_ffn = args.in[6]; F.w_query = args.in[7]; F.sub_keys = args.in[8]; F.expert_u = args.in[9]; F.expert_v = args.in[10]; F.norm_final = args.in[11];
    F.out = args.out; F.ws = args.ws;
    for (int u = F.tid; u < (LDS_BYTES - LDSCTL_OFF) / 4; u += NWAVES * 64) ((LAS unsigned*)(F.lds + LDSCTL_OFF))[u] = 0u;
    __syncthreads();
    XcdBarrier bar = xcd_barrier_post((unsigned*)(F.ws + WS_CTL), F.MISC + 8);
#define GRID_BAR() xcd_barrier(bar)

#ifndef PROBE_DUP
#define PROBE_DUP -1
#endif
#ifdef UBENCH
    {
        unsigned r0 = F.tid, r1 = F.tid * 3, r2 = F.tid * 5, r3 = F.tid * 7; float f0 = 1.f, f1 = 2.f, f2 = 3.f, f3 = 4.f; f32x2 p0 = {1.f, 2.f}, p1 = {3.f, 4.f}, q0 = {0.f, 0.f}, q1 = {0.f, 0.f}, q2 = {0.f, 0.f}, q3 = {0.f, 0.f};
        for (int it = 0; it < 20000; ++it) {
#pragma unroll
            for (int k = 0; k < 4; ++k) {
#if UBENCH == 1
                asm volatile("v_cvt_pk_f32_fp8_e32 %0, %4\n v_cvt_pk_f32_fp8_e32 %1, %5\n v_cvt_pk_f32_fp8_e32 %2, %6\n v_cvt_pk_f32_fp8_e32 %3, %7" : "=v"(q0), "=v"(q1), "=v"(q2), "=v"(q3) : "v"(r0), "v"(r1), "v"(r2), "v"(r3));
#elif UBENCH == 2
                asm volatile("v_cvt_f32_ubyte0_e32 %0, %4\n v_cvt_f32_ubyte1_e32 %1, %5\n v_cvt_f32_ubyte2_e32 %2, %6\n v_cvt_f32_ubyte3_e32 %3, %7" : "=v"(f0), "=v"(f1), "=v"(f2), "=v"(f3) : "v"(r0), "v"(r1), "v"(r2), "v"(r3));
#elif UBENCH == 3
                asm volatile("v_pk_fma_f32 %0, %4, %5, %0\n v_pk_fma_f32 %1, %4, %5, %1\n v_pk_fma_f32 %2, %4, %5, %2\n v_pk_fma_f32 %3, %4, %5, %3" : "+v"(q0), "+v"(q1), "+v"(q2), "+v"(q3) : "v"(p0), "v"(p1));
#elif UBENCH == 4
                asm volatile("v_dot2_f32_f16 %0, %4, %5, %0\n v_dot2_f32_f16 %1, %4, %6, %1\n v_dot2_f32_f16 %2, %5, %6, %2\n v_dot2_f32_f16 %3, %6, %7, %3" : "+v"(f0), "+v"(f1), "+v"(f2), "+v"(f3) : "v"(r0), "v"(r1), "v"(r2), "v"(r3));
#elif UBENCH == 5
                asm volatile("v_perm_b32 %0, %4, %5, %6\n v_perm_b32 %1, %5, %6, %7\n v_perm_b32 %2, %4, %6, %7\n v_perm_b32 %3, %4, %5, %7" : "=v"(f0), "=v"(f1), "=v"(f2), "=v"(f3) : "v"(r0), "v"(r1), "v"(r2), "v"(r3));
#elif UBENCH == 6
                asm volatile("v_fma_f32 %0, %4, %5, %0\n v_fma_f32 %1, %4, %5, %1\n v_fma_f32 %2, %4, %5, %2\n v_fma_f32 %3, %4, %5, %3" : "+v"(f0), "+v"(f1), "+v"(f2), "+v"(f3) : "v"(p0.x), "v"(p1.y));
#elif UBENCH == 8
                asm volatile("v_pk_fma_f16 %0, %4, %5, %0\n v_pk_fma_f16 %1, %4, %5, %1\n v_pk_fma_f16 %2, %4, %5, %2\n v_pk_fma_f16 %3, %4, %5, %3" : "+v"(f0), "+v"(f1), "+v"(f2), "+v"(f3) : "v"(r0), "v"(r1));
#elif UBENCH == 9
                asm volatile("v_cvt_scalef32_pk_f16_fp8 %0, %4, 1.0\n v_cvt_scalef32_pk_f16_fp8 %1, %5, 1.0\n v_cvt_scalef32_pk_f16_fp8 %2, %6, 1.0\n v_cvt_scalef32_pk_f16_fp8 %3, %7, 1.0" : "=v"(f0), "=v"(f1), "=v"(f2), "=v"(f3) : "v"(r0), "v"(r1), "v"(r2), "v"(r3));
#elif UBENCH == 10
                asm volatile("v_cvt_pk_f32_fp8_sdwa %0, %4 src0_sel:WORD_1\n v_cvt_pk_f32_fp8_sdwa %1, %5 src0_sel:WORD_1\n v_cvt_pk_f32_fp8_sdwa %2, %6 src0_sel:WORD_1\n v_cvt_pk_f32_fp8_sdwa %3, %7 src0_sel:WORD_1" : "=v"(q0), "=v"(q1), "=v"(q2), "=v"(q3) : "v"(r0), "v"(r1), "v"(r2), "v"(r3));
#elif UBENCH == 7
                asm volatile("v_dot4_i32_i8 %0, %4, %5, %0\n v_dot4_i32_i8 %1, %4, %6, %1\n v_dot4_i32_i8 %2, %5, %6, %2\n v_dot4_i32_i8 %3, %6, %7, %3" : "+v"(f0), "+v"(f1), "+v"(f2), "+v"(f3) : "v"(r0), "v"(r1), "v"(r2), "v"(r3));
#endif
            }
        }
        float* dump = (float*)(F.ws + WS_Z);
        dump[(size_t)blockIdx.x * 512 + F.tid] = f0 + f1 + f2 + f3 + q0.x + q1.y + q2.x + q3.y;
    }
#endif
    p0_prologue(F);
    if (PROBE_DUP == 0) { GRID_BAR(); p0_prologue(F); }
    GRID_BAR();
    {
        pg8::Gemm g{(const pg8::bf16_t*)(F.ws + WS_XB), (const pg8::bf16_t*)(F.ws + WS_WIN), M, NZ, D}; pg8::StaticOrder S; S.init(M, NZ, F.G, (int)blockIdx.x);
        pg8::EpiZ E{(pg8::bf16_t*)(F.ws + WS_Z), NZ, (const float*)(F.ws + WS_R1), DATT, QSCALE};
        pg8::gemm_phase<pg8::EpiZ, pg8::StaticOrder, PG8_ALIGN, PG8_SP2>(F.lds + RING_OFF, g, S, E);
        if (PROBE_DUP == 1) { GRID_BAR(); pg8::gemm_phase<pg8::EpiZ, pg8::StaticOrder, PG8_ALIGN, PG8_SP2>(F.lds + RING_OFF, g, S, E); }
    }
    GRID_BAR();
    for (int u = F.vcu; u < ATT_UNITS; u += F.G) attn_unit(F, u);
    if (PROBE_DUP == 2) { GRID_BAR(); for (int u = F.vcu; u < ATT_UNITS; u += F.G) attn_unit(F, u); }
    pool_rows(F);
    if (PROBE_DUP == 3) { GRID_BAR(); pool_rows(F); }
    GRID_BAR();
    merge_rows(F);
    if (PROBE_DUP == 4) { GRID_BAR(); merge_rows(F); }
    GRID_BAR();
    {
        pg8::Gemm g{(const pg8::bf16_t*)(F.ws + WS_MIX), (const pg8::bf16_t*)(F.ws + WS_WOUT), M, D, D}; pg8::StaticOrder S; S.init(M, D, F.G, (int)blockIdx.x);
        pg8::EpiRes E{F.x, F.out, (pg8::bf16_t*)(F.ws + WS_XB), (float*)(F.ws + WS_SS), D};
        pg8::gemm_phase<pg8::EpiRes, pg8::StaticOrder, PG8_ALIGN, PG8_SP2>(F.lds + RING_OFF, g, S, E);
        if (PROBE_DUP == 5) { GRID_BAR(); pg8::gemm_phase<pg8::EpiRes, pg8::StaticOrder, PG8_ALIGN, PG8_SP2>(F.lds + RING_OFF, g, S, E); }
    }
    GRID_BAR();
    {
        pg8::Gemm g{(const pg8::bf16_t*)(F.ws + WS_XB), (const pg8::bf16_t*)(F.ws + WS_WSC), M, NSC, D}; pg8::StaticOrder S; S.init(M, NSC, F.G, (int)blockIdx.x);
        pg8::EpiF16 E{(unsigned short*)(F.ws + WS_SCH), NSC};
        pg8::gemm_phase<pg8::EpiF16, pg8::StaticOrder, PG8_ALIGN, PG8_SP2>(F.lds + RING_OFF, g, S, E);
        if (PROBE_DUP == 6) { GRID_BAR(); pg8::gemm_phase<pg8::EpiF16, pg8::StaticOrder, PG8_ALIGN, PG8_SP2>(F.lds + RING_OFF, g, S, E); }
    }
    GRID_BAR();
    topk_phase(F);
    if (PROBE_DUP == 7) { GRID_BAR(); topk_phase(F); }
    GRID_BAR();
#ifndef PROBE_U2
#define PROBE_U2 0
#endif
#ifndef PROBE_UMASK
#define PROBE_UMASK 0x3fffu
#endif
    for (int blk = F.vcu; blk < M / 128; blk += F.G) { if (PROBE_U2) { peer_u_phase<PROBE_UMASK, true>(F, blk); __syncthreads(); } peer_u_phase<0x3fffu, false>(F, blk);
#ifdef PROBE_VMASK
        peer_v_phase<PROBE_VMASK, true>(F, blk); __syncthreads();
#endif
        peer_v_phase<0x3fffu, false>(F, blk); __syncthreads(); }
}

extern "C" void kernel_launch(void* const* d_in, const int* in_sizes, int n_in, void* d_out, int out_size, void* d_ws, size_t ws_size, hipStream_t stream) {
    static int grid = 0;
    if (grid == 0) {
        if (n_in != 12 || in_sizes[0] != M * D || out_size != M * D || ws_size < WS_END) { fprintf(stderr, "kernel_launch: unexpected shapes (n_in %d, in0 %d, out %d, ws %zu); nothing launched\n", n_in, n_in > 0 ? in_sizes[0] : -1, out_size, ws_size); grid = -1; return; }
        int dev = 0, cus = 0, per_cu = 0;
        if (hipGetDevice(&dev) != hipSuccess || hipDeviceGetAttribute(&cus, hipDeviceAttributeMultiprocessorCount, dev) != hipSuccess) { grid = -1; return; }
        if (hipFuncSetAttribute((const void*)hymba_fwd, hipFuncAttributeMaxDynamicSharedMemorySize, LDS_BYTES) != hipSuccess) { fprintf(stderr, "kernel_launch: hipFuncSetAttribute failed\n"); grid = -1; return; }
        if (hipOccupancyMaxActiveBlocksPerMultiprocessor(&per_cu, (const void*)hymba_fwd, NWAVES * 64, LDS_BYTES) != hipSuccess || per_cu < 1)
            fprintf(stderr, "kernel_launch: note: occupancy query reports %d workgroups per CU\n", per_cu);
        (void)hipGetLastError();
        grid = cus;
    }
    if (grid < 0) return;
    if (hipMemsetAsync((char*)d_ws + WS_CTL, 0, CTL_ZERO_BYTES, stream) != hipSuccess) { fprintf(stderr, "kernel_launch: hipMemsetAsync failed\n"); return; }
    Args a{};
    for (int i = 0; i < 12; ++i) a.in[i] = (const float*)d_in[i];
    a.out = (float*)d_out; a.ws = (unsigned char*)d_ws;
    hipLaunchKernelGGL(hymba_fwd, dim3(grid), dim3(NWAVES * 64), LDS_BYTES, stream, a);
    const hipError_t le = hipPeekAtLastError();
    if (le != hipSuccess) fprintf(stderr, "kernel_launch: launch failed: %s\n", hipGetErrorName(le));
}
```

```cpp
#include <hip/hip_runtime.h>
#include <cstdio>
#include <cstdint>
namespace pg8 {
#define PG8_LAS __attribute__((address_space(3)))
typedef unsigned short bf16_t;
typedef short bf16x8 __attribute__((ext_vector_type(8)));
typedef float f32x4 __attribute__((ext_vector_type(4)));
typedef unsigned u32x4 __attribute__((ext_vector_type(4)));
constexpr int BM = 256, BK = 64, HALF = 128, HTB = HALF * BK * 2  , STAGE_BYTES = 8 * HTB, NXCD = 8, WGM = 8;

__host__ __device__ __forceinline__ int lds_byte(int r, int c) { const int st = (r >> 4) * 2 + (c >> 5), rr = r & 15, cc = c & 31, ob = rr * 64 + cc * 2; return st * 1024 + (ob ^ (((ob >> 9) & 1) << 5)); }
__host__ __device__ __forceinline__ void stage_rc(int b, int& R, int& C) { const int st = b / 1024, sb = b % 1024, swz = sb ^ (((sb >> 9) & 1) << 5); R = (st >> 1) * 16 + swz / 64; C = (st & 1) * 32 + (swz % 64) / 2; }
__host__ __device__ __forceinline__ int perm32(int rho) { const int n = rho >> 4, i = rho & 15; return 8 * (i >> 2) + 4 * n + (i & 3); }

struct Unit { int pm, pn; };
struct Gemm { const bf16_t* A; const bf16_t* Bt; int M, N, K; };

struct StaticOrder {
    int nM, nN, nwg, G, c;
    __host__ __device__ void init(int M, int N, int G_, int c_) { nM = M / BM; nN = N / BM; nwg = nM * nN; G = G_; c = c_; }
    __host__ __device__ bool next(int i, Unit& u) const {
        const long L = (long)i * G + c; if (L >= nwg) return false;
        int wgid = (int)L; { const int q = nwg / NXCD, r = nwg % NXCD, xcd = wgid % NXCD, off = wgid / NXCD; wgid = (xcd < r ? xcd * (q + 1) : r * (q + 1) + (xcd - r) * q) + off; }
        const int nig = WGM * nN, gid = wgid / nig, fm = gid * WGM, gsz = (nM - fm) < WGM ? (nM - fm) : WGM;
        u.pm = fm + ((wgid % nig) % gsz); u.pn = (wgid % nig) / gsz; return true;
    }
    __device__ __forceinline__ void a_ready(const Unit&) const {}
    __device__ __forceinline__ void done(const Unit&) const {}
};

__device__ __forceinline__ unsigned cvt_pk_bf16(float lo, float hi) { unsigned r; asm volatile("v_cvt_pk_bf16_f32 %0, %1, %2" : "=v"(r) : "v"(lo), "v"(hi)); return r; }
struct EpiZ {
    static constexpr bool PERM = true, AFTER_DRAIN = false;
    bf16_t* ZH; bf16_t* ZP; const float* rs; int qcols; float qscale; int seq, nh, mrows;
    __device__ __forceinline__ void operator()(const f32x4 (&acc)[2][2][4][2], const Unit& u, int wr, int wc, int fr, int fq) const {
        const int row0 = u.pm * BM + wr * 64 + fr; const int colt = u.pn * BM;
        const float sc = (colt < qcols) ? qscale : 1.f;
        const int col0 = colt + wc * 32 + 8 * fq;
#pragma unroll
        for (int ai = 0; ai < 2; ++ai)
#pragma unroll
            for (int m = 0; m < 4; ++m) { const int row = row0 + ai * HALF + m * 16; const float s = rs[row] * sc; const int bq = row / seq, sq = row - bq * seq;
#pragma unroll
                for (int bj = 0; bj < 2; ++bj) { const f32x4 v0 = acc[ai][bj][m][0] * s, v1 = acc[ai][bj][m][1] * s; const int cc = col0 + bj * HALF;
                    u32x4 w; w.x = cvt_pk_bf16(v0[0], v0[1]); w.y = cvt_pk_bf16(v0[2], v0[3]); w.z = cvt_pk_bf16(v1[0], v1[1]); w.w = cvt_pk_bf16(v1[2], v1[3]);
                    bf16_t* dst = (cc < 3 * 512) ? ZH + (size_t)(cc >> 9) * mrows * 512 + ((size_t)(bq * nh + ((cc >> 6) & 7)) * seq + sq) * 64 + (cc & 63)
                                                 : ZP + (size_t)row * 512 + (cc - 3 * 512);
                    *(u32x4*)dst = w; } }
    }
};
struct EpiRes {
    static constexpr bool PERM = true, AFTER_DRAIN = false;
    bf16_t* XB; float* SS; int ldc;
    __device__ __forceinline__ void operator()(const f32x4 (&acc)[2][2][4][2], const Unit& u, int wr, int wc, int fr, int fq) const {
        const int row0 = u.pm * BM + wr * 64 + fr; const int col0 = u.pn * BM + wc * 32 + 8 * fq;
#pragma unroll
        for (int ai = 0; ai < 2; ++ai)
#pragma unroll
            for (int m = 0; m < 4; ++m) { const int row = row0 + ai * HALF + m * 16; const size_t off = (size_t)row * ldc + col0; float ss = 0.f;
#pragma unroll
                for (int bj = 0; bj < 2; ++bj) {
                    const u32x4 xw = *(const u32x4*)(XB + off + bj * HALF);
                    f32x4 v0 = acc[ai][bj][m][0], v1 = acc[ai][bj][m][1];
                    v0[0] += __builtin_bit_cast(float, xw.x << 16); v0[1] += __builtin_bit_cast(float, xw.x & 0xffff0000u); v0[2] += __builtin_bit_cast(float, xw.y << 16); v0[3] += __builtin_bit_cast(float, xw.y & 0xffff0000u);
                    v1[0] += __builtin_bit_cast(float, xw.z << 16); v1[1] += __builtin_bit_cast(float, xw.z & 0xffff0000u); v1[2] += __builtin_bit_cast(float, xw.w << 16); v1[3] += __builtin_bit_cast(float, xw.w & 0xffff0000u);
                    ss += (v0[0] * v0[0] + v0[1] * v0[1]) + (v0[2] * v0[2] + v0[3] * v0[3]) + (v1[0] * v1[0] + v1[1] * v1[1]) + (v1[2] * v1[2] + v1[3] * v1[3]);
                    u32x4 w; w.x = cvt_pk_bf16(v0[0], v0[1]); w.y = cvt_pk_bf16(v0[2], v0[3]); w.z = cvt_pk_bf16(v1[0], v1[1]); w.w = cvt_pk_bf16(v1[2], v1[3]);
                    *(u32x4*)(XB + off + bj * HALF) = w; }
                ss += __shfl_xor(ss, 16); ss += __shfl_xor(ss, 32);
                if (fq == 0) SS[(size_t)row * 16 + u.pn * 4 + wc] = ss;
                if (m & 1) asm volatile("" ::: "memory"); }
    }
};
typedef _Float16 f16x2_t __attribute__((ext_vector_type(2)));
__device__ __forceinline__ unsigned cvt_pk_f16(float lo, float hi) { const f16x2_t h = {(_Float16)lo, (_Float16)hi}; return __builtin_bit_cast(unsigned, h); }
struct EpiF16 {
    static constexpr bool PERM = true, AFTER_DRAIN = false;
    unsigned short* O; int ldc;
    __device__ __forceinline__ void operator()(const f32x4 (&acc)[2][2][4][2], const Unit& u, int wr, int wc, int fr, int fq) const {
        const int row0 = u.pm * BM + wr * 64 + fr; const int col0 = u.pn * BM + wc * 32 + 8 * fq;
#pragma unroll
        for (int ai = 0; ai < 2; ++ai)
#pragma unroll
            for (int m = 0; m < 4; ++m) { unsigned short* rowp = O + (size_t)(row0 + ai * HALF + m * 16) * ldc + col0;
#pragma unroll
                for (int bj = 0; bj < 2; ++bj) { const f32x4 v0 = acc[ai][bj][m][0], v1 = acc[ai][bj][m][1];
                    u32x4 w; w.x = cvt_pk_f16(v0[0], v0[1]); w.y = cvt_pk_f16(v0[2], v0[3]); w.z = cvt_pk_f16(v1[0], v1[1]); w.w = cvt_pk_f16(v1[2], v1[3]);
                    *(u32x4*)(rowp + bj * HALF) = w; } }
    }
};

template <class Epi, class Sched, bool ALIGN_EPI = false, bool SP2 = false>
__device__ __forceinline__ void gemm_phase(PG8_LAS unsigned char* lds, const Gemm g, const Sched& S, const Epi& E) {
    const int tid = threadIdx.x, wid = __builtin_amdgcn_readfirstlane(tid >> 6), lane = tid & 63, wr = wid >> 2, wc = wid & 3, fr = lane & 15, fq = lane >> 4;
    const int K = g.K, nt = K / BK;
    unsigned voffA[2], voffB[2];
#pragma unroll
    for (int i = 0; i < 2; ++i) { int R, C; stage_rc(tid * 16 + i * 8192, R, C); const int Rb = Epi::PERM ? ((R & ~31) + perm32(R & 31)) : R;
        voffA[i] = (unsigned)(R * K + C) * 2u; voffB[i] = (unsigned)(Rb * K + C) * 2u; }
    const size_t kstep = (size_t)(BK * 2);
    const size_t hstep = (size_t)HALF * K * 2;
    const size_t tstep = 2 * hstep;
    const unsigned ldsw = (unsigned)wid * 1024u;
    const int aoff = lds_byte(wr * 64 + fr, fq * 8), boff = lds_byte(wc * 32 + fr, fq * 8);
#define PG8_SA(b, h) (((b) * 2 + (h)) * HTB)
#define PG8_SB(b, h) ((4 + (b) * 2 + (h)) * HTB)
#define PG8_STAGE(bufoff, gbase, voff) do { _Pragma("unroll") for (int _i = 0; _i < 2; ++_i) \
        __builtin_amdgcn_global_load_lds((const unsigned*)((const char*)(gbase) + (voff)[_i]), (PG8_LAS unsigned*)(lds + (bufoff) + ldsw + _i * 8192), 16, 0, 0); } while (0)
#define PG8_LDA(dst, b, h) do { _Pragma("unroll") for (int m = 0; m < 4; ++m) _Pragma("unroll") for (int k = 0; k < 2; ++k) dst[m][k] = *(const PG8_LAS bf16x8*)(lds + PG8_SA(b, h) + aoff + m * 2048 + k * 1024); } while (0)
#define PG8_LDB(dst, b, h) do { _Pragma("unroll") for (int n = 0; n < 2; ++n) _Pragma("unroll") for (int k = 0; k < 2; ++k) dst[n][k] = *(const PG8_LAS bf16x8*)(lds + PG8_SB(b, h) + boff + n * 2048 + k * 1024); } while (0)
#define PG8_MMA(ai, bj, At, Bt) do { __builtin_amdgcn_s_setprio(1); _Pragma("unroll") for (int m = 0; m < 4; ++m) _Pragma("unroll") for (int n = 0; n < 2; ++n) _Pragma("unroll") for (int k = 0; k < 2; ++k) \
        acc[ai][bj][m][n] = __builtin_amdgcn_mfma_f32_16x16x32_bf16(Bt[n][k], At[m][k], acc[ai][bj][m][n], 0, 0, 0); __builtin_amdgcn_s_setprio(0); } while (0)
#define PG8_WAIT_V(n) asm volatile("s_waitcnt vmcnt(" #n ")" ::: "memory")
#define PG8_WAIT_L(n) asm volatile("s_waitcnt lgkmcnt(" #n ")" ::: "memory")
#define PG8_BAR __builtin_amdgcn_s_barrier()
#define PG8_SCHED __builtin_amdgcn_sched_barrier(0)
    Unit cur, nxt; int ui = 0;
    if (!S.next(0, cur)) return;
    f32x4 acc[2][2][4][2];
#pragma unroll
    for (int a = 0; a < 2; ++a)
#pragma unroll
        for (int b = 0; b < 2; ++b)
#pragma unroll
            for (int m = 0; m < 4; ++m)
#pragma unroll
                for (int n = 0; n < 2; ++n) acc[a][b][m][n] = (f32x4){0.f, 0.f, 0.f, 0.f};
    bf16x8 At[4][2], B0[2][2], B1[2][2];
    const char* cA = (const char*)g.A + (size_t)cur.pm * tstep; const char* cB = (const char*)g.Bt + (size_t)cur.pn * tstep;
    S.a_ready(cur);
    if constexpr (SP2) {
        PG8_STAGE(PG8_SB(0, 0), cB, voffB); PG8_STAGE(PG8_SB(0, 1), cB + hstep, voffB); PG8_STAGE(PG8_SA(0, 0), cA, voffA); PG8_STAGE(PG8_SA(0, 1), cA + hstep, voffA);
        if (wr == 1) PG8_BAR;
        PG8_WAIT_V(2); PG8_BAR;
        PG8_STAGE(PG8_SB(1, 0), cB + kstep, voffB); PG8_STAGE(PG8_SA(1, 0), cA + kstep, voffA); PG8_STAGE(PG8_SB(1, 1), cB + hstep + kstep, voffB);
        PG8_WAIT_V(6); PG8_BAR;
    } else {
        PG8_STAGE(PG8_SB(0, 0), cB, voffB); PG8_STAGE(PG8_SA(0, 0), cA, voffA); PG8_STAGE(PG8_SB(0, 1), cB + hstep, voffB); PG8_STAGE(PG8_SA(0, 1), cA + hstep, voffA);
        if (wr == 1) PG8_BAR;
        PG8_WAIT_V(4); PG8_BAR;
        PG8_STAGE(PG8_SB(1, 0), cB + kstep, voffB); PG8_STAGE(PG8_SA(1, 0), cA + kstep, voffA); PG8_STAGE(PG8_SB(1, 1), cB + hstep + kstep, voffB);
        PG8_WAIT_V(6); PG8_BAR;
    }
    for (;;) {
        const bool has_next = S.next(ui + 1, nxt);
        const char* nA = has_next ? (const char*)g.A + (size_t)nxt.pm * tstep : cA; const char* nB = has_next ? (const char*)g.Bt + (size_t)nxt.pn * tstep : cB;
        for (int t = 0; t < nt; t += 2) {
            const bool last = (t == nt - 2);
            const char* a1 = cA + (size_t)(t + 1) * kstep;
            const char* a2 = last ? nA : cA + (size_t)(t + 2) * kstep; const char* b2 = last ? nB : cB + (size_t)(t + 2) * kstep;
            const char* a3 = a2 + kstep; const char* b3 = b2 + kstep;
            if (last && has_next) S.a_ready(nxt);
            if constexpr (SP2) {
            PG8_LDB(B0, 0, 0); PG8_LDB(B1, 0, 1); PG8_SCHED; PG8_LDA(At, 0, 0); PG8_STAGE(PG8_SA(1, 1), a1 + hstep, voffA);
            PG8_WAIT_V(8); PG8_WAIT_L(0); PG8_BAR; PG8_MMA(0, 0, At, B0); PG8_MMA(0, 1, At, B1); PG8_BAR; PG8_SCHED;
            PG8_LDA(At, 0, 1); PG8_STAGE(PG8_SB(0, 0), b2, voffB); PG8_STAGE(PG8_SB(0, 1), b2 + hstep, voffB); PG8_STAGE(PG8_SA(0, 0), a2, voffA);
            PG8_WAIT_V(8); PG8_WAIT_L(0); PG8_BAR; PG8_MMA(1, 0, At, B0); PG8_MMA(1, 1, At, B1); PG8_BAR; PG8_SCHED;
            PG8_LDB(B0, 1, 0); PG8_LDB(B1, 1, 1); PG8_SCHED; PG8_LDA(At, 1, 0); PG8_STAGE(PG8_SA(0, 1), a2 + hstep, voffA);
            PG8_WAIT_V(8); PG8_WAIT_L(0); PG8_BAR; PG8_MMA(0, 0, At, B0); PG8_MMA(0, 1, At, B1); PG8_BAR; PG8_SCHED;
            PG8_LDA(At, 1, 1); PG8_STAGE(PG8_SB(1, 0), b3, voffB); PG8_STAGE(PG8_SB(1, 1), b3 + hstep, voffB); PG8_STAGE(PG8_SA(1, 0), a3, voffA);
            PG8_WAIT_V(8); PG8_WAIT_L(0); PG8_BAR; PG8_MMA(1, 0, At, B0); PG8_MMA(1, 1, At, B1); PG8_BAR; PG8_SCHED;
            } else {
            PG8_LDB(B0, 0, 0); PG8_SCHED; PG8_LDA(At, 0, 0); PG8_STAGE(PG8_SA(1, 1), a1 + hstep, voffA);
            PG8_WAIT_L(8); PG8_BAR; PG8_WAIT_L(0); PG8_MMA(0, 0, At, B0); PG8_BAR; PG8_SCHED;
            PG8_LDB(B1, 0, 1); PG8_STAGE(PG8_SB(0, 0), b2, voffB);
            PG8_BAR; PG8_WAIT_L(0); PG8_MMA(0, 1, At, B1); PG8_BAR;
            PG8_LDA(At, 0, 1); PG8_STAGE(PG8_SA(0, 0), a2, voffA);
            PG8_BAR; PG8_WAIT_L(0); PG8_MMA(1, 0, At, B0); PG8_BAR; PG8_SCHED;
            PG8_STAGE(PG8_SB(0, 1), b2 + hstep, voffB);
            PG8_WAIT_V(6); PG8_BAR; PG8_MMA(1, 1, At, B1); PG8_BAR;
            PG8_LDB(B0, 1, 0); PG8_SCHED; PG8_LDA(At, 1, 0); PG8_STAGE(PG8_SA(0, 1), a2 + hstep, voffA);
            PG8_WAIT_L(8); PG8_BAR; PG8_WAIT_L(0); PG8_MMA(0, 0, At, B0); PG8_BAR; PG8_SCHED;
            PG8_LDB(B1, 1, 1); PG8_STAGE(PG8_SB(1, 0), b3, voffB);
            PG8_BAR; PG8_WAIT_L(0); PG8_MMA(0, 1, At, B1); PG8_BAR;
            PG8_LDA(At, 1, 1); PG8_STAGE(PG8_SA(1, 0), a3, voffA);
            PG8_BAR; PG8_WAIT_L(0); PG8_MMA(1, 0, At, B0); PG8_BAR; PG8_SCHED;
            PG8_STAGE(PG8_SB(1, 1), b3 + hstep, voffB);
            PG8_WAIT_V(6); PG8_BAR; PG8_MMA(1, 1, At, B1); PG8_BAR;
            }
        }
        if constexpr (ALIGN_EPI) { if (wr == 0) PG8_BAR; }
        if constexpr (!Epi::AFTER_DRAIN) { E(acc, cur, wr, wc, fr, fq); S.done(cur); }
        if (!has_next) break;
#pragma unroll
        for (int a = 0; a < 2; ++a)
#pragma unroll
            for (int b = 0; b < 2; ++b)
#pragma unroll
                for (int m = 0; m < 4; ++m)
#pragma unroll
                    for (int n = 0; n < 2; ++n) acc[a][b][m][n] = (f32x4){0.f, 0.f, 0.f, 0.f};
        cur = nxt; cA = nA; cB = nB; ++ui;
        if constexpr (ALIGN_EPI) { if (wr == 1) PG8_BAR; }
    }
    PG8_WAIT_V(0);
    if constexpr (!ALIGN_EPI) { if (wr == 0) PG8_BAR; }
    PG8_BAR;
    if constexpr (Epi::AFTER_DRAIN) { E.fused(acc, cur, wr, wc, fr, fq, lds, wid, lane); S.done(cur); }
#undef PG8_SA
#undef PG8_SB
#undef PG8_STAGE
#undef PG8_LDA
#undef PG8_LDB
#undef PG8_MMA
#undef PG8_WAIT_V
#undef PG8_WAIT_L
#undef PG8_BAR
#undef PG8_SCHED
}
}
#define PG8_SP2 true
#define PG8_ALIGN true

constexpr int NWAVES = 8;
constexpr int BATCH = 4, SEQ = 8192, D = 1024, M = BATCH * SEQ;
constexpr int NH = 8, HD = 64, DATT = 512, DPOOL = 512, NZ = 3 * DATT + DPOOL;
constexpr int PEER_H = 8, NKEYS = 128, NEXP = NKEYS * NKEYS, TOPK = 16, NSC = PEER_H * 2 * NKEYS;
constexpr float EPS = 1e-6f;
constexpr float QSCALE = 0.125f * 1.4426950408889634f;

constexpr size_t MiB = 1u << 20;
constexpr size_t WS_CTL = 0, CTL_ZERO_BYTES = 64 * 1024;
constexpr size_t WS_R1 = 1 * MiB;
constexpr size_t WS_SS = 2 * MiB;
constexpr size_t WS_LSE = 4 * MiB;
constexpr size_t WS_WIN = 8 * MiB;
constexpr size_t WS_WOUT = 12 * MiB;
constexpr size_t WS_WSC = 14 * MiB;
constexpr size_t WS_EU = 32 * MiB, WS_EV = 64 * MiB;
constexpr size_t WS_XB = 96 * MiB;
constexpr size_t WS_Z = 160 * MiB;
constexpr size_t WS_ZP = 256 * MiB;
constexpr size_t WS_OB = 288 * MiB;
constexpr size_t WS_MIX = 384 * MiB;
constexpr size_t WS_SC = 160 * MiB;
constexpr size_t WS_SCH = 224 * MiB;
constexpr size_t WS_IDX = 448 * MiB, WS_GATE = 464 * MiB;
constexpr size_t WS_END = 480 * MiB;
static_assert(WS_SC + (size_t)M * NSC * 4 <= WS_IDX, "ws map");

constexpr int LDS_BYTES = 147456;
constexpr int LDSCTL_OFF = 146432, MISC_OFF = LDSCTL_OFF + 320;
constexpr int RING_OFF = 0;

#define GAS __attribute__((address_space(1)))
#define LAS __attribute__((address_space(3)))
typedef unsigned short bf16;
typedef unsigned v4u __attribute__((ext_vector_type(4)));
typedef unsigned v2u __attribute__((ext_vector_type(2)));
typedef float f32x4 __attribute__((ext_vector_type(4)));
typedef float f32x16 __attribute__((ext_vector_type(16)));
typedef short bf16x8 __attribute__((ext_vector_type(8)));
typedef short s16x4 __attribute__((ext_vector_type(4)));
typedef GAS unsigned gu32;
#define RLX_AGENT __ATOMIC_RELAXED, __HIP_MEMORY_SCOPE_AGENT
#define LDS_WAIT() asm volatile("s_waitcnt lgkmcnt(0)" ::: "memory")
#define VM_WAIT() asm volatile("s_waitcnt vmcnt(0)" ::: "memory")
__device__ __forceinline__ unsigned f2bf(float f) { unsigned u = __builtin_bit_cast(unsigned, f); return (u + 0x7fffu + ((u >> 16) & 1u)) >> 16; }
typedef float f32x2_cv __attribute__((ext_vector_type(2))); typedef __bf16 bf16x2_cv __attribute__((ext_vector_type(2)));
__device__ __forceinline__ unsigned pk2(float lo, float hi) { const f32x2_cv v = {lo, hi}; const bf16x2_cv b = __builtin_convertvector(v, bf16x2_cv); return __builtin_bit_cast(unsigned, b); }
__device__ __forceinline__ float bflo(unsigned w) { return __builtin_bit_cast(float, w << 16); }
__device__ __forceinline__ float bfhi(unsigned w) { return __builtin_bit_cast(float, w & 0xffff0000u); }
#define XB_TMO      128
#define XB_XCNT(j)  (256  + 64 * (j))
#define XB_XSUB(j)  (1280 + 64 * (j))
#define XB_XGEN(j)  (2304 + 64 * (j))
#define XB_TOP      3328
#define XB_TOPGEN   3392
#define XCD_BAR_WORDS 3456
#define XB_SPIN_CAP (1u << 18)

__device__ __forceinline__ unsigned xb_ld(unsigned* p)              { return __hip_atomic_load(p, __ATOMIC_RELAXED, __HIP_MEMORY_SCOPE_AGENT); }
__device__ __forceinline__ unsigned xb_add(unsigned* p, unsigned v) { return __hip_atomic_fetch_add(p, v, __ATOMIC_RELAXED, __HIP_MEMORY_SCOPE_AGENT); }
__device__ __forceinline__ unsigned xb_xcc_id() { return (unsigned)__builtin_amdgcn_s_getreg((3 << 11) | 20) & 0xFu; }
#define XB_SPIN(cond, bar) do { unsigned _sp = 0; while (cond) { __builtin_amdgcn_s_sleep(1); \
    if ((++_sp & 255u) == 0u) { if (xb_ld(&(bar)[XB_TMO])) break; if (_sp > XB_SPIN_CAP) { atomicAdd(&(bar)[XB_TMO], 1u); break; } } } } while (0)

struct XcdBarrier {
    unsigned* bar; unsigned x;
    volatile LAS unsigned* st;
};

__device__ __forceinline__ XcdBarrier xcd_barrier_post(unsigned* bar, volatile LAS unsigned* st) {
    XcdBarrier b; b.bar = bar; b.x = xb_xcc_id(); b.st = st;
    if (threadIdx.x == 0) (void)xb_add(&bar[XB_XCNT(b.x)], 1u);
    return b;
}
__device__ __forceinline__ void xcd_barrier_complete(unsigned* bar, unsigned x, unsigned& nloc, unsigned& nx) {
    const unsigned G = gridDim.x * gridDim.y * gridDim.z;
    unsigned sum, cnt, mine, sp = 0u;
    for (;;) {
        sum = 0u; cnt = 0u; mine = 0u;
#pragma unroll
        for (unsigned j = 0; j < 16; ++j) { const unsigned c = xb_ld(&bar[XB_XCNT(j)]); sum += c; cnt += (c > 0u) ? 1u : 0u; mine = (j == x) ? c : mine; }
        if (sum == G) break;
        __builtin_amdgcn_s_sleep(1);
        if ((++sp & 255u) == 0u) { if (xb_ld(&bar[XB_TMO])) break; if (sp > XB_SPIN_CAP) { atomicAdd(&bar[XB_TMO], 1u); break; } }
    }
    nloc = mine > 0u ? mine : 1u; nx = cnt > 0u ? cnt : 1u;
}

__device__ __forceinline__ void xcd_barrier(const XcdBarrier& b) {
    asm volatile("s_waitcnt vmcnt(0)" ::: "memory");
    __syncthreads();
    if (threadIdx.x == 0) {
        unsigned* bar = b.bar;
        __builtin_amdgcn_s_waitcnt(0);
        unsigned nloc = b.st[0], nx = b.st[1];
        if (nloc == 0u) { xcd_barrier_complete(bar, b.x, nloc, nx); b.st[0] = nloc; b.st[1] = nx; }
        const unsigned old = xb_add(&bar[XB_XSUB(b.x)], 1u);
        const unsigned gen = old / nloc;
        if (old + 1u == (gen + 1u) * nloc) {
            __builtin_amdgcn_fence(__ATOMIC_RELEASE, "agent");
            asm volatile("s_waitcnt vmcnt(0)" ::: "memory");
            const unsigned og = xb_add(&bar[XB_TOP], 1u);
            const unsigned tg = og / nx;
            if (og + 1u == (tg + 1u) * nx) xb_add(&bar[XB_TOPGEN], 1u);
            else XB_SPIN(xb_ld(&bar[XB_TOPGEN]) == tg, bar);
            __builtin_amdgcn_fence(__ATOMIC_ACQUIRE, "agent");
            xb_add(&bar[XB_XGEN(b.x)], 1u);
            asm volatile("s_waitcnt vmcnt(0)" ::: "memory");
        } else {
            XB_SPIN(xb_ld(&bar[XB_XGEN(b.x)]) == gen, bar);
            __builtin_amdgcn_fence(__ATOMIC_ACQUIRE, "agent");
            asm volatile("s_waitcnt vmcnt(0)" ::: "memory");
        }
    }
    __syncthreads();
}

struct Frame {
    LAS unsigned char* lds;
    volatile LAS unsigned* MISC;
    int tid, lane, wave;
    int vcu, G;
    const float *x, *norm_mix, *w_in, *w_pool, *pool_scale, *w_out, *norm_ffn, *w_query, *sub_keys, *expert_u, *expert_v, *norm_final;
    float* out;
    unsigned char* ws;
};

__device__ __forceinline__ float wave_sum(float v) {
#pragma unroll
    for (int o = 1; o < 64; o <<= 1) v += __shfl_xor(v, o);
    return v;
}

__device__ __forceinline__ void p0_transpose_item(const float* W, int N, const float* ks, bf16* WT, int ldo, int col_off, LAS float* scr, int item, int lane) {
    const int nblk = N / 32, kb = item / nblk, nb = item % nblk, k0 = 64 * kb, n0 = 32 * nb;
#pragma unroll 8
    for (int i = 0; i < 32; ++i) { const int kk = 2 * i + (lane >> 5); const float s = ks ? ks[k0 + kk] : 1.f; scr[kk * 33 + (lane & 31)] = W[(size_t)(k0 + kk) * N + n0 + (lane & 31)] * s; }
    LDS_WAIT(); asm volatile("" ::: "memory");
    const int c = lane & 7;
#pragma unroll
    for (int j = 0; j < 4; ++j) { const int n = (lane >> 3) + 8 * j; const LAS float* s = scr + (8 * c) * 33 + n;
        v4u o; o.x = pk2(s[0 * 33], s[1 * 33]); o.y = pk2(s[2 * 33], s[3 * 33]); o.z = pk2(s[4 * 33], s[5 * 33]); o.w = pk2(s[6 * 33], s[7 * 33]);
        *(GAS v4u*)(WT + (size_t)(n0 + n) * ldo + col_off + k0 + 8 * c) = o; }
    LDS_WAIT(); asm volatile("" ::: "memory");
}

__device__ __forceinline__ void p0_prologue(Frame& F) {
    LAS float* scr = (LAS float*)(F.lds + RING_OFF + F.wave * 16384);
    const int gw = F.vcu * NWAVES + F.wave, NGW = F.G * NWAVES;
    bf16* WIN = (bf16*)(F.ws + WS_WIN); bf16* WOUT = (bf16*)(F.ws + WS_WOUT); bf16* WSC = (bf16*)(F.ws + WS_WSC);
    constexpr int I_IN = (D / 64) * (NZ / 32), I_OUT = (DATT / 64) * (D / 32);
    for (int it = gw; it < I_IN + I_OUT; it += NGW) {
        if (it < I_IN) p0_transpose_item(F.w_in, NZ, F.norm_mix, WIN, D, 0, scr, it, F.lane);
        else p0_transpose_item(F.w_out, D, nullptr, WOUT, D, 0, scr, it - I_IN, F.lane);
    }
    const int gt = (F.vcu * NWAVES + F.wave) * 64 + F.lane, NGT = F.G * NWAVES * 64;
    for (int it = gt; it < DPOOL * (D / 4); it += NGT) {
        const int cin = it / (D / 4), n4 = (it % (D / 4)) * 4, g = cin >> 7;
        const float* wp = F.w_pool + (size_t)cin * 128;
        const float* ps = F.pool_scale + g * 128;
        const float* wo = F.w_out + (size_t)(DATT + g * 128) * D + n4;
        f32x4 acc = {0.f, 0.f, 0.f, 0.f};
#pragma unroll 16
        for (int d = 0; d < 128; ++d) { const float a = wp[d] * ps[d]; const f32x4 b = *(const f32x4*)(wo + (size_t)d * D); acc += a * b; }
#pragma unroll
        for (int j = 0; j < 4; ++j) WOUT[(size_t)(n4 + j) * D + DATT + cin] = (bf16)f2bf(acc[j]);
    }
    {
        LAS float* sk = (LAS float*)(F.lds + RING_OFF);
        for (int base = F.vcu * NWAVES; base < 16 * 128; base += F.G * NWAVES) {
            const int blk = base >> 7;
            __syncthreads();
            for (int idx = F.tid; idx < 128 * 32; idx += NWAVES * 64) { const int key = idx >> 5, c4 = (idx & 31) * 4;
                *(LAS f32x4*)(sk + key * 132 + c4) = *(const f32x4*)(F.sub_keys + (size_t)(blk * 128 + key) * 128 + c4); }
            __syncthreads();
            const int d0 = ((base + F.wave) & 127) * 8;
            const float* wq = F.w_query + (size_t)d0 * NSC + blk * 128;
            LAS float* wql = (LAS float*)(F.lds + RING_OFF + 128 * 132 * 4 + F.wave * 4096);
#pragma unroll
            for (int j = 0; j < 4; ++j) { const int r = 2 * j + (F.lane >> 5), cc = (F.lane & 31) * 4; *(LAS f32x4*)(wql + r * 128 + cc) = *(const f32x4*)(wq + (size_t)r * NSC + cc); }
            LDS_WAIT(); asm volatile("" ::: "memory");
            float acc[2][8];
#pragma unroll
            for (int i = 0; i < 2; ++i)
#pragma unroll
                for (int j = 0; j < 8; ++j) acc[i][j] = 0.f;
#pragma unroll 2
            for (int c = 0; c < 128; c += 4) {
                const f32x4 a0 = *(const LAS f32x4*)(sk + (2 * F.lane) * 132 + c), a1 = *(const LAS f32x4*)(sk + (2 * F.lane + 1) * 132 + c);
#pragma unroll
                for (int j = 0; j < 8; ++j) { const f32x4 wv = *(const LAS f32x4*)(wql + j * 128 + c);
                    acc[0][j] += a0[0] * wv[0] + a0[1] * wv[1] + a0[2] * wv[2] + a0[3] * wv[3]; acc[1][j] += a1[0] * wv[0] + a1[1] * wv[1] + a1[2] * wv[2] + a1[3] * wv[3]; }
            }
            const f32x4 g0 = *(const f32x4*)(F.norm_ffn + d0), g1 = *(const f32x4*)(F.norm_ffn + d0 + 4);
#pragma unroll
            for (int i = 0; i < 2; ++i) { v4u o; o.x = pk2(acc[i][0] * g0[0], acc[i][1] * g0[1]); o.y = pk2(acc[i][2] * g0[2], acc[i][3] * g0[3]); o.z = pk2(acc[i][4] * g1[0], acc[i][5] * g1[1]); o.w = pk2(acc[i][6] * g1[2], acc[i][7] * g1[3]);
                *(GAS v4u*)(WSC + (size_t)(blk * 128 + 2 * F.lane + i) * D + d0) = o; }
        }
        __syncthreads();
    }
    {
        bf16* XB = (bf16*)(F.ws + WS_XB); float* R1 = (float*)(F.ws + WS_R1);
        for (int m0 = gw * 4; m0 < M; m0 += NGW * 4) {
            f32x4 a[4][4];
#pragma unroll
            for (int r = 0; r < 4; ++r) { const float* xr = F.x + (size_t)(m0 + r) * D + 8 * F.lane;
                a[r][0] = *(const f32x4*)(xr); a[r][1] = *(const f32x4*)(xr + 4); a[r][2] = *(const f32x4*)(xr + 512); a[r][3] = *(const f32x4*)(xr + 516); }
#pragma unroll
            for (int r = 0; r < 4; ++r) { float s = 0.f;
#pragma unroll
                for (int q = 0; q < 4; ++q) s += (a[r][q][0] * a[r][q][0] + a[r][q][1] * a[r][q][1]) + (a[r][q][2] * a[r][q][2] + a[r][q][3] * a[r][q][3]);
#pragma unroll
                for (int j = 0; j < 2; ++j) { v4u o; o.x = pk2(a[r][2 * j][0], a[r][2 * j][1]); o.y = pk2(a[r][2 * j][2], a[r][2 * j][3]); o.z = pk2(a[r][2 * j + 1][0], a[r][2 * j + 1][1]); o.w = pk2(a[r][2 * j + 1][2], a[r][2 * j + 1][3]);
                    *(GAS v4u*)(XB + (size_t)(m0 + r) * D + 8 * F.lane + 512 * j) = o; }
                s = wave_sum(s);
                if (F.lane == 0) R1[m0 + r] = 1.0f / sqrtf(s * (1.0f / D) + EPS); }
        }
    }
}

constexpr int ATT_KEYS = 384, ATT_KCH = ATT_KEYS * 16 + 16;
constexpr int ATT_K_OFF = 0, ATT_V_OFF = 8 * ATT_KCH;
constexpr int ATT_VDH = 24 * 1024 + 64;
constexpr int ATT_OST_OFF = ATT_V_OFF + 2 * ATT_VDH;
constexpr int ATT_LDS_END = ATT_OST_OFF + NWAVES * 4096;
static_assert(ATT_V_OFF % 16 == 0 && ATT_OST_OFF % 16 == 0 && ATT_LDS_END <= LDSCTL_OFF, "attention LDS map");
constexpr int ATT_UNITS = BATCH * NH * 96;

__device__ __forceinline__ int crow(int r, int hi) { return (r & 3) + 8 * (r >> 2) + 4 * hi; }
__device__ __forceinline__ s16x4 vtr(const LAS unsigned char* p) { return __builtin_bit_cast(s16x4, __builtin_amdgcn_ds_read_tr16_b64_v4i16((LAS s16x4*)p)); }

struct AttnDec { int b, h, br, dsh, pair, s0, res; size_t tokbase; };
__device__ __forceinline__ AttnDec attn_decode(int unit) {
    AttnDec d; const int bh = unit / 96, rem = unit % 96, idx = rem & 31;
    d.br = rem >> 5; d.b = bh >> 3; d.h = bh & 7; d.dsh = 2 * d.br;
    const int ppr = 32 >> d.dsh;
    const int res = idx / ppr; d.res = res; d.pair = idx % ppr; d.s0 = d.pair * 256 - 128;
    d.tokbase = (size_t)d.b * SEQ + res; return d;
}
__device__ __forceinline__ void attn_fetch(Frame& F, int unit, v4u (&kv)[6], v4u (&vv)[6]) {
    const AttnDec d = attn_decode(unit); const bf16* ZHh = (const bf16*)(F.ws + WS_Z) + ((size_t)(d.b * NH + d.h) * SEQ + d.res) * HD;
    int tid = F.tid; asm volatile("" : "+v"(tid));
#pragma unroll
    for (int it = 0; it < 6; ++it) { const int p = tid + 512 * it, key = p >> 3, c = p & 7; int s = d.s0 + key; s = s < 0 ? 0 : s;
        const bf16* row = ZHh + ((size_t)s << d.dsh) * HD + c * 8;
        kv[it] = *(const GAS v4u*)(row + (size_t)M * DATT); vv[it] = *(const GAS v4u*)(row + (size_t)2 * M * DATT); }
}
__device__ __forceinline__ void attn_fetch_q(Frame& F, int unit, bf16x8 (&qr)[4]) {
    const AttnDec d = attn_decode(unit); const bf16* ZHh = (const bf16*)(F.ws + WS_Z) + ((size_t)(d.b * NH + d.h) * SEQ + d.res) * HD;
    int ln = F.lane; asm volatile("" : "+v"(ln));
    const int r32 = ln & 31, hi = ln >> 5, sq0 = d.pair * 256 + 32 * F.wave;
    const bf16* qrow = ZHh + ((size_t)(sq0 + r32) << d.dsh) * HD + hi * 8;
#pragma unroll
    for (int d0 = 0; d0 < 4; ++d0) qr[d0] = *(const GAS bf16x8*)(qrow + d0 * 16);
}
__device__ __forceinline__ void attn_stage(Frame& F, const v4u (&kv)[6], const v4u (&vv)[6]) {
    int tid = F.tid; asm volatile("" : "+v"(tid));
#pragma unroll
    for (int it = 0; it < 6; ++it) { const int p = tid + 512 * it, key = p >> 3, c = p & 7;
        *(LAS v4u*)(F.lds + ATT_K_OFF + c * ATT_KCH + key * 16) = kv[it];
        *(LAS v4u*)(F.lds + ATT_V_OFF + (c >> 2) * ATT_VDH + (key >> 4) * 1024 + (key & 15) * 64 + (c & 3) * 16) = vv[it]; }
}

__device__ __forceinline__ void attn_compute(Frame& F, int unit, const bf16x8 (&qr)[4]) {
    int lane = F.lane; asm volatile("" : "+v"(lane));
    const int w = F.wave, r32 = lane & 31, hi = lane >> 5;
    const AttnDec dd = attn_decode(unit);
    const int h = dd.h, br = dd.br, dsh = dd.dsh, pair = dd.pair; const size_t tokbase = dd.tokbase;
    const int sq0 = pair * 256 + 32 * w;
    f32x16 p[5];
#pragma unroll
    for (int j = 0; j < 5; ++j) {
        p[j] = f32x16{};
        const LAS unsigned char* kb = F.lds + ATT_K_OFF + hi * ATT_KCH + (32 * (w + j) + r32) * 16;
#pragma unroll
        for (int d0 = 0; d0 < 4; ++d0) { const bf16x8 kf = *(const LAS bf16x8*)(kb + 2 * d0 * ATT_KCH); p[j] = __builtin_amdgcn_mfma_f32_32x32x16_bf16(kf, qr[d0], p[j], 0, 0, 0); }
    }
    const float NEGB = -1e30f;
#pragma unroll
    for (int r = 0; r < 16; ++r) { const int kj = crow(r, hi); if (kj < r32) p[0][r] = NEGB; if (kj > r32) p[4][r] = NEGB; }
    if (pair == 0) {
#pragma unroll
        for (int j = 0; j < 4; ++j) if (w + j < 4) {
#pragma unroll
            for (int r = 0; r < 16; ++r) p[j][r] = NEGB; }
    }
    float mx = NEGB;
#pragma unroll
    for (int j = 0; j < 5; ++j)
#pragma unroll
        for (int r = 0; r < 16; ++r) mx = fmaxf(mx, p[j][r]);
    mx = fmaxf(mx, __shfl_xor(mx, 32));
    float l = 0.f;
#pragma unroll
    for (int j = 0; j < 5; ++j)
#pragma unroll
        for (int r = 0; r < 16; ++r) { const float e = __builtin_amdgcn_exp2f(p[j][r] - mx); p[j][r] = e; l += e; }
    l += __shfl_xor(l, 32);
    f32x16 o[2]; o[0] = f32x16{}; o[1] = f32x16{};
    const LAS unsigned char* vb = F.lds + ATT_V_OFF + (4 * hi + ((lane & 15) >> 2)) * 64 + ((lane >> 4) & 1) * 32 + (lane & 3) * 8;
#pragma unroll
    for (int j = 0; j < 5; ++j)
#pragma unroll
        for (int s = 0; s < 2; ++s) {
            v4u pw; pw.x = pk2(p[j][8 * s + 0], p[j][8 * s + 1]); pw.y = pk2(p[j][8 * s + 2], p[j][8 * s + 3]); pw.z = pk2(p[j][8 * s + 4], p[j][8 * s + 5]); pw.w = pk2(p[j][8 * s + 6], p[j][8 * s + 7]);
            const bf16x8 pa = __builtin_bit_cast(bf16x8, pw);
#pragma unroll
            for (int dh = 0; dh < 2; ++dh) {
                const LAS unsigned char* vp = vb + dh * ATT_VDH + (2 * (w + j) + s) * 1024;
                const s16x4 lo = vtr(vp), hh = vtr(vp + 512);
                const bf16x8 vf = (bf16x8){lo[0], lo[1], lo[2], lo[3], hh[0], hh[1], hh[2], hh[3]};
                o[dh] = __builtin_amdgcn_mfma_f32_32x32x16_bf16(pa, vf, o[dh], 0, 0, 0);
            }
        }
    const float rl = 1.0f / l;
    bf16* OB = (bf16*)(F.ws + WS_OB) + (size_t)br * M * DATT;
    float* LSE = (float*)(F.ws + WS_LSE) + (size_t)br * M * NH;
    LAS bf16* stg = (LAS bf16*)(F.lds + ATT_OST_OFF + w * 4096);
#pragma unroll
    for (int r = 0; r < 16; ++r) { const int orow = crow(r, hi); const float rr = __shfl(rl, orow);
        { const unsigned w2 = pk2(o[0][r] * rr, o[1][r] * rr); stg[orow * 64 + r32] = (bf16)(w2 & 0xffffu); stg[orow * 64 + 32 + r32] = (bf16)(w2 >> 16); } }
    if (hi == 0) LSE[(tokbase + ((size_t)(sq0 + r32) << dsh)) * NH + h] = mx + __builtin_amdgcn_logf(l);
    LDS_WAIT();
#pragma unroll
    for (int i = 0; i < 4; ++i) { const int row = i * 8 + (lane >> 3), ch = lane & 7; const v4u v = *(const LAS v4u*)(stg + row * 64 + ch * 8);
        *(GAS v4u*)(OB + (tokbase + ((size_t)(sq0 + row) << dsh)) * DATT + h * HD + ch * 8) = v; }
}


__device__ __forceinline__ void pool_rows(Frame& F) {
    const bf16* ZP = (const bf16*)(F.ws + WS_ZP); bf16* MIX = (bf16*)(F.ws + WS_MIX);
    const int gw = F.vcu * NWAVES + F.wave, NGW = F.G * NWAVES;
    const int win = 2 << (F.lane >> 4);
    constexpr int TPW = 16;
    for (int it = gw; it < M / TPW; it += NGW) {
        const int tb = it * TPW, sb = tb & (SEQ - 1);
        const bf16* zc = ZP + (size_t)tb * DPOOL + 8 * F.lane;
        v4u rows[31];
#pragma unroll
        for (int k = 0; k < 31; ++k) { const int s = sb - 15 + k; rows[k] = (s >= 0) ? *(const GAS v4u*)(zc + (long)(k - 15) * DPOOL) : (v4u){0u, 0u, 0u, 0u}; }
        float ps[8];
#pragma unroll
        for (int e = 0; e < 8; ++e) ps[e] = 0.f;
#pragma unroll
        for (int k = 0; k < 15; ++k) if (k >= 16 - win) { const v4u v = rows[k];
            ps[0] += bflo(v.x); ps[1] += bfhi(v.x); ps[2] += bflo(v.y); ps[3] += bfhi(v.y); ps[4] += bflo(v.z); ps[5] += bfhi(v.z); ps[6] += bflo(v.w); ps[7] += bfhi(v.w); }
#pragma unroll
        for (int i = 0; i < TPW; ++i) {
            const int s = sb + i; const v4u z0 = rows[15 + i];
            ps[0] += bflo(z0.x); ps[1] += bfhi(z0.x); ps[2] += bflo(z0.y); ps[3] += bfhi(z0.y); ps[4] += bflo(z0.z); ps[5] += bfhi(z0.z); ps[6] += bflo(z0.w); ps[7] += bfhi(z0.w);
            const int cnt = (s + 1) < win ? (s + 1) : win; const float inv = 1.0f / (float)cnt;
            v4u o; o.x = pk2(ps[0] * inv - bflo(z0.x), ps[1] * inv - bfhi(z0.x)); o.y = pk2(ps[2] * inv - bflo(z0.y), ps[3] * inv - bfhi(z0.y));
            o.z = pk2(ps[4] * inv - bflo(z0.z), ps[5] * inv - bfhi(z0.z)); o.w = pk2(ps[6] * inv - bflo(z0.w), ps[7] * inv - bfhi(z0.w));
            *(GAS v4u*)(MIX + (size_t)(tb + i) * D + DATT + 8 * F.lane) = o;
            const v4u l2 = rows[15 + i - 1], l4 = rows[15 + i - 3], l8 = rows[15 + i - 7], l16 = rows[15 + i - 15];
            const v4u v = (win == 2) ? l2 : (win == 4) ? l4 : (win == 8) ? l8 : l16;
            ps[0] -= bflo(v.x); ps[1] -= bfhi(v.x); ps[2] -= bflo(v.y); ps[3] -= bfhi(v.y); ps[4] -= bflo(v.z); ps[5] -= bfhi(v.z); ps[6] -= bflo(v.w); ps[7] -= bfhi(v.w);
        }
    }
}

__device__ __forceinline__ void merge_rows(Frame& F) {
    const bf16* OB = (const bf16*)(F.ws + WS_OB); const float* LSE = (const float*)(F.ws + WS_LSE); bf16* MIX = (bf16*)(F.ws + WS_MIX);
    const int gw = F.vcu * NWAVES + F.wave, NGW = F.G * NWAVES;
#pragma unroll 2
    for (int t = gw; t < M; t += NGW) {
        const int h = F.lane >> 3;
        const float l0 = LSE[(size_t)t * NH + h], l1 = LSE[(size_t)(M + t) * NH + h], l2 = LSE[(size_t)(2 * M + t) * NH + h];
        const size_t off = (size_t)t * DATT + 8 * F.lane;
        const v4u a = *(const GAS v4u*)(OB + off), b = *(const GAS v4u*)(OB + (size_t)M * DATT + off), c = *(const GAS v4u*)(OB + (size_t)2 * M * DATT + off);
        const float mx = fmaxf(l0, fmaxf(l1, l2));
        float w0 = __builtin_amdgcn_exp2f(l0 - mx), w1 = __builtin_amdgcn_exp2f(l1 - mx), w2 = __builtin_amdgcn_exp2f(l2 - mx);
        const float inv = 1.0f / (w0 + w1 + w2); w0 *= inv; w1 *= inv; w2 *= inv;
        v4u o;
        o.x = pk2(w0 * bflo(a.x) + w1 * bflo(b.x) + w2 * bflo(c.x), w0 * bfhi(a.x) + w1 * bfhi(b.x) + w2 * bfhi(c.x));
        o.y = pk2(w0 * bflo(a.y) + w1 * bflo(b.y) + w2 * bflo(c.y), w0 * bfhi(a.y) + w1 * bfhi(b.y) + w2 * bfhi(c.y));
        o.z = pk2(w0 * bflo(a.z) + w1 * bflo(b.z) + w2 * bflo(c.z), w0 * bfhi(a.z) + w1 * bfhi(b.z) + w2 * bfhi(c.z));
        o.w = pk2(w0 * bflo(a.w) + w1 * bflo(b.w) + w2 * bflo(c.w), w0 * bfhi(a.w) + w1 * bfhi(b.w) + w2 * bfhi(c.w));
        *(GAS v4u*)(MIX + (size_t)t * D + 8 * F.lane) = o;
    }
}

constexpr int TK_ROW = 68;
constexpr int TK_WAVE_BYTES = 64 * TK_ROW * 4;
static_assert(NWAVES * TK_WAVE_BYTES <= LDSCTL_OFF, "top-k LDS map");

__device__ __forceinline__ unsigned f2ord(float f) { const unsigned u = __builtin_bit_cast(unsigned, f); return (u & 0x80000000u) ? ~u : (u | 0x80000000u); }
__device__ __forceinline__ float ord2f(unsigned k) { const unsigned u = (k & 0x80000000u) ? (k & 0x7fffffffu) : ~k; return __builtin_bit_cast(float, u); }
#define TK_CE(a, b) do { const unsigned hi_ = max(a, b), lo_ = min(a, b); a = hi_; b = lo_; } while (0)
#define TK_SORT16(N) do { TK_CE(N[0], N[1]); TK_CE(N[2], N[3]); TK_CE(N[0], N[2]); TK_CE(N[1], N[3]); TK_CE(N[1], N[2]); TK_CE(N[4], N[5]); TK_CE(N[6], N[7]); TK_CE(N[4], N[6]); TK_CE(N[5], N[7]); TK_CE(N[5], N[6]); TK_CE(N[0], N[4]); TK_CE(N[2], N[6]); TK_CE(N[2], N[4]); TK_CE(N[1], N[5]); TK_CE(N[3], N[7]); TK_CE(N[3], N[5]); TK_CE(N[1], N[2]); TK_CE(N[3], N[4]); TK_CE(N[5], N[6]); TK_CE(N[8], N[9]); TK_CE(N[10], N[11]); TK_CE(N[8], N[10]); TK_CE(N[9], N[11]); TK_CE(N[9], N[10]); TK_CE(N[12], N[13]); TK_CE(N[14], N[15]); TK_CE(N[12], N[14]); TK_CE(N[13], N[15]); TK_CE(N[13], N[14]); TK_CE(N[8], N[12]); TK_CE(N[10], N[14]); TK_CE(N[10], N[12]); TK_CE(N[9], N[13]); TK_CE(N[11], N[15]); TK_CE(N[11], N[13]); TK_CE(N[9], N[10]); TK_CE(N[11], N[12]); TK_CE(N[13], N[14]); TK_CE(N[0], N[8]); TK_CE(N[4], N[12]); TK_CE(N[4], N[8]); TK_CE(N[2], N[10]); TK_CE(N[6], N[14]); TK_CE(N[6], N[10]); TK_CE(N[2], N[4]); TK_CE(N[6], N[8]); TK_CE(N[10], N[12]); TK_CE(N[1], N[9]); TK_CE(N[5], N[13]); TK_CE(N[5], N[9]); TK_CE(N[3], N[11]); TK_CE(N[7], N[15]); TK_CE(N[7], N[11]); TK_CE(N[3], N[5]); TK_CE(N[7], N[9]); TK_CE(N[11], N[13]); TK_CE(N[1], N[2]); TK_CE(N[3], N[4]); TK_CE(N[5], N[6]); TK_CE(N[7], N[8]); TK_CE(N[9], N[10]); TK_CE(N[11], N[12]); TK_CE(N[13], N[14]); } while (0)
#define TK_BMERGE16(L) do { TK_CE(L[0], L[8]); TK_CE(L[1], L[9]); TK_CE(L[2], L[10]); TK_CE(L[3], L[11]); TK_CE(L[4], L[12]); TK_CE(L[5], L[13]); TK_CE(L[6], L[14]); TK_CE(L[7], L[15]); TK_CE(L[0], L[4]); TK_CE(L[1], L[5]); TK_CE(L[2], L[6]); TK_CE(L[3], L[7]); TK_CE(L[8], L[12]); TK_CE(L[9], L[13]); TK_CE(L[10], L[14]); TK_CE(L[11], L[15]); TK_CE(L[0], L[2]); TK_CE(L[1], L[3]); TK_CE(L[4], L[6]); TK_CE(L[5], L[7]); TK_CE(L[8], L[10]); TK_CE(L[9], L[11]); TK_CE(L[12], L[14]); TK_CE(L[13], L[15]); TK_CE(L[0], L[1]); TK_CE(L[2], L[3]); TK_CE(L[4], L[5]); TK_CE(L[6], L[7]); TK_CE(L[8], L[9]); TK_CE(L[10], L[11]); TK_CE(L[12], L[13]); TK_CE(L[14], L[15]); } while (0)
#define TK_INSERT(L, xin) do { unsigned x_ = (xin); _Pragma("unroll") for (int i_ = 0; i_ < 16; ++i_) { const unsigned hi_ = max(L[i_], x_); x_ = min(L[i_], x_); L[i_] = hi_; } } while (0)

constexpr int EXP_NCH = 2 * NEXP;
__device__ __forceinline__ void expcvt_load(Frame& F, int ci, f32x4 (&a)[4], int lane) {
    const float* src = (ci < NEXP ? F.expert_u + (size_t)ci * D : F.expert_v + (size_t)(ci - NEXP) * D) + 16 * lane;
#pragma unroll
    for (int q = 0; q < 4; ++q) a[q] = *(const GAS f32x4*)(src + 4 * q);
}
constexpr float EV8_SCALE = 112.0f;
__device__ __forceinline__ void expcvt_store(Frame& F, int ci, const f32x4 (&a)[4], int lane) {
    const bool isu = ci < NEXP; v4u o;
    if (isu) {
#pragma unroll
        for (int q = 0; q < 4; ++q) { f32x4 v = a[q] * 32.0f; v = v * *(const GAS f32x4*)(F.norm_ffn + 16 * lane + 4 * q);
            int w = __builtin_amdgcn_cvt_pk_fp8_f32(v[0], v[1], 0, false); w = __builtin_amdgcn_cvt_pk_fp8_f32(v[2], v[3], w, true); o[q] = (unsigned)w; }
    } else {
#pragma unroll
        for (int q = 0; q < 4; ++q) { unsigned w = 0;
#pragma unroll
            for (int e = 0; e < 4; ++e) { float r = __builtin_rintf(a[q][e] * EV8_SCALE); r = __builtin_fminf(__builtin_fmaxf(r, -127.0f), 127.0f); w |= ((unsigned)(int)r & 0xffu) << (8 * e); }
            o[q] = w; }
    }
    unsigned char* dst = (isu ? F.ws + WS_EU + (size_t)ci * D : F.ws + WS_EV + (size_t)(ci - NEXP) * D) + 16 * lane;
    *(GAS v4u*)dst = o;
}

__device__ __forceinline__ void tk_fetch(const unsigned short* SCH, int t0, int rnd, v4u (&sn)[8], int lane) {
    const int p = rnd >> 1, kc = rnd & 1;
#pragma unroll
    for (int i = 0; i < 8; ++i) { const int pr = 8 * i + (lane >> 3), tl = pr >> 3, h = pr & 7;
        sn[i] = *(const GAS v4u*)(SCH + (size_t)(t0 + tl) * NSC + h * 256 + p * 128 + kc * 64 + (lane & 7) * 8); }
}

__device__ __forceinline__ void topk_phase(Frame& F) {
    const unsigned short* SCH = (const unsigned short*)(F.ws + WS_SCH); const float* SS = (const float*)(F.ws + WS_SS);
    int* IDX = (int*)(F.ws + WS_IDX); float* GATE = (float*)(F.ws + WS_GATE);
    const int gw = F.vcu * NWAVES + F.wave, NGW = F.G * NWAVES, lane = F.lane;
    LAS float* st = (LAS float*)(F.lds + F.wave * TK_WAVE_BYTES);
    int cnext = gw;
    v4u sn[8];
    for (int it = gw; it < M / 8; it += NGW) {
        const int t0 = it * 8;
        unsigned L0[16], L1[16];
#pragma unroll
        for (int i = 0; i < 16; ++i) { L0[i] = 0u; L1[i] = 0u; }
        if (it == gw) tk_fetch(SCH, t0, 0, sn, lane);
#pragma unroll
        for (int rnd = 0; rnd < 4; ++rnd) {
            const int p = rnd >> 1, kc = rnd & 1;
            v4u sc[8];
#pragma unroll
            for (int i = 0; i < 8; ++i) sc[i] = sn[i];
            if (rnd < 3) tk_fetch(SCH, t0, rnd + 1, sn, lane); else if (it + NGW < M / 8) tk_fetch(SCH, (it + NGW) * 8, 0, sn, lane);
            f32x4 xa[4], xb[4]; const int c0 = cnext, c1 = cnext + NGW;
            if (c0 < EXP_NCH) expcvt_load(F, c0, xa, lane); if (c1 < EXP_NCH) expcvt_load(F, c1, xb, lane);
#pragma unroll
            for (int i = 0; i < 8; ++i) { const int pr = 8 * i + (lane >> 3);
                const v4u v = sc[i];
                f32x4 lo, hi;
#pragma unroll
                for (int e = 0; e < 2; ++e) { const unsigned wa = v[e], wb = v[2 + e];
                    const pg8::f16x2_t a = __builtin_bit_cast(pg8::f16x2_t, wa), b = __builtin_bit_cast(pg8::f16x2_t, wb);
                    lo[2 * e] = (float)a.x; lo[2 * e + 1] = (float)a.y; hi[2 * e] = (float)b.x; hi[2 * e + 1] = (float)b.y; }
                *(LAS f32x4*)(st + pr * TK_ROW + (lane & 7) * 8) = lo; *(LAS f32x4*)(st + pr * TK_ROW + (lane & 7) * 8 + 4) = hi; }
            LDS_WAIT(); asm volatile("" ::: "memory");
#pragma unroll 1
            for (int q = 0; q < 4; ++q) {
                unsigned N[16];
#pragma unroll
                for (int u = 0; u < 4; ++u) { const f32x4 v = *(const LAS f32x4*)(st + lane * TK_ROW + q * 16 + u * 4);
#pragma unroll
                    for (int e = 0; e < 4; ++e) N[4 * u + e] = (f2ord(v[e]) & ~127u) | (unsigned)(127 - (kc * 64 + q * 16 + u * 4 + e)); }
                TK_SORT16(N);
                if (p == 0) {
#pragma unroll
                    for (int i = 0; i < 16; ++i) L0[i] = max(L0[i], N[15 - i]);
                    TK_BMERGE16(L0);
                } else {
#pragma unroll
                    for (int i = 0; i < 16; ++i) L1[i] = max(L1[i], N[15 - i]);
                    TK_BMERGE16(L1);
                }
            }
            if (c0 < EXP_NCH) expcvt_store(F, c0, xa, lane); if (c1 < EXP_NCH) expcvt_store(F, c1, xb, lane);
            cnext += 2 * NGW;
            LDS_WAIT(); asm volatile("" ::: "memory");
        }
        LAS float* pv0 = st; LAS float* pv1 = st + 16 * 64; LAS int* pi0 = (LAS int*)(st + 32 * 64); LAS int* pi1 = (LAS int*)(st + 48 * 64);
        float v0[16], v1[16];
#pragma unroll
        for (int i = 0; i < 16; ++i) { v0[i] = ord2f(L0[i] & ~127u); v1[i] = ord2f(L1[i] & ~127u);
            pv0[i * 64 + lane] = v0[i]; pv1[i * 64 + lane] = v1[i]; pi0[i * 64 + lane] = 127 - (int)(L0[i] & 127u); pi1[i * 64 + lane] = 127 - (int)(L1[i] & 127u); }
        unsigned T[16];
#pragma unroll
        for (int i = 0; i < 16; ++i) T[i] = 0u;
        {
            unsigned N[16]; int nn = 0;
#pragma unroll
            for (int i = 0; i < 16; ++i)
#pragma unroll
                for (int j = 0; j < 16; ++j) if ((i + 1) * (j + 1) <= 16) {
                    N[nn & 15] = (f2ord(v0[i] + v1[j]) & ~255u) | (unsigned)(255 - (i * 16 + j)); ++nn;
                    if ((nn & 15) == 0 || nn == 50) {
                        if (nn == 50) { N[2] = 0u; N[3] = 0u; N[4] = 0u; N[5] = 0u; N[6] = 0u; N[7] = 0u; N[8] = 0u; N[9] = 0u; N[10] = 0u; N[11] = 0u; N[12] = 0u; N[13] = 0u; N[14] = 0u; N[15] = 0u; }
                        TK_SORT16(N);
#pragma unroll
                        for (int q = 0; q < 16; ++q) T[q] = max(T[q], N[15 - q]);
                        TK_BMERGE16(T);
                    }
                }
        }
        LDS_WAIT(); asm volatile("" ::: "memory");
        const int tl = lane >> 3, h = lane & 7, t = t0 + tl;
        float ssum = 0.f;
        { const float* sp = SS + (size_t)t * 16;
#pragma unroll
          for (int i = 0; i < 4; ++i) { const f32x4 v = *(const GAS f32x4*)(sp + 4 * i); ssum += (v[0] + v[1]) + (v[2] + v[3]); } }
        const float r2 = 1.0f / sqrtf(ssum * (1.0f / D) + EPS);
        float bs[16]; int ex[16]; float mxs = -3.0e38f;
#pragma unroll
        for (int k = 0; k < 16; ++k) { const int pos = 255 - (int)(T[k] & 255u), i = pos >> 4, j = pos & 15;
            bs[k] = (pv0[i * 64 + lane] + pv1[j * 64 + lane]) * r2; ex[k] = pi0[i * 64 + lane] * NKEYS + pi1[j * 64 + lane]; mxs = fmaxf(mxs, bs[k]); }
        float den = 0.f;
#pragma unroll
        for (int k = 0; k < 16; ++k) { bs[k] = __expf(bs[k] - mxs); den += bs[k]; }
        const float inv = 1.0f / den;
        int* ip = IDX + ((size_t)t * PEER_H + h) * TOPK; float* gp = GATE + ((size_t)t * PEER_H + h) * TOPK;
#pragma unroll
        for (int k = 0; k < 16; k += 4) { *(GAS v4u*)(ip + k) = (v4u){(unsigned)ex[k], (unsigned)ex[k + 1], (unsigned)ex[k + 2], (unsigned)ex[k + 3]};
            *(GAS f32x4*)(gp + k) = (f32x4){bs[k] * inv, bs[k + 1] * inv, bs[k + 2] * inv, bs[k + 3] * inv}; }
        LDS_WAIT(); asm volatile("" ::: "memory");
    }
    for (; cnext < EXP_NCH; cnext += NGW) { f32x4 xa[4]; expcvt_load(F, cnext, xa, lane); expcvt_store(F, cnext, xa, lane); }
}

typedef float f32x2 __attribute__((ext_vector_type(2)));
typedef long l64x2 __attribute__((ext_vector_type(2)));
constexpr float EU_SCALE = 32.0f, EV_SCALE = 4.0f;
__device__ __forceinline__ float gelu_erf(float v) {
    const float av = __builtin_fabsf(v), t = __builtin_amdgcn_rcpf(av * 0.2316418882f + 1.0f);
    float q = t * 0.5307027145f + (-0.7265760135f); q = q * t + 0.7107068705f; q = q * t + (-0.142248368f); q = q * t + 0.127414796f; q = q * t;
    const float e = __builtin_amdgcn_exp2f((v * v) * (-0.72134752044f));
    const float m = v * (q * e);
    return v < 0.f ? m : v - m;
}
constexpr int PU_WAVE_LDS = 10496;
constexpr int PU_SL = 0, PU_HIST = 8192, PU_DSCR = 9216, PU_CNT = 10240;
static_assert(NWAVES * PU_WAVE_LDS <= LDSCTL_OFF, "PEER U LDS map");
#ifndef PEER_UACT_EXPR
#define PEER_UACT_EXPR gelu_erf(a * (1.0f / EU_SCALE)) * gt
#endif
#ifndef PEER_ACT_EXPR
#define PEER_ACT_EXPR __builtin_bit_cast(float, itv.y)
#endif
#ifndef PEER_V_ITEMS
#define PEER_V_ITEMS 128
#endif
constexpr int PV_LIST = 0, PV_SSP = 32768;

#ifndef PROBE_NOBPERM
#define PROBE_NOBPERM 0
#endif
__device__ __forceinline__ void peer_u_loadA(v4u (&A)[16], const unsigned char* EU, unsigned e, int lane) {
    int l3 = lane & 3; asm volatile("" : "+v"(l3));
    const GAS unsigned char* rowp = (const GAS unsigned char*)EU + (size_t)e * D + 16 * l3;
#pragma unroll
    for (int i = 0; i < 16; ++i) A[i] = *(const GAS v4u*)(rowp + 64 * i);
}
template <unsigned EMASK, bool DUMMY> __device__ __forceinline__ void peer_u_phase(Frame& F, int blk) {
    const int* IDX = (const int*)(F.ws + WS_IDX); const float* GATE = (const float*)(F.ws + WS_GATE); const float* SS = (const float*)(F.ws + WS_SS);
    const unsigned char* EU = F.ws + WS_EU; unsigned* VE = (unsigned*)(F.ws + WS_SC); float* VA = (float*)(F.ws + WS_SC + (size_t)M * 128 * 4);
    int lane = F.lane; asm volatile("" : "+v"(lane));
    const int c = lane & 15, g = lane >> 4;
    const int T0 = blk * 128 + F.wave * 16;
    LAS unsigned char* wl = F.lds + F.wave * PU_WAVE_LDS;
    LAS unsigned* SL = (LAS unsigned*)(wl + PU_SL); LAS unsigned* HIST = (LAS unsigned*)(wl + PU_HIST); LAS float* DSCR = (LAS float*)(wl + PU_DSCR); LAS unsigned* CNT = (LAS unsigned*)(wl + PU_CNT);
    *(LAS v4u*)(HIST + 4 * lane) = (v4u){0u, 0u, 0u, 0u};
    if (lane < 16) CNT[lane] = 0u;
    LDS_WAIT(); asm volatile("" ::: "memory");
    unsigned ev[32];
#pragma unroll
    for (int q = 0; q < 32; ++q) ev[q] = (unsigned)IDX[(size_t)T0 * 128 + q * 64 + lane];
#pragma unroll
    for (int q = 0; q < 32; ++q) __hip_atomic_fetch_add(HIST + (ev[q] >> 6), 1u, __ATOMIC_RELAXED, __HIP_MEMORY_SCOPE_WAVEFRONT);
    LDS_WAIT(); asm volatile("" ::: "memory");
    {
        const v4u hv = *(const LAS v4u*)(HIST + 4 * lane); const unsigned tot = hv.x + hv.y + hv.z + hv.w; unsigned inc = tot;
#pragma unroll
        for (int o = 1; o < 64; o <<= 1) { const unsigned n = (unsigned)__shfl_up((int)inc, o); if (lane >= o) inc += n; }
        const unsigned ex = inc - tot;
        LDS_WAIT(); asm volatile("" ::: "memory");
        *(LAS v4u*)(HIST + 4 * lane) = (v4u){ex, ex + hv.x, ex + hv.x + hv.y, ex + hv.x + hv.y + hv.z};
    }
    LDS_WAIT(); asm volatile("" ::: "memory");
#pragma unroll
    for (int q = 0; q < 32; ++q) { const unsigned p = (unsigned)(q * 64 + lane); const unsigned e = ev[q];
        const unsigned pos = __hip_atomic_fetch_add(HIST + (e >> 6), 1u, __ATOMIC_RELAXED, __HIP_MEMORY_SCOPE_WAVEFRONT); SL[pos] = (e << 11) | p; }
    LDS_WAIT(); asm volatile("" ::: "memory");
    l64x2 Bop[16];
    {
        const int tB = T0 + c; float s = 0.f;
#pragma unroll
        for (int i = 0; i < 4; ++i) { const f32x4 v = *(const GAS f32x4*)(SS + (size_t)tB * 16 + 4 * i); s += (v[0] + v[1]) + (v[2] + v[3]); }
        const float r2 = 1.0f / sqrtf(s * (1.0f / D) + EPS);
        int gq = g; asm volatile("" : "+v"(gq));
        const bf16* xp = (const bf16*)(F.ws + WS_XB) + (size_t)tB * D + 16 * gq;
#pragma unroll
        for (int i = 0; i < 16; ++i) { v4u o; const v4u xa = *(const GAS v4u*)(xp + 64 * i), xb = *(const GAS v4u*)(xp + 64 * i + 8);
#pragma unroll
            for (int q = 0; q < 2; ++q) { const unsigned w0 = xa[2 * q], w1 = xa[2 * q + 1];
                int w = __builtin_amdgcn_cvt_pk_fp8_f32(bflo(w0) * r2, bfhi(w0) * r2, 0, false); w = __builtin_amdgcn_cvt_pk_fp8_f32(bflo(w1) * r2, bfhi(w1) * r2, w, true); o[q] = (unsigned)w; }
#pragma unroll
            for (int q = 0; q < 2; ++q) { const unsigned w0 = xb[2 * q], w1 = xb[2 * q + 1];
                int w = __builtin_amdgcn_cvt_pk_fp8_f32(bflo(w0) * r2, bfhi(w0) * r2, 0, false); w = __builtin_amdgcn_cvt_pk_fp8_f32(bflo(w1) * r2, bfhi(w1) * r2, w, true); o[2 + q] = (unsigned)w; }
            Bop[i] = __builtin_bit_cast(l64x2, o); if ((i & 7) == 7) asm volatile("" : "+v"(Bop[i - 7]), "+v"(Bop[i - 6]), "+v"(Bop[i - 5]), "+v"(Bop[i - 4]), "+v"(Bop[i - 3]), "+v"(Bop[i - 2]), "+v"(Bop[i - 1]), "+v"(Bop[i]) :: "memory"); }
    }
#define PU_TAIL(b) *(LAS f32x4*)(DSCR + 4 * lane) = acc; LDS_WAIT(); asm volatile("" ::: "memory"); if (lane < 16) { const unsigned p = itcur & 2047u, cr = p >> 7, e = itcur >> 11; const float a = DSCR[((lane >> 2) * 16 + cr) * 4 + (lane & 3)]; const float act = PEER_UACT_EXPR; const unsigned pos = __hip_atomic_fetch_add(CNT + cr, 1u, __ATOMIC_RELAXED, __HIP_MEMORY_SCOPE_WAVEFRONT); if (!DUMMY) { VE[(size_t)(T0 + cr) * 128 + pos] = e << 10; VA[(size_t)(T0 + cr) * 128 + pos] = act; }     else if (act == 123.456f) VA[0] = act; } LDS_WAIT(); asm volatile("" ::: "memory");
    v4u A0[16], A1[16];
    const int psrc = (4 * c + g) * 4;
    { const unsigned i0_ = SL[lane >> 2], i1_ = SL[16 + (lane >> 2)];
      peer_u_loadA(A0, EU, (i0_ >> 11) & EMASK, lane); peer_u_loadA(A1, EU, (i1_ >> 11) & EMASK, lane); }
#define PU_STEP(Acur, b) do { \
        const unsigned itcur = SL[16 * (b) + c]; \
        float gt = 0.f; if (lane < 16) gt = GATE[(size_t)T0 * 128 + (itcur & 2047u)]; \
        const int bn = ((b) + 2 < 128) ? (b) + 2 : (b); \
        const unsigned itl = SL[16 * bn + (lane >> 2)]; \
        int l3 = lane & 3; asm volatile("" : "+v"(l3)); \
        const GAS unsigned char* nrow = (const GAS unsigned char*)EU + (size_t)((itl >> 11) & EMASK) * D + 16 * l3; \
        f32x4 acc = {0.f, 0.f, 0.f, 0.f}; \
        _Pragma("unroll") for (int i = 0; i < 16; ++i) { v4u t; \
            _Pragma("unroll") for (int w = 0; w < 4; ++w) t[w] = (DUMMY && PROBE_NOBPERM) ? Acur[i][w] : (unsigned)__builtin_amdgcn_ds_bpermute(psrc, (int)Acur[i][w]); \
            Acur[i] = *(const GAS v4u*)(nrow + 64 * i); \
            const l64x2 a2 = __builtin_bit_cast(l64x2, t); \
            acc = __builtin_amdgcn_mfma_f32_16x16x32_fp8_fp8(a2.x, Bop[i].x, acc, 0, 0, 0); acc = __builtin_amdgcn_mfma_f32_16x16x32_fp8_fp8(a2.y, Bop[i].y, acc, 0, 0, 0); } \
        PU_TAIL(b) \
    } while (0)
#pragma unroll 1
    for (int b = 0; b < 128; b += 2) { PU_STEP(A0, b); PU_STEP(A1, b + 1); }
#undef PU_STEP
#undef PU_TAIL
}

template <unsigned EMASK, bool DUMMY, class Bar> __device__ __forceinline__ void peer_v_phase(Frame& F, int blk, const Bar& bar, bool sync) {
    const unsigned char* EV = F.ws + WS_EV; const unsigned* VE = (const unsigned*)(F.ws + WS_SC); const float* VA = (const float*)(F.ws + WS_SC + (size_t)M * 128 * 4);
    int lane = F.lane; asm volatile("" : "+v"(lane));
    const int q = lane >> 3, c = lane & 7, w = F.wave;
    const int CB = blk * 128;
    const LAS unsigned* LE = (const LAS unsigned*)(F.lds + PV_LIST); const LAS unsigned* LA8 = (const LAS unsigned*)(F.lds + PV_LIST + 16384);
    LAS float* SCL = (LAS float*)(F.lds + PV_LIST + 16384 + 4096); LAS float* SSP = (LAS float*)(F.lds + PV_SSP);
    const unsigned voff = 128u * (unsigned)w + 16u * (unsigned)c;
    const __amdgpu_buffer_rsrc_t evr = __builtin_amdgcn_make_buffer_rsrc((void*)EV, 0, NEXP * D, 0x00020000);
#pragma unroll 1
    for (int rd = 0; rd < 4; ++rd) {
        const int TB = CB + 32 * rd;
        if (sync) xcd_barrier(bar); else
        __syncthreads();
        {
            const int tt = F.tid >> 4, sub = F.tid & 15;
            const GAS v4u* se = (const GAS v4u*)(VE + (size_t)TB * 128) + F.tid * 2; LAS v4u* de = (LAS v4u*)(F.lds + PV_LIST) + F.tid * 2;
            const v4u e0 = se[0], e1 = se[1];
            const GAS f32x4* sa = (const GAS f32x4*)(VA + (size_t)TB * 128) + F.tid * 2; const f32x4 a0 = sa[0], a1 = sa[1];
            float am = fmaxf(fmaxf(fmaxf(__builtin_fabsf(a0[0]), __builtin_fabsf(a0[1])), fmaxf(__builtin_fabsf(a0[2]), __builtin_fabsf(a0[3]))), fmaxf(fmaxf(__builtin_fabsf(a1[0]), __builtin_fabsf(a1[1])), fmaxf(__builtin_fabsf(a1[2]), __builtin_fabsf(a1[3]))));
            am = fmaxf(am, __shfl_xor(am, 1)); am = fmaxf(am, __shfl_xor(am, 2)); am = fmaxf(am, __shfl_xor(am, 4)); am = fmaxf(am, __shfl_xor(am, 8));
            am = fmaxf(am, 1e-30f); const float qs = 127.0f / am;
            unsigned p0 = 0, p1 = 0;
#pragma unroll
            for (int e = 0; e < 4; ++e) { p0 |= ((unsigned)(int)__builtin_rintf(a0[e] * qs) & 0xffu) << (8 * e); p1 |= ((unsigned)(int)__builtin_rintf(a1[e] * qs) & 0xffu) << (8 * e); }
            de[0] = e0; de[1] = e1;
            *(LAS v2u*)(F.lds + PV_LIST + 16384 + (tt * 32 + sub * 2) * 4) = (v2u){p0, p1};
            if (sub == 0) SCL[tt] = am * (1.0f / 127.0f);
        }
        __syncthreads();
        int yi[4][16];
#pragma unroll
        for (int gI = 0; gI < 4; ++gI)
#pragma unroll
            for (int e = 0; e < 16; ++e) yi[gI][e] = 0;
        v4u vv[4][4];
#pragma unroll
        for (int ii = 0; ii < 4; ++ii)
#pragma unroll
            for (int gI = 0; gI < 4; ++gI) { const int li = (8 * gI + q) * 128 + ii;
                vv[ii][gI] = __builtin_amdgcn_raw_buffer_load_b128(evr, (int)((LE[li] & (EMASK << 10)) + voff), 0, 0); }
#pragma unroll 1
        for (int i0 = 0; i0 < 128; i0 += 4) {
            const int inx = (i0 + 4 < 128) ? i0 + 4 : i0;
#pragma unroll
            for (int gI = 0; gI < 4; ++gI) {
                const v4u r0 = vv[0][gI], r1 = vv[1][gI], r2 = vv[2][gI], r3 = vv[3][gI];
                const int a4 = (int)LA8[(8 * gI + q) * 32 + (i0 >> 2)];
#pragma unroll
                for (int ii = 0; ii < 4; ++ii) { const int li = (8 * gI + q) * 128 + inx + ii;
                    vv[ii][gI] = __builtin_amdgcn_raw_buffer_load_b128(evr, (int)((LE[li] & (EMASK << 10)) + voff), 0, 0); }
#pragma unroll
                for (int d = 0; d < 4; ++d) {
                    const unsigned P = __builtin_amdgcn_perm(r1[d], r0[d], 0x05010400u), Q = __builtin_amdgcn_perm(r1[d], r0[d], 0x07030602u);
                    const unsigned R = __builtin_amdgcn_perm(r3[d], r2[d], 0x05010400u), S = __builtin_amdgcn_perm(r3[d], r2[d], 0x07030602u);
                    yi[gI][4 * d + 0] = __builtin_amdgcn_sdot4((int)__builtin_amdgcn_perm(R, P, 0x05040100u), a4, yi[gI][4 * d + 0], false);
                    yi[gI][4 * d + 1] = __builtin_amdgcn_sdot4((int)__builtin_amdgcn_perm(R, P, 0x07060302u), a4, yi[gI][4 * d + 1], false);
                    yi[gI][4 * d + 2] = __builtin_amdgcn_sdot4((int)__builtin_amdgcn_perm(S, Q, 0x05040100u), a4, yi[gI][4 * d + 2], false);
                    yi[gI][4 * d + 3] = __builtin_amdgcn_sdot4((int)__builtin_amdgcn_perm(S, Q, 0x07060302u), a4, yi[gI][4 * d + 3], false); }
            }
        }
        f32x2 y[4][8];
#pragma unroll
        for (int gI = 0; gI < 4; ++gI) { const float sc = SCL[8 * gI + q] * (1.0f / EV8_SCALE);
#pragma unroll
            for (int e = 0; e < 8; ++e) y[gI][e] = (f32x2){(float)yi[gI][2 * e] * sc, (float)yi[gI][2 * e + 1] * sc}; }
#pragma unroll
        for (int gI = 0; gI < 4; ++gI) { const bf16* xr = (const bf16*)(F.ws + WS_XB) + (size_t)(TB + 8 * gI + q) * D + voff; float ss = 0.f;
            const v4u xa = *(const GAS v4u*)xr, xb = *(const GAS v4u*)(xr + 8);
#pragma unroll
            for (int j = 0; j < 4; ++j) { const unsigned w0 = (j < 2 ? xa : xb)[2 * (j & 1)], w1 = (j < 2 ? xa : xb)[2 * (j & 1) + 1];
                y[gI][2 * j] += (f32x2){bflo(w0), bfhi(w0)}; y[gI][2 * j + 1] += (f32x2){bflo(w1), bfhi(w1)};
                ss += (y[gI][2 * j].x * y[gI][2 * j].x + y[gI][2 * j].y * y[gI][2 * j].y) + (y[gI][2 * j + 1].x * y[gI][2 * j + 1].x + y[gI][2 * j + 1].y * y[gI][2 * j + 1].y); }
            ss += __shfl_xor(ss, 1); ss += __shfl_xor(ss, 2); ss += __shfl_xor(ss, 4);
            if (c == 0) SSP[(8 * gI + q) * 8 + w] = ss; }
        __syncthreads();
#pragma unroll
        for (int gI = 0; gI < 4; ++gI) { const LAS f32x4* sp = (const LAS f32x4*)(SSP + (8 * gI + q) * 8); const f32x4 s0 = sp[0], s1 = sp[1];
            const float tot = ((s0[0] + s0[1]) + (s0[2] + s0[3])) + ((s1[0] + s1[1]) + (s1[2] + s1[3]));
            const float r3 = 1.0f / sqrtf(tot * (1.0f / D) + EPS);
            float* orow = (DUMMY ? (float*)(F.ws + 192 * MiB) : F.out) + (size_t)(TB + 8 * gI + q) * D + voff;
#pragma unroll
            for (int j = 0; j < 4; ++j) { const f32x4 gn = *(const GAS f32x4*)(F.norm_final + voff + 4 * j);
                *(GAS f32x4*)(orow + 4 * j) = (f32x4){y[gI][2 * j].x * r3 * gn[0], y[gI][2 * j].y * r3 * gn[1], y[gI][2 * j + 1].x * r3 * gn[2], y[gI][2 * j + 1].y * r3 * gn[3]}; } }
    }
}

struct Args { const float* in[12]; float* out; unsigned char* ws; };
__global__ void __launch_bounds__(NWAVES * 64, 2) hymba_fwd(Args args) {
    extern __shared__ __attribute__((aligned(16))) unsigned char lds[];
    Frame F;
    F.lds = (LAS unsigned char*)lds;
    F.MISC = (volatile LAS unsigned*)(F.lds + MISC_OFF);
    F.tid = threadIdx.x; F.lane = F.tid & 63; F.wave = __builtin_amdgcn_readfirstlane(F.tid >> 6);
    F.G = gridDim.x; { const int bx = blockIdx.x; F.vcu = (F.G % 8 == 0) ? (bx % 8) * (F.G / 8) + bx / 8 : bx; }
    F.x = args.in[0]; F.norm_mix = args.in[1]; F.w_in = args.in[2]; F.w_pool = args.in[3]; F.pool_scale = args.in[4]; F.w_out = args.in[5];
    F.norm_ffn = args.in[6]; F.w_query = args.in[7]; F.sub_keys = args.in[8]; F.expert_u = args.in[9]; F.expert_v = args.in[10]; F.norm_final = args.in[11];
    F.out = args.out; F.ws = args.ws;
    for (int u = F.tid; u < (LDS_BYTES - LDSCTL_OFF) / 4; u += NWAVES * 64) ((LAS unsigned*)(F.lds + LDSCTL_OFF))[u] = 0u;
    __syncthreads();
    XcdBarrier bar = xcd_barrier_post((unsigned*)(F.ws + WS_CTL), F.MISC + 8);
#define GRID_BAR() xcd_barrier(bar)
#ifndef PROBE_SPIN
#define PROBE_SPIN -1
#endif
    unsigned long long ps_t0 = 0;
#define PH_BEGIN(k) do { if (PROBE_SPIN == (k)) ps_t0 = __builtin_amdgcn_s_memrealtime(); } while (0)
#define PH_END(k) do { if (PROBE_SPIN == (k)) { const unsigned long long t1 = __builtin_amdgcn_s_memrealtime(), dt = t1 - ps_t0; while (__builtin_amdgcn_s_memrealtime() - t1 < dt) __builtin_amdgcn_s_sleep(8); } } while (0)

#ifndef PROBE_DUP
#define PROBE_DUP -1
#endif
#ifdef TRTEST
    {
        LAS unsigned char* tb = F.lds + 4096 * F.wave;
        for (int i = F.lane; i < 512; i += 64) tb[i] = (unsigned char)((i & 127) ^ ((i >> 7) * 0x55));
        LDS_WAIT(); asm volatile("" ::: "memory");
        typedef int v2i_t __attribute__((ext_vector_type(2)));
        const int l16 = F.lane & 15, grp = F.lane >> 4;
#if TRTEST == 1
        const int roff = (l16 >> 1) * 16 + (l16 & 1) * 8;
#else
        const int roff = (l16 & 7) * 16 + (l16 >> 3) * 8;
#endif
        const v2i_t rr = __builtin_amdgcn_ds_read_tr8_b64_v2i32((LAS v2i_t*)(tb + grp * 128 + roff));
        unsigned long long got = ((unsigned long long)(unsigned)rr.y << 32) | (unsigned)rr.x, want = 0;
        for (int j = 0; j < 8; ++j) want |= (unsigned long long)(unsigned char)(((j * 16 + l16) & 127) ^ (grp * 0x55)) << (8 * j);
        if (got != want) __hip_atomic_store((unsigned*)(F.ws + WS_CTL) + 8, 1u, RLX_AGENT);
        LDS_WAIT(); asm volatile("" ::: "memory");
        __syncthreads();
    }
#endif
#ifdef UBENCH
    {
        unsigned r0 = F.tid, r1 = F.tid * 3, r2 = F.tid * 5, r3 = F.tid * 7; float f0 = 1.f, f1 = 2.f, f2 = 3.f, f3 = 4.f; f32x2 p0 = {1.f, 2.f}, p1 = {3.f, 4.f}, q0 = {0.f, 0.f}, q1 = {0.f, 0.f}, q2 = {0.f, 0.f}, q3 = {0.f, 0.f};
        for (int it = 0; it < 20000; ++it) {
#pragma unroll
            for (int k = 0; k < 4; ++k) {
#if UBENCH == 1
                asm volatile("v_cvt_pk_f32_fp8_e32 %0, %4\n v_cvt_pk_f32_fp8_e32 %1, %5\n v_cvt_pk_f32_fp8_e32 %2, %6\n v_cvt_pk_f32_fp8_e32 %3, %7" : "=v"(q0), "=v"(q1), "=v"(q2), "=v"(q3) : "v"(r0), "v"(r1), "v"(r2), "v"(r3));
#elif UBENCH == 2
                asm volatile("v_cvt_f32_ubyte0_e32 %0, %4\n v_cvt_f32_ubyte1_e32 %1, %5\n v_cvt_f32_ubyte2_e32 %2, %6\n v_cvt_f32_ubyte3_e32 %3, %7" : "=v"(f0), "=v"(f1), "=v"(f2), "=v"(f3) : "v"(r0), "v"(r1), "v"(r2), "v"(r3));
#elif UBENCH == 3
                asm volatile("v_pk_fma_f32 %0, %4, %5, %0\n v_pk_fma_f32 %1, %4, %5, %1\n v_pk_fma_f32 %2, %4, %5, %2\n v_pk_fma_f32 %3, %4, %5, %3" : "+v"(q0), "+v"(q1), "+v"(q2), "+v"(q3) : "v"(p0), "v"(p1));
#elif UBENCH == 4
                asm volatile("v_dot2_f32_f16 %0, %4, %5, %0\n v_dot2_f32_f16 %1, %4, %6, %1\n v_dot2_f32_f16 %2, %5, %6, %2\n v_dot2_f32_f16 %3, %6, %7, %3" : "+v"(f0), "+v"(f1), "+v"(f2), "+v"(f3) : "v"(r0), "v"(r1), "v"(r2), "v"(r3));
#elif UBENCH == 5
                asm volatile("v_perm_b32 %0, %4, %5, %6\n v_perm_b32 %1, %5, %6, %7\n v_perm_b32 %2, %4, %6, %7\n v_perm_b32 %3, %4, %5, %7" : "=v"(f0), "=v"(f1), "=v"(f2), "=v"(f3) : "v"(r0), "v"(r1), "v"(r2), "v"(r3));
#elif UBENCH == 6
                asm volatile("v_fma_f32 %0, %4, %5, %0\n v_fma_f32 %1, %4, %5, %1\n v_fma_f32 %2, %4, %5, %2\n v_fma_f32 %3, %4, %5, %3" : "+v"(f0), "+v"(f1), "+v"(f2), "+v"(f3) : "v"(p0.x), "v"(p1.y));
#elif UBENCH == 8
                asm volatile("v_pk_fma_f16 %0, %4, %5, %0\n v_pk_fma_f16 %1, %4, %5, %1\n v_pk_fma_f16 %2, %4, %5, %2\n v_pk_fma_f16 %3, %4, %5, %3" : "+v"(f0), "+v"(f1), "+v"(f2), "+v"(f3) : "v"(r0), "v"(r1));
#elif UBENCH == 9
                asm volatile("v_cvt_scalef32_pk_f16_fp8 %0, %4, 1.0\n v_cvt_scalef32_pk_f16_fp8 %1, %5, 1.0\n v_cvt_scalef32_pk_f16_fp8 %2, %6, 1.0\n v_cvt_scalef32_pk_f16_fp8 %3, %7, 1.0" : "=v"(f0), "=v"(f1), "=v"(f2), "=v"(f3) : "v"(r0), "v"(r1), "v"(r2), "v"(r3));
#elif UBENCH == 10
                asm volatile("v_cvt_pk_f32_fp8_sdwa %0, %4 src0_sel:WORD_1\n v_cvt_pk_f32_fp8_sdwa %1, %5 src0_sel:WORD_1\n v_cvt_pk_f32_fp8_sdwa %2, %6 src0_sel:WORD_1\n v_cvt_pk_f32_fp8_sdwa %3, %7 src0_sel:WORD_1" : "=v"(q0), "=v"(q1), "=v"(q2), "=v"(q3) : "v"(r0), "v"(r1), "v"(r2), "v"(r3));
#elif UBENCH == 7
                asm volatile("v_dot4_i32_i8 %0, %4, %5, %0\n v_dot4_i32_i8 %1, %4, %6, %1\n v_dot4_i32_i8 %2, %5, %6, %2\n v_dot4_i32_i8 %3, %6, %7, %3" : "+v"(f0), "+v"(f1), "+v"(f2), "+v"(f3) : "v"(r0), "v"(r1), "v"(r2), "v"(r3));
#endif
            }
        }
        float* dump = (float*)(F.ws + WS_Z);
        dump[(size_t)blockIdx.x * 512 + F.tid] = f0 + f1 + f2 + f3 + q0.x + q1.y + q2.x + q3.y;
    }
#endif
    PH_BEGIN(0); p0_prologue(F); PH_END(0);
    if (PROBE_DUP == 0) { GRID_BAR(); p0_prologue(F); }
    GRID_BAR();
    PH_BEGIN(1);
    {
        pg8::Gemm g{(const pg8::bf16_t*)(F.ws + WS_XB), (const pg8::bf16_t*)(F.ws + WS_WIN), M, NZ, D}; pg8::StaticOrder S; S.init(M, NZ, F.G, (int)blockIdx.x);
        pg8::EpiZ E{(pg8::bf16_t*)(F.ws + WS_Z), (pg8::bf16_t*)(F.ws + WS_ZP), (const float*)(F.ws + WS_R1), DATT, QSCALE, SEQ, NH, M};
        pg8::gemm_phase<pg8::EpiZ, pg8::StaticOrder, PG8_ALIGN, PG8_SP2>(F.lds + RING_OFF, g, S, E);
        if (PROBE_DUP == 1) { GRID_BAR(); pg8::gemm_phase<pg8::EpiZ, pg8::StaticOrder, PG8_ALIGN, PG8_SP2>(F.lds + RING_OFF, g, S, E); }
    }
    PH_END(1);
    GRID_BAR();
    PH_BEGIN(2);
    {
        v4u kv[6], vv[6]; bf16x8 qc[4], qn[4];
        int u = F.vcu;
        if (u < ATT_UNITS) { attn_fetch(F, u, kv, vv); attn_fetch_q(F, u, qn); }
        for (; u < ATT_UNITS; u += F.G) {
#pragma unroll
            for (int d0 = 0; d0 < 4; ++d0) qc[d0] = qn[d0];
            attn_stage(F, kv, vv);
            __syncthreads();
            if (u + F.G < ATT_UNITS) { attn_fetch(F, u + F.G, kv, vv); attn_fetch_q(F, u + F.G, qn); }
            attn_compute(F, u, qc);
            __syncthreads();
        }
    }
    PH_END(2);
    PH_BEGIN(3); pool_rows(F); PH_END(3);
    if (PROBE_DUP == 3) { GRID_BAR(); pool_rows(F); }
    GRID_BAR();
    PH_BEGIN(4); merge_rows(F); PH_END(4);
    if (PROBE_DUP == 4) { GRID_BAR(); merge_rows(F); }
    GRID_BAR();
    PH_BEGIN(5);
    {
        pg8::Gemm g{(const pg8::bf16_t*)(F.ws + WS_MIX), (const pg8::bf16_t*)(F.ws + WS_WOUT), M, D, D}; pg8::StaticOrder S; S.init(M, D, F.G, (int)blockIdx.x);
        pg8::EpiRes E{(pg8::bf16_t*)(F.ws + WS_XB), (float*)(F.ws + WS_SS), D};
        pg8::gemm_phase<pg8::EpiRes, pg8::StaticOrder, PG8_ALIGN, PG8_SP2>(F.lds + RING_OFF, g, S, E);
        if (PROBE_DUP == 5) { GRID_BAR(); pg8::gemm_phase<pg8::EpiRes, pg8::StaticOrder, PG8_ALIGN, PG8_SP2>(F.lds + RING_OFF, g, S, E); }
    }
    PH_END(5);
    GRID_BAR();
    PH_BEGIN(6);
    {
        pg8::Gemm g{(const pg8::bf16_t*)(F.ws + WS_XB), (const pg8::bf16_t*)(F.ws + WS_WSC), M, NSC, D}; pg8::StaticOrder S; S.init(M, NSC, F.G, (int)blockIdx.x);
        pg8::EpiF16 E{(unsigned short*)(F.ws + WS_SCH), NSC};
        pg8::gemm_phase<pg8::EpiF16, pg8::StaticOrder, PG8_ALIGN, PG8_SP2>(F.lds + RING_OFF, g, S, E);
        if (PROBE_DUP == 6) { GRID_BAR(); pg8::gemm_phase<pg8::EpiF16, pg8::StaticOrder, PG8_ALIGN, PG8_SP2>(F.lds + RING_OFF, g, S, E); }
    }
    PH_END(6);
    GRID_BAR();
    PH_BEGIN(7); topk_phase(F); PH_END(7);
    if (PROBE_DUP == 7) { GRID_BAR(); topk_phase(F); }
    GRID_BAR();
#ifndef VSYNC
#define VSYNC 0
#endif
#ifndef PROBE_U2
#define PROBE_U2 0
#endif
#ifndef PROBE_UMASK
#define PROBE_UMASK 0x3fffu
#endif
    for (int blk = F.vcu; blk < M / 128; blk += F.G) { if (PROBE_U2) { peer_u_phase<PROBE_UMASK, true>(F, blk); __syncthreads(); } PH_BEGIN(8); peer_u_phase<0x3fffu, false>(F, blk); PH_END(8);
#ifdef PROBE_VMASK
        peer_v_phase<PROBE_VMASK, true>(F, blk, bar, false); __syncthreads();
#endif
        PH_BEGIN(9); peer_v_phase<0x3fffu, false>(F, blk, bar, VSYNC && (M / 128 == F.G)); PH_END(9); __syncthreads(); }
#ifdef TRTEST
    GRID_BAR();
    if (blockIdx.x == 0 && F.tid == 0 && __hip_atomic_load((unsigned*)(F.ws + WS_CTL) + 8, RLX_AGENT) != 0u) F.out[0] = __builtin_nanf("");
#endif
}

extern "C" void kernel_launch(void* const* d_in, const int* in_sizes, int n_in, void* d_out, int out_size, void* d_ws, size_t ws_size, hipStream_t stream) {
    static int grid = 0;
    if (grid == 0) {
        if (n_in != 12 || in_sizes[0] != M * D || out_size != M * D || ws_size < WS_END) { fprintf(stderr, "kernel_launch: unexpected shapes (n_in %d, in0 %d, out %d, ws %zu); nothing launched\n", n_in, n_in > 0 ? in_sizes[0] : -1, out_size, ws_size); grid = -1; return; }
        int dev = 0, cus = 0, per_cu = 0;
        if (hipGetDevice(&dev) != hipSuccess || hipDeviceGetAttribute(&cus, hipDeviceAttributeMultiprocessorCount, dev) != hipSuccess) { grid = -1; return; }
        if (hipFuncSetAttribute((const void*)hymba_fwd, hipFuncAttributeMaxDynamicSharedMemorySize, LDS_BYTES) != hipSuccess) { fprintf(stderr, "kernel_launch: hipFuncSetAttribute failed\n"); grid = -1; return; }
        if (hipOccupancyMaxActiveBlocksPerMultiprocessor(&per_cu, (const void*)hymba_fwd, NWAVES * 64, LDS_BYTES) != hipSuccess || per_cu < 1)
            fprintf(stderr, "kernel_launch: note: occupancy query reports %d workgroups per CU\n", per_cu);
        (void)hipGetLastError();
        grid = cus;
    }
    if (grid < 0) return;
    if (hipMemsetAsync((char*)d_ws + WS_CTL, 0, CTL_ZERO_BYTES, stream) != hipSuccess) { fprintf(stderr, "kernel_launch: hipMemsetAsync failed\n"); return; }
    Args a{};
    for (int i = 0; i < 12; ++i) a.in[i] = (const float*)d_in[i];
    a.out = (float*)d_out; a.ws = (unsigned char*)d_ws;
    hipLaunchKernelGGL(hymba_fwd, dim3(grid), dim3(NWAVES * 64), LDS_BYTES, stream, a);
    const hipError_t le = hipPeekAtLastError();
    if (le != hipSuccess) fprintf(stderr, "kernel_launch: launch failed: %s\n", hipGetErrorName(le));
}
```

```cpp
#include <hip/hip_runtime.h>
#include <cstdio>
#include <cstdint>
namespace pg8 {
#define PG8_LAS __attribute__((address_space(3)))
typedef unsigned short bf16_t;
typedef short bf16x8 __attribute__((ext_vector_type(8)));
typedef float f32x4 __attribute__((ext_vector_type(4)));
typedef unsigned u32x4 __attribute__((ext_vector_type(4)));
constexpr int BM = 256, BK = 64, HALF = 128, HTB = HALF * BK * 2  , STAGE_BYTES = 8 * HTB, NXCD = 8, WGM = 8;

__host__ __device__ __forceinline__ int lds_byte(int r, int c) { const int st = (r >> 4) * 2 + (c >> 5), rr = r & 15, cc = c & 31, ob = rr * 64 + cc * 2; return st * 1024 + (ob ^ (((ob >> 9) & 1) << 5)); }
__host__ __device__ __forceinline__ void stage_rc(int b, int& R, int& C) { const int st = b / 1024, sb = b % 1024, swz = sb ^ (((sb >> 9) & 1) << 5); R = (st >> 1) * 16 + swz / 64; C = (st & 1) * 32 + (swz % 64) / 2; }
__host__ __device__ __forceinline__ int perm32(int rho) { const int n = rho >> 4, i = rho & 15; return 8 * (i >> 2) + 4 * n + (i & 3); }

struct Unit { int pm, pn; };
struct Gemm { const bf16_t* A; const bf16_t* Bt; int M, N, K; };

struct StaticOrder {
    int nM, nN, nwg, G, c;
    __host__ __device__ void init(int M, int N, int G_, int c_) { nM = M / BM; nN = N / BM; nwg = nM * nN; G = G_; c = c_; }
    __host__ __device__ bool next(int i, Unit& u) const {
        const long L = (long)i * G + c; if (L >= nwg) return false;
        int wgid = (int)L; { const int q = nwg / NXCD, r = nwg % NXCD, xcd = wgid % NXCD, off = wgid / NXCD; wgid = (xcd < r ? xcd * (q + 1) : r * (q + 1) + (xcd - r) * q) + off; }
        const int nig = WGM * nN, gid = wgid / nig, fm = gid * WGM, gsz = (nM - fm) < WGM ? (nM - fm) : WGM;
        u.pm = fm + ((wgid % nig) % gsz); u.pn = (wgid % nig) / gsz; return true;
    }
    __device__ __forceinline__ void a_ready(const Unit&) const {}
    __device__ __forceinline__ void done(const Unit&) const {}
};

__device__ __forceinline__ unsigned cvt_pk_bf16(float lo, float hi) { unsigned r; asm volatile("v_cvt_pk_bf16_f32 %0, %1, %2" : "=v"(r) : "v"(lo), "v"(hi)); return r; }
struct EpiZ {
    static constexpr bool PERM = true, AFTER_DRAIN = false;
    bf16_t* ZH; bf16_t* ZP; const float* rs; int qcols; float qscale; int seq, nh, mrows;
    __device__ __forceinline__ void operator()(const f32x4 (&acc)[2][2][4][2], const Unit& u, int wr, int wc, int fr, int fq) const {
        const int row0 = u.pm * BM + wr * 64 + fr; const int colt = u.pn * BM;
        const float sc = (colt < qcols) ? qscale : 1.f;
        const int col0 = colt + wc * 32 + 8 * fq;
#pragma unroll
        for (int ai = 0; ai < 2; ++ai)
#pragma unroll
            for (int m = 0; m < 4; ++m) { const int row = row0 + ai * HALF + m * 16; const float s = rs[row] * sc; const int bq = row / seq, sq = row - bq * seq;
#pragma unroll
                for (int bj = 0; bj < 2; ++bj) { const f32x4 v0 = acc[ai][bj][m][0] * s, v1 = acc[ai][bj][m][1] * s; const int cc = col0 + bj * HALF;
                    u32x4 w; w.x = cvt_pk_bf16(v0[0], v0[1]); w.y = cvt_pk_bf16(v0[2], v0[3]); w.z = cvt_pk_bf16(v1[0], v1[1]); w.w = cvt_pk_bf16(v1[2], v1[3]);
                    bf16_t* dst = (cc < 3 * 512) ? ZH + (size_t)(cc >> 9) * mrows * 512 + ((size_t)(bq * nh + ((cc >> 6) & 7)) * seq + sq) * 64 + (cc & 63)
                                                 : ZP + (size_t)row * 512 + (cc - 3 * 512);
                    *(u32x4*)dst = w; } }
    }
};
struct EpiRes {
    static constexpr bool PERM = true, AFTER_DRAIN = false;
    bf16_t* XB; float* SS; int ldc;
    __device__ __forceinline__ void operator()(const f32x4 (&acc)[2][2][4][2], const Unit& u, int wr, int wc, int fr, int fq) const {
        const int row0 = u.pm * BM + wr * 64 + fr; const int col0 = u.pn * BM + wc * 32 + 8 * fq;
#pragma unroll
        for (int ai = 0; ai < 2; ++ai)
#pragma unroll
            for (int m = 0; m < 4; ++m) { const int row = row0 + ai * HALF + m * 16; const size_t off = (size_t)row * ldc + col0; float ss = 0.f;
#pragma unroll
                for (int bj = 0; bj < 2; ++bj) {
                    const u32x4 xw = *(const u32x4*)(XB + off + bj * HALF);
                    f32x4 v0 = acc[ai][bj][m][0], v1 = acc[ai][bj][m][1];
                    v0[0] += __builtin_bit_cast(float, xw.x << 16); v0[1] += __builtin_bit_cast(float, xw.x & 0xffff0000u); v0[2] += __builtin_bit_cast(float, xw.y << 16); v0[3] += __builtin_bit_cast(float, xw.y & 0xffff0000u);
                    v1[0] += __builtin_bit_cast(float, xw.z << 16); v1[1] += __builtin_bit_cast(float, xw.z & 0xffff0000u); v1[2] += __builtin_bit_cast(float, xw.w << 16); v1[3] += __builtin_bit_cast(float, xw.w & 0xffff0000u);
                    ss += (v0[0] * v0[0] + v0[1] * v0[1]) + (v0[2] * v0[2] + v0[3] * v0[3]) + (v1[0] * v1[0] + v1[1] * v1[1]) + (v1[2] * v1[2] + v1[3] * v1[3]);
                    u32x4 w; w.x = cvt_pk_bf16(v0[0], v0[1]); w.y = cvt_pk_bf16(v0[2], v0[3]); w.z = cvt_pk_bf16(v1[0], v1[1]); w.w = cvt_pk_bf16(v1[2], v1[3]);
                    *(u32x4*)(XB + off + bj * HALF) = w; }
                ss += __shfl_xor(ss, 16); ss += __shfl_xor(ss, 32);
                if (fq == 0) SS[(size_t)row * 16 + u.pn * 4 + wc] = ss;
                if (m & 1) asm volatile("" ::: "memory"); }
    }
};
typedef _Float16 f16x2_t __attribute__((ext_vector_type(2)));
__device__ __forceinline__ unsigned cvt_pk_f16(float lo, float hi) { const f16x2_t h = {(_Float16)lo, (_Float16)hi}; return __builtin_bit_cast(unsigned, h); }
struct EpiF16 {
    static constexpr bool PERM = true, AFTER_DRAIN = false;
    unsigned short* O; int ldc;
    __device__ __forceinline__ void operator()(const f32x4 (&acc)[2][2][4][2], const Unit& u, int wr, int wc, int fr, int fq) const {
        const int row0 = u.pm * BM + wr * 64 + fr; const int col0 = u.pn * BM + wc * 32 + 8 * fq;
#pragma unroll
        for (int ai = 0; ai < 2; ++ai)
#pragma unroll
            for (int m = 0; m < 4; ++m) { unsigned short* rowp = O + (size_t)(row0 + ai * HALF + m * 16) * ldc + col0;
#pragma unroll
                for (int bj = 0; bj < 2; ++bj) { const f32x4 v0 = acc[ai][bj][m][0], v1 = acc[ai][bj][m][1];
                    u32x4 w; w.x = cvt_pk_f16(v0[0], v0[1]); w.y = cvt_pk_f16(v0[2], v0[3]); w.z = cvt_pk_f16(v1[0], v1[1]); w.w = cvt_pk_f16(v1[2], v1[3]);
                    *(u32x4*)(rowp + bj * HALF) = w; } }
    }
};

template <class Epi, class Sched, bool ALIGN_EPI = false, bool SP2 = false>
__device__ __forceinline__ void gemm_phase(PG8_LAS unsigned char* lds, const Gemm g, const Sched& S, const Epi& E) {
    const int tid = threadIdx.x, wid = __builtin_amdgcn_readfirstlane(tid >> 6), lane = tid & 63, wr = wid >> 2, wc = wid & 3, fr = lane & 15, fq = lane >> 4;
    const int K = g.K, nt = K / BK;
    unsigned voffA[2], voffB[2];
#pragma unroll
    for (int i = 0; i < 2; ++i) { int R, C; stage_rc(tid * 16 + i * 8192, R, C); const int Rb = Epi::PERM ? ((R & ~31) + perm32(R & 31)) : R;
        voffA[i] = (unsigned)(R * K + C) * 2u; voffB[i] = (unsigned)(Rb * K + C) * 2u; }
    const size_t kstep = (size_t)(BK * 2);
    const size_t hstep = (size_t)HALF * K * 2;
    const size_t tstep = 2 * hstep;
    const unsigned ldsw = (unsigned)wid * 1024u;
    const int aoff = lds_byte(wr * 64 + fr, fq * 8), boff = lds_byte(wc * 32 + fr, fq * 8);
#define PG8_SA(b, h) (((b) * 2 + (h)) * HTB)
#define PG8_SB(b, h) ((4 + (b) * 2 + (h)) * HTB)
#define PG8_STAGE(bufoff, gbase, voff) do { _Pragma("unroll") for (int _i = 0; _i < 2; ++_i) \
        __builtin_amdgcn_global_load_lds((const unsigned*)((const char*)(gbase) + (voff)[_i]), (PG8_LAS unsigned*)(lds + (bufoff) + ldsw + _i * 8192), 16, 0, 0); } while (0)
#define PG8_LDA(dst, b, h) do { _Pragma("unroll") for (int m = 0; m < 4; ++m) _Pragma("unroll") for (int k = 0; k < 2; ++k) dst[m][k] = *(const PG8_LAS bf16x8*)(lds + PG8_SA(b, h) + aoff + m * 2048 + k * 1024); } while (0)
#define PG8_LDB(dst, b, h) do { _Pragma("unroll") for (int n = 0; n < 2; ++n) _Pragma("unroll") for (int k = 0; k < 2; ++k) dst[n][k] = *(const PG8_LAS bf16x8*)(lds + PG8_SB(b, h) + boff + n * 2048 + k * 1024); } while (0)
#define PG8_MMA(ai, bj, At, Bt) do { __builtin_amdgcn_s_setprio(1); _Pragma("unroll") for (int m = 0; m < 4; ++m) _Pragma("unroll") for (int n = 0; n < 2; ++n) _Pragma("unroll") for (int k = 0; k < 2; ++k) \
        acc[ai][bj][m][n] = __builtin_amdgcn_mfma_f32_16x16x32_bf16(Bt[n][k], At[m][k], acc[ai][bj][m][n], 0, 0, 0); __builtin_amdgcn_s_setprio(0); } while (0)
#define PG8_WAIT_V(n) asm volatile("s_waitcnt vmcnt(" #n ")" ::: "memory")
#define PG8_WAIT_L(n) asm volatile("s_waitcnt lgkmcnt(" #n ")" ::: "memory")
#define PG8_BAR __builtin_amdgcn_s_barrier()
#define PG8_SCHED __builtin_amdgcn_sched_barrier(0)
    Unit cur, nxt; int ui = 0;
    if (!S.next(0, cur)) return;
    f32x4 acc[2][2][4][2];
#pragma unroll
    for (int a = 0; a < 2; ++a)
#pragma unroll
        for (int b = 0; b < 2; ++b)
#pragma unroll
            for (int m = 0; m < 4; ++m)
#pragma unroll
                for (int n = 0; n < 2; ++n) acc[a][b][m][n] = (f32x4){0.f, 0.f, 0.f, 0.f};
    bf16x8 At[4][2], B0[2][2], B1[2][2];
    const char* cA = (const char*)g.A + (size_t)cur.pm * tstep; const char* cB = (const char*)g.Bt + (size_t)cur.pn * tstep;
    S.a_ready(cur);
    if constexpr (SP2) {
        PG8_STAGE(PG8_SB(0, 0), cB, voffB); PG8_STAGE(PG8_SB(0, 1), cB + hstep, voffB); PG8_STAGE(PG8_SA(0, 0), cA, voffA); PG8_STAGE(PG8_SA(0, 1), cA + hstep, voffA);
        if (wr == 1) PG8_BAR;
        PG8_WAIT_V(2); PG8_BAR;
        PG8_STAGE(PG8_SB(1, 0), cB + kstep, voffB); PG8_STAGE(PG8_SA(1, 0), cA + kstep, voffA); PG8_STAGE(PG8_SB(1, 1), cB + hstep + kstep, voffB);
        PG8_WAIT_V(6); PG8_BAR;
    } else {
        PG8_STAGE(PG8_SB(0, 0), cB, voffB); PG8_STAGE(PG8_SA(0, 0), cA, voffA); PG8_STAGE(PG8_SB(0, 1), cB + hstep, voffB); PG8_STAGE(PG8_SA(0, 1), cA + hstep, voffA);
        if (wr == 1) PG8_BAR;
        PG8_WAIT_V(4); PG8_BAR;
        PG8_STAGE(PG8_SB(1, 0), cB + kstep, voffB); PG8_STAGE(PG8_SA(1, 0), cA + kstep, voffA); PG8_STAGE(PG8_SB(1, 1), cB + hstep + kstep, voffB);
        PG8_WAIT_V(6); PG8_BAR;
    }
    for (;;) {
        const bool has_next = S.next(ui + 1, nxt);
        const char* nA = has_next ? (const char*)g.A + (size_t)nxt.pm * tstep : cA; const char* nB = has_next ? (const char*)g.Bt + (size_t)nxt.pn * tstep : cB;
        for (int t = 0; t < nt; t += 2) {
            const bool last = (t == nt - 2);
            const char* a1 = cA + (size_t)(t + 1) * kstep;
            const char* a2 = last ? nA : cA + (size_t)(t + 2) * kstep; const char* b2 = last ? nB : cB + (size_t)(t + 2) * kstep;
            const char* a3 = a2 + kstep; const char* b3 = b2 + kstep;
            if (last && has_next) S.a_ready(nxt);
            if constexpr (SP2) {
            PG8_LDB(B0, 0, 0); PG8_LDB(B1, 0, 1); PG8_SCHED; PG8_LDA(At, 0, 0); PG8_STAGE(PG8_SA(1, 1), a1 + hstep, voffA);
            PG8_WAIT_V(8); PG8_WAIT_L(0); PG8_BAR; PG8_MMA(0, 0, At, B0); PG8_MMA(0, 1, At, B1); PG8_BAR; PG8_SCHED;
            PG8_LDA(At, 0, 1); PG8_STAGE(PG8_SB(0, 0), b2, voffB); PG8_STAGE(PG8_SB(0, 1), b2 + hstep, voffB); PG8_STAGE(PG8_SA(0, 0), a2, voffA);
            PG8_WAIT_V(8); PG8_WAIT_L(0); PG8_BAR; PG8_MMA(1, 0, At, B0); PG8_MMA(1, 1, At, B1); PG8_BAR; PG8_SCHED;
            PG8_LDB(B0, 1, 0); PG8_LDB(B1, 1, 1); PG8_SCHED; PG8_LDA(At, 1, 0); PG8_STAGE(PG8_SA(0, 1), a2 + hstep, voffA);
            PG8_WAIT_V(8); PG8_WAIT_L(0); PG8_BAR; PG8_MMA(0, 0, At, B0); PG8_MMA(0, 1, At, B1); PG8_BAR; PG8_SCHED;
            PG8_LDA(At, 1, 1); PG8_STAGE(PG8_SB(1, 0), b3, voffB); PG8_STAGE(PG8_SB(1, 1), b3 + hstep, voffB); PG8_STAGE(PG8_SA(1, 0), a3, voffA);
            PG8_WAIT_V(8); PG8_WAIT_L(0); PG8_BAR; PG8_MMA(1, 0, At, B0); PG8_MMA(1, 1, At, B1); PG8_BAR; PG8_SCHED;
            } else {
            PG8_LDB(B0, 0, 0); PG8_SCHED; PG8_LDA(At, 0, 0); PG8_STAGE(PG8_SA(1, 1), a1 + hstep, voffA);
            PG8_WAIT_L(8); PG8_BAR; PG8_WAIT_L(0); PG8_MMA(0, 0, At, B0); PG8_BAR; PG8_SCHED;
            PG8_LDB(B1, 0, 1); PG8_STAGE(PG8_SB(0, 0), b2, voffB);
            PG8_BAR; PG8_WAIT_L(0); PG8_MMA(0, 1, At, B1); PG8_BAR;
            PG8_LDA(At, 0, 1); PG8_STAGE(PG8_SA(0, 0), a2, voffA);
            PG8_BAR; PG8_WAIT_L(0); PG8_MMA(1, 0, At, B0); PG8_BAR; PG8_SCHED;
            PG8_STAGE(PG8_SB(0, 1), b2 + hstep, voffB);
            PG8_WAIT_V(6); PG8_BAR; PG8_MMA(1, 1, At, B1); PG8_BAR;
            PG8_LDB(B0, 1, 0); PG8_SCHED; PG8_LDA(At, 1, 0); PG8_STAGE(PG8_SA(0, 1), a2 + hstep, voffA);
            PG8_WAIT_L(8); PG8_BAR; PG8_WAIT_L(0); PG8_MMA(0, 0, At, B0); PG8_BAR; PG8_SCHED;
            PG8_LDB(B1, 1, 1); PG8_STAGE(PG8_SB(1, 0), b3, voffB);
            PG8_BAR; PG8_WAIT_L(0); PG8_MMA(0, 1, At, B1); PG8_BAR;
            PG8_LDA(At, 1, 1); PG8_STAGE(PG8_SA(1, 0), a3, voffA);
            PG8_BAR; PG8_WAIT_L(0); PG8_MMA(1, 0, At, B0); PG8_BAR; PG8_SCHED;
            PG8_STAGE(PG8_SB(1, 1), b3 + hstep, voffB);
            PG8_WAIT_V(6); PG8_BAR; PG8_MMA(1, 1, At, B1); PG8_BAR;
            }
        }
        if constexpr (ALIGN_EPI) { if (wr == 0) PG8_BAR; }
        if constexpr (!Epi::AFTER_DRAIN) { E(acc, cur, wr, wc, fr, fq); S.done(cur); }
        if (!has_next) break;
#pragma unroll
        for (int a = 0; a < 2; ++a)
#pragma unroll
            for (int b = 0; b < 2; ++b)
#pragma unroll
                for (int m = 0; m < 4; ++m)
#pragma unroll
                    for (int n = 0; n < 2; ++n) acc[a][b][m][n] = (f32x4){0.f, 0.f, 0.f, 0.f};
        cur = nxt; cA = nA; cB = nB; ++ui;
        if constexpr (ALIGN_EPI) { if (wr == 1) PG8_BAR; }
    }
    PG8_WAIT_V(0);
    if constexpr (!ALIGN_EPI) { if (wr == 0) PG8_BAR; }
    PG8_BAR;
    if constexpr (Epi::AFTER_DRAIN) { E.fused(acc, cur, wr, wc, fr, fq, lds, wid, lane); S.done(cur); }
#undef PG8_SA
#undef PG8_SB
#undef PG8_STAGE
#undef PG8_LDA
#undef PG8_LDB
#undef PG8_MMA
#undef PG8_WAIT_V
#undef PG8_WAIT_L
#undef PG8_BAR
#undef PG8_SCHED
}
}
#define PG8_SP2 true
#define PG8_ALIGN true

constexpr int NWAVES = 8;
constexpr int BATCH = 4, SEQ = 8192, D = 1024, M = BATCH * SEQ;
constexpr int NH = 8, HD = 64, DATT = 512, DPOOL = 512, NZ = 3 * DATT + DPOOL;
constexpr int PEER_H = 8, NKEYS = 128, NEXP = NKEYS * NKEYS, TOPK = 16, NSC = PEER_H * 2 * NKEYS;
constexpr float EPS = 1e-6f;
constexpr float QSCALE = 0.125f * 1.4426950408889634f;

constexpr size_t MiB = 1u << 20;
constexpr size_t WS_CTL = 0, CTL_ZERO_BYTES = 64 * 1024;
constexpr size_t WS_R1 = 1 * MiB;
constexpr size_t WS_SS = 2 * MiB;
constexpr size_t WS_LSE = 4 * MiB;
constexpr size_t WS_WIN = 8 * MiB;
constexpr size_t WS_WOUT = 12 * MiB;
constexpr size_t WS_WSC = 14 * MiB;
constexpr size_t WS_EU = 32 * MiB, WS_EV = 64 * MiB;
constexpr size_t WS_XB = 96 * MiB;
constexpr size_t WS_Z = 160 * MiB;
constexpr size_t WS_ZP = 256 * MiB;
constexpr size_t WS_OB = 288 * MiB;
constexpr size_t WS_MIX = 384 * MiB;
constexpr size_t WS_SC = 160 * MiB;
constexpr size_t WS_SCH = 224 * MiB;
constexpr size_t WS_IDX = 448 * MiB, WS_GATE = 464 * MiB;
constexpr size_t WS_END = 480 * MiB;
static_assert(WS_SC + (size_t)M * NSC * 4 <= WS_IDX, "ws map");

constexpr int LDS_BYTES = 147456;
constexpr int LDSCTL_OFF = 146432, MISC_OFF = LDSCTL_OFF + 320;
constexpr int RING_OFF = 0;

#define GAS __attribute__((address_space(1)))
#define LAS __attribute__((address_space(3)))
typedef unsigned short bf16;
typedef unsigned v4u __attribute__((ext_vector_type(4)));
typedef unsigned v2u __attribute__((ext_vector_type(2)));
typedef float f32x4 __attribute__((ext_vector_type(4)));
typedef float f32x16 __attribute__((ext_vector_type(16)));
typedef short bf16x8 __attribute__((ext_vector_type(8)));
typedef short s16x4 __attribute__((ext_vector_type(4)));
typedef GAS unsigned gu32;
#define RLX_AGENT __ATOMIC_RELAXED, __HIP_MEMORY_SCOPE_AGENT
#define LDS_WAIT() asm volatile("s_waitcnt lgkmcnt(0)" ::: "memory")
#define VM_WAIT() asm volatile("s_waitcnt vmcnt(0)" ::: "memory")
__device__ __forceinline__ unsigned f2bf(float f) { unsigned u = __builtin_bit_cast(unsigned, f); return (u + 0x7fffu + ((u >> 16) & 1u)) >> 16; }
typedef float f32x2_cv __attribute__((ext_vector_type(2))); typedef __bf16 bf16x2_cv __attribute__((ext_vector_type(2)));
__device__ __forceinline__ unsigned pk2(float lo, float hi) { const f32x2_cv v = {lo, hi}; const bf16x2_cv b = __builtin_convertvector(v, bf16x2_cv); return __builtin_bit_cast(unsigned, b); }
__device__ __forceinline__ float bflo(unsigned w) { return __builtin_bit_cast(float, w << 16); }
__device__ __forceinline__ float bfhi(unsigned w) { return __builtin_bit_cast(float, w & 0xffff0000u); }
#define XB_TMO      128
#define XB_XCNT(j)  (256  + 64 * (j))
#define XB_XSUB(j)  (1280 + 64 * (j))
#define XB_XGEN(j)  (2304 + 64 * (j))
#define XB_TOP      3328
#define XB_TOPGEN   3392
#define XCD_BAR_WORDS 3456
#define XB_SPIN_CAP (1u << 18)

__device__ __forceinline__ unsigned xb_ld(unsigned* p)              { return __hip_atomic_load(p, __ATOMIC_RELAXED, __HIP_MEMORY_SCOPE_AGENT); }
__device__ __forceinline__ unsigned xb_add(unsigned* p, unsigned v) { return __hip_atomic_fetch_add(p, v, __ATOMIC_RELAXED, __HIP_MEMORY_SCOPE_AGENT); }
__device__ __forceinline__ unsigned xb_xcc_id() { return (unsigned)__builtin_amdgcn_s_getreg((3 << 11) | 20) & 0xFu; }
#define XB_SPIN(cond, bar) do { unsigned _sp = 0; while (cond) { __builtin_amdgcn_s_sleep(1); \
    if ((++_sp & 255u) == 0u) { if (xb_ld(&(bar)[XB_TMO])) break; if (_sp > XB_SPIN_CAP) { atomicAdd(&(bar)[XB_TMO], 1u); break; } } } } while (0)

struct XcdBarrier {
    unsigned* bar; unsigned x;
    volatile LAS unsigned* st;
};

__device__ __forceinline__ XcdBarrier xcd_barrier_post(unsigned* bar, volatile LAS unsigned* st) {
    XcdBarrier b; b.bar = bar; b.x = xb_xcc_id(); b.st = st;
    if (threadIdx.x == 0) (void)xb_add(&bar[XB_XCNT(b.x)], 1u);
    return b;
}
__device__ __forceinline__ void xcd_barrier_complete(unsigned* bar, unsigned x, unsigned& nloc, unsigned& nx) {
    const unsigned G = gridDim.x * gridDim.y * gridDim.z;
    unsigned sum, cnt, mine, sp = 0u;
    for (;;) {
        sum = 0u; cnt = 0u; mine = 0u;
#pragma unroll
        for (unsigned j = 0; j < 16; ++j) { const unsigned c = xb_ld(&bar[XB_XCNT(j)]); sum += c; cnt += (c > 0u) ? 1u : 0u; mine = (j == x) ? c : mine; }
        if (sum == G) break;
        __builtin_amdgcn_s_sleep(1);
        if ((++sp & 255u) == 0u) { if (xb_ld(&bar[XB_TMO])) break; if (sp > XB_SPIN_CAP) { atomicAdd(&bar[XB_TMO], 1u); break; } }
    }
    nloc = mine > 0u ? mine : 1u; nx = cnt > 0u ? cnt : 1u;
}

__device__ __forceinline__ void xcd_barrier(const XcdBarrier& b) {
    asm volatile("s_waitcnt vmcnt(0)" ::: "memory");
    __syncthreads();
    if (threadIdx.x == 0) {
        unsigned* bar = b.bar;
        __builtin_amdgcn_s_waitcnt(0);
        unsigned nloc = b.st[0], nx = b.st[1];
        if (nloc == 0u) { xcd_barrier_complete(bar, b.x, nloc, nx); b.st[0] = nloc; b.st[1] = nx; }
        const unsigned old = xb_add(&bar[XB_XSUB(b.x)], 1u);
        const unsigned gen = old / nloc;
        if (old + 1u == (gen + 1u) * nloc) {
            __builtin_amdgcn_fence(__ATOMIC_RELEASE, "agent");
            asm volatile("s_waitcnt vmcnt(0)" ::: "memory");
            const unsigned og = xb_add(&bar[XB_TOP], 1u);
            const unsigned tg = og / nx;
            if (og + 1u == (tg + 1u) * nx) xb_add(&bar[XB_TOPGEN], 1u);
            else XB_SPIN(xb_ld(&bar[XB_TOPGEN]) == tg, bar);
            __builtin_amdgcn_fence(__ATOMIC_ACQUIRE, "agent");
            xb_add(&bar[XB_XGEN(b.x)], 1u);
            asm volatile("s_waitcnt vmcnt(0)" ::: "memory");
        } else {
            XB_SPIN(xb_ld(&bar[XB_XGEN(b.x)]) == gen, bar);
            __builtin_amdgcn_fence(__ATOMIC_ACQUIRE, "agent");
            asm volatile("s_waitcnt vmcnt(0)" ::: "memory");
        }
    }
    __syncthreads();
}

struct Frame {
    LAS unsigned char* lds;
    volatile LAS unsigned* MISC;
    int tid, lane, wave;
    int vcu, G;
    const float *x, *norm_mix, *w_in, *w_pool, *pool_scale, *w_out, *norm_ffn, *w_query, *sub_keys, *expert_u, *expert_v, *norm_final;
    float* out;
    unsigned char* ws;
};

__device__ __forceinline__ float wave_sum(float v) {
#pragma unroll
    for (int o = 1; o < 64; o <<= 1) v += __shfl_xor(v, o);
    return v;
}

__device__ __forceinline__ void p0_transpose_item(const float* W, int N, const float* ks, bf16* WT, int ldo, int col_off, LAS float* scr, int item, int lane) {
    const int nblk = N / 32, kb = item / nblk, nb = item % nblk, k0 = 64 * kb, n0 = 32 * nb;
#pragma unroll 8
    for (int i = 0; i < 32; ++i) { const int kk = 2 * i + (lane >> 5); const float s = ks ? ks[k0 + kk] : 1.f; scr[kk * 33 + (lane & 31)] = W[(size_t)(k0 + kk) * N + n0 + (lane & 31)] * s; }
    LDS_WAIT(); asm volatile("" ::: "memory");
    const int c = lane & 7;
#pragma unroll
    for (int j = 0; j < 4; ++j) { const int n = (lane >> 3) + 8 * j; const LAS float* s = scr + (8 * c) * 33 + n;
        v4u o; o.x = pk2(s[0 * 33], s[1 * 33]); o.y = pk2(s[2 * 33], s[3 * 33]); o.z = pk2(s[4 * 33], s[5 * 33]); o.w = pk2(s[6 * 33], s[7 * 33]);
        *(GAS v4u*)(WT + (size_t)(n0 + n) * ldo + col_off + k0 + 8 * c) = o; }
    LDS_WAIT(); asm volatile("" ::: "memory");
}

__device__ __forceinline__ void p0_prologue(Frame& F) {
    LAS float* scr = (LAS float*)(F.lds + RING_OFF + F.wave * 16384);
    const int gw = F.vcu * NWAVES + F.wave, NGW = F.G * NWAVES;
    bf16* WIN = (bf16*)(F.ws + WS_WIN); bf16* WOUT = (bf16*)(F.ws + WS_WOUT); bf16* WSC = (bf16*)(F.ws + WS_WSC);
    constexpr int I_IN = (D / 64) * (NZ / 32), I_OUT = (DATT / 64) * (D / 32);
    for (int it = gw; it < I_IN + I_OUT; it += NGW) {
        if (it < I_IN) p0_transpose_item(F.w_in, NZ, F.norm_mix, WIN, D, 0, scr, it, F.lane);
        else p0_transpose_item(F.w_out, D, nullptr, WOUT, D, 0, scr, it - I_IN, F.lane);
    }
    const int gt = (F.vcu * NWAVES + F.wave) * 64 + F.lane, NGT = F.G * NWAVES * 64;
    for (int it = gt; it < DPOOL * (D / 4); it += NGT) {
        const int cin = it / (D / 4), n4 = (it % (D / 4)) * 4, g = cin >> 7;
        const float* wp = F.w_pool + (size_t)cin * 128;
        const float* ps = F.pool_scale + g * 128;
        const float* wo = F.w_out + (size_t)(DATT + g * 128) * D + n4;
        f32x4 acc = {0.f, 0.f, 0.f, 0.f};
#pragma unroll 16
        for (int d = 0; d < 128; ++d) { const float a = wp[d] * ps[d]; const f32x4 b = *(const f32x4*)(wo + (size_t)d * D); acc += a * b; }
#pragma unroll
        for (int j = 0; j < 4; ++j) WOUT[(size_t)(n4 + j) * D + DATT + cin] = (bf16)f2bf(acc[j]);
    }
    {
        LAS float* sk = (LAS float*)(F.lds + RING_OFF);
        for (int base = F.vcu * NWAVES; base < 16 * 128; base += F.G * NWAVES) {
            const int blk = base >> 7;
            __syncthreads();
            for (int idx = F.tid; idx < 128 * 32; idx += NWAVES * 64) { const int key = idx >> 5, c4 = (idx & 31) * 4;
                *(LAS f32x4*)(sk + key * 132 + c4) = *(const f32x4*)(F.sub_keys + (size_t)(blk * 128 + key) * 128 + c4); }
            __syncthreads();
            const int d0 = ((base + F.wave) & 127) * 8;
            const float* wq = F.w_query + (size_t)d0 * NSC + blk * 128;
            LAS float* wql = (LAS float*)(F.lds + RING_OFF + 128 * 132 * 4 + F.wave * 4096);
#pragma unroll
            for (int j = 0; j < 4; ++j) { const int r = 2 * j + (F.lane >> 5), cc = (F.lane & 31) * 4; *(LAS f32x4*)(wql + r * 128 + cc) = *(const f32x4*)(wq + (size_t)r * NSC + cc); }
            LDS_WAIT(); asm volatile("" ::: "memory");
            float acc[2][8];
#pragma unroll
            for (int i = 0; i < 2; ++i)
#pragma unroll
                for (int j = 0; j < 8; ++j) acc[i][j] = 0.f;
#pragma unroll 2
            for (int c = 0; c < 128; c += 4) {
                const f32x4 a0 = *(const LAS f32x4*)(sk + (2 * F.lane) * 132 + c), a1 = *(const LAS f32x4*)(sk + (2 * F.lane + 1) * 132 + c);
#pragma unroll
                for (int j = 0; j < 8; ++j) { const f32x4 wv = *(const LAS f32x4*)(wql + j * 128 + c);
                    acc[0][j] += a0[0] * wv[0] + a0[1] * wv[1] + a0[2] * wv[2] + a0[3] * wv[3]; acc[1][j] += a1[0] * wv[0] + a1[1] * wv[1] + a1[2] * wv[2] + a1[3] * wv[3]; }
            }
            const f32x4 g0 = *(const f32x4*)(F.norm_ffn + d0), g1 = *(const f32x4*)(F.norm_ffn + d0 + 4);
#pragma unroll
            for (int i = 0; i < 2; ++i) { v4u o; o.x = pk2(acc[i][0] * g0[0], acc[i][1] * g0[1]); o.y = pk2(acc[i][2] * g0[2], acc[i][3] * g0[3]); o.z = pk2(acc[i][4] * g1[0], acc[i][5] * g1[1]); o.w = pk2(acc[i][6] * g1[2], acc[i][7] * g1[3]);
                *(GAS v4u*)(WSC + (size_t)(blk * 128 + 2 * F.lane + i) * D + d0) = o; }
        }
        __syncthreads();
    }
    {
        bf16* XB = (bf16*)(F.ws + WS_XB); float* R1 = (float*)(F.ws + WS_R1);
        for (int m0 = gw * 4; m0 < M; m0 += NGW * 4) {
            f32x4 a[4][4];
#pragma unroll
            for (int r = 0; r < 4; ++r) { const float* xr = F.x + (size_t)(m0 + r) * D + 8 * F.lane;
                a[r][0] = *(const f32x4*)(xr); a[r][1] = *(const f32x4*)(xr + 4); a[r][2] = *(const f32x4*)(xr + 512); a[r][3] = *(const f32x4*)(xr + 516); }
#pragma unroll
            for (int r = 0; r < 4; ++r) { float s = 0.f;
#pragma unroll
                for (int q = 0; q < 4; ++q) s += (a[r][q][0] * a[r][q][0] + a[r][q][1] * a[r][q][1]) + (a[r][q][2] * a[r][q][2] + a[r][q][3] * a[r][q][3]);
#pragma unroll
                for (int j = 0; j < 2; ++j) { v4u o; o.x = pk2(a[r][2 * j][0], a[r][2 * j][1]); o.y = pk2(a[r][2 * j][2], a[r][2 * j][3]); o.z = pk2(a[r][2 * j + 1][0], a[r][2 * j + 1][1]); o.w = pk2(a[r][2 * j + 1][2], a[r][2 * j + 1][3]);
                    *(GAS v4u*)(XB + (size_t)(m0 + r) * D + 8 * F.lane + 512 * j) = o; }
                s = wave_sum(s);
                if (F.lane == 0) R1[m0 + r] = 1.0f / sqrtf(s * (1.0f / D) + EPS); }
        }
    }
}

constexpr int ATT_KEYS = 384, ATT_KCH = ATT_KEYS * 16 + 16;
constexpr int ATT_K_OFF = 0, ATT_V_OFF = 8 * ATT_KCH;
constexpr int ATT_VDH = 24 * 1024 + 64;
constexpr int ATT_OST_OFF = ATT_V_OFF + 2 * ATT_VDH;
constexpr int ATT_LDS_END = ATT_OST_OFF + NWAVES * 4096;
static_assert(ATT_V_OFF % 16 == 0 && ATT_OST_OFF % 16 == 0 && ATT_LDS_END <= LDSCTL_OFF, "attention LDS map");
constexpr int ATT_UNITS = BATCH * NH * 96;

__device__ __forceinline__ int crow(int r, int hi) { return (r & 3) + 8 * (r >> 2) + 4 * hi; }
__device__ __forceinline__ s16x4 vtr(const LAS unsigned char* p) { return __builtin_bit_cast(s16x4, __builtin_amdgcn_ds_read_tr16_b64_v4i16((LAS s16x4*)p)); }

struct AttnDec { int b, h, br, dsh, pair, s0, res; size_t tokbase; };
__device__ __forceinline__ AttnDec attn_decode(int unit) {
    AttnDec d; const int bh = unit / 96, rem = unit % 96, idx = rem & 31;
    d.br = rem >> 5; d.b = bh >> 3; d.h = bh & 7; d.dsh = 2 * d.br;
    const int ppr = 32 >> d.dsh;
    const int res = idx / ppr; d.res = res; d.pair = idx % ppr; d.s0 = d.pair * 256 - 128;
    d.tokbase = (size_t)d.b * SEQ + res; return d;
}
__device__ __forceinline__ void attn_fetch(Frame& F, int unit, v4u (&kv)[6], v4u (&vv)[6]) {
    const AttnDec d = attn_decode(unit); const bf16* ZHh = (const bf16*)(F.ws + WS_Z) + ((size_t)(d.b * NH + d.h) * SEQ + d.res) * HD;
    int tid = F.tid; asm volatile("" : "+v"(tid));
#pragma unroll
    for (int it = 0; it < 6; ++it) { const int p = tid + 512 * it, key = p >> 3, c = p & 7; int s = d.s0 + key; s = s < 0 ? 0 : s;
        const bf16* row = ZHh + ((size_t)s << d.dsh) * HD + c * 8;
        kv[it] = *(const GAS v4u*)(row + (size_t)M * DATT); vv[it] = *(const GAS v4u*)(row + (size_t)2 * M * DATT); }
}
__device__ __forceinline__ void attn_fetch_q(Frame& F, int unit, bf16x8 (&qr)[4]) {
    const AttnDec d = attn_decode(unit); const bf16* ZHh = (const bf16*)(F.ws + WS_Z) + ((size_t)(d.b * NH + d.h) * SEQ + d.res) * HD;
    int ln = F.lane; asm volatile("" : "+v"(ln));
    const int r32 = ln & 31, hi = ln >> 5, sq0 = d.pair * 256 + 32 * F.wave;
    const bf16* qrow = ZHh + ((size_t)(sq0 + r32) << d.dsh) * HD + hi * 8;
#pragma unroll
    for (int d0 = 0; d0 < 4; ++d0) qr[d0] = *(const GAS bf16x8*)(qrow + d0 * 16);
}
__device__ __forceinline__ void attn_stage(Frame& F, const v4u (&kv)[6], const v4u (&vv)[6]) {
    int tid = F.tid; asm volatile("" : "+v"(tid));
#pragma unroll
    for (int it = 0; it < 6; ++it) { const int p = tid + 512 * it, key = p >> 3, c = p & 7;
        *(LAS v4u*)(F.lds + ATT_K_OFF + c * ATT_KCH + key * 16) = kv[it];
        *(LAS v4u*)(F.lds + ATT_V_OFF + (c >> 2) * ATT_VDH + (key >> 4) * 1024 + (key & 15) * 64 + (c & 3) * 16) = vv[it]; }
}

__device__ __forceinline__ void attn_compute(Frame& F, int unit, const bf16x8 (&qr)[4]) {
    int lane = F.lane; asm volatile("" : "+v"(lane));
    const int w = F.wave, r32 = lane & 31, hi = lane >> 5;
    const AttnDec dd = attn_decode(unit);
    const int h = dd.h, br = dd.br, dsh = dd.dsh, pair = dd.pair; const size_t tokbase = dd.tokbase;
    const int sq0 = pair * 256 + 32 * w;
    f32x16 p[5];
#pragma unroll
    for (int j = 0; j < 5; ++j) {
        p[j] = f32x16{};
        const LAS unsigned char* kb = F.lds + ATT_K_OFF + hi * ATT_KCH + (32 * (w + j) + r32) * 16;
#pragma unroll
        for (int d0 = 0; d0 < 4; ++d0) { const bf16x8 kf = *(const LAS bf16x8*)(kb + 2 * d0 * ATT_KCH); p[j] = __builtin_amdgcn_mfma_f32_32x32x16_bf16(kf, qr[d0], p[j], 0, 0, 0); }
    }
    const float NEGB = -1e30f;
#pragma unroll
    for (int r = 0; r < 16; ++r) { const int kj = crow(r, hi); if (kj < r32) p[0][r] = NEGB; if (kj > r32) p[4][r] = NEGB; }
    if (pair == 0) {
#pragma unroll
        for (int j = 0; j < 4; ++j) if (w + j < 4) {
#pragma unroll
            for (int r = 0; r < 16; ++r) p[j][r] = NEGB; }
    }
    float mx = NEGB;
#pragma unroll
    for (int j = 0; j < 5; ++j)
#pragma unroll
        for (int r = 0; r < 16; ++r) mx = fmaxf(mx, p[j][r]);
    mx = fmaxf(mx, __shfl_xor(mx, 32));
    float l = 0.f;
#pragma unroll
    for (int j = 0; j < 5; ++j)
#pragma unroll
        for (int r = 0; r < 16; ++r) { const float e = __builtin_amdgcn_exp2f(p[j][r] - mx); p[j][r] = e; l += e; }
    l += __shfl_xor(l, 32);
    f32x16 o[2]; o[0] = f32x16{}; o[1] = f32x16{};
    const LAS unsigned char* vb = F.lds + ATT_V_OFF + (4 * hi + ((lane & 15) >> 2)) * 64 + ((lane >> 4) & 1) * 32 + (lane & 3) * 8;
#pragma unroll
    for (int j = 0; j < 5; ++j)
#pragma unroll
        for (int s = 0; s < 2; ++s) {
            v4u pw; pw.x = pk2(p[j][8 * s + 0], p[j][8 * s + 1]); pw.y = pk2(p[j][8 * s + 2], p[j][8 * s + 3]); pw.z = pk2(p[j][8 * s + 4], p[j][8 * s + 5]); pw.w = pk2(p[j][8 * s + 6], p[j][8 * s + 7]);
            const bf16x8 pa = __builtin_bit_cast(bf16x8, pw);
#pragma unroll
            for (int dh = 0; dh < 2; ++dh) {
                const LAS unsigned char* vp = vb + dh * ATT_VDH + (2 * (w + j) + s) * 1024;
                const s16x4 lo = vtr(vp), hh = vtr(vp + 512);
                const bf16x8 vf = (bf16x8){lo[0], lo[1], lo[2], lo[3], hh[0], hh[1], hh[2], hh[3]};
                o[dh] = __builtin_amdgcn_mfma_f32_32x32x16_bf16(pa, vf, o[dh], 0, 0, 0);
            }
        }
    const float rl = 1.0f / l;
    bf16* OB = (bf16*)(F.ws + WS_OB) + (size_t)br * M * DATT;
    float* LSE = (float*)(F.ws + WS_LSE) + (size_t)br * M * NH;
    LAS bf16* stg = (LAS bf16*)(F.lds + ATT_OST_OFF + w * 4096);
#pragma unroll
    for (int r = 0; r < 16; ++r) { const int orow = crow(r, hi); const float rr = __shfl(rl, orow);
        { const unsigned w2 = pk2(o[0][r] * rr, o[1][r] * rr); stg[orow * 64 + r32] = (bf16)(w2 & 0xffffu); stg[orow * 64 + 32 + r32] = (bf16)(w2 >> 16); } }
    if (hi == 0) LSE[(tokbase + ((size_t)(sq0 + r32) << dsh)) * NH + h] = mx + __builtin_amdgcn_logf(l);
    LDS_WAIT();
#pragma unroll
    for (int i = 0; i < 4; ++i) { const int row = i * 8 + (lane >> 3), ch = lane & 7; const v4u v = *(const LAS v4u*)(stg + row * 64 + ch * 8);
        *(GAS v4u*)(OB + (tokbase + ((size_t)(sq0 + row) << dsh)) * DATT + h * HD + ch * 8) = v; }
}


__device__ __forceinline__ void pool_rows(Frame& F) {
    const bf16* ZP = (const bf16*)(F.ws + WS_ZP); bf16* MIX = (bf16*)(F.ws + WS_MIX);
    const int gw = F.vcu * NWAVES + F.wave, NGW = F.G * NWAVES;
    const int win = 2 << (F.lane >> 4);
    constexpr int TPW = 16;
    for (int it = gw; it < M / TPW; it += NGW) {
        const int tb = it * TPW, sb = tb & (SEQ - 1);
        const bf16* zc = ZP + (size_t)tb * DPOOL + 8 * F.lane;
        v4u rows[31];
#pragma unroll
        for (int k = 0; k < 31; ++k) { const int s = sb - 15 + k; rows[k] = (s >= 0) ? *(const GAS v4u*)(zc + (long)(k - 15) * DPOOL) : (v4u){0u, 0u, 0u, 0u}; }
        float ps[8];
#pragma unroll
        for (int e = 0; e < 8; ++e) ps[e] = 0.f;
#pragma unroll
        for (int k = 0; k < 15; ++k) if (k >= 16 - win) { const v4u v = rows[k];
            ps[0] += bflo(v.x); ps[1] += bfhi(v.x); ps[2] += bflo(v.y); ps[3] += bfhi(v.y); ps[4] += bflo(v.z); ps[5] += bfhi(v.z); ps[6] += bflo(v.w); ps[7] += bfhi(v.w); }
#pragma unroll
        for (int i = 0; i < TPW; ++i) {
            const int s = sb + i; const v4u z0 = rows[15 + i];
            ps[0] += bflo(z0.x); ps[1] += bfhi(z0.x); ps[2] += bflo(z0.y); ps[3] += bfhi(z0.y); ps[4] += bflo(z0.z); ps[5] += bfhi(z0.z); ps[6] += bflo(z0.w); ps[7] += bfhi(z0.w);
            const int cnt = (s + 1) < win ? (s + 1) : win; const float inv = 1.0f / (float)cnt;
            v4u o; o.x = pk2(ps[0] * inv - bflo(z0.x), ps[1] * inv - bfhi(z0.x)); o.y = pk2(ps[2] * inv - bflo(z0.y), ps[3] * inv - bfhi(z0.y));
            o.z = pk2(ps[4] * inv - bflo(z0.z), ps[5] * inv - bfhi(z0.z)); o.w = pk2(ps[6] * inv - bflo(z0.w), ps[7] * inv - bfhi(z0.w));
            *(GAS v4u*)(MIX + (size_t)(tb + i) * D + DATT + 8 * F.lane) = o;
            const v4u l2 = rows[15 + i - 1], l4 = rows[15 + i - 3], l8 = rows[15 + i - 7], l16 = rows[15 + i - 15];
            const v4u v = (win == 2) ? l2 : (win == 4) ? l4 : (win == 8) ? l8 : l16;
            ps[0] -= bflo(v.x); ps[1] -= bfhi(v.x); ps[2] -= bflo(v.y); ps[3] -= bfhi(v.y); ps[4] -= bflo(v.z); ps[5] -= bfhi(v.z); ps[6] -= bflo(v.w); ps[7] -= bfhi(v.w);
        }
    }
}

__device__ __forceinline__ void merge_rows(Frame& F) {
    const bf16* OB = (const bf16*)(F.ws + WS_OB); const float* LSE = (const float*)(F.ws + WS_LSE); bf16* MIX = (bf16*)(F.ws + WS_MIX);
    const int gw = F.vcu * NWAVES + F.wave, NGW = F.G * NWAVES;
#pragma unroll 2
    for (int t = gw; t < M; t += NGW) {
        const int h = F.lane >> 3;
        const float l0 = LSE[(size_t)t * NH + h], l1 = LSE[(size_t)(M + t) * NH + h], l2 = LSE[(size_t)(2 * M + t) * NH + h];
        const size_t off = (size_t)t * DATT + 8 * F.lane;
        const v4u a = *(const GAS v4u*)(OB + off), b = *(const GAS v4u*)(OB + (size_t)M * DATT + off), c = *(const GAS v4u*)(OB + (size_t)2 * M * DATT + off);
        const float mx = fmaxf(l0, fmaxf(l1, l2));
        float w0 = __builtin_amdgcn_exp2f(l0 - mx), w1 = __builtin_amdgcn_exp2f(l1 - mx), w2 = __builtin_amdgcn_exp2f(l2 - mx);
        const float inv = 1.0f / (w0 + w1 + w2); w0 *= inv; w1 *= inv; w2 *= inv;
        v4u o;
        o.x = pk2(w0 * bflo(a.x) + w1 * bflo(b.x) + w2 * bflo(c.x), w0 * bfhi(a.x) + w1 * bfhi(b.x) + w2 * bfhi(c.x));
        o.y = pk2(w0 * bflo(a.y) + w1 * bflo(b.y) + w2 * bflo(c.y), w0 * bfhi(a.y) + w1 * bfhi(b.y) + w2 * bfhi(c.y));
        o.z = pk2(w0 * bflo(a.z) + w1 * bflo(b.z) + w2 * bflo(c.z), w0 * bfhi(a.z) + w1 * bfhi(b.z) + w2 * bfhi(c.z));
        o.w = pk2(w0 * bflo(a.w) + w1 * bflo(b.w) + w2 * bflo(c.w), w0 * bfhi(a.w) + w1 * bfhi(b.w) + w2 * bfhi(c.w));
        *(GAS v4u*)(MIX + (size_t)t * D + 8 * F.lane) = o;
    }
}

constexpr int TK_ROW = 68;
constexpr int TK_WAVE_BYTES = 64 * TK_ROW * 4;
static_assert(NWAVES * TK_WAVE_BYTES <= LDSCTL_OFF, "top-k LDS map");

__device__ __forceinline__ unsigned f2ord(float f) { const unsigned u = __builtin_bit_cast(unsigned, f); return (u & 0x80000000u) ? ~u : (u | 0x80000000u); }
__device__ __forceinline__ float ord2f(unsigned k) { const unsigned u = (k & 0x80000000u) ? (k & 0x7fffffffu) : ~k; return __builtin_bit_cast(float, u); }
#define TK_CE(a, b) do { const unsigned hi_ = max(a, b), lo_ = min(a, b); a = hi_; b = lo_; } while (0)
#define TK_SORT16(N) do { TK_CE(N[0], N[1]); TK_CE(N[2], N[3]); TK_CE(N[0], N[2]); TK_CE(N[1], N[3]); TK_CE(N[1], N[2]); TK_CE(N[4], N[5]); TK_CE(N[6], N[7]); TK_CE(N[4], N[6]); TK_CE(N[5], N[7]); TK_CE(N[5], N[6]); TK_CE(N[0], N[4]); TK_CE(N[2], N[6]); TK_CE(N[2], N[4]); TK_CE(N[1], N[5]); TK_CE(N[3], N[7]); TK_CE(N[3], N[5]); TK_CE(N[1], N[2]); TK_CE(N[3], N[4]); TK_CE(N[5], N[6]); TK_CE(N[8], N[9]); TK_CE(N[10], N[11]); TK_CE(N[8], N[10]); TK_CE(N[9], N[11]); TK_CE(N[9], N[10]); TK_CE(N[12], N[13]); TK_CE(N[14], N[15]); TK_CE(N[12], N[14]); TK_CE(N[13], N[15]); TK_CE(N[13], N[14]); TK_CE(N[8], N[12]); TK_CE(N[10], N[14]); TK_CE(N[10], N[12]); TK_CE(N[9], N[13]); TK_CE(N[11], N[15]); TK_CE(N[11], N[13]); TK_CE(N[9], N[10]); TK_CE(N[11], N[12]); TK_CE(N[13], N[14]); TK_CE(N[0], N[8]); TK_CE(N[4], N[12]); TK_CE(N[4], N[8]); TK_CE(N[2], N[10]); TK_CE(N[6], N[14]); TK_CE(N[6], N[10]); TK_CE(N[2], N[4]); TK_CE(N[6], N[8]); TK_CE(N[10], N[12]); TK_CE(N[1], N[9]); TK_CE(N[5], N[13]); TK_CE(N[5], N[9]); TK_CE(N[3], N[11]); TK_CE(N[7], N[15]); TK_CE(N[7], N[11]); TK_CE(N[3], N[5]); TK_CE(N[7], N[9]); TK_CE(N[11], N[13]); TK_CE(N[1], N[2]); TK_CE(N[3], N[4]); TK_CE(N[5], N[6]); TK_CE(N[7], N[8]); TK_CE(N[9], N[10]); TK_CE(N[11], N[12]); TK_CE(N[13], N[14]); } while (0)
#define TK_BMERGE16(L) do { TK_CE(L[0], L[8]); TK_CE(L[1], L[9]); TK_CE(L[2], L[10]); TK_CE(L[3], L[11]); TK_CE(L[4], L[12]); TK_CE(L[5], L[13]); TK_CE(L[6], L[14]); TK_CE(L[7], L[15]); TK_CE(L[0], L[4]); TK_CE(L[1], L[5]); TK_CE(L[2], L[6]); TK_CE(L[3], L[7]); TK_CE(L[8], L[12]); TK_CE(L[9], L[13]); TK_CE(L[10], L[14]); TK_CE(L[11], L[15]); TK_CE(L[0], L[2]); TK_CE(L[1], L[3]); TK_CE(L[4], L[6]); TK_CE(L[5], L[7]); TK_CE(L[8], L[10]); TK_CE(L[9], L[11]); TK_CE(L[12], L[14]); TK_CE(L[13], L[15]); TK_CE(L[0], L[1]); TK_CE(L[2], L[3]); TK_CE(L[4], L[5]); TK_CE(L[6], L[7]); TK_CE(L[8], L[9]); TK_CE(L[10], L[11]); TK_CE(L[12], L[13]); TK_CE(L[14], L[15]); } while (0)
#define TK_INSERT(L, xin) do { unsigned x_ = (xin); _Pragma("unroll") for (int i_ = 0; i_ < 16; ++i_) { const unsigned hi_ = max(L[i_], x_); x_ = min(L[i_], x_); L[i_] = hi_; } } while (0)

constexpr int EXP_NCH = 2 * NEXP;
__device__ __forceinline__ void expcvt_load(Frame& F, int ci, f32x4 (&a)[4], int lane) {
    const float* src = (ci < NEXP ? F.expert_u + (size_t)ci * D : F.expert_v + (size_t)(ci - NEXP) * D) + 16 * lane;
#pragma unroll
    for (int q = 0; q < 4; ++q) a[q] = *(const GAS f32x4*)(src + 4 * q);
}
constexpr float EV8_SCALE = 112.0f;
__device__ __forceinline__ void expcvt_store(Frame& F, int ci, const f32x4 (&a)[4], int lane) {
    const bool isu = ci < NEXP; v4u o;
    if (isu) {
        f32x4 v[4];
#pragma unroll
        for (int q = 0; q < 4; ++q) { v[q] = a[q] * 56.0f; v[q] = v[q] * *(const GAS f32x4*)(F.norm_ffn + 16 * lane + 4 * q); }
        unsigned w2[2];
        w2[0] = __builtin_amdgcn_cvt_scalef32_pk_fp4_f32(0u, v[0][0], v[0][1], 1.0f, 0); w2[0] = __builtin_amdgcn_cvt_scalef32_pk_fp4_f32(w2[0], v[0][2], v[0][3], 1.0f, 1);
        w2[0] = __builtin_amdgcn_cvt_scalef32_pk_fp4_f32(w2[0], v[1][0], v[1][1], 1.0f, 2); w2[0] = __builtin_amdgcn_cvt_scalef32_pk_fp4_f32(w2[0], v[1][2], v[1][3], 1.0f, 3);
        w2[1] = __builtin_amdgcn_cvt_scalef32_pk_fp4_f32(0u, v[2][0], v[2][1], 1.0f, 0); w2[1] = __builtin_amdgcn_cvt_scalef32_pk_fp4_f32(w2[1], v[2][2], v[2][3], 1.0f, 1);
        w2[1] = __builtin_amdgcn_cvt_scalef32_pk_fp4_f32(w2[1], v[3][0], v[3][1], 1.0f, 2); w2[1] = __builtin_amdgcn_cvt_scalef32_pk_fp4_f32(w2[1], v[3][2], v[3][3], 1.0f, 3);
        *(GAS v2u*)(F.ws + WS_EU + (size_t)ci * (D / 2) + 8 * lane) = (v2u){w2[0], w2[1]};
        return;
    } else {
#pragma unroll
        for (int q = 0; q < 4; ++q) { unsigned w = 0;
#pragma unroll
            for (int e = 0; e < 4; ++e) { float r = __builtin_rintf(a[q][e] * EV8_SCALE); r = __builtin_fminf(__builtin_fmaxf(r, -127.0f), 127.0f); w |= ((unsigned)(int)r & 0xffu) << (8 * e); }
            o[q] = w; }
    }
    unsigned char* dst = F.ws + WS_EV + (size_t)(ci - NEXP) * D + 16 * lane;
    *(GAS v4u*)dst = o;
}

__device__ __forceinline__ void tk_fetch(const unsigned short* SCH, int t0, int rnd, v4u (&sn)[8], int lane) {
    const int p = rnd >> 1, kc = rnd & 1;
#pragma unroll
    for (int i = 0; i < 8; ++i) { const int pr = 8 * i + (lane >> 3), tl = pr >> 3, h = pr & 7;
        sn[i] = *(const GAS v4u*)(SCH + (size_t)(t0 + tl) * NSC + h * 256 + p * 128 + kc * 64 + (lane & 7) * 8); }
}

__device__ __forceinline__ void topk_phase(Frame& F) {
    const unsigned short* SCH = (const unsigned short*)(F.ws + WS_SCH); const float* SS = (const float*)(F.ws + WS_SS);
    int* IDX = (int*)(F.ws + WS_IDX); float* GATE = (float*)(F.ws + WS_GATE);
    const int gw = F.vcu * NWAVES + F.wave, NGW = F.G * NWAVES, lane = F.lane;
    LAS float* st = (LAS float*)(F.lds + F.wave * TK_WAVE_BYTES);
    int cnext = gw;
    v4u sn[8];
    for (int it = gw; it < M / 8; it += NGW) {
        const int t0 = it * 8;
        unsigned L0[16], L1[16];
#pragma unroll
        for (int i = 0; i < 16; ++i) { L0[i] = 0u; L1[i] = 0u; }
        if (it == gw) tk_fetch(SCH, t0, 0, sn, lane);
#pragma unroll
        for (int rnd = 0; rnd < 4; ++rnd) {
            const int p = rnd >> 1, kc = rnd & 1;
            v4u sc[8];
#pragma unroll
            for (int i = 0; i < 8; ++i) sc[i] = sn[i];
            if (rnd < 3) tk_fetch(SCH, t0, rnd + 1, sn, lane); else if (it + NGW < M / 8) tk_fetch(SCH, (it + NGW) * 8, 0, sn, lane);
            f32x4 xa[4], xb[4]; const int c0 = cnext, c1 = cnext + NGW;
            if (c0 < EXP_NCH) expcvt_load(F, c0, xa, lane); if (c1 < EXP_NCH) expcvt_load(F, c1, xb, lane);
#pragma unroll
            for (int i = 0; i < 8; ++i) { const int pr = 8 * i + (lane >> 3);
                const v4u v = sc[i];
                f32x4 lo, hi;
#pragma unroll
                for (int e = 0; e < 2; ++e) { const unsigned wa = v[e], wb = v[2 + e];
                    const pg8::f16x2_t a = __builtin_bit_cast(pg8::f16x2_t, wa), b = __builtin_bit_cast(pg8::f16x2_t, wb);
                    lo[2 * e] = (float)a.x; lo[2 * e + 1] = (float)a.y; hi[2 * e] = (float)b.x; hi[2 * e + 1] = (float)b.y; }
                *(LAS f32x4*)(st + pr * TK_ROW + (lane & 7) * 8) = lo; *(LAS f32x4*)(st + pr * TK_ROW + (lane & 7) * 8 + 4) = hi; }
            LDS_WAIT(); asm volatile("" ::: "memory");
#pragma unroll 1
            for (int q = 0; q < 4; ++q) {
                unsigned N[16];
#pragma unroll
                for (int u = 0; u < 4; ++u) { const f32x4 v = *(const LAS f32x4*)(st + lane * TK_ROW + q * 16 + u * 4);
#pragma unroll
                    for (int e = 0; e < 4; ++e) N[4 * u + e] = (f2ord(v[e]) & ~127u) | (unsigned)(127 - (kc * 64 + q * 16 + u * 4 + e)); }
                TK_SORT16(N);
                if (p == 0) {
#pragma unroll
                    for (int i = 0; i < 16; ++i) L0[i] = max(L0[i], N[15 - i]);
                    TK_BMERGE16(L0);
                } else {
#pragma unroll
                    for (int i = 0; i < 16; ++i) L1[i] = max(L1[i], N[15 - i]);
                    TK_BMERGE16(L1);
                }
            }
            if (c0 < EXP_NCH) expcvt_store(F, c0, xa, lane); if (c1 < EXP_NCH) expcvt_store(F, c1, xb, lane);
            cnext += 2 * NGW;
            LDS_WAIT(); asm volatile("" ::: "memory");
        }
        LAS float* pv0 = st; LAS float* pv1 = st + 16 * 64; LAS int* pi0 = (LAS int*)(st + 32 * 64); LAS int* pi1 = (LAS int*)(st + 48 * 64);
        float v0[16], v1[16];
#pragma unroll
        for (int i = 0; i < 16; ++i) { v0[i] = ord2f(L0[i] & ~127u); v1[i] = ord2f(L1[i] & ~127u);
            pv0[i * 64 + lane] = v0[i]; pv1[i * 64 + lane] = v1[i]; pi0[i * 64 + lane] = 127 - (int)(L0[i] & 127u); pi1[i * 64 + lane] = 127 - (int)(L1[i] & 127u); }
        unsigned T[16];
#pragma unroll
        for (int i = 0; i < 16; ++i) T[i] = 0u;
        {
            unsigned N[16]; int nn = 0;
#pragma unroll
            for (int i = 0; i < 16; ++i)
#pragma unroll
                for (int j = 0; j < 16; ++j) if ((i + 1) * (j + 1) <= 16) {
                    N[nn & 15] = (f2ord(v0[i] + v1[j]) & ~255u) | (unsigned)(255 - (i * 16 + j)); ++nn;
                    if ((nn & 15) == 0 || nn == 50) {
                        if (nn == 50) { N[2] = 0u; N[3] = 0u; N[4] = 0u; N[5] = 0u; N[6] = 0u; N[7] = 0u; N[8] = 0u; N[9] = 0u; N[10] = 0u; N[11] = 0u; N[12] = 0u; N[13] = 0u; N[14] = 0u; N[15] = 0u; }
                        TK_SORT16(N);
#pragma unroll
                        for (int q = 0; q < 16; ++q) T[q] = max(T[q], N[15 - q]);
                        TK_BMERGE16(T);
                    }
                }
        }
        LDS_WAIT(); asm volatile("" ::: "memory");
        const int tl = lane >> 3, h = lane & 7, t = t0 + tl;
        float ssum = 0.f;
        { const float* sp = SS + (size_t)t * 16;
#pragma unroll
          for (int i = 0; i < 4; ++i) { const f32x4 v = *(const GAS f32x4*)(sp + 4 * i); ssum += (v[0] + v[1]) + (v[2] + v[3]); } }
        const float r2 = 1.0f / sqrtf(ssum * (1.0f / D) + EPS);
        float bs[16]; int ex[16]; float mxs = -3.0e38f;
#pragma unroll
        for (int k = 0; k < 16; ++k) { const int pos = 255 - (int)(T[k] & 255u), i = pos >> 4, j = pos & 15;
            bs[k] = (pv0[i * 64 + lane] + pv1[j * 64 + lane]) * r2; ex[k] = pi0[i * 64 + lane] * NKEYS + pi1[j * 64 + lane]; mxs = fmaxf(mxs, bs[k]); }
        float den = 0.f;
#pragma unroll
        for (int k = 0; k < 16; ++k) { bs[k] = __expf(bs[k] - mxs); den += bs[k]; }
        const float inv = 1.0f / den;
        int* ip = IDX + ((size_t)t * PEER_H + h) * TOPK; float* gp = GATE + ((size_t)t * PEER_H + h) * TOPK;
#pragma unroll
        for (int k = 0; k < 16; k += 4) { *(GAS v4u*)(ip + k) = (v4u){(unsigned)ex[k], (unsigned)ex[k + 1], (unsigned)ex[k + 2], (unsigned)ex[k + 3]};
            *(GAS f32x4*)(gp + k) = (f32x4){bs[k] * inv, bs[k + 1] * inv, bs[k + 2] * inv, bs[k + 3] * inv}; }
        LDS_WAIT(); asm volatile("" ::: "memory");
    }
    for (; cnext < EXP_NCH; cnext += NGW) { f32x4 xa[4]; expcvt_load(F, cnext, xa, lane); expcvt_store(F, cnext, xa, lane); }
}

typedef float f32x2 __attribute__((ext_vector_type(2)));
typedef long l64x2 __attribute__((ext_vector_type(2)));
constexpr float EU_SCALE = 56.0f, EV_SCALE = 4.0f;
__device__ __forceinline__ float gelu_erf(float v) {
    const float av = __builtin_fabsf(v), t = __builtin_amdgcn_rcpf(av * 0.2316418882f + 1.0f);
    float q = t * 0.5307027145f + (-0.7265760135f); q = q * t + 0.7107068705f; q = q * t + (-0.142248368f); q = q * t + 0.127414796f; q = q * t;
    const float e = __builtin_amdgcn_exp2f((v * v) * (-0.72134752044f));
    const float m = v * (q * e);
    return v < 0.f ? m : v - m;
}
constexpr int PU_WAVE_LDS = 10496;
constexpr int PU_SL = 0, PU_HIST = 8192, PU_DSCR = 9216, PU_CNT = 10240;
static_assert(NWAVES * PU_WAVE_LDS <= LDSCTL_OFF, "PEER U LDS map");
#ifndef PEER_UACT_EXPR
#define PEER_UACT_EXPR gelu_erf(a * (1.0f / EU_SCALE)) * gt
#endif
#ifndef PEER_ACT_EXPR
#define PEER_ACT_EXPR __builtin_bit_cast(float, itv.y)
#endif
#ifndef PEER_V_ITEMS
#define PEER_V_ITEMS 128
#endif
constexpr int PV_LIST = 0, PV_SSP = 32768;

#ifndef PROBE_NOBPERM
#define PROBE_NOBPERM 0
#endif
typedef int v8i_t __attribute__((ext_vector_type(8)));
__device__ __forceinline__ void peer_u_loadA(v4u (&A)[8], const unsigned char* EU, unsigned e, int lane) {
    int l3 = lane & 3; asm volatile("" : "+v"(l3));
    const GAS unsigned char* rowp = (const GAS unsigned char*)EU + (size_t)e * (D / 2) + 16 * l3;
#pragma unroll
    for (int i = 0; i < 8; ++i) A[i] = *(const GAS v4u*)(rowp + 64 * i);
}
template <unsigned EMASK, bool DUMMY> __device__ __forceinline__ void peer_u_phase(Frame& F, int blk) {
    const int* IDX = (const int*)(F.ws + WS_IDX); const float* GATE = (const float*)(F.ws + WS_GATE); const float* SS = (const float*)(F.ws + WS_SS);
    const unsigned char* EU = F.ws + WS_EU; unsigned* VE = (unsigned*)(F.ws + WS_SC); float* VA = (float*)(F.ws + WS_SC + (size_t)M * 128 * 4);
    int lane = F.lane; asm volatile("" : "+v"(lane));
    const int c = lane & 15, g = lane >> 4;
    const int T0 = blk * 128 + F.wave * 16;
    LAS unsigned char* wl = F.lds + F.wave * PU_WAVE_LDS;
    LAS unsigned* SL = (LAS unsigned*)(wl + PU_SL); LAS unsigned* HIST = (LAS unsigned*)(wl + PU_HIST); LAS float* DSCR = (LAS float*)(wl + PU_DSCR); LAS unsigned* CNT = (LAS unsigned*)(wl + PU_CNT);
    *(LAS v4u*)(HIST + 4 * lane) = (v4u){0u, 0u, 0u, 0u};
    if (lane < 16) CNT[lane] = 0u;
    LDS_WAIT(); asm volatile("" ::: "memory");
    unsigned ev[32];
#pragma unroll
    for (int q = 0; q < 32; ++q) ev[q] = (unsigned)IDX[(size_t)T0 * 128 + q * 64 + lane];
#pragma unroll
    for (int q = 0; q < 32; ++q) __hip_atomic_fetch_add(HIST + (ev[q] >> 6), 1u, __ATOMIC_RELAXED, __HIP_MEMORY_SCOPE_WAVEFRONT);
    LDS_WAIT(); asm volatile("" ::: "memory");
    {
        const v4u hv = *(const LAS v4u*)(HIST + 4 * lane); const unsigned tot = hv.x + hv.y + hv.z + hv.w; unsigned inc = tot;
#pragma unroll
        for (int o = 1; o < 64; o <<= 1) { const unsigned n = (unsigned)__shfl_up((int)inc, o); if (lane >= o) inc += n; }
        const unsigned ex = inc - tot;
        LDS_WAIT(); asm volatile("" ::: "memory");
        *(LAS v4u*)(HIST + 4 * lane) = (v4u){ex, ex + hv.x, ex + hv.x + hv.y, ex + hv.x + hv.y + hv.z};
    }
    LDS_WAIT(); asm volatile("" ::: "memory");
#pragma unroll
    for (int q = 0; q < 32; ++q) { const unsigned p = (unsigned)(q * 64 + lane); const unsigned e = ev[q];
        const unsigned pos = __hip_atomic_fetch_add(HIST + (e >> 6), 1u, __ATOMIC_RELAXED, __HIP_MEMORY_SCOPE_WAVEFRONT); SL[pos] = (e << 11) | p; }
    LDS_WAIT(); asm volatile("" ::: "memory");
    v8i_t Bop[8];
    {
        const int tB = T0 + c; float s = 0.f;
#pragma unroll
        for (int i = 0; i < 4; ++i) { const f32x4 v = *(const GAS f32x4*)(SS + (size_t)tB * 16 + 4 * i); s += (v[0] + v[1]) + (v[2] + v[3]); }
        const float r2 = 1.0f / sqrtf(s * (1.0f / D) + EPS);
        int gq = g; asm volatile("" : "+v"(gq));
        const bf16* xp = (const bf16*)(F.ws + WS_XB) + (size_t)tB * D + 16 * gq;
#pragma unroll
        for (int i = 0; i < 8; ++i) { v8i_t o;
#pragma unroll
            for (int k = 0; k < 4; ++k) { const v4u xa = *(const GAS v4u*)(xp + 128 * i + 64 * (k >> 1) + 8 * (k & 1));
#pragma unroll
                for (int q = 0; q < 2; ++q) { const unsigned w0 = xa[2 * q], w1 = xa[2 * q + 1];
                    int w = __builtin_amdgcn_cvt_pk_fp8_f32(bflo(w0) * r2, bfhi(w0) * r2, 0, false); w = __builtin_amdgcn_cvt_pk_fp8_f32(bflo(w1) * r2, bfhi(w1) * r2, w, true); o[2 * k + q] = w; } }
            Bop[i] = o; if ((i & 3) == 3) asm volatile("" : "+v"(Bop[i - 3]), "+v"(Bop[i - 2]), "+v"(Bop[i - 1]), "+v"(Bop[i]) :: "memory"); }
    }
#define PU_TAIL(b) *(LAS f32x4*)(DSCR + 4 * lane) = acc; LDS_WAIT(); asm volatile("" ::: "memory"); if (lane < 16) { const unsigned p = itcur & 2047u, cr = p >> 7, e = itcur >> 11; const float a = DSCR[((lane >> 2) * 16 + cr) * 4 + (lane & 3)]; const float act = PEER_UACT_EXPR; const unsigned pos = __hip_atomic_fetch_add(CNT + cr, 1u, __ATOMIC_RELAXED, __HIP_MEMORY_SCOPE_WAVEFRONT); if (!DUMMY) { VE[(size_t)(T0 + cr) * 128 + pos] = e << 10; VA[(size_t)(T0 + cr) * 128 + pos] = act; }     else if (act == 123.456f) VA[0] = act; } LDS_WAIT(); asm volatile("" ::: "memory");
    v4u A0[8], A1[8];
    const int psrc = (4 * c + g) * 4;
    { const unsigned i0_ = SL[lane >> 2], i1_ = SL[16 + (lane >> 2)];
      peer_u_loadA(A0, EU, (i0_ >> 11) & EMASK, lane); peer_u_loadA(A1, EU, (i1_ >> 11) & EMASK, lane); }
#define PU_STEP(Acur, b) do { \
        const unsigned itcur = SL[16 * (b) + c]; \
        float gt = 0.f; if (lane < 16) gt = GATE[(size_t)T0 * 128 + (itcur & 2047u)]; \
        const int bn = ((b) + 2 < 128) ? (b) + 2 : (b); \
        const unsigned itl = SL[16 * bn + (lane >> 2)]; \
        int l3 = lane & 3; asm volatile("" : "+v"(l3)); \
        const GAS unsigned char* nrow = (const GAS unsigned char*)EU + (size_t)((itl >> 11) & EMASK) * (D / 2) + 16 * l3; \
        f32x4 acc = {0.f, 0.f, 0.f, 0.f}; \
        _Pragma("unroll") for (int i = 0; i < 8; ++i) { v4u t; \
            _Pragma("unroll") for (int w = 0; w < 4; ++w) t[w] = (DUMMY && PROBE_NOBPERM) ? Acur[i][w] : (unsigned)__builtin_amdgcn_ds_bpermute(psrc, (int)Acur[i][w]); \
            Acur[i] = *(const GAS v4u*)(nrow + 64 * i); \
            const v8i_t a8 = {(int)t[0], (int)t[1], (int)t[2], (int)t[3], 0, 0, 0, 0}; \
            acc = __builtin_amdgcn_mfma_scale_f32_16x16x128_f8f6f4(a8, Bop[i], acc, 4  , 0  , 0, 0x7f7f7f7f, 0, 0x7f7f7f7f); } \
        PU_TAIL(b) \
    } while (0)
#pragma unroll 1
    for (int b = 0; b < 128; b += 2) { PU_STEP(A0, b); PU_STEP(A1, b + 1); }
#undef PU_STEP
#undef PU_TAIL
}

template <unsigned EMASK, bool DUMMY, class Bar> __device__ __forceinline__ void peer_v_phase(Frame& F, int blk, const Bar& bar, bool sync) {
    const unsigned char* EV = F.ws + WS_EV; const unsigned* VE = (const unsigned*)(F.ws + WS_SC); const float* VA = (const float*)(F.ws + WS_SC + (size_t)M * 128 * 4);
    int lane = F.lane; asm volatile("" : "+v"(lane));
    const int q = lane >> 3, c = lane & 7, w = F.wave;
    const int CB = blk * 128;
    const LAS unsigned* LE = (const LAS unsigned*)(F.lds + PV_LIST); const LAS unsigned* LA8 = (const LAS unsigned*)(F.lds + PV_LIST + 16384);
    LAS float* SCL = (LAS float*)(F.lds + PV_LIST + 16384 + 4096); LAS float* SSP = (LAS float*)(F.lds + PV_SSP);
    const unsigned voff = 128u * (unsigned)w + 16u * (unsigned)c;
    const __amdgpu_buffer_rsrc_t evr = __builtin_amdgcn_make_buffer_rsrc((void*)EV, 0, NEXP * D, 0x00020000);
#pragma unroll 1
    for (int rd = 0; rd < 4; ++rd) {
        const int TB = CB + 32 * rd;
        if (sync) xcd_barrier(bar); else
        __syncthreads();
        {
            const int tt = F.tid >> 4, sub = F.tid & 15;
            const GAS v4u* se = (const GAS v4u*)(VE + (size_t)TB * 128) + F.tid * 2; LAS v4u* de = (LAS v4u*)(F.lds + PV_LIST) + F.tid * 2;
            const v4u e0 = se[0], e1 = se[1];
            const GAS f32x4* sa = (const GAS f32x4*)(VA + (size_t)TB * 128) + F.tid * 2; const f32x4 a0 = sa[0], a1 = sa[1];
            float am = fmaxf(fmaxf(fmaxf(__builtin_fabsf(a0[0]), __builtin_fabsf(a0[1])), fmaxf(__builtin_fabsf(a0[2]), __builtin_fabsf(a0[3]))), fmaxf(fmaxf(__builtin_fabsf(a1[0]), __builtin_fabsf(a1[1])), fmaxf(__builtin_fabsf(a1[2]), __builtin_fabsf(a1[3]))));
            am = fmaxf(am, __shfl_xor(am, 1)); am = fmaxf(am, __shfl_xor(am, 2)); am = fmaxf(am, __shfl_xor(am, 4)); am = fmaxf(am, __shfl_xor(am, 8));
            am = fmaxf(am, 1e-30f); const float qs = 127.0f / am;
            unsigned p0 = 0, p1 = 0;
#pragma unroll
            for (int e = 0; e < 4; ++e) { p0 |= ((unsigned)(int)__builtin_rintf(a0[e] * qs) & 0xffu) << (8 * e); p1 |= ((unsigned)(int)__builtin_rintf(a1[e] * qs) & 0xffu) << (8 * e); }
            de[0] = e0; de[1] = e1;
            *(LAS v2u*)(F.lds + PV_LIST + 16384 + (tt * 32 + sub * 2) * 4) = (v2u){p0, p1};
            if (sub == 0) SCL[tt] = am * (1.0f / 127.0f);
        }
        __syncthreads();
        int yi[4][16];
#pragma unroll
        for (int gI = 0; gI < 4; ++gI)
#pragma unroll
            for (int e = 0; e < 16; ++e) yi[gI][e] = 0;
        v4u vv[4][4];
#pragma unroll
        for (int ii = 0; ii < 4; ++ii)
#pragma unroll
            for (int gI = 0; gI < 4; ++gI) { const int li = (8 * gI + q) * 128 + ii;
                vv[ii][gI] = __builtin_amdgcn_raw_buffer_load_b128(evr, (int)((LE[li] & (EMASK << 10)) + voff), 0, 0); }
#pragma unroll 1
        for (int i0 = 0; i0 < 128; i0 += 4) {
            const int inx = (i0 + 4 < 128) ? i0 + 4 : i0;
#pragma unroll
            for (int gI = 0; gI < 4; ++gI) {
                const v4u r0 = vv[0][gI], r1 = vv[1][gI], r2 = vv[2][gI], r3 = vv[3][gI];
                const int a4 = (int)LA8[(8 * gI + q) * 32 + (i0 >> 2)];
#pragma unroll
                for (int ii = 0; ii < 4; ++ii) { const int li = (8 * gI + q) * 128 + inx + ii;
                    vv[ii][gI] = __builtin_amdgcn_raw_buffer_load_b128(evr, (int)((LE[li] & (EMASK << 10)) + voff), 0, 0); }
#pragma unroll
                for (int d = 0; d < 4; ++d) {
                    const unsigned P = __builtin_amdgcn_perm(r1[d], r0[d], 0x05010400u), Q = __builtin_amdgcn_perm(r1[d], r0[d], 0x07030602u);
                    const unsigned R = __builtin_amdgcn_perm(r3[d], r2[d], 0x05010400u), S = __builtin_amdgcn_perm(r3[d], r2[d], 0x07030602u);
                    yi[gI][4 * d + 0] = __builtin_amdgcn_sdot4((int)__builtin_amdgcn_perm(R, P, 0x05040100u), a4, yi[gI][4 * d + 0], false);
                    yi[gI][4 * d + 1] = __builtin_amdgcn_sdot4((int)__builtin_amdgcn_perm(R, P, 0x07060302u), a4, yi[gI][4 * d + 1], false);
                    yi[gI][4 * d + 2] = __builtin_amdgcn_sdot4((int)__builtin_amdgcn_perm(S, Q, 0x05040100u), a4, yi[gI][4 * d + 2], false);
                    yi[gI][4 * d + 3] = __builtin_amdgcn_sdot4((int)__builtin_amdgcn_perm(S, Q, 0x07060302u), a4, yi[gI][4 * d + 3], false); }
            }
        }
        f32x2 y[4][8];
#pragma unroll
        for (int gI = 0; gI < 4; ++gI) { const float sc = SCL[8 * gI + q] * (1.0f / EV8_SCALE);
#pragma unroll
            for (int e = 0; e < 8; ++e) y[gI][e] = (f32x2){(float)yi[gI][2 * e] * sc, (float)yi[gI][2 * e + 1] * sc}; }
#pragma unroll
        for (int gI = 0; gI < 4; ++gI) { const bf16* xr = (const bf16*)(F.ws + WS_XB) + (size_t)(TB + 8 * gI + q) * D + voff; float ss = 0.f;
            const v4u xa = *(const GAS v4u*)xr, xb = *(const GAS v4u*)(xr + 8);
#pragma unroll
            for (int j = 0; j < 4; ++j) { const unsigned w0 = (j < 2 ? xa : xb)[2 * (j & 1)], w1 = (j < 2 ? xa : xb)[2 * (j & 1) + 1];
                y[gI][2 * j] += (f32x2){bflo(w0), bfhi(w0)}; y[gI][2 * j + 1] += (f32x2){bflo(w1), bfhi(w1)};
                ss += (y[gI][2 * j].x * y[gI][2 * j].x + y[gI][2 * j].y * y[gI][2 * j].y) + (y[gI][2 * j + 1].x * y[gI][2 * j + 1].x + y[gI][2 * j + 1].y * y[gI][2 * j + 1].y); }
            ss += __shfl_xor(ss, 1); ss += __shfl_xor(ss, 2); ss += __shfl_xor(ss, 4);
            if (c == 0) SSP[(8 * gI + q) * 8 + w] = ss; }
        __syncthreads();
#pragma unroll
        for (int gI = 0; gI < 4; ++gI) { const LAS f32x4* sp = (const LAS f32x4*)(SSP + (8 * gI + q) * 8); const f32x4 s0 = sp[0], s1 = sp[1];
            const float tot = ((s0[0] + s0[1]) + (s0[2] + s0[3])) + ((s1[0] + s1[1]) + (s1[2] + s1[3]));
            const float r3 = 1.0f / sqrtf(tot * (1.0f / D) + EPS);
            float* orow = (DUMMY ? (float*)(F.ws + 192 * MiB) : F.out) + (size_t)(TB + 8 * gI + q) * D + voff;
#pragma unroll
            for (int j = 0; j < 4; ++j) { const f32x4 gn = *(const GAS f32x4*)(F.norm_final + voff + 4 * j);
                *(GAS f32x4*)(orow + 4 * j) = (f32x4){y[gI][2 * j].x * r3 * gn[0], y[gI][2 * j].y * r3 * gn[1], y[gI][2 * j + 1].x * r3 * gn[2], y[gI][2 * j + 1].y * r3 * gn[3]}; } }
    }
}

struct Args { const float* in[12]; float* out; unsigned char* ws; };
__global__ void __launch_bounds__(NWAVES * 64, 2) hymba_fwd(Args args) {
    extern __shared__ __attribute__((aligned(16))) unsigned char lds[];
    Frame F;
    F.lds = (LAS unsigned char*)lds;
    F.MISC = (volatile LAS unsigned*)(F.lds + MISC_OFF);
    F.tid = threadIdx.x; F.lane = F.tid & 63; F.wave = __builtin_amdgcn_readfirstlane(F.tid >> 6);
    F.G = gridDim.x; { const int bx = blockIdx.x; F.vcu = (F.G % 8 == 0) ? (bx % 8) * (F.G / 8) + bx / 8 : bx; }
    F.x = args.in[0]; F.norm_mix = args.in[1]; F.w_in = args.in[2]; F.w_pool = args.in[3]; F.pool_scale = args.in[4]; F.w_out = args.in[5];
    F.norm_ffn = args.in[6]; F.w_query = args.in[7]; F.sub_keys = args.in[8]; F.expert_u = args.in[9]; F.expert_v = args.in[10]; F.norm_final = args.in[11];
    F.out = args.out; F.ws = args.ws;
    for (int u = F.tid; u < (LDS_BYTES - LDSCTL_OFF) / 4; u += NWAVES * 64) ((LAS unsigned*)(F.lds + LDSCTL_OFF))[u] = 0u;
    __syncthreads();
    XcdBarrier bar = xcd_barrier_post((unsigned*)(F.ws + WS_CTL), F.MISC + 8);
#define GRID_BAR() xcd_barrier(bar)
#ifndef PROBE_SPIN
#define PROBE_SPIN -1
#endif
    unsigned long long ps_t0 = 0;
#define PH_BEGIN(k) do { if (PROBE_SPIN == (k)) ps_t0 = __builtin_amdgcn_s_memrealtime(); } while (0)
#define PH_END(k) do { if (PROBE_SPIN == (k)) { const unsigned long long t1 = __builtin_amdgcn_s_memrealtime(), dt = t1 - ps_t0; while (__builtin_amdgcn_s_memrealtime() - t1 < dt) __builtin_amdgcn_s_sleep(8); } } while (0)

#ifndef PROBE_DUP
#define PROBE_DUP -1
#endif
#ifdef DIAGS
    if (blockIdx.x == 0 && F.wave == 0) {
        typedef int v8i_d __attribute__((ext_vector_type(8)));
        const int g0 = (DIAGS) >> 5, j0 = (DIAGS) & 31, r0 = 3;
        const int lg = F.lane >> 4;
        v8i_d A = {0, 0, 0, 0, 0, 0, 0, 0};
        if (F.lane == 16 * g0 + r0) A[j0 >> 3] = 0x2 << (4 * (j0 & 7));
        int P = 0;
        for (int bit = 0; bit < 7; ++bit) {
            v8i_d B;
#pragma unroll
            for (int rg = 0; rg < 8; ++rg) { unsigned w = 0;
#pragma unroll
                for (int by = 0; by < 4; ++by) { const int j = 4 * rg + by; if (((lg * 32 + j) >> bit) & 1) w |= 0x38u << (8 * by); }
                B[rg] = (int)w; }
            f32x4 acc = {0.f, 0.f, 0.f, 0.f};
            acc = __builtin_amdgcn_mfma_scale_f32_16x16x128_f8f6f4(A, B, acc, 4, 0, 0, 0x7f7f7f7f, 0, 0x7f7f7f7f);
            const float dsel = acc[r0 & 3];
            const float d = __builtin_bit_cast(float, __builtin_amdgcn_readlane(__builtin_bit_cast(int, dsel), 16 * (r0 >> 2)));
            if (d > 0.5f) P |= 1 << bit;
        }
        const unsigned long long t1 = __builtin_amdgcn_s_memrealtime();
        while (__builtin_amdgcn_s_memrealtime() - t1 < (unsigned long long)(P + 1) * 10000ull) __builtin_amdgcn_s_sleep(8);
    }
#endif
#ifdef TRTEST
    {
        LAS unsigned char* tb = F.lds + 4096 * F.wave;
        for (int i = F.lane; i < 512; i += 64) tb[i] = (unsigned char)((i & 127) ^ ((i >> 7) * 0x55));
        LDS_WAIT(); asm volatile("" ::: "memory");
        typedef int v2i_t __attribute__((ext_vector_type(2)));
        const int l16 = F.lane & 15, grp = F.lane >> 4;
#if TRTEST == 1
        const int roff = (l16 >> 1) * 16 + (l16 & 1) * 8;
#else
        const int roff = (l16 & 7) * 16 + (l16 >> 3) * 8;
#endif
        const v2i_t rr = __builtin_amdgcn_ds_read_tr8_b64_v2i32((LAS v2i_t*)(tb + grp * 128 + roff));
        unsigned long long got = ((unsigned long long)(unsigned)rr.y << 32) | (unsigned)rr.x, want = 0;
        for (int j = 0; j < 8; ++j) want |= (unsigned long long)(unsigned char)(((j * 16 + l16) & 127) ^ (grp * 0x55)) << (8 * j);
        if (got != want) __hip_atomic_store((unsigned*)(F.ws + WS_CTL) + 8, 1u, RLX_AGENT);
        LDS_WAIT(); asm volatile("" ::: "memory");
        __syncthreads();
    }
#endif
#ifdef UBENCH
    {
        unsigned r0 = F.tid, r1 = F.tid * 3, r2 = F.tid * 5, r3 = F.tid * 7; float f0 = 1.f, f1 = 2.f, f2 = 3.f, f3 = 4.f; f32x2 p0 = {1.f, 2.f}, p1 = {3.f, 4.f}, q0 = {0.f, 0.f}, q1 = {0.f, 0.f}, q2 = {0.f, 0.f}, q3 = {0.f, 0.f};
        for (int it = 0; it < 20000; ++it) {
#pragma unroll
            for (int k = 0; k < 4; ++k) {
#if UBENCH == 1
                asm volatile("v_cvt_pk_f32_fp8_e32 %0, %4\n v_cvt_pk_f32_fp8_e32 %1, %5\n v_cvt_pk_f32_fp8_e32 %2, %6\n v_cvt_pk_f32_fp8_e32 %3, %7" : "=v"(q0), "=v"(q1), "=v"(q2), "=v"(q3) : "v"(r0), "v"(r1), "v"(r2), "v"(r3));
#elif UBENCH == 2
                asm volatile("v_cvt_f32_ubyte0_e32 %0, %4\n v_cvt_f32_ubyte1_e32 %1, %5\n v_cvt_f32_ubyte2_e32 %2, %6\n v_cvt_f32_ubyte3_e32 %3, %7" : "=v"(f0), "=v"(f1), "=v"(f2), "=v"(f3) : "v"(r0), "v"(r1), "v"(r2), "v"(r3));
#elif UBENCH == 3
                asm volatile("v_pk_fma_f32 %0, %4, %5, %0\n v_pk_fma_f32 %1, %4, %5, %1\n v_pk_fma_f32 %2, %4, %5, %2\n v_pk_fma_f32 %3, %4, %5, %3" : "+v"(q0), "+v"(q1), "+v"(q2), "+v"(q3) : "v"(p0), "v"(p1));
#elif UBENCH == 4
                asm volatile("v_dot2_f32_f16 %0, %4, %5, %0\n v_dot2_f32_f16 %1, %4, %6, %1\n v_dot2_f32_f16 %2, %5, %6, %2\n v_dot2_f32_f16 %3, %6, %7, %3" : "+v"(f0), "+v"(f1), "+v"(f2), "+v"(f3) : "v"(r0), "v"(r1), "v"(r2), "v"(r3));
#elif UBENCH == 5
                asm volatile("v_perm_b32 %0, %4, %5, %6\n v_perm_b32 %1, %5, %6, %7\n v_perm_b32 %2, %4, %6, %7\n v_perm_b32 %3, %4, %5, %7" : "=v"(f0), "=v"(f1), "=v"(f2), "=v"(f3) : "v"(r0), "v"(r1), "v"(r2), "v"(r3));
#elif UBENCH == 6
                asm volatile("v_fma_f32 %0, %4, %5, %0\n v_fma_f32 %1, %4, %5, %1\n v_fma_f32 %2, %4, %5, %2\n v_fma_f32 %3, %4, %5, %3" : "+v"(f0), "+v"(f1), "+v"(f2), "+v"(f3) : "v"(p0.x), "v"(p1.y));
#elif UBENCH == 8
                asm volatile("v_pk_fma_f16 %0, %4, %5, %0\n v_pk_fma_f16 %1, %4, %5, %1\n v_pk_fma_f16 %2, %4, %5, %2\n v_pk_fma_f16 %3, %4, %5, %3" : "+v"(f0), "+v"(f1), "+v"(f2), "+v"(f3) : "v"(r0), "v"(r1));
#elif UBENCH == 9
                asm volatile("v_cvt_scalef32_pk_f16_fp8 %0, %4, 1.0\n v_cvt_scalef32_pk_f16_fp8 %1, %5, 1.0\n v_cvt_scalef32_pk_f16_fp8 %2, %6, 1.0\n v_cvt_scalef32_pk_f16_fp8 %3, %7, 1.0" : "=v"(f0), "=v"(f1), "=v"(f2), "=v"(f3) : "v"(r0), "v"(r1), "v"(r2), "v"(r3));
#elif UBENCH == 10
                asm volatile("v_cvt_pk_f32_fp8_sdwa %0, %4 src0_sel:WORD_1\n v_cvt_pk_f32_fp8_sdwa %1, %5 src0_sel:WORD_1\n v_cvt_pk_f32_fp8_sdwa %2, %6 src0_sel:WORD_1\n v_cvt_pk_f32_fp8_sdwa %3, %7 src0_sel:WORD_1" : "=v"(q0), "=v"(q1), "=v"(q2), "=v"(q3) : "v"(r0), "v"(r1), "v"(r2), "v"(r3));
#elif UBENCH == 7
                asm volatile("v_dot4_i32_i8 %0, %4, %5, %0\n v_dot4_i32_i8 %1, %4, %6, %1\n v_dot4_i32_i8 %2, %5, %6, %2\n v_dot4_i32_i8 %3, %6, %7, %3" : "+v"(f0), "+v"(f1), "+v"(f2), "+v"(f3) : "v"(r0), "v"(r1), "v"(r2), "v"(r3));
#endif
            }
        }
        float* dump = (float*)(F.ws + WS_Z);
        dump[(size_t)blockIdx.x * 512 + F.tid] = f0 + f1 + f2 + f3 + q0.x + q1.y + q2.x + q3.y;
    }
#endif
    PH_BEGIN(0); p0_prologue(F); PH_END(0);
    if (PROBE_DUP == 0) { GRID_BAR(); p0_prologue(F); }
    GRID_BAR();
    PH_BEGIN(1);
    {
        pg8::Gemm g{(const pg8::bf16_t*)(F.ws + WS_XB), (const pg8::bf16_t*)(F.ws + WS_WIN), M, NZ, D}; pg8::StaticOrder S; S.init(M, NZ, F.G, (int)blockIdx.x);
        pg8::EpiZ E{(pg8::bf16_t*)(F.ws + WS_Z), (pg8::bf16_t*)(F.ws + WS_ZP), (const float*)(F.ws + WS_R1), DATT, QSCALE, SEQ, NH, M};
        pg8::gemm_phase<pg8::EpiZ, pg8::StaticOrder, PG8_ALIGN, PG8_SP2>(F.lds + RING_OFF, g, S, E);
        if (PROBE_DUP == 1) { GRID_BAR(); pg8::gemm_phase<pg8::EpiZ, pg8::StaticOrder, PG8_ALIGN, PG8_SP2>(F.lds + RING_OFF, g, S, E); }
    }
    PH_END(1);
    GRID_BAR();
    PH_BEGIN(2);
    {
        v4u kv[6], vv[6]; bf16x8 qc[4], qn[4];
        int u = F.vcu;
        if (u < ATT_UNITS) { attn_fetch(F, u, kv, vv); attn_fetch_q(F, u, qn); }
        for (; u < ATT_UNITS; u += F.G) {
#pragma unroll
            for (int d0 = 0; d0 < 4; ++d0) qc[d0] = qn[d0];
            attn_stage(F, kv, vv);
            __syncthreads();
            if (u + F.G < ATT_UNITS) { attn_fetch(F, u + F.G, kv, vv); attn_fetch_q(F, u + F.G, qn); }
            attn_compute(F, u, qc);
            __syncthreads();
        }
    }
    PH_END(2);
    PH_BEGIN(3); pool_rows(F); PH_END(3);
    if (PROBE_DUP == 3) { GRID_BAR(); pool_rows(F); }
    GRID_BAR();
    PH_BEGIN(4); merge_rows(F); PH_END(4);
    if (PROBE_DUP == 4) { GRID_BAR(); merge_rows(F); }
    GRID_BAR();
    PH_BEGIN(5);
    {
        pg8::Gemm g{(const pg8::bf16_t*)(F.ws + WS_MIX), (const pg8::bf16_t*)(F.ws + WS_WOUT), M, D, D}; pg8::StaticOrder S; S.init(M, D, F.G, (int)blockIdx.x);
        pg8::EpiRes E{(pg8::bf16_t*)(F.ws + WS_XB), (float*)(F.ws + WS_SS), D};
        pg8::gemm_phase<pg8::EpiRes, pg8::StaticOrder, PG8_ALIGN, PG8_SP2>(F.lds + RING_OFF, g, S, E);
        if (PROBE_DUP == 5) { GRID_BAR(); pg8::gemm_phase<pg8::EpiRes, pg8::StaticOrder, PG8_ALIGN, PG8_SP2>(F.lds + RING_OFF, g, S, E); }
    }
    PH_END(5);
    GRID_BAR();
    PH_BEGIN(6);
    {
        pg8::Gemm g{(const pg8::bf16_t*)(F.ws + WS_XB), (const pg8::bf16_t*)(F.ws + WS_WSC), M, NSC, D}; pg8::StaticOrder S; S.init(M, NSC, F.G, (int)blockIdx.x);
        pg8::EpiF16 E{(unsigned short*)(F.ws + WS_SCH), NSC};
        pg8::gemm_phase<pg8::EpiF16, pg8::StaticOrder, PG8_ALIGN, PG8_SP2>(F.lds + RING_OFF, g, S, E);
        if (PROBE_DUP == 6) { GRID_BAR(); pg8::gemm_phase<pg8::EpiF16, pg8::StaticOrder, PG8_ALIGN, PG8_SP2>(F.lds + RING_OFF, g, S, E); }
    }
    PH_END(6);
    GRID_BAR();
    PH_BEGIN(7); topk_phase(F); PH_END(7);
    if (PROBE_DUP == 7) { GRID_BAR(); topk_phase(F); }
    GRID_BAR();
#ifndef VSYNC
#define VSYNC 0
#endif
#ifndef PROBE_U2
#define PROBE_U2 0
#endif
#ifndef PROBE_UMASK
#define PROBE_UMASK 0x3fffu
#endif
    for (int blk = F.vcu; blk < M / 128; blk += F.G) { if (PROBE_U2) { peer_u_phase<PROBE_UMASK, true>(F, blk); __syncthreads(); } PH_BEGIN(8); peer_u_phase<0x3fffu, false>(F, blk); PH_END(8);
#ifdef PROBE_VMASK
        peer_v_phase<PROBE_VMASK, true>(F, blk, bar, false); __syncthreads();
#endif
        PH_BEGIN(9); peer_v_phase<0x3fffu, false>(F, blk, bar, VSYNC && (M / 128 == F.G)); PH_END(9); __syncthreads(); }
#ifdef TRTEST
    GRID_BAR();
    if (blockIdx.x == 0 && F.tid == 0 && __hip_atomic_load((unsigned*)(F.ws + WS_CTL) + 8, RLX_AGENT) != 0u) F.out[0] = __builtin_nanf("");
#endif
}

extern "C" void kernel_launch(void* const* d_in, const int* in_sizes, int n_in, void* d_out, int out_size, void* d_ws, size_t ws_size, hipStream_t stream) {
    static int grid = 0;
    if (grid == 0) {
        if (n_in != 12 || in_sizes[0] != M * D || out_size != M * D || ws_size < WS_END) { fprintf(stderr, "kernel_launch: unexpected shapes (n_in %d, in0 %d, out %d, ws %zu); nothing launched\n", n_in, n_in > 0 ? in_sizes[0] : -1, out_size, ws_size); grid = -1; return; }
        int dev = 0, cus = 0, per_cu = 0;
        if (hipGetDevice(&dev) != hipSuccess || hipDeviceGetAttribute(&cus, hipDeviceAttributeMultiprocessorCount, dev) != hipSuccess) { grid = -1; return; }
        if (hipFuncSetAttribute((const void*)hymba_fwd, hipFuncAttributeMaxDynamicSharedMemorySize, LDS_BYTES) != hipSuccess) { fprintf(stderr, "kernel_launch: hipFuncSetAttribute failed\n"); grid = -1; return; }
        if (hipOccupancyMaxActiveBlocksPerMultiprocessor(&per_cu, (const void*)hymba_fwd, NWAVES * 64, LDS_BYTES) != hipSuccess || per_cu < 1)
            fprintf(stderr, "kernel_launch: note: occupancy query reports %d workgroups per CU\n", per_cu);
        (void)hipGetLastError();
        grid = cus;
    }
    if (grid < 0) return;
    if (hipMemsetAsync((char*)d_ws + WS_CTL, 0, CTL_ZERO_BYTES, stream) != hipSuccess) { fprintf(stderr, "kernel_launch: hipMemsetAsync failed\n"); return; }
    Args a{};
    for (int i = 0; i < 12; ++i) a.in[i] = (const float*)d_in[i];
    a.out = (float*)d_out; a.ws = (unsigned char*)d_ws;
    hipLaunchKernelGGL(hymba_fwd, dim3(grid), dim3(NWAVES * 64), LDS_BYTES, stream, a);
    const hipError_t le = hipPeekAtLastError();
    if (le != hipSuccess) fprintf(stderr, "kernel_launch: launch failed: %s\n", hipGetErrorName(le));
}
```

```cpp
#include <hip/hip_runtime.h>
#include <cstdio>
#include <cstdint>
namespace pg8 {
#define PG8_LAS __attribute__((address_space(3)))
typedef unsigned short bf16_t;
typedef short bf16x8 __attribute__((ext_vector_type(8)));
typedef float f32x4 __attribute__((ext_vector_type(4)));
typedef unsigned u32x4 __attribute__((ext_vector_type(4)));
constexpr int BM = 256, BK = 64, HALF = 128, HTB = HALF * BK * 2  , STAGE_BYTES = 8 * HTB, NXCD = 8, WGM = 8;

__host__ __device__ __forceinline__ int lds_byte(int r, int c) { const int st = (r >> 4) * 2 + (c >> 5), rr = r & 15, cc = c & 31, ob = rr * 64 + cc * 2; return st * 1024 + (ob ^ (((ob >> 9) & 1) << 5)); }
__host__ __device__ __forceinline__ void stage_rc(int b, int& R, int& C) { const int st = b / 1024, sb = b % 1024, swz = sb ^ (((sb >> 9) & 1) << 5); R = (st >> 1) * 16 + swz / 64; C = (st & 1) * 32 + (swz % 64) / 2; }
__host__ __device__ __forceinline__ int perm32(int rho) { const int n = rho >> 4, i = rho & 15; return 8 * (i >> 2) + 4 * n + (i & 3); }

struct Unit { int pm, pn; };
struct Gemm { const bf16_t* A; const bf16_t* Bt; int M, N, K; };

struct StaticOrder {
    int nM, nN, nwg, G, c;
    __host__ __device__ void init(int M, int N, int G_, int c_) { nM = M / BM; nN = N / BM; nwg = nM * nN; G = G_; c = c_; }
    __host__ __device__ bool next(int i, Unit& u) const {
        const long L = (long)i * G + c; if (L >= nwg) return false;
        int wgid = (int)L; { const int q = nwg / NXCD, r = nwg % NXCD, xcd = wgid % NXCD, off = wgid / NXCD; wgid = (xcd < r ? xcd * (q + 1) : r * (q + 1) + (xcd - r) * q) + off; }
        const int nig = WGM * nN, gid = wgid / nig, fm = gid * WGM, gsz = (nM - fm) < WGM ? (nM - fm) : WGM;
        u.pm = fm + ((wgid % nig) % gsz); u.pn = (wgid % nig) / gsz; return true;
    }
    __device__ __forceinline__ void a_ready(const Unit&) const {}
    __device__ __forceinline__ void done(const Unit&) const {}
};

__device__ __forceinline__ unsigned cvt_pk_bf16(float lo, float hi) { unsigned r; asm volatile("v_cvt_pk_bf16_f32 %0, %1, %2" : "=v"(r) : "v"(lo), "v"(hi)); return r; }
struct EpiZ {
    static constexpr bool PERM = true, AFTER_DRAIN = false;
    bf16_t* ZH; bf16_t* ZP; const float* rs; int qcols; float qscale; int seq, nh, mrows;
    __device__ __forceinline__ void operator()(const f32x4 (&acc)[2][2][4][2], const Unit& u, int wr, int wc, int fr, int fq) const {
        const int row0 = u.pm * BM + wr * 64 + fr; const int colt = u.pn * BM;
        const float sc = (colt < qcols) ? qscale : 1.f;
        const int col0 = colt + wc * 32 + 8 * fq;
#pragma unroll
        for (int ai = 0; ai < 2; ++ai)
#pragma unroll
            for (int m = 0; m < 4; ++m) { const int row = row0 + ai * HALF + m * 16; const float s = rs[row] * sc; const int bq = row / seq, sq = row - bq * seq;
#pragma unroll
                for (int bj = 0; bj < 2; ++bj) { const f32x4 v0 = acc[ai][bj][m][0] * s, v1 = acc[ai][bj][m][1] * s; const int cc = col0 + bj * HALF;
                    u32x4 w; w.x = cvt_pk_bf16(v0[0], v0[1]); w.y = cvt_pk_bf16(v0[2], v0[3]); w.z = cvt_pk_bf16(v1[0], v1[1]); w.w = cvt_pk_bf16(v1[2], v1[3]);
                    bf16_t* dst = (cc < 3 * 512) ? ZH + (size_t)(cc >> 9) * mrows * 512 + ((size_t)(bq * nh + ((cc >> 6) & 7)) * seq + sq) * 64 + (cc & 63)
                                                 : ZP + (size_t)row * 512 + (cc - 3 * 512);
                    *(u32x4*)dst = w; } }
    }
};
struct EpiRes {
    static constexpr bool PERM = true, AFTER_DRAIN = false;
    bf16_t* XB; float* SS; int ldc;
    __device__ __forceinline__ void operator()(const f32x4 (&acc)[2][2][4][2], const Unit& u, int wr, int wc, int fr, int fq) const {
        const int row0 = u.pm * BM + wr * 64 + fr; const int col0 = u.pn * BM + wc * 32 + 8 * fq;
#pragma unroll
        for (int ai = 0; ai < 2; ++ai)
#pragma unroll
            for (int m = 0; m < 4; ++m) { const int row = row0 + ai * HALF + m * 16; const size_t off = (size_t)row * ldc + col0; float ss = 0.f;
#pragma unroll
                for (int bj = 0; bj < 2; ++bj) {
                    const u32x4 xw = *(const u32x4*)(XB + off + bj * HALF);
                    f32x4 v0 = acc[ai][bj][m][0], v1 = acc[ai][bj][m][1];
                    v0[0] += __builtin_bit_cast(float, xw.x << 16); v0[1] += __builtin_bit_cast(float, xw.x & 0xffff0000u); v0[2] += __builtin_bit_cast(float, xw.y << 16); v0[3] += __builtin_bit_cast(float, xw.y & 0xffff0000u);
                    v1[0] += __builtin_bit_cast(float, xw.z << 16); v1[1] += __builtin_bit_cast(float, xw.z & 0xffff0000u); v1[2] += __builtin_bit_cast(float, xw.w << 16); v1[3] += __builtin_bit_cast(float, xw.w & 0xffff0000u);
                    ss += (v0[0] * v0[0] + v0[1] * v0[1]) + (v0[2] * v0[2] + v0[3] * v0[3]) + (v1[0] * v1[0] + v1[1] * v1[1]) + (v1[2] * v1[2] + v1[3] * v1[3]);
                    u32x4 w; w.x = cvt_pk_bf16(v0[0], v0[1]); w.y = cvt_pk_bf16(v0[2], v0[3]); w.z = cvt_pk_bf16(v1[0], v1[1]); w.w = cvt_pk_bf16(v1[2], v1[3]);
                    *(u32x4*)(XB + off + bj * HALF) = w; }
                ss += __shfl_xor(ss, 16); ss += __shfl_xor(ss, 32);
                if (fq == 0) SS[(size_t)row * 16 + u.pn * 4 + wc] = ss;
                if (m & 1) asm volatile("" ::: "memory"); }
    }
};
typedef _Float16 f16x2_t __attribute__((ext_vector_type(2)));
__device__ __forceinline__ unsigned cvt_pk_f16(float lo, float hi) { const f16x2_t h = {(_Float16)lo, (_Float16)hi}; return __builtin_bit_cast(unsigned, h); }
struct EpiF16 {
    static constexpr bool PERM = true, AFTER_DRAIN = false;
    unsigned short* O; int ldc;
    __device__ __forceinline__ void operator()(const f32x4 (&acc)[2][2][4][2], const Unit& u, int wr, int wc, int fr, int fq) const {
        const int row0 = u.pm * BM + wr * 64 + fr; const int col0 = u.pn * BM + wc * 32 + 8 * fq;
#pragma unroll
        for (int ai = 0; ai < 2; ++ai)
#pragma unroll
            for (int m = 0; m < 4; ++m) { unsigned short* rowp = O + (size_t)(row0 + ai * HALF + m * 16) * ldc + col0;
#pragma unroll
                for (int bj = 0; bj < 2; ++bj) { const f32x4 v0 = acc[ai][bj][m][0], v1 = acc[ai][bj][m][1];
                    u32x4 w; w.x = cvt_pk_f16(v0[0], v0[1]); w.y = cvt_pk_f16(v0[2], v0[3]); w.z = cvt_pk_f16(v1[0], v1[1]); w.w = cvt_pk_f16(v1[2], v1[3]);
                    *(u32x4*)(rowp + bj * HALF) = w; } }
    }
};

template <class Epi, class Sched, bool ALIGN_EPI = false, bool SP2 = false>
__device__ __forceinline__ void gemm_phase(PG8_LAS unsigned char* lds, const Gemm g, const Sched& S, const Epi& E) {
    const int tid = threadIdx.x, wid = __builtin_amdgcn_readfirstlane(tid >> 6), lane = tid & 63, wr = wid >> 2, wc = wid & 3, fr = lane & 15, fq = lane >> 4;
    const int K = g.K, nt = K / BK;
    unsigned voffA[2], voffB[2];
#pragma unroll
    for (int i = 0; i < 2; ++i) { int R, C; stage_rc(tid * 16 + i * 8192, R, C); const int Rb = Epi::PERM ? ((R & ~31) + perm32(R & 31)) : R;
        voffA[i] = (unsigned)(R * K + C) * 2u; voffB[i] = (unsigned)(Rb * K + C) * 2u; }
    const size_t kstep = (size_t)(BK * 2);
    const size_t hstep = (size_t)HALF * K * 2;
    const size_t tstep = 2 * hstep;
    const unsigned ldsw = (unsigned)wid * 1024u;
    const int aoff = lds_byte(wr * 64 + fr, fq * 8), boff = lds_byte(wc * 32 + fr, fq * 8);
#define PG8_SA(b, h) (((b) * 2 + (h)) * HTB)
#define PG8_SB(b, h) ((4 + (b) * 2 + (h)) * HTB)
#define PG8_STAGE(bufoff, gbase, voff) do { _Pragma("unroll") for (int _i = 0; _i < 2; ++_i) \
        __builtin_amdgcn_global_load_lds((const unsigned*)((const char*)(gbase) + (voff)[_i]), (PG8_LAS unsigned*)(lds + (bufoff) + ldsw + _i * 8192), 16, 0, 0); } while (0)
#define PG8_LDA(dst, b, h) do { _Pragma("unroll") for (int m = 0; m < 4; ++m) _Pragma("unroll") for (int k = 0; k < 2; ++k) dst[m][k] = *(const PG8_LAS bf16x8*)(lds + PG8_SA(b, h) + aoff + m * 2048 + k * 1024); } while (0)
#define PG8_LDB(dst, b, h) do { _Pragma("unroll") for (int n = 0; n < 2; ++n) _Pragma("unroll") for (int k = 0; k < 2; ++k) dst[n][k] = *(const PG8_LAS bf16x8*)(lds + PG8_SB(b, h) + boff + n * 2048 + k * 1024); } while (0)
#define PG8_MMA(ai, bj, At, Bt) do { __builtin_amdgcn_s_setprio(1); _Pragma("unroll") for (int m = 0; m < 4; ++m) _Pragma("unroll") for (int n = 0; n < 2; ++n) _Pragma("unroll") for (int k = 0; k < 2; ++k) \
        acc[ai][bj][m][n] = __builtin_amdgcn_mfma_f32_16x16x32_bf16(Bt[n][k], At[m][k], acc[ai][bj][m][n], 0, 0, 0); __builtin_amdgcn_s_setprio(0); } while (0)
#define PG8_WAIT_V(n) asm volatile("s_waitcnt vmcnt(" #n ")" ::: "memory")
#define PG8_WAIT_L(n) asm volatile("s_waitcnt lgkmcnt(" #n ")" ::: "memory")
#define PG8_BAR __builtin_amdgcn_s_barrier()
#define PG8_SCHED __builtin_amdgcn_sched_barrier(0)
    Unit cur, nxt; int ui = 0;
    if (!S.next(0, cur)) return;
    f32x4 acc[2][2][4][2];
#pragma unroll
    for (int a = 0; a < 2; ++a)
#pragma unroll
        for (int b = 0; b < 2; ++b)
#pragma unroll
            for (int m = 0; m < 4; ++m)
#pragma unroll
                for (int n = 0; n < 2; ++n) acc[a][b][m][n] = (f32x4){0.f, 0.f, 0.f, 0.f};
    bf16x8 At[4][2], B0[2][2], B1[2][2];
    const char* cA = (const char*)g.A + (size_t)cur.pm * tstep; const char* cB = (const char*)g.Bt + (size_t)cur.pn * tstep;
    S.a_ready(cur);
    if constexpr (SP2) {
        PG8_STAGE(PG8_SB(0, 0), cB, voffB); PG8_STAGE(PG8_SB(0, 1), cB + hstep, voffB); PG8_STAGE(PG8_SA(0, 0), cA, voffA); PG8_STAGE(PG8_SA(0, 1), cA + hstep, voffA);
        if (wr == 1) PG8_BAR;
        PG8_WAIT_V(2); PG8_BAR;
        PG8_STAGE(PG8_SB(1, 0), cB + kstep, voffB); PG8_STAGE(PG8_SA(1, 0), cA + kstep, voffA); PG8_STAGE(PG8_SB(1, 1), cB + hstep + kstep, voffB);
        PG8_WAIT_V(6); PG8_BAR;
    } else {
        PG8_STAGE(PG8_SB(0, 0), cB, voffB); PG8_STAGE(PG8_SA(0, 0), cA, voffA); PG8_STAGE(PG8_SB(0, 1), cB + hstep, voffB); PG8_STAGE(PG8_SA(0, 1), cA + hstep, voffA);
        if (wr == 1) PG8_BAR;
        PG8_WAIT_V(4); PG8_BAR;
        PG8_STAGE(PG8_SB(1, 0), cB + kstep, voffB); PG8_STAGE(PG8_SA(1, 0), cA + kstep, voffA); PG8_STAGE(PG8_SB(1, 1), cB + hstep + kstep, voffB);
        PG8_WAIT_V(6); PG8_BAR;
    }
    for (;;) {
        const bool has_next = S.next(ui + 1, nxt);
        const char* nA = has_next ? (const char*)g.A + (size_t)nxt.pm * tstep : cA; const char* nB = has_next ? (const char*)g.Bt + (size_t)nxt.pn * tstep : cB;
        for (int t = 0; t < nt; t += 2) {
            const bool last = (t == nt - 2);
            const char* a1 = cA + (size_t)(t + 1) * kstep;
            const char* a2 = last ? nA : cA + (size_t)(t + 2) * kstep; const char* b2 = last ? nB : cB + (size_t)(t + 2) * kstep;
            const char* a3 = a2 + kstep; const char* b3 = b2 + kstep;
            if (last && has_next) S.a_ready(nxt);
            if constexpr (SP2) {
            PG8_LDB(B0, 0, 0); PG8_LDB(B1, 0, 1); PG8_SCHED; PG8_LDA(At, 0, 0); PG8_STAGE(PG8_SA(1, 1), a1 + hstep, voffA);
            PG8_WAIT_V(8); PG8_WAIT_L(0); PG8_BAR; PG8_MMA(0, 0, At, B0); PG8_MMA(0, 1, At, B1); PG8_BAR; PG8_SCHED;
            PG8_LDA(At, 0, 1); PG8_STAGE(PG8_SB(0, 0), b2, voffB); PG8_STAGE(PG8_SB(0, 1), b2 + hstep, voffB); PG8_STAGE(PG8_SA(0, 0), a2, voffA);
            PG8_WAIT_V(8); PG8_WAIT_L(0); PG8_BAR; PG8_MMA(1, 0, At, B0); PG8_MMA(1, 1, At, B1); PG8_BAR; PG8_SCHED;
            PG8_LDB(B0, 1, 0); PG8_LDB(B1, 1, 1); PG8_SCHED; PG8_LDA(At, 1, 0); PG8_STAGE(PG8_SA(0, 1), a2 + hstep, voffA);
            PG8_WAIT_V(8); PG8_WAIT_L(0); PG8_BAR; PG8_MMA(0, 0, At, B0); PG8_MMA(0, 1, At, B1); PG8_BAR; PG8_SCHED;
            PG8_LDA(At, 1, 1); PG8_STAGE(PG8_SB(1, 0), b3, voffB); PG8_STAGE(PG8_SB(1, 1), b3 + hstep, voffB); PG8_STAGE(PG8_SA(1, 0), a3, voffA);
            PG8_WAIT_V(8); PG8_WAIT_L(0); PG8_BAR; PG8_MMA(1, 0, At, B0); PG8_MMA(1, 1, At, B1); PG8_BAR; PG8_SCHED;
            } else {
            PG8_LDB(B0, 0, 0); PG8_SCHED; PG8_LDA(At, 0, 0); PG8_STAGE(PG8_SA(1, 1), a1 + hstep, voffA);
            PG8_WAIT_L(8); PG8_BAR; PG8_WAIT_L(0); PG8_MMA(0, 0, At, B0); PG8_BAR; PG8_SCHED;
            PG8_LDB(B1, 0, 1); PG8_STAGE(PG8_SB(0, 0), b2, voffB);
            PG8_BAR; PG8_WAIT_L(0); PG8_MMA(0, 1, At, B1); PG8_BAR;
            PG8_LDA(At, 0, 1); PG8_STAGE(PG8_SA(0, 0), a2, voffA);
            PG8_BAR; PG8_WAIT_L(0); PG8_MMA(1, 0, At, B0); PG8_BAR; PG8_SCHED;
            PG8_STAGE(PG8_SB(0, 1), b2 + hstep, voffB);
            PG8_WAIT_V(6); PG8_BAR; PG8_MMA(1, 1, At, B1); PG8_BAR;
            PG8_LDB(B0, 1, 0); PG8_SCHED; PG8_LDA(At, 1, 0); PG8_STAGE(PG8_SA(0, 1), a2 + hstep, voffA);
            PG8_WAIT_L(8); PG8_BAR; PG8_WAIT_L(0); PG8_MMA(0, 0, At, B0); PG8_BAR; PG8_SCHED;
            PG8_LDB(B1, 1, 1); PG8_STAGE(PG8_SB(1, 0), b3, voffB);
            PG8_BAR; PG8_WAIT_L(0); PG8_MMA(0, 1, At, B1); PG8_BAR;
            PG8_LDA(At, 1, 1); PG8_STAGE(PG8_SA(1, 0), a3, voffA);
            PG8_BAR; PG8_WAIT_L(0); PG8_MMA(1, 0, At, B0); PG8_BAR; PG8_SCHED;
            PG8_STAGE(PG8_SB(1, 1), b3 + hstep, voffB);
            PG8_WAIT_V(6); PG8_BAR; PG8_MMA(1, 1, At, B1); PG8_BAR;
            }
        }
        if constexpr (ALIGN_EPI) { if (wr == 0) PG8_BAR; }
        if constexpr (!Epi::AFTER_DRAIN) { E(acc, cur, wr, wc, fr, fq); S.done(cur); }
        if (!has_next) break;
#pragma unroll
        for (int a = 0; a < 2; ++a)
#pragma unroll
            for (int b = 0; b < 2; ++b)
#pragma unroll
                for (int m = 0; m < 4; ++m)
#pragma unroll
                    for (int n = 0; n < 2; ++n) acc[a][b][m][n] = (f32x4){0.f, 0.f, 0.f, 0.f};
        cur = nxt; cA = nA; cB = nB; ++ui;
        if constexpr (ALIGN_EPI) { if (wr == 1) PG8_BAR; }
    }
    PG8_WAIT_V(0);
    if constexpr (!ALIGN_EPI) { if (wr == 0) PG8_BAR; }
    PG8_BAR;
    if constexpr (Epi::AFTER_DRAIN) { E.fused(acc, cur, wr, wc, fr, fq, lds, wid, lane); S.done(cur); }
#undef PG8_SA
#undef PG8_SB
#undef PG8_STAGE
#undef PG8_LDA
#undef PG8_LDB
#undef PG8_MMA
#undef PG8_WAIT_V
#undef PG8_WAIT_L
#undef PG8_BAR
#undef PG8_SCHED
}
}
#define PG8_SP2 true
#define PG8_ALIGN true

constexpr int NWAVES = 8;
constexpr int BATCH = 4, SEQ = 8192, D = 1024, M = BATCH * SEQ;
constexpr int NH = 8, HD = 64, DATT = 512, DPOOL = 512, NZ = 3 * DATT + DPOOL;
constexpr int PEER_H = 8, NKEYS = 128, NEXP = NKEYS * NKEYS, TOPK = 16, NSC = PEER_H * 2 * NKEYS;
constexpr float EPS = 1e-6f;
constexpr float QSCALE = 0.125f * 1.4426950408889634f;

constexpr size_t MiB = 1u << 20;
constexpr size_t WS_CTL = 0, CTL_ZERO_BYTES = 64 * 1024;
constexpr size_t WS_R1 = 1 * MiB;
constexpr size_t WS_SS = 2 * MiB;
constexpr size_t WS_LSE = 4 * MiB;
constexpr size_t WS_WIN = 8 * MiB;
constexpr size_t WS_WOUT = 12 * MiB;
constexpr size_t WS_WSC = 14 * MiB;
constexpr size_t WS_EU = 32 * MiB, WS_EV = 64 * MiB;
constexpr size_t WS_XB = 96 * MiB;
constexpr size_t WS_Z = 160 * MiB;
constexpr size_t WS_ZP = 256 * MiB;
constexpr size_t WS_OB = 288 * MiB;
constexpr size_t WS_MIX = 384 * MiB;
constexpr size_t WS_SC = 160 * MiB;
constexpr size_t WS_SCH = 224 * MiB;
constexpr size_t WS_IDX = 448 * MiB, WS_GATE = 464 * MiB;
constexpr size_t WS_END = 480 * MiB;
static_assert(WS_SC + (size_t)M * NSC * 4 <= WS_IDX, "ws map");

constexpr int LDS_BYTES = 147456;
constexpr int LDSCTL_OFF = 146432, MISC_OFF = LDSCTL_OFF + 320;
constexpr int RING_OFF = 0;

#define GAS __attribute__((address_space(1)))
#define LAS __attribute__((address_space(3)))
typedef unsigned short bf16;
typedef unsigned v4u __attribute__((ext_vector_type(4)));
typedef unsigned v2u __attribute__((ext_vector_type(2)));
typedef float f32x4 __attribute__((ext_vector_type(4)));
typedef float f32x16 __attribute__((ext_vector_type(16)));
typedef short bf16x8 __attribute__((ext_vector_type(8)));
typedef short s16x4 __attribute__((ext_vector_type(4)));
typedef GAS unsigned gu32;
#define RLX_AGENT __ATOMIC_RELAXED, __HIP_MEMORY_SCOPE_AGENT
#define LDS_WAIT() asm volatile("s_waitcnt lgkmcnt(0)" ::: "memory")
#define VM_WAIT() asm volatile("s_waitcnt vmcnt(0)" ::: "memory")
__device__ __forceinline__ unsigned f2bf(float f) { unsigned u = __builtin_bit_cast(unsigned, f); return (u + 0x7fffu + ((u >> 16) & 1u)) >> 16; }
typedef float f32x2_cv __attribute__((ext_vector_type(2))); typedef __bf16 bf16x2_cv __attribute__((ext_vector_type(2)));
__device__ __forceinline__ unsigned pk2(float lo, float hi) { const f32x2_cv v = {lo, hi}; const bf16x2_cv b = __builtin_convertvector(v, bf16x2_cv); return __builtin_bit_cast(unsigned, b); }
__device__ __forceinline__ float bflo(unsigned w) { return __builtin_bit_cast(float, w << 16); }
__device__ __forceinline__ float bfhi(unsigned w) { return __builtin_bit_cast(float, w & 0xffff0000u); }
#define XB_TMO      128
#define XB_XCNT(j)  (256  + 64 * (j))
#define XB_XSUB(j)  (1280 + 64 * (j))
#define XB_XGEN(j)  (2304 + 64 * (j))
#define XB_TOP      3328
#define XB_TOPGEN   3392
#define XCD_BAR_WORDS 3456
#define XB_SPIN_CAP (1u << 18)

__device__ __forceinline__ unsigned xb_ld(unsigned* p)              { return __hip_atomic_load(p, __ATOMIC_RELAXED, __HIP_MEMORY_SCOPE_AGENT); }
__device__ __forceinline__ unsigned xb_add(unsigned* p, unsigned v) { return __hip_atomic_fetch_add(p, v, __ATOMIC_RELAXED, __HIP_MEMORY_SCOPE_AGENT); }
__device__ __forceinline__ unsigned xb_xcc_id() { return (unsigned)__builtin_amdgcn_s_getreg((3 << 11) | 20) & 0xFu; }
#define XB_SPIN(cond, bar) do { unsigned _sp = 0; while (cond) { __builtin_amdgcn_s_sleep(1); \
    if ((++_sp & 255u) == 0u) { if (xb_ld(&(bar)[XB_TMO])) break; if (_sp > XB_SPIN_CAP) { atomicAdd(&(bar)[XB_TMO], 1u); break; } } } } while (0)

struct XcdBarrier {
    unsigned* bar; unsigned x;
    volatile LAS unsigned* st;
};

__device__ __forceinline__ XcdBarrier xcd_barrier_post(unsigned* bar, volatile LAS unsigned* st) {
    XcdBarrier b; b.bar = bar; b.x = xb_xcc_id(); b.st = st;
    if (threadIdx.x == 0) (void)xb_add(&bar[XB_XCNT(b.x)], 1u);
    return b;
}
__device__ __forceinline__ void xcd_barrier_complete(unsigned* bar, unsigned x, unsigned& nloc, unsigned& nx) {
    const unsigned G = gridDim.x * gridDim.y * gridDim.z;
    unsigned sum, cnt, mine, sp = 0u;
    for (;;) {
        sum = 0u; cnt = 0u; mine = 0u;
#pragma unroll
        for (unsigned j = 0; j < 16; ++j) { const unsigned c = xb_ld(&bar[XB_XCNT(j)]); sum += c; cnt += (c > 0u) ? 1u : 0u; mine = (j == x) ? c : mine; }
        if (sum == G) break;
        __builtin_amdgcn_s_sleep(1);
        if ((++sp & 255u) == 0u) { if (xb_ld(&bar[XB_TMO])) break; if (sp > XB_SPIN_CAP) { atomicAdd(&bar[XB_TMO], 1u); break; } }
    }
    nloc = mine > 0u ? mine : 1u; nx = cnt > 0u ? cnt : 1u;
}

__device__ __forceinline__ void xcd_barrier(const XcdBarrier& b) {
    asm volatile("s_waitcnt vmcnt(0)" ::: "memory");
    __syncthreads();
    if (threadIdx.x == 0) {
        unsigned* bar = b.bar;
        __builtin_amdgcn_s_waitcnt(0);
        unsigned nloc = b.st[0], nx = b.st[1];
        if (nloc == 0u) { xcd_barrier_complete(bar, b.x, nloc, nx); b.st[0] = nloc; b.st[1] = nx; }
        const unsigned old = xb_add(&bar[XB_XSUB(b.x)], 1u);
        const unsigned gen = old / nloc;
        if (old + 1u == (gen + 1u) * nloc) {
            __builtin_amdgcn_fence(__ATOMIC_RELEASE, "agent");
            asm volatile("s_waitcnt vmcnt(0)" ::: "memory");
            const unsigned og = xb_add(&bar[XB_TOP], 1u);
            const unsigned tg = og / nx;
            if (og + 1u == (tg + 1u) * nx) xb_add(&bar[XB_TOPGEN], 1u);
            else XB_SPIN(xb_ld(&bar[XB_TOPGEN]) == tg, bar);
            __builtin_amdgcn_fence(__ATOMIC_ACQUIRE, "agent");
            xb_add(&bar[XB_XGEN(b.x)], 1u);
            asm volatile("s_waitcnt vmcnt(0)" ::: "memory");
        } else {
            XB_SPIN(xb_ld(&bar[XB_XGEN(b.x)]) == gen, bar);
            __builtin_amdgcn_fence(__ATOMIC_ACQUIRE, "agent");
            asm volatile("s_waitcnt vmcnt(0)" ::: "memory");
        }
    }
    __syncthreads();
}

struct Frame {
    LAS unsigned char* lds;
    volatile LAS unsigned* MISC;
    int tid, lane, wave;
    int vcu, G;
    const float *x, *norm_mix, *w_in, *w_pool, *pool_scale, *w_out, *norm_ffn, *w_query, *sub_keys, *expert_u, *expert_v, *norm_final;
    float* out;
    unsigned char* ws;
};

__device__ __forceinline__ float wave_sum(float v) {
#pragma unroll
    for (int o = 1; o < 64; o <<= 1) v += __shfl_xor(v, o);
    return v;
}

__device__ __forceinline__ void p0_transpose_item(const float* W, int N, const float* ks, bf16* WT, int ldo, int col_off, LAS float* scr, int item, int lane) {
    const int nblk = N / 32, kb = item / nblk, nb = item % nblk, k0 = 64 * kb, n0 = 32 * nb;
#pragma unroll 8
    for (int i = 0; i < 32; ++i) { const int kk = 2 * i + (lane >> 5); const float s = ks ? ks[k0 + kk] : 1.f; scr[kk * 33 + (lane & 31)] = W[(size_t)(k0 + kk) * N + n0 + (lane & 31)] * s; }
    LDS_WAIT(); asm volatile("" ::: "memory");
    const int c = lane & 7;
#pragma unroll
    for (int j = 0; j < 4; ++j) { const int n = (lane >> 3) + 8 * j; const LAS float* s = scr + (8 * c) * 33 + n;
        v4u o; o.x = pk2(s[0 * 33], s[1 * 33]); o.y = pk2(s[2 * 33], s[3 * 33]); o.z = pk2(s[4 * 33], s[5 * 33]); o.w = pk2(s[6 * 33], s[7 * 33]);
        *(GAS v4u*)(WT + (size_t)(n0 + n) * ldo + col_off + k0 + 8 * c) = o; }
    LDS_WAIT(); asm volatile("" ::: "memory");
}

__device__ __forceinline__ void p0_prologue(Frame& F) {
    LAS float* scr = (LAS float*)(F.lds + RING_OFF + F.wave * 16384);
    const int gw = F.vcu * NWAVES + F.wave, NGW = F.G * NWAVES;
    bf16* WIN = (bf16*)(F.ws + WS_WIN); bf16* WOUT = (bf16*)(F.ws + WS_WOUT); bf16* WSC = (bf16*)(F.ws + WS_WSC);
    constexpr int I_IN = (D / 64) * (NZ / 32), I_OUT = (DATT / 64) * (D / 32);
    for (int it = gw; it < I_IN + I_OUT; it += NGW) {
        if (it < I_IN) p0_transpose_item(F.w_in, NZ, F.norm_mix, WIN, D, 0, scr, it, F.lane);
        else p0_transpose_item(F.w_out, D, nullptr, WOUT, D, 0, scr, it - I_IN, F.lane);
    }
    const int gt = (F.vcu * NWAVES + F.wave) * 64 + F.lane, NGT = F.G * NWAVES * 64;
    for (int it = gt; it < DPOOL * (D / 4); it += NGT) {
        const int cin = it / (D / 4), n4 = (it % (D / 4)) * 4, g = cin >> 7;
        const float* wp = F.w_pool + (size_t)cin * 128;
        const float* ps = F.pool_scale + g * 128;
        const float* wo = F.w_out + (size_t)(DATT + g * 128) * D + n4;
        f32x4 acc = {0.f, 0.f, 0.f, 0.f};
#pragma unroll 16
        for (int d = 0; d < 128; ++d) { const float a = wp[d] * ps[d]; const f32x4 b = *(const f32x4*)(wo + (size_t)d * D); acc += a * b; }
#pragma unroll
        for (int j = 0; j < 4; ++j) WOUT[(size_t)(n4 + j) * D + DATT + cin] = (bf16)f2bf(acc[j]);
    }
    {
        LAS float* sk = (LAS float*)(F.lds + RING_OFF);
        for (int base = F.vcu * NWAVES; base < 16 * 128; base += F.G * NWAVES) {
            const int blk = base >> 7;
            __syncthreads();
            for (int idx = F.tid; idx < 128 * 32; idx += NWAVES * 64) { const int key = idx >> 5, c4 = (idx & 31) * 4;
                *(LAS f32x4*)(sk + key * 132 + c4) = *(const f32x4*)(F.sub_keys + (size_t)(blk * 128 + key) * 128 + c4); }
            __syncthreads();
            const int d0 = ((base + F.wave) & 127) * 8;
            const float* wq = F.w_query + (size_t)d0 * NSC + blk * 128;
            LAS float* wql = (LAS float*)(F.lds + RING_OFF + 128 * 132 * 4 + F.wave * 4096);
#pragma unroll
            for (int j = 0; j < 4; ++j) { const int r = 2 * j + (F.lane >> 5), cc = (F.lane & 31) * 4; *(LAS f32x4*)(wql + r * 128 + cc) = *(const f32x4*)(wq + (size_t)r * NSC + cc); }
            LDS_WAIT(); asm volatile("" ::: "memory");
            float acc[2][8];
#pragma unroll
            for (int i = 0; i < 2; ++i)
#pragma unroll
                for (int j = 0; j < 8; ++j) acc[i][j] = 0.f;
#pragma unroll 2
            for (int c = 0; c < 128; c += 4) {
                const f32x4 a0 = *(const LAS f32x4*)(sk + (2 * F.lane) * 132 + c), a1 = *(const LAS f32x4*)(sk + (2 * F.lane + 1) * 132 + c);
#pragma unroll
                for (int j = 0; j < 8; ++j) { const f32x4 wv = *(const LAS f32x4*)(wql + j * 128 + c);
                    acc[0][j] += a0[0] * wv[0] + a0[1] * wv[1] + a0[2] * wv[2] + a0[3] * wv[3]; acc[1][j] += a1[0] * wv[0] + a1[1] * wv[1] + a1[2] * wv[2] + a1[3] * wv[3]; }
            }
            const f32x4 g0 = *(const f32x4*)(F.norm_ffn + d0), g1 = *(const f32x4*)(F.norm_ffn + d0 + 4);
#pragma unroll
            for (int i = 0; i < 2; ++i) { v4u o; o.x = pk2(acc[i][0] * g0[0], acc[i][1] * g0[1]); o.y = pk2(acc[i][2] * g0[2], acc[i][3] * g0[3]); o.z = pk2(acc[i][4] * g1[0], acc[i][5] * g1[1]); o.w = pk2(acc[i][6] * g1[2], acc[i][7] * g1[3]);
                *(GAS v4u*)(WSC + (size_t)(blk * 128 + 2 * F.lane + i) * D + d0) = o; }
        }
        __syncthreads();
    }
    {
        bf16* XB = (bf16*)(F.ws + WS_XB); float* R1 = (float*)(F.ws + WS_R1);
        for (int m0 = gw * 4; m0 < M; m0 += NGW * 4) {
            f32x4 a[4][4];
#pragma unroll
            for (int r = 0; r < 4; ++r) { const float* xr = F.x + (size_t)(m0 + r) * D + 8 * F.lane;
                a[r][0] = *(const f32x4*)(xr); a[r][1] = *(const f32x4*)(xr + 4); a[r][2] = *(const f32x4*)(xr + 512); a[r][3] = *(const f32x4*)(xr + 516); }
#pragma unroll
            for (int r = 0; r < 4; ++r) { float s = 0.f;
#pragma unroll
                for (int q = 0; q < 4; ++q) s += (a[r][q][0] * a[r][q][0] + a[r][q][1] * a[r][q][1]) + (a[r][q][2] * a[r][q][2] + a[r][q][3] * a[r][q][3]);
#pragma unroll
                for (int j = 0; j < 2; ++j) { v4u o; o.x = pk2(a[r][2 * j][0], a[r][2 * j][1]); o.y = pk2(a[r][2 * j][2], a[r][2 * j][3]); o.z = pk2(a[r][2 * j + 1][0], a[r][2 * j + 1][1]); o.w = pk2(a[r][2 * j + 1][2], a[r][2 * j + 1][3]);
                    *(GAS v4u*)(XB + (size_t)(m0 + r) * D + 8 * F.lane + 512 * j) = o; }
                s = wave_sum(s);
                if (F.lane == 0) R1[m0 + r] = 1.0f / sqrtf(s * (1.0f / D) + EPS); }
        }
    }
}

constexpr int ATT_KEYS = 384, ATT_KCH = ATT_KEYS * 16 + 16;
constexpr int ATT_K_OFF = 0, ATT_V_OFF = 8 * ATT_KCH;
constexpr int ATT_VDH = 24 * 1024 + 64;
constexpr int ATT_OST_OFF = ATT_V_OFF + 2 * ATT_VDH;
constexpr int ATT_LDS_END = ATT_OST_OFF + NWAVES * 4096;
static_assert(ATT_V_OFF % 16 == 0 && ATT_OST_OFF % 16 == 0 && ATT_LDS_END <= LDSCTL_OFF, "attention LDS map");
constexpr int ATT_UNITS = BATCH * NH * 96;

__device__ __forceinline__ int crow(int r, int hi) { return (r & 3) + 8 * (r >> 2) + 4 * hi; }
__device__ __forceinline__ s16x4 vtr(const LAS unsigned char* p) { return __builtin_bit_cast(s16x4, __builtin_amdgcn_ds_read_tr16_b64_v4i16((LAS s16x4*)p)); }

struct AttnDec { int b, h, br, dsh, pair, s0, res; size_t tokbase; };
__device__ __forceinline__ AttnDec attn_decode(int unit) {
    AttnDec d; const int bh = unit / 96, rem = unit % 96, idx = rem & 31;
    d.br = rem >> 5; d.b = bh >> 3; d.h = bh & 7; d.dsh = 2 * d.br;
    const int ppr = 32 >> d.dsh;
    const int res = idx / ppr; d.res = res; d.pair = idx % ppr; d.s0 = d.pair * 256 - 128;
    d.tokbase = (size_t)d.b * SEQ + res; return d;
}
__device__ __forceinline__ void attn_fetch(Frame& F, int unit, v4u (&kv)[6], v4u (&vv)[6]) {
    const AttnDec d = attn_decode(unit); const bf16* ZHh = (const bf16*)(F.ws + WS_Z) + ((size_t)(d.b * NH + d.h) * SEQ + d.res) * HD;
    int tid = F.tid; asm volatile("" : "+v"(tid));
#pragma unroll
    for (int it = 0; it < 6; ++it) { const int p = tid + 512 * it, key = p >> 3, c = p & 7; int s = d.s0 + key; s = s < 0 ? 0 : s;
        const bf16* row = ZHh + ((size_t)s << d.dsh) * HD + c * 8;
        kv[it] = *(const GAS v4u*)(row + (size_t)M * DATT); vv[it] = *(const GAS v4u*)(row + (size_t)2 * M * DATT); }
}
__device__ __forceinline__ void attn_fetch_q(Frame& F, int unit, bf16x8 (&qr)[4]) {
    const AttnDec d = attn_decode(unit); const bf16* ZHh = (const bf16*)(F.ws + WS_Z) + ((size_t)(d.b * NH + d.h) * SEQ + d.res) * HD;
    int ln = F.lane; asm volatile("" : "+v"(ln));
    const int r32 = ln & 31, hi = ln >> 5, sq0 = d.pair * 256 + 32 * F.wave;
    const bf16* qrow = ZHh + ((size_t)(sq0 + r32) << d.dsh) * HD + hi * 8;
#pragma unroll
    for (int d0 = 0; d0 < 4; ++d0) qr[d0] = *(const GAS bf16x8*)(qrow + d0 * 16);
}
__device__ __forceinline__ void attn_stage(Frame& F, const v4u (&kv)[6], const v4u (&vv)[6]) {
    int tid = F.tid; asm volatile("" : "+v"(tid));
#pragma unroll
    for (int it = 0; it < 6; ++it) { const int p = tid + 512 * it, key = p >> 3, c = p & 7;
        *(LAS v4u*)(F.lds + ATT_K_OFF + c * ATT_KCH + key * 16) = kv[it];
        *(LAS v4u*)(F.lds + ATT_V_OFF + (c >> 2) * ATT_VDH + (key >> 4) * 1024 + (key & 15) * 64 + (c & 3) * 16) = vv[it]; }
}

__device__ __forceinline__ void attn_compute(Frame& F, int unit, const bf16x8 (&qr)[4]) {
    int lane = F.lane; asm volatile("" : "+v"(lane));
    const int w = F.wave, r32 = lane & 31, hi = lane >> 5;
    const AttnDec dd = attn_decode(unit);
    const int h = dd.h, br = dd.br, dsh = dd.dsh, pair = dd.pair; const size_t tokbase = dd.tokbase;
    const int sq0 = pair * 256 + 32 * w;
    f32x16 p[5];
#pragma unroll
    for (int j = 0; j < 5; ++j) {
        p[j] = f32x16{};
        const LAS unsigned char* kb = F.lds + ATT_K_OFF + hi * ATT_KCH + (32 * (w + j) + r32) * 16;
#pragma unroll
        for (int d0 = 0; d0 < 4; ++d0) { const bf16x8 kf = *(const LAS bf16x8*)(kb + 2 * d0 * ATT_KCH); p[j] = __builtin_amdgcn_mfma_f32_32x32x16_bf16(kf, qr[d0], p[j], 0, 0, 0); }
    }
    const float NEGB = -1e30f;
#pragma unroll
    for (int r = 0; r < 16; ++r) { const int kj = crow(r, hi); if (kj < r32) p[0][r] = NEGB; if (kj > r32) p[4][r] = NEGB; }
    if (pair == 0) {
#pragma unroll
        for (int j = 0; j < 4; ++j) if (w + j < 4) {
#pragma unroll
            for (int r = 0; r < 16; ++r) p[j][r] = NEGB; }
    }
    float mx = NEGB;
#pragma unroll
    for (int j = 0; j < 5; ++j)
#pragma unroll
        for (int r = 0; r < 16; ++r) mx = fmaxf(mx, p[j][r]);
    mx = fmaxf(mx, __shfl_xor(mx, 32));
    float l = 0.f;
#pragma unroll
    for (int j = 0; j < 5; ++j)
#pragma unroll
        for (int r = 0; r < 16; ++r) { const float e = __builtin_amdgcn_exp2f(p[j][r] - mx); p[j][r] = e; l += e; }
    l += __shfl_xor(l, 32);
    f32x16 o[2]; o[0] = f32x16{}; o[1] = f32x16{};
    const LAS unsigned char* vb = F.lds + ATT_V_OFF + (4 * hi + ((lane & 15) >> 2)) * 64 + ((lane >> 4) & 1) * 32 + (lane & 3) * 8;
#pragma unroll
    for (int j = 0; j < 5; ++j)
#pragma unroll
        for (int s = 0; s < 2; ++s) {
            v4u pw; pw.x = pk2(p[j][8 * s + 0], p[j][8 * s + 1]); pw.y = pk2(p[j][8 * s + 2], p[j][8 * s + 3]); pw.z = pk2(p[j][8 * s + 4], p[j][8 * s + 5]); pw.w = pk2(p[j][8 * s + 6], p[j][8 * s + 7]);
            const bf16x8 pa = __builtin_bit_cast(bf16x8, pw);
#pragma unroll
            for (int dh = 0; dh < 2; ++dh) {
                const LAS unsigned char* vp = vb + dh * ATT_VDH + (2 * (w + j) + s) * 1024;
                const s16x4 lo = vtr(vp), hh = vtr(vp + 512);
                const bf16x8 vf = (bf16x8){lo[0], lo[1], lo[2], lo[3], hh[0], hh[1], hh[2], hh[3]};
                o[dh] = __builtin_amdgcn_mfma_f32_32x32x16_bf16(pa, vf, o[dh], 0, 0, 0);
            }
        }
    const float rl = 1.0f / l;
    bf16* OB = (bf16*)(F.ws + WS_OB) + (size_t)br * M * DATT;
    float* LSE = (float*)(F.ws + WS_LSE) + (size_t)br * M * NH;
    LAS bf16* stg = (LAS bf16*)(F.lds + ATT_OST_OFF + w * 4096);
#pragma unroll
    for (int r = 0; r < 16; ++r) { const int orow = crow(r, hi); const float rr = __shfl(rl, orow);
        { const unsigned w2 = pk2(o[0][r] * rr, o[1][r] * rr); stg[orow * 64 + r32] = (bf16)(w2 & 0xffffu); stg[orow * 64 + 32 + r32] = (bf16)(w2 >> 16); } }
    if (hi == 0) LSE[(tokbase + ((size_t)(sq0 + r32) << dsh)) * NH + h] = mx + __builtin_amdgcn_logf(l);
    LDS_WAIT();
#pragma unroll
    for (int i = 0; i < 4; ++i) { const int row = i * 8 + (lane >> 3), ch = lane & 7; const v4u v = *(const LAS v4u*)(stg + row * 64 + ch * 8);
        *(GAS v4u*)(OB + (tokbase + ((size_t)(sq0 + row) << dsh)) * DATT + h * HD + ch * 8) = v; }
}


__device__ __forceinline__ void pool_rows(Frame& F) {
    const bf16* ZP = (const bf16*)(F.ws + WS_ZP); bf16* MIX = (bf16*)(F.ws + WS_MIX);
    const int gw = F.vcu * NWAVES + F.wave, NGW = F.G * NWAVES;
    const int win = 2 << (F.lane >> 4);
    constexpr int TPW = 16;
    for (int it = gw; it < M / TPW; it += NGW) {
        const int tb = it * TPW, sb = tb & (SEQ - 1);
        const bf16* zc = ZP + (size_t)tb * DPOOL + 8 * F.lane;
        v4u rows[31];
#pragma unroll
        for (int k = 0; k < 31; ++k) { const int s = sb - 15 + k; rows[k] = (s >= 0) ? *(const GAS v4u*)(zc + (long)(k - 15) * DPOOL) : (v4u){0u, 0u, 0u, 0u}; }
        float ps[8];
#pragma unroll
        for (int e = 0; e < 8; ++e) ps[e] = 0.f;
#pragma unroll
        for (int k = 0; k < 15; ++k) if (k >= 16 - win) { const v4u v = rows[k];
            ps[0] += bflo(v.x); ps[1] += bfhi(v.x); ps[2] += bflo(v.y); ps[3] += bfhi(v.y); ps[4] += bflo(v.z); ps[5] += bfhi(v.z); ps[6] += bflo(v.w); ps[7] += bfhi(v.w); }
#pragma unroll
        for (int i = 0; i < TPW; ++i) {
            const int s = sb + i; const v4u z0 = rows[15 + i];
            ps[0] += bflo(z0.x); ps[1] += bfhi(z0.x); ps[2] += bflo(z0.y); ps[3] += bfhi(z0.y); ps[4] += bflo(z0.z); ps[5] += bfhi(z0.z); ps[6] += bflo(z0.w); ps[7] += bfhi(z0.w);
            const int cnt = (s + 1) < win ? (s + 1) : win; const float inv = 1.0f / (float)cnt;
            v4u o; o.x = pk2(ps[0] * inv - bflo(z0.x), ps[1] * inv - bfhi(z0.x)); o.y = pk2(ps[2] * inv - bflo(z0.y), ps[3] * inv - bfhi(z0.y));
            o.z = pk2(ps[4] * inv - bflo(z0.z), ps[5] * inv - bfhi(z0.z)); o.w = pk2(ps[6] * inv - bflo(z0.w), ps[7] * inv - bfhi(z0.w));
            *(GAS v4u*)(MIX + (size_t)(tb + i) * D + DATT + 8 * F.lane) = o;
            const v4u l2 = rows[15 + i - 1], l4 = rows[15 + i - 3], l8 = rows[15 + i - 7], l16 = rows[15 + i - 15];
            const v4u v = (win == 2) ? l2 : (win == 4) ? l4 : (win == 8) ? l8 : l16;
            ps[0] -= bflo(v.x); ps[1] -= bfhi(v.x); ps[2] -= bflo(v.y); ps[3] -= bfhi(v.y); ps[4] -= bflo(v.z); ps[5] -= bfhi(v.z); ps[6] -= bflo(v.w); ps[7] -= bfhi(v.w);
        }
    }
}

__device__ __forceinline__ void merge_rows(Frame& F) {
    const bf16* OB = (const bf16*)(F.ws + WS_OB); const float* LSE = (const float*)(F.ws + WS_LSE); bf16* MIX = (bf16*)(F.ws + WS_MIX);
    const int gw = F.vcu * NWAVES + F.wave, NGW = F.G * NWAVES;
#pragma unroll 2
    for (int t = gw; t < M; t += NGW) {
        const int h = F.lane >> 3;
        const float l0 = LSE[(size_t)t * NH + h], l1 = LSE[(size_t)(M + t) * NH + h], l2 = LSE[(size_t)(2 * M + t) * NH + h];
        const size_t off = (size_t)t * DATT + 8 * F.lane;
        const v4u a = *(const GAS v4u*)(OB + off), b = *(const GAS v4u*)(OB + (size_t)M * DATT + off), c = *(const GAS v4u*)(OB + (size_t)2 * M * DATT + off);
        const float mx = fmaxf(l0, fmaxf(l1, l2));
        float w0 = __builtin_amdgcn_exp2f(l0 - mx), w1 = __builtin_amdgcn_exp2f(l1 - mx), w2 = __builtin_amdgcn_exp2f(l2 - mx);
        const float inv = 1.0f / (w0 + w1 + w2); w0 *= inv; w1 *= inv; w2 *= inv;
        v4u o;
        o.x = pk2(w0 * bflo(a.x) + w1 * bflo(b.x) + w2 * bflo(c.x), w0 * bfhi(a.x) + w1 * bfhi(b.x) + w2 * bfhi(c.x));
        o.y = pk2(w0 * bflo(a.y) + w1 * bflo(b.y) + w2 * bflo(c.y), w0 * bfhi(a.y) + w1 * bfhi(b.y) + w2 * bfhi(c.y));
        o.z = pk2(w0 * bflo(a.z) + w1 * bflo(b.z) + w2 * bflo(c.z), w0 * bfhi(a.z) + w1 * bfhi(b.z) + w2 * bfhi(c.z));
        o.w = pk2(w0 * bflo(a.w) + w1 * bflo(b.w) + w2 * bflo(c.w), w0 * bfhi(a.w) + w1 * bfhi(b.w) + w2 * bfhi(c.w));
        *(GAS v4u*)(MIX + (size_t)t * D + 8 * F.lane) = o;
    }
}

constexpr int TK_ROW = 68;
constexpr int TK_WAVE_BYTES = 64 * TK_ROW * 4;
static_assert(NWAVES * TK_WAVE_BYTES <= LDSCTL_OFF, "top-k LDS map");

__device__ __forceinline__ unsigned f2ord(float f) { const unsigned u = __builtin_bit_cast(unsigned, f); return (u & 0x80000000u) ? ~u : (u | 0x80000000u); }
__device__ __forceinline__ float ord2f(unsigned k) { const unsigned u = (k & 0x80000000u) ? (k & 0x7fffffffu) : ~k; return __builtin_bit_cast(float, u); }
#define TK_CE(a, b) do { const unsigned hi_ = max(a, b), lo_ = min(a, b); a = hi_; b = lo_; } while (0)
#define TK_SORT16(N) do { TK_CE(N[0], N[1]); TK_CE(N[2], N[3]); TK_CE(N[0], N[2]); TK_CE(N[1], N[3]); TK_CE(N[1], N[2]); TK_CE(N[4], N[5]); TK_CE(N[6], N[7]); TK_CE(N[4], N[6]); TK_CE(N[5], N[7]); TK_CE(N[5], N[6]); TK_CE(N[0], N[4]); TK_CE(N[2], N[6]); TK_CE(N[2], N[4]); TK_CE(N[1], N[5]); TK_CE(N[3], N[7]); TK_CE(N[3], N[5]); TK_CE(N[1], N[2]); TK_CE(N[3], N[4]); TK_CE(N[5], N[6]); TK_CE(N[8], N[9]); TK_CE(N[10], N[11]); TK_CE(N[8], N[10]); TK_CE(N[9], N[11]); TK_CE(N[9], N[10]); TK_CE(N[12], N[13]); TK_CE(N[14], N[15]); TK_CE(N[12], N[14]); TK_CE(N[13], N[15]); TK_CE(N[13], N[14]); TK_CE(N[8], N[12]); TK_CE(N[10], N[14]); TK_CE(N[10], N[12]); TK_CE(N[9], N[13]); TK_CE(N[11], N[15]); TK_CE(N[11], N[13]); TK_CE(N[9], N[10]); TK_CE(N[11], N[12]); TK_CE(N[13], N[14]); TK_CE(N[0], N[8]); TK_CE(N[4], N[12]); TK_CE(N[4], N[8]); TK_CE(N[2], N[10]); TK_CE(N[6], N[14]); TK_CE(N[6], N[10]); TK_CE(N[2], N[4]); TK_CE(N[6], N[8]); TK_CE(N[10], N[12]); TK_CE(N[1], N[9]); TK_CE(N[5], N[13]); TK_CE(N[5], N[9]); TK_CE(N[3], N[11]); TK_CE(N[7], N[15]); TK_CE(N[7], N[11]); TK_CE(N[3], N[5]); TK_CE(N[7], N[9]); TK_CE(N[11], N[13]); TK_CE(N[1], N[2]); TK_CE(N[3], N[4]); TK_CE(N[5], N[6]); TK_CE(N[7], N[8]); TK_CE(N[9], N[10]); TK_CE(N[11], N[12]); TK_CE(N[13], N[14]); } while (0)
#define TK_BMERGE16(L) do { TK_CE(L[0], L[8]); TK_CE(L[1], L[9]); TK_CE(L[2], L[10]); TK_CE(L[3], L[11]); TK_CE(L[4], L[12]); TK_CE(L[5], L[13]); TK_CE(L[6], L[14]); TK_CE(L[7], L[15]); TK_CE(L[0], L[4]); TK_CE(L[1], L[5]); TK_CE(L[2], L[6]); TK_CE(L[3], L[7]); TK_CE(L[8], L[12]); TK_CE(L[9], L[13]); TK_CE(L[10], L[14]); TK_CE(L[11], L[15]); TK_CE(L[0], L[2]); TK_CE(L[1], L[3]); TK_CE(L[4], L[6]); TK_CE(L[5], L[7]); TK_CE(L[8], L[10]); TK_CE(L[9], L[11]); TK_CE(L[12], L[14]); TK_CE(L[13], L[15]); TK_CE(L[0], L[1]); TK_CE(L[2], L[3]); TK_CE(L[4], L[5]); TK_CE(L[6], L[7]); TK_CE(L[8], L[9]); TK_CE(L[10], L[11]); TK_CE(L[12], L[13]); TK_CE(L[14], L[15]); } while (0)
#define TK_INSERT(L, xin) do { unsigned x_ = (xin); _Pragma("unroll") for (int i_ = 0; i_ < 16; ++i_) { const unsigned hi_ = max(L[i_], x_); x_ = min(L[i_], x_); L[i_] = hi_; } } while (0)

constexpr int EXP_NCH = 2 * NEXP;
__device__ __forceinline__ void expcvt_load(Frame& F, int ci, f32x4 (&a)[4], int lane) {
    const float* src = (ci < NEXP ? F.expert_u + (size_t)ci * D : F.expert_v + (size_t)(ci - NEXP) * D) + 16 * lane;
#pragma unroll
    for (int q = 0; q < 4; ++q) a[q] = *(const GAS f32x4*)(src + 4 * q);
}
__device__ __forceinline__ void expcvt_store(Frame& F, int ci, const f32x4 (&a)[4], int lane) {
    const bool isu = ci < NEXP;
    if (isu) {
        f32x4 v[4];
#pragma unroll
        for (int q = 0; q < 4; ++q) { v[q] = a[q] * 56.0f; v[q] = v[q] * *(const GAS f32x4*)(F.norm_ffn + 16 * lane + 4 * q); }
        unsigned w2[2];
        w2[0] = __builtin_amdgcn_cvt_scalef32_pk_fp4_f32(0u, v[0][0], v[0][1], 1.0f, 0); w2[0] = __builtin_amdgcn_cvt_scalef32_pk_fp4_f32(w2[0], v[0][2], v[0][3], 1.0f, 1);
        w2[0] = __builtin_amdgcn_cvt_scalef32_pk_fp4_f32(w2[0], v[1][0], v[1][1], 1.0f, 2); w2[0] = __builtin_amdgcn_cvt_scalef32_pk_fp4_f32(w2[0], v[1][2], v[1][3], 1.0f, 3);
        w2[1] = __builtin_amdgcn_cvt_scalef32_pk_fp4_f32(0u, v[2][0], v[2][1], 1.0f, 0); w2[1] = __builtin_amdgcn_cvt_scalef32_pk_fp4_f32(w2[1], v[2][2], v[2][3], 1.0f, 1);
        w2[1] = __builtin_amdgcn_cvt_scalef32_pk_fp4_f32(w2[1], v[3][0], v[3][1], 1.0f, 2); w2[1] = __builtin_amdgcn_cvt_scalef32_pk_fp4_f32(w2[1], v[3][2], v[3][3], 1.0f, 3);
        *(GAS v2u*)(F.ws + WS_EU + (size_t)ci * (D / 2) + 8 * lane) = (v2u){w2[0], w2[1]};
        return;
    }
    {
        f32x4 v[4];
#pragma unroll
        for (int q = 0; q < 4; ++q) v[q] = a[q] * 7.0f;
        unsigned w2[2];
        w2[0] = __builtin_amdgcn_cvt_scalef32_pk_fp4_f32(0u, v[0][0], v[0][1], 1.0f, 0); w2[0] = __builtin_amdgcn_cvt_scalef32_pk_fp4_f32(w2[0], v[0][2], v[0][3], 1.0f, 1);
        w2[0] = __builtin_amdgcn_cvt_scalef32_pk_fp4_f32(w2[0], v[1][0], v[1][1], 1.0f, 2); w2[0] = __builtin_amdgcn_cvt_scalef32_pk_fp4_f32(w2[0], v[1][2], v[1][3], 1.0f, 3);
        w2[1] = __builtin_amdgcn_cvt_scalef32_pk_fp4_f32(0u, v[2][0], v[2][1], 1.0f, 0); w2[1] = __builtin_amdgcn_cvt_scalef32_pk_fp4_f32(w2[1], v[2][2], v[2][3], 1.0f, 1);
        w2[1] = __builtin_amdgcn_cvt_scalef32_pk_fp4_f32(w2[1], v[3][0], v[3][1], 1.0f, 2); w2[1] = __builtin_amdgcn_cvt_scalef32_pk_fp4_f32(w2[1], v[3][2], v[3][3], 1.0f, 3);
        *(GAS v2u*)(F.ws + WS_EV + (size_t)(ci - NEXP) * (D / 2) + 8 * lane) = (v2u){w2[0], w2[1]};
    }
}
__device__ __forceinline__ void tk_fetch(const unsigned short* SCH, int t0, int rnd, v4u (&sn)[8], int lane) {
    const int p = rnd >> 1, kc = rnd & 1;
#pragma unroll
    for (int i = 0; i < 8; ++i) { const int pr = 8 * i + (lane >> 3), tl = pr >> 3, h = pr & 7;
        sn[i] = *(const GAS v4u*)(SCH + (size_t)(t0 + tl) * NSC + h * 256 + p * 128 + kc * 64 + (lane & 7) * 8); }
}

__device__ __forceinline__ void topk_phase(Frame& F) {
    const unsigned short* SCH = (const unsigned short*)(F.ws + WS_SCH); const float* SS = (const float*)(F.ws + WS_SS);
    int* IDX = (int*)(F.ws + WS_IDX); float* GATE = (float*)(F.ws + WS_GATE);
    const int gw = F.vcu * NWAVES + F.wave, NGW = F.G * NWAVES, lane = F.lane;
    LAS float* st = (LAS float*)(F.lds + F.wave * TK_WAVE_BYTES);
    int cnext = gw;
    v4u sn[8];
    for (int it = gw; it < M / 8; it += NGW) {
        const int t0 = it * 8;
        unsigned L0[16], L1[16];
#pragma unroll
        for (int i = 0; i < 16; ++i) { L0[i] = 0u; L1[i] = 0u; }
        if (it == gw) tk_fetch(SCH, t0, 0, sn, lane);
#pragma unroll
        for (int rnd = 0; rnd < 4; ++rnd) {
            const int p = rnd >> 1, kc = rnd & 1;
            v4u sc[8];
#pragma unroll
            for (int i = 0; i < 8; ++i) sc[i] = sn[i];
            if (rnd < 3) tk_fetch(SCH, t0, rnd + 1, sn, lane); else if (it + NGW < M / 8) tk_fetch(SCH, (it + NGW) * 8, 0, sn, lane);
            f32x4 xa[4], xb[4]; const int c0 = cnext, c1 = cnext + NGW;
            if (c0 < EXP_NCH) expcvt_load(F, c0, xa, lane); if (c1 < EXP_NCH) expcvt_load(F, c1, xb, lane);
#pragma unroll
            for (int i = 0; i < 8; ++i) { const int pr = 8 * i + (lane >> 3);
                const v4u v = sc[i];
                f32x4 lo, hi;
#pragma unroll
                for (int e = 0; e < 2; ++e) { const unsigned wa = v[e], wb = v[2 + e];
                    const pg8::f16x2_t a = __builtin_bit_cast(pg8::f16x2_t, wa), b = __builtin_bit_cast(pg8::f16x2_t, wb);
                    lo[2 * e] = (float)a.x; lo[2 * e + 1] = (float)a.y; hi[2 * e] = (float)b.x; hi[2 * e + 1] = (float)b.y; }
                *(LAS f32x4*)(st + pr * TK_ROW + (lane & 7) * 8) = lo; *(LAS f32x4*)(st + pr * TK_ROW + (lane & 7) * 8 + 4) = hi; }
            LDS_WAIT(); asm volatile("" ::: "memory");
#pragma unroll 1
            for (int q = 0; q < 4; ++q) {
                unsigned N[16];
#pragma unroll
                for (int u = 0; u < 4; ++u) { const f32x4 v = *(const LAS f32x4*)(st + lane * TK_ROW + q * 16 + u * 4);
#pragma unroll
                    for (int e = 0; e < 4; ++e) N[4 * u + e] = (f2ord(v[e]) & ~127u) | (unsigned)(127 - (kc * 64 + q * 16 + u * 4 + e)); }
                TK_SORT16(N);
                if (p == 0) {
#pragma unroll
                    for (int i = 0; i < 16; ++i) L0[i] = max(L0[i], N[15 - i]);
                    TK_BMERGE16(L0);
                } else {
#pragma unroll
                    for (int i = 0; i < 16; ++i) L1[i] = max(L1[i], N[15 - i]);
                    TK_BMERGE16(L1);
                }
            }
            if (c0 < EXP_NCH) expcvt_store(F, c0, xa, lane); if (c1 < EXP_NCH) expcvt_store(F, c1, xb, lane);
            cnext += 2 * NGW;
            LDS_WAIT(); asm volatile("" ::: "memory");
        }
        LAS float* pv0 = st; LAS float* pv1 = st + 16 * 64; LAS int* pi0 = (LAS int*)(st + 32 * 64); LAS int* pi1 = (LAS int*)(st + 48 * 64);
        float v0[16], v1[16];
#pragma unroll
        for (int i = 0; i < 16; ++i) { v0[i] = ord2f(L0[i] & ~127u); v1[i] = ord2f(L1[i] & ~127u);
            pv0[i * 64 + lane] = v0[i]; pv1[i * 64 + lane] = v1[i]; pi0[i * 64 + lane] = 127 - (int)(L0[i] & 127u); pi1[i * 64 + lane] = 127 - (int)(L1[i] & 127u); }
        unsigned T[16];
#pragma unroll
        for (int i = 0; i < 16; ++i) T[i] = 0u;
        {
            unsigned N[16]; int nn = 0;
#pragma unroll
            for (int i = 0; i < 16; ++i)
#pragma unroll
                for (int j = 0; j < 16; ++j) if ((i + 1) * (j + 1) <= 16) {
                    N[nn & 15] = (f2ord(v0[i] + v1[j]) & ~255u) | (unsigned)(255 - (i * 16 + j)); ++nn;
                    if ((nn & 15) == 0 || nn == 50) {
                        if (nn == 50) { N[2] = 0u; N[3] = 0u; N[4] = 0u; N[5] = 0u; N[6] = 0u; N[7] = 0u; N[8] = 0u; N[9] = 0u; N[10] = 0u; N[11] = 0u; N[12] = 0u; N[13] = 0u; N[14] = 0u; N[15] = 0u; }
                        TK_SORT16(N);
#pragma unroll
                        for (int q = 0; q < 16; ++q) T[q] = max(T[q], N[15 - q]);
                        TK_BMERGE16(T);
                    }
                }
        }
        LDS_WAIT(); asm volatile("" ::: "memory");
        const int tl = lane >> 3, h = lane & 7, t = t0 + tl;
        float ssum = 0.f;
        { const float* sp = SS + (size_t)t * 16;
#pragma unroll
          for (int i = 0; i < 4; ++i) { const f32x4 v = *(const GAS f32x4*)(sp + 4 * i); ssum += (v[0] + v[1]) + (v[2] + v[3]); } }
        const float r2 = 1.0f / sqrtf(ssum * (1.0f / D) + EPS);
        float bs[16]; int ex[16]; float mxs = -3.0e38f;
#pragma unroll
        for (int k = 0; k < 16; ++k) { const int pos = 255 - (int)(T[k] & 255u), i = pos >> 4, j = pos & 15;
            bs[k] = (pv0[i * 64 + lane] + pv1[j * 64 + lane]) * r2; ex[k] = pi0[i * 64 + lane] * NKEYS + pi1[j * 64 + lane]; mxs = fmaxf(mxs, bs[k]); }
        float den = 0.f;
#pragma unroll
        for (int k = 0; k < 16; ++k) { bs[k] = __expf(bs[k] - mxs); den += bs[k]; }
        const float inv = 1.0f / den;
        int* ip = IDX + ((size_t)t * PEER_H + h) * TOPK; float* gp = GATE + ((size_t)t * PEER_H + h) * TOPK;
#pragma unroll
        for (int k = 0; k < 16; k += 4) { *(GAS v4u*)(ip + k) = (v4u){(unsigned)ex[k], (unsigned)ex[k + 1], (unsigned)ex[k + 2], (unsigned)ex[k + 3]};
            *(GAS f32x4*)(gp + k) = (f32x4){bs[k] * inv, bs[k + 1] * inv, bs[k + 2] * inv, bs[k + 3] * inv}; }
        LDS_WAIT(); asm volatile("" ::: "memory");
    }
    for (; cnext < EXP_NCH; cnext += NGW) { f32x4 xa[4]; expcvt_load(F, cnext, xa, lane); expcvt_store(F, cnext, xa, lane); }
}

typedef float f32x2 __attribute__((ext_vector_type(2)));
typedef long l64x2 __attribute__((ext_vector_type(2)));
constexpr float EU_SCALE = 56.0f, EV_SCALE = 4.0f;
__device__ __forceinline__ float gelu_erf(float v) {
    const float av = __builtin_fabsf(v), t = __builtin_amdgcn_rcpf(av * 0.2316418882f + 1.0f);
    float q = t * 0.5307027145f + (-0.7265760135f); q = q * t + 0.7107068705f; q = q * t + (-0.142248368f); q = q * t + 0.127414796f; q = q * t;
    const float e = __builtin_amdgcn_exp2f((v * v) * (-0.72134752044f));
    const float m = v * (q * e);
    return v < 0.f ? m : v - m;
}
constexpr int PU_WAVE_LDS = 17408;
constexpr int PU_SL = 0, PU_E16 = 8192, PU_TOK = 12288, PU_ACT = 14336, PU_HIST = 16384, PU_DSCR = 16384;
constexpr int PV_SSP = NWAVES * PU_WAVE_LDS;
static_assert(PV_SSP + 512 <= LDSCTL_OFF, "PEER LDS map");
constexpr float ACT_SCALE = 64.0f, EV4_SCALE = 7.0f;
#ifndef PEER_UACT_EXPR
#define PEER_UACT_EXPR gelu_erf(a * (1.0f / EU_SCALE)) * gt
#endif
#ifndef PEER_ACT_EXPR
#define PEER_ACT_EXPR __builtin_bit_cast(float, itv.y)
#endif
#ifndef PEER_V_ITEMS
#define PEER_V_ITEMS 128
#endif

#ifndef PROBE_NOBPERM
#define PROBE_NOBPERM 0
#endif
typedef int v8i_t __attribute__((ext_vector_type(8)));
__device__ __forceinline__ void peer_u_loadA(v4u (&A)[8], const unsigned char* EU, unsigned e, int lane) {
    int l3 = lane & 3; asm volatile("" : "+v"(l3));
    const GAS unsigned char* rowp = (const GAS unsigned char*)EU + (size_t)e * (D / 2) + 16 * l3;
#pragma unroll
    for (int i = 0; i < 8; ++i) A[i] = *(const GAS v4u*)(rowp + 64 * i);
}
template <unsigned EMASK, bool DUMMY> __device__ __forceinline__ void peer_u_phase(Frame& F, int blk) {
    const int* IDX = (const int*)(F.ws + WS_IDX); const float* GATE = (const float*)(F.ws + WS_GATE); const float* SS = (const float*)(F.ws + WS_SS);
    const unsigned char* EU = F.ws + WS_EU;
    int lane = F.lane; asm volatile("" : "+v"(lane));
    const int c = lane & 15, g = lane >> 4;
    const int T0 = blk * 128 + F.wave * 16;
    LAS unsigned char* wl = F.lds + F.wave * PU_WAVE_LDS;
    LAS unsigned* SL = (LAS unsigned*)(wl + PU_SL); LAS unsigned* HIST = (LAS unsigned*)(wl + PU_HIST); LAS float* DSCR = (LAS float*)(wl + PU_DSCR);
    LAS unsigned short* E16 = (LAS unsigned short*)(wl + PU_E16); LAS unsigned char* TOK8 = wl + PU_TOK; LAS unsigned char* ACT8 = wl + PU_ACT;
    *(LAS v4u*)(HIST + 4 * lane) = (v4u){0u, 0u, 0u, 0u};
    LDS_WAIT(); asm volatile("" ::: "memory");
    unsigned ev[32];
#pragma unroll
    for (int q = 0; q < 32; ++q) ev[q] = (unsigned)IDX[(size_t)T0 * 128 + q * 64 + lane];
#pragma unroll
    for (int q = 0; q < 32; ++q) __hip_atomic_fetch_add(HIST + (ev[q] >> 6), 1u, __ATOMIC_RELAXED, __HIP_MEMORY_SCOPE_WAVEFRONT);
    LDS_WAIT(); asm volatile("" ::: "memory");
    {
        const v4u hv = *(const LAS v4u*)(HIST + 4 * lane); const unsigned tot = hv.x + hv.y + hv.z + hv.w; unsigned inc = tot;
#pragma unroll
        for (int o = 1; o < 64; o <<= 1) { const unsigned n = (unsigned)__shfl_up((int)inc, o); if (lane >= o) inc += n; }
        const unsigned ex = inc - tot;
        LDS_WAIT(); asm volatile("" ::: "memory");
        *(LAS v4u*)(HIST + 4 * lane) = (v4u){ex, ex + hv.x, ex + hv.x + hv.y, ex + hv.x + hv.y + hv.z};
    }
    LDS_WAIT(); asm volatile("" ::: "memory");
#pragma unroll
    for (int q = 0; q < 32; ++q) { const unsigned p = (unsigned)(q * 64 + lane); const unsigned e = ev[q];
        const unsigned pos = __hip_atomic_fetch_add(HIST + (e >> 6), 1u, __ATOMIC_RELAXED, __HIP_MEMORY_SCOPE_WAVEFRONT); SL[pos] = (e << 11) | p; }
    LDS_WAIT(); asm volatile("" ::: "memory");
    v8i_t Bop[8];
    {
        const int tB = T0 + c; float s = 0.f;
#pragma unroll
        for (int i = 0; i < 4; ++i) { const f32x4 v = *(const GAS f32x4*)(SS + (size_t)tB * 16 + 4 * i); s += (v[0] + v[1]) + (v[2] + v[3]); }
        const float r2 = 1.0f / sqrtf(s * (1.0f / D) + EPS);
        int gq = g; asm volatile("" : "+v"(gq));
        const bf16* xp = (const bf16*)(F.ws + WS_XB) + (size_t)tB * D + 16 * gq;
#pragma unroll
        for (int i = 0; i < 8; ++i) { v8i_t o;
#pragma unroll
            for (int k = 0; k < 4; ++k) { const v4u xa = *(const GAS v4u*)(xp + 128 * i + 64 * (k >> 1) + 8 * (k & 1));
#pragma unroll
                for (int q = 0; q < 2; ++q) { const unsigned w0 = xa[2 * q], w1 = xa[2 * q + 1];
                    int w = __builtin_amdgcn_cvt_pk_fp8_f32(bflo(w0) * r2, bfhi(w0) * r2, 0, false); w = __builtin_amdgcn_cvt_pk_fp8_f32(bflo(w1) * r2, bfhi(w1) * r2, w, true); o[2 * k + q] = w; } }
            Bop[i] = o; if ((i & 3) == 3) asm volatile("" : "+v"(Bop[i - 3]), "+v"(Bop[i - 2]), "+v"(Bop[i - 1]), "+v"(Bop[i]) :: "memory"); }
    }
#define PU_TAIL(b) *(LAS f32x4*)(DSCR + 4 * lane) = acc; LDS_WAIT(); asm volatile("" ::: "memory"); if (lane < 16) { const unsigned p = itcur & 2047u, cr = p >> 7, e = itcur >> 11; const float a = DSCR[((lane >> 2) * 16 + cr) * 4 + (lane & 3)]; const float sact = (PEER_UACT_EXPR) * ACT_SCALE; const unsigned a8 = (unsigned)__builtin_amdgcn_cvt_pk_fp8_f32(sact, 0.f, 0, false) & 0xffu; if (!DUMMY) { E16[16 * (b) + lane] = (unsigned short)e; TOK8[16 * (b) + lane] = (unsigned char)cr; ACT8[16 * (b) + lane] = (unsigned char)a8; } } LDS_WAIT(); asm volatile("" ::: "memory");
    v4u A0[8], A1[8];
    const int psrc = (4 * c + g) * 4;
    { const unsigned i0_ = SL[lane >> 2], i1_ = SL[16 + (lane >> 2)];
      peer_u_loadA(A0, EU, (i0_ >> 11) & EMASK, lane); peer_u_loadA(A1, EU, (i1_ >> 11) & EMASK, lane); }
#define PU_STEP(Acur, b) do { \
        const unsigned itcur = SL[16 * (b) + c]; \
        float gt = 0.f; if (lane < 16) gt = GATE[(size_t)T0 * 128 + (itcur & 2047u)]; \
        const int bn = ((b) + 2 < 128) ? (b) + 2 : (b); \
        const unsigned itl = SL[16 * bn + (lane >> 2)]; \
        int l3 = lane & 3; asm volatile("" : "+v"(l3)); \
        const GAS unsigned char* nrow = (const GAS unsigned char*)EU + (size_t)((itl >> 11) & EMASK) * (D / 2) + 16 * l3; \
        f32x4 acc = {0.f, 0.f, 0.f, 0.f}; \
        _Pragma("unroll") for (int i = 0; i < 8; ++i) { v4u t; \
            _Pragma("unroll") for (int w = 0; w < 4; ++w) t[w] = (DUMMY && PROBE_NOBPERM) ? Acur[i][w] : (unsigned)__builtin_amdgcn_ds_bpermute(psrc, (int)Acur[i][w]); \
            Acur[i] = *(const GAS v4u*)(nrow + 64 * i); \
            const v8i_t a8 = {(int)t[0], (int)t[1], (int)t[2], (int)t[3], 0, 0, 0, 0}; \
            acc = __builtin_amdgcn_mfma_scale_f32_16x16x128_f8f6f4(a8, Bop[i], acc, 4  , 0  , 0, 0x7f7f7f7f, 0, 0x7f7f7f7f); } \
        PU_TAIL(b) \
    } while (0)
#pragma unroll 1
    for (int b = 0; b < 128; b += 2) { PU_STEP(A0, b); PU_STEP(A1, b + 1); }
#undef PU_STEP
#undef PU_TAIL
}

template <unsigned EMASK> __device__ __forceinline__ void peer_v_phase(Frame& F, int blk) {
    typedef int v2i_t __attribute__((ext_vector_type(2)));
    int lane = F.lane; asm volatile("" : "+v"(lane));
    const int w = F.wave;
    LAS unsigned char* stg = F.lds + w * PU_WAVE_LDS;
    LAS float* SSP = (LAS float*)(F.lds + PV_SSP);
    const __amdgpu_buffer_rsrc_t evr = __builtin_amdgcn_make_buffer_rsrc((void*)(F.ws + WS_EV), 0, NEXP * (D / 2), 0x00020000);
    const int t16 = lane & 15, g4 = lane >> 4;
    const unsigned tsplat = (unsigned)t16 * 0x01010101u;
    const int srow = lane >> 2, sc16 = lane & 3;
    const int et = lane >> 2, eq = lane & 3;
    const unsigned coff = 64u * (unsigned)w + 16u * (unsigned)sc16;
    __syncthreads();
#pragma unroll 1
    for (int g = 0; g < 8; ++g) {
        const LAS unsigned char* gl = F.lds + g * PU_WAVE_LDS;
        const LAS unsigned short* E16 = (const LAS unsigned short*)(gl + PU_E16); const LAS unsigned char* TOK8 = gl + PU_TOK; const LAS unsigned char* ACT8 = gl + PU_ACT;
        const int T0 = blk * 128 + g * 16;
        f32x4 acc[8];
#pragma unroll
        for (int j = 0; j < 8; ++j) acc[j] = (f32x4){0.f, 0.f, 0.f, 0.f};
        v4u sv[2][8];
#pragma unroll
        for (int u = 0; u < 2; ++u)
#pragma unroll
            for (int m = 0; m < 8; ++m) sv[u][m] = __builtin_amdgcn_raw_buffer_load_b128(evr, (int)(((unsigned)E16[128 * u + 16 * m + srow] & EMASK) * 512u + coff), 0, 0);
#pragma unroll 1
        for (int b0 = 0; b0 < 16; b0 += 2) {
#pragma unroll
          for (int u = 0; u < 2; ++u) { const int b = b0 + u;
#pragma unroll
            for (int m = 0; m < 8; ++m) { const int row = 16 * m + srow; *(LAS v4u*)(stg + 64 * row + 16 * (sc16 ^ ((row >> 1) & 3))) = sv[u][m]; }
            const int bn = (b + 2 < 16) ? b + 2 : b;
#pragma unroll
            for (int m = 0; m < 8; ++m) sv[u][m] = __builtin_amdgcn_raw_buffer_load_b128(evr, (int)(((unsigned)E16[128 * bn + 16 * m + srow] & EMASK) * 512u + coff), 0, 0);
            const v4u tk0 = *(const LAS v4u*)(TOK8 + 128 * b + 16 * g4), tk1 = *(const LAS v4u*)(TOK8 + 128 * b + 64 + 16 * g4);
            const v4u ak0 = *(const LAS v4u*)(ACT8 + 128 * b + 16 * g4), ak1 = *(const LAS v4u*)(ACT8 + 128 * b + 64 + 16 * g4);
            v8i_t aop;
#pragma unroll
            for (int h = 0; h < 4; ++h) { const unsigned x0 = tk0[h] ^ tsplat, x1 = tk1[h] ^ tsplat;
                const unsigned z0 = ~((x0 | 0x80808080u) - 0x01010101u) & 0x80808080u, z1 = ~((x1 | 0x80808080u) - 0x01010101u) & 0x80808080u;
                aop[h] = (int)(ak0[h] & ((z0 >> 7) * 0xffu)); aop[4 + h] = (int)(ak1[h] & ((z1 >> 7) * 0xffu)); }
            asm volatile("" ::: "memory");
#pragma unroll
            for (int j = 0; j < 8; ++j) {
                const int r0 = 32 * g4 + t16, r1 = r0 + 16;
                const v2i_t lo = __builtin_amdgcn_ds_read_tr4_b64_v2i32((LAS v2i_t*)(stg + 64 * r0 + 16 * ((j >> 1) ^ ((r0 >> 1) & 3)) + 8 * (j & 1)));
                const v2i_t hi = __builtin_amdgcn_ds_read_tr4_b64_v2i32((LAS v2i_t*)(stg + 64 * r1 + 16 * ((j >> 1) ^ ((r1 >> 1) & 3)) + 8 * (j & 1)));
                const v8i_t bop = {lo.x, lo.y, hi.x, hi.y, 0, 0, 0, 0};
                acc[j] = __builtin_amdgcn_mfma_scale_f32_16x16x128_f8f6f4(aop, bop, acc[j], 0  , 4  , 0, 0x7f7f7f7f, 0, 0x7f7f7f7f); }
            asm volatile("" ::: "memory");
          }
        }
        LAS float* yt = (LAS float*)stg;
#pragma unroll
        for (int j = 0; j < 8; ++j)
#pragma unroll
            for (int v = 0; v < 4; ++v) yt[(4 * g4 + v) * 128 + 16 * j + t16] = acc[j][v];
        LDS_WAIT(); asm volatile("" ::: "memory");
        const bf16* xr = (const bf16*)(F.ws + WS_XB) + (size_t)(T0 + et) * D + 128 * w + 32 * eq;
        f32x4 x2[8]; float ss = 0.f;
#pragma unroll
        for (int k = 0; k < 4; ++k) { const v4u xw = *(const GAS v4u*)(xr + 8 * k); const f32x4 y0 = *(const LAS f32x4*)(yt + et * 128 + 32 * eq + 8 * k), y1 = *(const LAS f32x4*)(yt + et * 128 + 32 * eq + 8 * k + 4);
            const unsigned w0 = xw.x, w1 = xw.y, w2 = xw.z, w3 = xw.w; const float sc = 1.0f / (ACT_SCALE * EV4_SCALE);
            x2[2 * k] = (f32x4){bflo(w0) + y0[0] * sc, bfhi(w0) + y0[1] * sc, bflo(w1) + y0[2] * sc, bfhi(w1) + y0[3] * sc};
            x2[2 * k + 1] = (f32x4){bflo(w2) + y1[0] * sc, bfhi(w2) + y1[1] * sc, bflo(w3) + y1[2] * sc, bfhi(w3) + y1[3] * sc};
            const f32x4 o0 = x2[2 * k], o1 = x2[2 * k + 1];
            ss += (o0[0] * o0[0] + o0[1] * o0[1]) + (o0[2] * o0[2] + o0[3] * o0[3]) + (o1[0] * o1[0] + o1[1] * o1[1]) + (o1[2] * o1[2] + o1[3] * o1[3]); }
        ss += __shfl_xor(ss, 1); ss += __shfl_xor(ss, 2);
        if (eq == 0) SSP[et * 8 + w] = ss;
        __syncthreads();
        { const f32x4 s0 = *(const LAS f32x4*)(SSP + et * 8), s1 = *(const LAS f32x4*)(SSP + et * 8 + 4);
          const float tot = ((s0[0] + s0[1]) + (s0[2] + s0[3])) + ((s1[0] + s1[1]) + (s1[2] + s1[3]));
          const float r3 = 1.0f / sqrtf(tot * (1.0f / D) + EPS);
          float* orow = F.out + (size_t)(T0 + et) * D + 128 * w + 32 * eq; const float* gn = F.norm_final + 128 * w + 32 * eq;
#pragma unroll
          for (int k = 0; k < 8; ++k) { const f32x4 gv = *(const GAS f32x4*)(gn + 4 * k); const f32x4 v = x2[k];
              *(GAS f32x4*)(orow + 4 * k) = (f32x4){v[0] * r3 * gv[0], v[1] * r3 * gv[1], v[2] * r3 * gv[2], v[3] * r3 * gv[3]}; } }
        __syncthreads();
    }
}

struct Args { const float* in[12]; float* out; unsigned char* ws; };
__global__ void __launch_bounds__(NWAVES * 64, 2) hymba_fwd(Args args) {
    extern __shared__ __attribute__((aligned(16))) unsigned char lds[];
    Frame F;
    F.lds = (LAS unsigned char*)lds;
    F.MISC = (volatile LAS unsigned*)(F.lds + MISC_OFF);
    F.tid = threadIdx.x; F.lane = F.tid & 63; F.wave = __builtin_amdgcn_readfirstlane(F.tid >> 6);
    F.G = gridDim.x; { const int bx = blockIdx.x; F.vcu = (F.G % 8 == 0) ? (bx % 8) * (F.G / 8) + bx / 8 : bx; }
    F.x = args.in[0]; F.norm_mix = args.in[1]; F.w_in = args.in[2]; F.w_pool = args.in[3]; F.pool_scale = args.in[4]; F.w_out = args.in[5];
    F.norm_ffn = args.in[6]; F.w_query = args.in[7]; F.sub_keys = args.in[8]; F.expert_u = args.in[9]; F.expert_v = args.in[10]; F.norm_final = args.in[11];
    F.out = args.out; F.ws = args.ws;
    for (int u = F.tid; u < (LDS_BYTES - LDSCTL_OFF) / 4; u += NWAVES * 64) ((LAS unsigned*)(F.lds + LDSCTL_OFF))[u] = 0u;
    __syncthreads();
    XcdBarrier bar = xcd_barrier_post((unsigned*)(F.ws + WS_CTL), F.MISC + 8);
#define GRID_BAR() xcd_barrier(bar)
#ifndef PROBE_SPIN
#define PROBE_SPIN -1
#endif
    unsigned long long ps_t0 = 0;
#define PH_BEGIN(k) do { if (PROBE_SPIN == (k)) ps_t0 = __builtin_amdgcn_s_memrealtime(); } while (0)
#define PH_END(k) do { if (PROBE_SPIN == (k)) { const unsigned long long t1 = __builtin_amdgcn_s_memrealtime(), dt = t1 - ps_t0; while (__builtin_amdgcn_s_memrealtime() - t1 < dt) __builtin_amdgcn_s_sleep(8); } } while (0)

#ifndef PROBE_DUP
#define PROBE_DUP -1
#endif
#ifdef TR4TEST
    {
        LAS unsigned char* tb = F.lds + 4096 * F.wave;
        for (int i = F.lane; i < 512; i += 64) { const int grp = i >> 7, r = (i >> 3) & 15, cb = i & 7;
            const unsigned lo = (unsigned)(r + 3 * (2 * cb) + 5 * grp) & 15u, hi = (unsigned)(r + 3 * (2 * cb + 1) + 5 * grp) & 15u; tb[i] = (unsigned char)(lo | (hi << 4)); }
        LDS_WAIT(); asm volatile("" ::: "memory");
        typedef int v2i_t4 __attribute__((ext_vector_type(2)));
        const int l16 = F.lane & 15, grp = F.lane >> 4;
#if TR4TEST == 1
        const int roff = l16 * 8;
#else
        const int roff = ((l16 + 1) & 15) * 8;
#endif
        const v2i_t4 rr = __builtin_amdgcn_ds_read_tr4_b64_v2i32((LAS v2i_t4*)(tb + grp * 128 + roff));
        const unsigned long long got = ((unsigned long long)(unsigned)rr.y << 32) | (unsigned)rr.x; unsigned long long want = 0;
        for (int j = 0; j < 16; ++j) want |= (unsigned long long)((unsigned)(j + 3 * l16 + 5 * grp) & 15u) << (4 * j);
        if (got != want) __hip_atomic_store((unsigned*)(F.ws + WS_CTL) + 8, 1u, RLX_AGENT);
        LDS_WAIT(); asm volatile("" ::: "memory");
        __syncthreads();
    }
#endif
#ifdef DIAGS
    if (blockIdx.x == 0 && F.wave == 0) {
        typedef int v8i_d __attribute__((ext_vector_type(8)));
        const int g0 = (DIAGS) >> 5, j0 = (DIAGS) & 31, r0 = 3;
        const int lg = F.lane >> 4;
        v8i_d A = {0, 0, 0, 0, 0, 0, 0, 0};
        if (F.lane == 16 * g0 + r0) A[j0 >> 3] = 0x2 << (4 * (j0 & 7));
        int P = 0;
        for (int bit = 0; bit < 7; ++bit) {
            v8i_d B;
#pragma unroll
            for (int rg = 0; rg < 8; ++rg) { unsigned w = 0;
#pragma unroll
                for (int by = 0; by < 4; ++by) { const int j = 4 * rg + by; if (((lg * 32 + j) >> bit) & 1) w |= 0x38u << (8 * by); }
                B[rg] = (int)w; }
            f32x4 acc = {0.f, 0.f, 0.f, 0.f};
            acc = __builtin_amdgcn_mfma_scale_f32_16x16x128_f8f6f4(A, B, acc, 4, 0, 0, 0x7f7f7f7f, 0, 0x7f7f7f7f);
            const float dsel = acc[r0 & 3];
            const float d = __builtin_bit_cast(float, __builtin_amdgcn_readlane(__builtin_bit_cast(int, dsel), 16 * (r0 >> 2)));
            if (d > 0.5f) P |= 1 << bit;
        }
        const unsigned long long t1 = __builtin_amdgcn_s_memrealtime();
        while (__builtin_amdgcn_s_memrealtime() - t1 < (unsigned long long)(P + 1) * 10000ull) __builtin_amdgcn_s_sleep(8);
    }
#endif
#ifdef TRTEST
    {
        LAS unsigned char* tb = F.lds + 4096 * F.wave;
        for (int i = F.lane; i < 512; i += 64) tb[i] = (unsigned char)((i & 127) ^ ((i >> 7) * 0x55));
        LDS_WAIT(); asm volatile("" ::: "memory");
        typedef int v2i_t __attribute__((ext_vector_type(2)));
        const int l16 = F.lane & 15, grp = F.lane >> 4;
#if TRTEST == 1
        const int roff = (l16 >> 1) * 16 + (l16 & 1) * 8;
#else
        const int roff = (l16 & 7) * 16 + (l16 >> 3) * 8;
#endif
        const v2i_t rr = __builtin_amdgcn_ds_read_tr8_b64_v2i32((LAS v2i_t*)(tb + grp * 128 + roff));
        unsigned long long got = ((unsigned long long)(unsigned)rr.y << 32) | (unsigned)rr.x, want = 0;
        for (int j = 0; j < 8; ++j) want |= (unsigned long long)(unsigned char)(((j * 16 + l16) & 127) ^ (grp * 0x55)) << (8 * j);
        if (got != want) __hip_atomic_store((unsigned*)(F.ws + WS_CTL) + 8, 1u, RLX_AGENT);
        LDS_WAIT(); asm volatile("" ::: "memory");
        __syncthreads();
    }
#endif
#ifdef UBENCH
    {
        unsigned r0 = F.tid, r1 = F.tid * 3, r2 = F.tid * 5, r3 = F.tid * 7; float f0 = 1.f, f1 = 2.f, f2 = 3.f, f3 = 4.f; f32x2 p0 = {1.f, 2.f}, p1 = {3.f, 4.f}, q0 = {0.f, 0.f}, q1 = {0.f, 0.f}, q2 = {0.f, 0.f}, q3 = {0.f, 0.f};
        for (int it = 0; it < 20000; ++it) {
#pragma unroll
            for (int k = 0; k < 4; ++k) {
#if UBENCH == 1
                asm volatile("v_cvt_pk_f32_fp8_e32 %0, %4\n v_cvt_pk_f32_fp8_e32 %1, %5\n v_cvt_pk_f32_fp8_e32 %2, %6\n v_cvt_pk_f32_fp8_e32 %3, %7" : "=v"(q0), "=v"(q1), "=v"(q2), "=v"(q3) : "v"(r0), "v"(r1), "v"(r2), "v"(r3));
#elif UBENCH == 2
                asm volatile("v_cvt_f32_ubyte0_e32 %0, %4\n v_cvt_f32_ubyte1_e32 %1, %5\n v_cvt_f32_ubyte2_e32 %2, %6\n v_cvt_f32_ubyte3_e32 %3, %7" : "=v"(f0), "=v"(f1), "=v"(f2), "=v"(f3) : "v"(r0), "v"(r1), "v"(r2), "v"(r3));
#elif UBENCH == 3
                asm volatile("v_pk_fma_f32 %0, %4, %5, %0\n v_pk_fma_f32 %1, %4, %5, %1\n v_pk_fma_f32 %2, %4, %5, %2\n v_pk_fma_f32 %3, %4, %5, %3" : "+v"(q0), "+v"(q1), "+v"(q2), "+v"(q3) : "v"(p0), "v"(p1));
#elif UBENCH == 4
                asm volatile("v_dot2_f32_f16 %0, %4, %5, %0\n v_dot2_f32_f16 %1, %4, %6, %1\n v_dot2_f32_f16 %2, %5, %6, %2\n v_dot2_f32_f16 %3, %6, %7, %3" : "+v"(f0), "+v"(f1), "+v"(f2), "+v"(f3) : "v"(r0), "v"(r1), "v"(r2), "v"(r3));
#elif UBENCH == 5
                asm volatile("v_perm_b32 %0, %4, %5, %6\n v_perm_b32 %1, %5, %6, %7\n v_perm_b32 %2, %4, %6, %7\n v_perm_b32 %3, %4, %5, %7" : "=v"(f0), "=v"(f1), "=v"(f2), "=v"(f3) : "v"(r0), "v"(r1), "v"(r2), "v"(r3));
#elif UBENCH == 6
                asm volatile("v_fma_f32 %0, %4, %5, %0\n v_fma_f32 %1, %4, %5, %1\n v_fma_f32 %2, %4, %5, %2\n v_fma_f32 %3, %4, %5, %3" : "+v"(f0), "+v"(f1), "+v"(f2), "+v"(f3) : "v"(p0.x), "v"(p1.y));
#elif UBENCH == 8
                asm volatile("v_pk_fma_f16 %0, %4, %5, %0\n v_pk_fma_f16 %1, %4, %5, %1\n v_pk_fma_f16 %2, %4, %5, %2\n v_pk_fma_f16 %3, %4, %5, %3" : "+v"(f0), "+v"(f1), "+v"(f2), "+v"(f3) : "v"(r0), "v"(r1));
#elif UBENCH == 9
                asm volatile("v_cvt_scalef32_pk_f16_fp8 %0, %4, 1.0\n v_cvt_scalef32_pk_f16_fp8 %1, %5, 1.0\n v_cvt_scalef32_pk_f16_fp8 %2, %6, 1.0\n v_cvt_scalef32_pk_f16_fp8 %3, %7, 1.0" : "=v"(f0), "=v"(f1), "=v"(f2), "=v"(f3) : "v"(r0), "v"(r1), "v"(r2), "v"(r3));
#elif UBENCH == 10
                asm volatile("v_cvt_pk_f32_fp8_sdwa %0, %4 src0_sel:WORD_1\n v_cvt_pk_f32_fp8_sdwa %1, %5 src0_sel:WORD_1\n v_cvt_pk_f32_fp8_sdwa %2, %6 src0_sel:WORD_1\n v_cvt_pk_f32_fp8_sdwa %3, %7 src0_sel:WORD_1" : "=v"(q0), "=v"(q1), "=v"(q2), "=v"(q3) : "v"(r0), "v"(r1), "v"(r2), "v"(r3));
#elif UBENCH == 7
                asm volatile("v_dot4_i32_i8 %0, %4, %5, %0\n v_dot4_i32_i8 %1, %4, %6, %1\n v_dot4_i32_i8 %2, %5, %6, %2\n v_dot4_i32_i8 %3, %6, %7, %3" : "+v"(f0), "+v"(f1), "+v"(f2), "+v"(f3) : "v"(r0), "v"(r1), "v"(r2), "v"(r3));
#endif
            }
        }
        float* dump = (float*)(F.ws + WS_Z);
        dump[(size_t)blockIdx.x * 512 + F.tid] = f0 + f1 + f2 + f3 + q0.x + q1.y + q2.x + q3.y;
    }
#endif
    PH_BEGIN(0); p0_prologue(F); PH_END(0);
    if (PROBE_DUP == 0) { GRID_BAR(); p0_prologue(F); }
    GRID_BAR();
    PH_BEGIN(1);
    {
        pg8::Gemm g{(const pg8::bf16_t*)(F.ws + WS_XB), (const pg8::bf16_t*)(F.ws + WS_WIN), M, NZ, D}; pg8::StaticOrder S; S.init(M, NZ, F.G, (int)blockIdx.x);
        pg8::EpiZ E{(pg8::bf16_t*)(F.ws + WS_Z), (pg8::bf16_t*)(F.ws + WS_ZP), (const float*)(F.ws + WS_R1), DATT, QSCALE, SEQ, NH, M};
        pg8::gemm_phase<pg8::EpiZ, pg8::StaticOrder, PG8_ALIGN, PG8_SP2>(F.lds + RING_OFF, g, S, E);
        if (PROBE_DUP == 1) { GRID_BAR(); pg8::gemm_phase<pg8::EpiZ, pg8::StaticOrder, PG8_ALIGN, PG8_SP2>(F.lds + RING_OFF, g, S, E); }
    }
    PH_END(1);
    GRID_BAR();
    PH_BEGIN(2);
    {
        v4u kv[6], vv[6]; bf16x8 qc[4], qn[4];
        int u = F.vcu;
        if (u < ATT_UNITS) { attn_fetch(F, u, kv, vv); attn_fetch_q(F, u, qn); }
        for (; u < ATT_UNITS; u += F.G) {
#pragma unroll
            for (int d0 = 0; d0 < 4; ++d0) qc[d0] = qn[d0];
            attn_stage(F, kv, vv);
            __syncthreads();
            if (u + F.G < ATT_UNITS) { attn_fetch(F, u + F.G, kv, vv); attn_fetch_q(F, u + F.G, qn); }
            attn_compute(F, u, qc);
            __syncthreads();
        }
    }
    PH_END(2);
    PH_BEGIN(3); pool_rows(F); PH_END(3);
    if (PROBE_DUP == 3) { GRID_BAR(); pool_rows(F); }
    GRID_BAR();
    PH_BEGIN(4); merge_rows(F); PH_END(4);
    if (PROBE_DUP == 4) { GRID_BAR(); merge_rows(F); }
    GRID_BAR();
    PH_BEGIN(5);
    {
        pg8::Gemm g{(const pg8::bf16_t*)(F.ws + WS_MIX), (const pg8::bf16_t*)(F.ws + WS_WOUT), M, D, D}; pg8::StaticOrder S; S.init(M, D, F.G, (int)blockIdx.x);
        pg8::EpiRes E{(pg8::bf16_t*)(F.ws + WS_XB), (float*)(F.ws + WS_SS), D};
        pg8::gemm_phase<pg8::EpiRes, pg8::StaticOrder, PG8_ALIGN, PG8_SP2>(F.lds + RING_OFF, g, S, E);
        if (PROBE_DUP == 5) { GRID_BAR(); pg8::gemm_phase<pg8::EpiRes, pg8::StaticOrder, PG8_ALIGN, PG8_SP2>(F.lds + RING_OFF, g, S, E); }
    }
    PH_END(5);
    GRID_BAR();
    PH_BEGIN(6);
    {
        pg8::Gemm g{(const pg8::bf16_t*)(F.ws + WS_XB), (const pg8::bf16_t*)(F.ws + WS_WSC), M, NSC, D}; pg8::StaticOrder S; S.init(M, NSC, F.G, (int)blockIdx.x);
        pg8::EpiF16 E{(unsigned short*)(F.ws + WS_SCH), NSC};
        pg8::gemm_phase<pg8::EpiF16, pg8::StaticOrder, PG8_ALIGN, PG8_SP2>(F.lds + RING_OFF, g, S, E);
        if (PROBE_DUP == 6) { GRID_BAR(); pg8::gemm_phase<pg8::EpiF16, pg8::StaticOrder, PG8_ALIGN, PG8_SP2>(F.lds + RING_OFF, g, S, E); }
    }
    PH_END(6);
    GRID_BAR();
    PH_BEGIN(7); topk_phase(F); PH_END(7);
    if (PROBE_DUP == 7) { GRID_BAR(); topk_phase(F); }
    GRID_BAR();
#ifndef VSYNC
#define VSYNC 0
#endif
#ifndef PROBE_U2
#define PROBE_U2 0
#endif
#ifndef PROBE_UMASK
#define PROBE_UMASK 0x3fffu
#endif
    for (int blk = F.vcu; blk < M / 128; blk += F.G) { PH_BEGIN(8); peer_u_phase<0x3fffu, false>(F, blk); PH_END(8); PH_BEGIN(9); peer_v_phase<0x3fffu>(F, blk); PH_END(9); }
#if defined(TRTEST) || defined(TR4TEST)
    GRID_BAR();
    if (blockIdx.x == 0 && F.tid == 0 && __hip_atomic_load((unsigned*)(F.ws + WS_CTL) + 8, RLX_AGENT) != 0u) F.out[0] = __builtin_nanf("");
#endif
}

extern "C" void kernel_launch(void* const* d_in, const int* in_sizes, int n_in, void* d_out, int out_size, void* d_ws, size_t ws_size, hipStream_t stream) {
    static int grid = 0;
    if (grid == 0) {
        if (n_in != 12 || in_sizes[0] != M * D || out_size != M * D || ws_size < WS_END) { fprintf(stderr, "kernel_launch: unexpected shapes (n_in %d, in0 %d, out %d, ws %zu); nothing launched\n", n_in, n_in > 0 ? in_sizes[0] : -1, out_size, ws_size); grid = -1; return; }
        int dev = 0, cus = 0, per_cu = 0;
        if (hipGetDevice(&dev) != hipSuccess || hipDeviceGetAttribute(&cus, hipDeviceAttributeMultiprocessorCount, dev) != hipSuccess) { grid = -1; return; }
        if (hipFuncSetAttribute((const void*)hymba_fwd, hipFuncAttributeMaxDynamicSharedMemorySize, LDS_BYTES) != hipSuccess) { fprintf(stderr, "kernel_launch: hipFuncSetAttribute failed\n"); grid = -1; return; }
        if (hipOccupancyMaxActiveBlocksPerMultiprocessor(&per_cu, (const void*)hymba_fwd, NWAVES * 64, LDS_BYTES) != hipSuccess || per_cu < 1)
            fprintf(stderr, "kernel_launch: note: occupancy query reports %d workgroups per CU\n", per_cu);
        (void)hipGetLastError();
        grid = cus;
    }
    if (grid < 0) return;
    if (hipMemsetAsync((char*)d_ws + WS_CTL, 0, CTL_ZERO_BYTES, stream) != hipSuccess) { fprintf(stderr, "kernel_launch: hipMemsetAsync failed\n"); return; }
    Args a{};
    for (int i = 0; i < 12; ++i) a.in[i] = (const float*)d_in[i];
    a.out = (float*)d_out; a.ws = (unsigned char*)d_ws;
    hipLaunchKernelGGL(hymba_fwd, dim3(grid), dim3(NWAVES * 64), LDS_BYTES, stream, a);
    const hipError_t le = hipPeekAtLastError();
    if (le != hipSuccess) fprintf(stderr, "kernel_launch: launch failed: %s\n", hipGetErrorName(le));
}
```

```cpp
#include <hip/hip_runtime.h>
#include <cstdio>
#include <cstdint>
namespace pg8 {
#define PG8_LAS __attribute__((address_space(3)))
typedef unsigned short bf16_t;
typedef short bf16x8 __attribute__((ext_vector_type(8)));
typedef float f32x4 __attribute__((ext_vector_type(4)));
typedef unsigned u32x4 __attribute__((ext_vector_type(4)));
constexpr int BM = 256, BK = 64, HALF = 128, HTB = HALF * BK * 2  , STAGE_BYTES = 8 * HTB, NXCD = 8, WGM = 8;

__host__ __device__ __forceinline__ int lds_byte(int r, int c) { const int st = (r >> 4) * 2 + (c >> 5), rr = r & 15, cc = c & 31, ob = rr * 64 + cc * 2; return st * 1024 + (ob ^ (((ob >> 9) & 1) << 5)); }
__host__ __device__ __forceinline__ void stage_rc(int b, int& R, int& C) { const int st = b / 1024, sb = b % 1024, swz = sb ^ (((sb >> 9) & 1) << 5); R = (st >> 1) * 16 + swz / 64; C = (st & 1) * 32 + (swz % 64) / 2; }
__host__ __device__ __forceinline__ int perm32(int rho) { const int n = rho >> 4, i = rho & 15; return 8 * (i >> 2) + 4 * n + (i & 3); }

struct Unit { int pm, pn; };
struct Gemm { const bf16_t* A; const bf16_t* Bt; int M, N, K; };

struct StaticOrder {
    int nM, nN, nwg, G, c;
    __host__ __device__ void init(int M, int N, int G_, int c_) { nM = M / BM; nN = N / BM; nwg = nM * nN; G = G_; c = c_; }
    __host__ __device__ bool next(int i, Unit& u) const {
        const long L = (long)i * G + c; if (L >= nwg) return false;
        int wgid = (int)L; { const int q = nwg / NXCD, r = nwg % NXCD, xcd = wgid % NXCD, off = wgid / NXCD; wgid = (xcd < r ? xcd * (q + 1) : r * (q + 1) + (xcd - r) * q) + off; }
        const int nig = WGM * nN, gid = wgid / nig, fm = gid * WGM, gsz = (nM - fm) < WGM ? (nM - fm) : WGM;
        u.pm = fm + ((wgid % nig) % gsz); u.pn = (wgid % nig) / gsz; return true;
    }
    __device__ __forceinline__ void a_ready(const Unit&) const {}
    __device__ __forceinline__ void done(const Unit&) const {}
};

__device__ __forceinline__ unsigned cvt_pk_bf16(float lo, float hi) { unsigned r; asm volatile("v_cvt_pk_bf16_f32 %0, %1, %2" : "=v"(r) : "v"(lo), "v"(hi)); return r; }
struct EpiZ {
    static constexpr bool PERM = true, AFTER_DRAIN = false;
    bf16_t* ZH; bf16_t* ZP; const float* rs; int qcols; float qscale; int seq, nh, mrows;
    __device__ __forceinline__ void operator()(const f32x4 (&acc)[2][2][4][2], const Unit& u, int wr, int wc, int fr, int fq) const {
        const int row0 = u.pm * BM + wr * 64 + fr; const int colt = u.pn * BM;
        const float sc = (colt < qcols) ? qscale : 1.f;
        const int col0 = colt + wc * 32 + 8 * fq;
#pragma unroll
        for (int ai = 0; ai < 2; ++ai)
#pragma unroll
            for (int m = 0; m < 4; ++m) { const int row = row0 + ai * HALF + m * 16; const float s = rs[row] * sc; const int bq = row / seq, sq = row - bq * seq;
#pragma unroll
                for (int bj = 0; bj < 2; ++bj) { const f32x4 v0 = acc[ai][bj][m][0] * s, v1 = acc[ai][bj][m][1] * s; const int cc = col0 + bj * HALF;
                    u32x4 w; w.x = cvt_pk_bf16(v0[0], v0[1]); w.y = cvt_pk_bf16(v0[2], v0[3]); w.z = cvt_pk_bf16(v1[0], v1[1]); w.w = cvt_pk_bf16(v1[2], v1[3]);
                    bf16_t* dst = (cc < 3 * 512) ? ZH + (size_t)(cc >> 9) * mrows * 512 + ((size_t)(bq * nh + ((cc >> 6) & 7)) * seq + sq) * 64 + (cc & 63)
                                                 : ZP + (size_t)row * 512 + (cc - 3 * 512);
                    *(u32x4*)dst = w; } }
    }
};
struct EpiRes {
    static constexpr bool PERM = true, AFTER_DRAIN = false;
    bf16_t* XB; float* SS; int ldc;
    __device__ __forceinline__ void operator()(const f32x4 (&acc)[2][2][4][2], const Unit& u, int wr, int wc, int fr, int fq) const {
        const int row0 = u.pm * BM + wr * 64 + fr; const int col0 = u.pn * BM + wc * 32 + 8 * fq;
#pragma unroll
        for (int ai = 0; ai < 2; ++ai)
#pragma unroll
            for (int m = 0; m < 4; ++m) { const int row = row0 + ai * HALF + m * 16; const size_t off = (size_t)row * ldc + col0; float ss = 0.f;
#pragma unroll
                for (int bj = 0; bj < 2; ++bj) {
                    const u32x4 xw = *(const u32x4*)(XB + off + bj * HALF);
                    f32x4 v0 = acc[ai][bj][m][0], v1 = acc[ai][bj][m][1];
                    v0[0] += __builtin_bit_cast(float, xw.x << 16); v0[1] += __builtin_bit_cast(float, xw.x & 0xffff0000u); v0[2] += __builtin_bit_cast(float, xw.y << 16); v0[3] += __builtin_bit_cast(float, xw.y & 0xffff0000u);
                    v1[0] += __builtin_bit_cast(float, xw.z << 16); v1[1] += __builtin_bit_cast(float, xw.z & 0xffff0000u); v1[2] += __builtin_bit_cast(float, xw.w << 16); v1[3] += __builtin_bit_cast(float, xw.w & 0xffff0000u);
                    ss += (v0[0] * v0[0] + v0[1] * v0[1]) + (v0[2] * v0[2] + v0[3] * v0[3]) + (v1[0] * v1[0] + v1[1] * v1[1]) + (v1[2] * v1[2] + v1[3] * v1[3]);
                    u32x4 w; w.x = cvt_pk_bf16(v0[0], v0[1]); w.y = cvt_pk_bf16(v0[2], v0[3]); w.z = cvt_pk_bf16(v1[0], v1[1]); w.w = cvt_pk_bf16(v1[2], v1[3]);
                    *(u32x4*)(XB + off + bj * HALF) = w; }
                ss += __shfl_xor(ss, 16); ss += __shfl_xor(ss, 32);
                if (fq == 0) SS[(size_t)row * 16 + u.pn * 4 + wc] = ss;
                if (m & 1) asm volatile("" ::: "memory"); }
    }
};
typedef _Float16 f16x2_t __attribute__((ext_vector_type(2)));
__device__ __forceinline__ unsigned cvt_pk_f16(float lo, float hi) { const f16x2_t h = {(_Float16)lo, (_Float16)hi}; return __builtin_bit_cast(unsigned, h); }
struct EpiF16 {
    static constexpr bool PERM = true, AFTER_DRAIN = false;
    unsigned short* O; int ldc;
    __device__ __forceinline__ void operator()(const f32x4 (&acc)[2][2][4][2], const Unit& u, int wr, int wc, int fr, int fq) const {
        const int row0 = u.pm * BM + wr * 64 + fr; const int col0 = u.pn * BM + wc * 32 + 8 * fq;
#pragma unroll
        for (int ai = 0; ai < 2; ++ai)
#pragma unroll
            for (int m = 0; m < 4; ++m) { unsigned short* rowp = O + (size_t)(row0 + ai * HALF + m * 16) * ldc + col0;
#pragma unroll
                for (int bj = 0; bj < 2; ++bj) { const f32x4 v0 = acc[ai][bj][m][0], v1 = acc[ai][bj][m][1];
                    u32x4 w; w.x = cvt_pk_f16(v0[0], v0[1]); w.y = cvt_pk_f16(v0[2], v0[3]); w.z = cvt_pk_f16(v1[0], v1[1]); w.w = cvt_pk_f16(v1[2], v1[3]);
                    *(u32x4*)(rowp + bj * HALF) = w; } }
    }
};

template <class Epi, class Sched, bool ALIGN_EPI = false, bool SP2 = false>
__device__ __forceinline__ void gemm_phase(PG8_LAS unsigned char* lds, const Gemm g, const Sched& S, const Epi& E) {
    const int tid = threadIdx.x, wid = __builtin_amdgcn_readfirstlane(tid >> 6), lane = tid & 63, wr = wid >> 2, wc = wid & 3, fr = lane & 15, fq = lane >> 4;
    const int K = g.K, nt = K / BK;
    unsigned voffA[2], voffB[2];
#pragma unroll
    for (int i = 0; i < 2; ++i) { int R, C; stage_rc(tid * 16 + i * 8192, R, C); const int Rb = Epi::PERM ? ((R & ~31) + perm32(R & 31)) : R;
        voffA[i] = (unsigned)(R * K + C) * 2u; voffB[i] = (unsigned)(Rb * K + C) * 2u; }
    const size_t kstep = (size_t)(BK * 2);
    const size_t hstep = (size_t)HALF * K * 2;
    const size_t tstep = 2 * hstep;
    const unsigned ldsw = (unsigned)wid * 1024u;
    const int aoff = lds_byte(wr * 64 + fr, fq * 8), boff = lds_byte(wc * 32 + fr, fq * 8);
#define PG8_SA(b, h) (((b) * 2 + (h)) * HTB)
#define PG8_SB(b, h) ((4 + (b) * 2 + (h)) * HTB)
#define PG8_STAGE(bufoff, gbase, voff) do { _Pragma("unroll") for (int _i = 0; _i < 2; ++_i) \
        __builtin_amdgcn_global_load_lds((const unsigned*)((const char*)(gbase) + (voff)[_i]), (PG8_LAS unsigned*)(lds + (bufoff) + ldsw + _i * 8192), 16, 0, 0); } while (0)
#define PG8_LDA(dst, b, h) do { _Pragma("unroll") for (int m = 0; m < 4; ++m) _Pragma("unroll") for (int k = 0; k < 2; ++k) dst[m][k] = *(const PG8_LAS bf16x8*)(lds + PG8_SA(b, h) + aoff + m * 2048 + k * 1024); } while (0)
#define PG8_LDB(dst, b, h) do { _Pragma("unroll") for (int n = 0; n < 2; ++n) _Pragma("unroll") for (int k = 0; k < 2; ++k) dst[n][k] = *(const PG8_LAS bf16x8*)(lds + PG8_SB(b, h) + boff + n * 2048 + k * 1024); } while (0)
#define PG8_MMA(ai, bj, At, Bt) do { __builtin_amdgcn_s_setprio(1); _Pragma("unroll") for (int m = 0; m < 4; ++m) _Pragma("unroll") for (int n = 0; n < 2; ++n) _Pragma("unroll") for (int k = 0; k < 2; ++k) \
        acc[ai][bj][m][n] = __builtin_amdgcn_mfma_f32_16x16x32_bf16(Bt[n][k], At[m][k], acc[ai][bj][m][n], 0, 0, 0); __builtin_amdgcn_s_setprio(0); } while (0)
#define PG8_WAIT_V(n) asm volatile("s_waitcnt vmcnt(" #n ")" ::: "memory")
#define PG8_WAIT_L(n) asm volatile("s_waitcnt lgkmcnt(" #n ")" ::: "memory")
#define PG8_BAR __builtin_amdgcn_s_barrier()
#define PG8_SCHED __builtin_amdgcn_sched_barrier(0)
    Unit cur, nxt; int ui = 0;
    if (!S.next(0, cur)) return;
    f32x4 acc[2][2][4][2];
#pragma unroll
    for (int a = 0; a < 2; ++a)
#pragma unroll
        for (int b = 0; b < 2; ++b)
#pragma unroll
            for (int m = 0; m < 4; ++m)
#pragma unroll
                for (int n = 0; n < 2; ++n) acc[a][b][m][n] = (f32x4){0.f, 0.f, 0.f, 0.f};
    bf16x8 At[4][2], B0[2][2], B1[2][2];
    const char* cA = (const char*)g.A + (size_t)cur.pm * tstep; const char* cB = (const char*)g.Bt + (size_t)cur.pn * tstep;
    S.a_ready(cur);
    if constexpr (SP2) {
        PG8_STAGE(PG8_SB(0, 0), cB, voffB); PG8_STAGE(PG8_SB(0, 1), cB + hstep, voffB); PG8_STAGE(PG8_SA(0, 0), cA, voffA); PG8_STAGE(PG8_SA(0, 1), cA + hstep, voffA);
        if (wr == 1) PG8_BAR;
        PG8_WAIT_V(2); PG8_BAR;
        PG8_STAGE(PG8_SB(1, 0), cB + kstep, voffB); PG8_STAGE(PG8_SA(1, 0), cA + kstep, voffA); PG8_STAGE(PG8_SB(1, 1), cB + hstep + kstep, voffB);
        PG8_WAIT_V(6); PG8_BAR;
    } else {
        PG8_STAGE(PG8_SB(0, 0), cB, voffB); PG8_STAGE(PG8_SA(0, 0), cA, voffA); PG8_STAGE(PG8_SB(0, 1), cB + hstep, voffB); PG8_STAGE(PG8_SA(0, 1), cA + hstep, voffA);
        if (wr == 1) PG8_BAR;
        PG8_WAIT_V(4); PG8_BAR;
        PG8_STAGE(PG8_SB(1, 0), cB + kstep, voffB); PG8_STAGE(PG8_SA(1, 0), cA + kstep, voffA); PG8_STAGE(PG8_SB(1, 1), cB + hstep + kstep, voffB);
        PG8_WAIT_V(6); PG8_BAR;
    }
    for (;;) {
        const bool has_next = S.next(ui + 1, nxt);
        const char* nA = has_next ? (const char*)g.A + (size_t)nxt.pm * tstep : cA; const char* nB = has_next ? (const char*)g.Bt + (size_t)nxt.pn * tstep : cB;
        for (int t = 0; t < nt; t += 2) {
            const bool last = (t == nt - 2);
            const char* a1 = cA + (size_t)(t + 1) * kstep;
            const char* a2 = last ? nA : cA + (size_t)(t + 2) * kstep; const char* b2 = last ? nB : cB + (size_t)(t + 2) * kstep;
            const char* a3 = a2 + kstep; const char* b3 = b2 + kstep;
            if (last && has_next) S.a_ready(nxt);
            if constexpr (SP2) {
            PG8_LDB(B0, 0, 0); PG8_LDB(B1, 0, 1); PG8_SCHED; PG8_LDA(At, 0, 0); PG8_STAGE(PG8_SA(1, 1), a1 + hstep, voffA);
            PG8_WAIT_V(8); PG8_WAIT_L(0); PG8_BAR; PG8_MMA(0, 0, At, B0); PG8_MMA(0, 1, At, B1); PG8_BAR; PG8_SCHED;
            PG8_LDA(At, 0, 1); PG8_STAGE(PG8_SB(0, 0), b2, voffB); PG8_STAGE(PG8_SB(0, 1), b2 + hstep, voffB); PG8_STAGE(PG8_SA(0, 0), a2, voffA);
            PG8_WAIT_V(8); PG8_WAIT_L(0); PG8_BAR; PG8_MMA(1, 0, At, B0); PG8_MMA(1, 1, At, B1); PG8_BAR; PG8_SCHED;
            PG8_LDB(B0, 1, 0); PG8_LDB(B1, 1, 1); PG8_SCHED; PG8_LDA(At, 1, 0); PG8_STAGE(PG8_SA(0, 1), a2 + hstep, voffA);
            PG8_WAIT_V(8); PG8_WAIT_L(0); PG8_BAR; PG8_MMA(0, 0, At, B0); PG8_MMA(0, 1, At, B1); PG8_BAR; PG8_SCHED;
            PG8_LDA(At, 1, 1); PG8_STAGE(PG8_SB(1, 0), b3, voffB); PG8_STAGE(PG8_SB(1, 1), b3 + hstep, voffB); PG8_STAGE(PG8_SA(1, 0), a3, voffA);
            PG8_WAIT_V(8); PG8_WAIT_L(0); PG8_BAR; PG8_MMA(1, 0, At, B0); PG8_MMA(1, 1, At, B1); PG8_BAR; PG8_SCHED;
            } else {
            PG8_LDB(B0, 0, 0); PG8_SCHED; PG8_LDA(At, 0, 0); PG8_STAGE(PG8_SA(1, 1), a1 + hstep, voffA);
            PG8_WAIT_L(8); PG8_BAR; PG8_WAIT_L(0); PG8_MMA(0, 0, At, B0); PG8_BAR; PG8_SCHED;
            PG8_LDB(B1, 0, 1); PG8_STAGE(PG8_SB(0, 0), b2, voffB);
            PG8_BAR; PG8_WAIT_L(0); PG8_MMA(0, 1, At, B1); PG8_BAR;
            PG8_LDA(At, 0, 1); PG8_STAGE(PG8_SA(0, 0), a2, voffA);
            PG8_BAR; PG8_WAIT_L(0); PG8_MMA(1, 0, At, B0); PG8_BAR; PG8_SCHED;
            PG8_STAGE(PG8_SB(0, 1), b2 + hstep, voffB);
            PG8_WAIT_V(6); PG8_BAR; PG8_MMA(1, 1, At, B1); PG8_BAR;
            PG8_LDB(B0, 1, 0); PG8_SCHED; PG8_LDA(At, 1, 0); PG8_STAGE(PG8_SA(0, 1), a2 + hstep, voffA);
            PG8_WAIT_L(8); PG8_BAR; PG8_WAIT_L(0); PG8_MMA(0, 0, At, B0); PG8_BAR; PG8_SCHED;
            PG8_LDB(B1, 1, 1); PG8_STAGE(PG8_SB(1, 0), b3, voffB);
            PG8_BAR; PG8_WAIT_L(0); PG8_MMA(0, 1, At, B1); PG8_BAR;
            PG8_LDA(At, 1, 1); PG8_STAGE(PG8_SA(1, 0), a3, voffA);
            PG8_BAR; PG8_WAIT_L(0); PG8_MMA(1, 0, At, B0); PG8_BAR; PG8_SCHED;
            PG8_STAGE(PG8_SB(1, 1), b3 + hstep, voffB);
            PG8_WAIT_V(6); PG8_BAR; PG8_MMA(1, 1, At, B1); PG8_BAR;
            }
        }
        if constexpr (ALIGN_EPI) { if (wr == 0) PG8_BAR; }
        if constexpr (!Epi::AFTER_DRAIN) { E(acc, cur, wr, wc, fr, fq); S.done(cur); }
        if (!has_next) break;
#pragma unroll
        for (int a = 0; a < 2; ++a)
#pragma unroll
            for (int b = 0; b < 2; ++b)
#pragma unroll
                for (int m = 0; m < 4; ++m)
#pragma unroll
                    for (int n = 0; n < 2; ++n) acc[a][b][m][n] = (f32x4){0.f, 0.f, 0.f, 0.f};
        cur = nxt; cA = nA; cB = nB; ++ui;
        if constexpr (ALIGN_EPI) { if (wr == 1) PG8_BAR; }
    }
    PG8_WAIT_V(0);
    if constexpr (!ALIGN_EPI) { if (wr == 0) PG8_BAR; }
    PG8_BAR;
    if constexpr (Epi::AFTER_DRAIN) { E.fused(acc, cur, wr, wc, fr, fq, lds, wid, lane); S.done(cur); }
#undef PG8_SA
#undef PG8_SB
#undef PG8_STAGE
#undef PG8_LDA
#undef PG8_LDB
#undef PG8_MMA
#undef PG8_WAIT_V
#undef PG8_WAIT_L
#undef PG8_BAR
#undef PG8_SCHED
}
}
#define PG8_SP2 true
#define PG8_ALIGN true

constexpr int NWAVES = 8;
constexpr int BATCH = 4, SEQ = 8192, D = 1024, M = BATCH * SEQ;
constexpr int NH = 8, HD = 64, DATT = 512, DPOOL = 512, NZ = 3 * DATT + DPOOL;
constexpr int PEER_H = 8, NKEYS = 128, NEXP = NKEYS * NKEYS, TOPK = 16, NSC = PEER_H * 2 * NKEYS;
constexpr float EPS = 1e-6f;
constexpr float QSCALE = 0.125f * 1.4426950408889634f;

constexpr size_t MiB = 1u << 20;
constexpr size_t WS_CTL = 0, CTL_ZERO_BYTES = 64 * 1024;
constexpr size_t WS_R1 = 1 * MiB;
constexpr size_t WS_SS = 2 * MiB;
constexpr size_t WS_LSE = 4 * MiB;
constexpr size_t WS_WIN = 8 * MiB;
constexpr size_t WS_WOUT = 12 * MiB;
constexpr size_t WS_WSC = 14 * MiB;
constexpr size_t WS_EU = 32 * MiB, WS_EV = 64 * MiB;
constexpr size_t WS_XB = 96 * MiB;
constexpr size_t WS_Z = 160 * MiB;
constexpr size_t WS_ZP = 256 * MiB;
constexpr size_t WS_OB = 288 * MiB;
constexpr size_t WS_MIX = 384 * MiB;
constexpr size_t WS_SC = 160 * MiB;
constexpr size_t WS_SCH = 224 * MiB;
constexpr size_t WS_IDX = 448 * MiB, WS_GATE = 464 * MiB;
constexpr size_t WS_END = 480 * MiB;
static_assert(WS_SC + (size_t)M * NSC * 4 <= WS_IDX, "ws map");

constexpr int LDS_BYTES = 147456;
constexpr int LDSCTL_OFF = 146432, MISC_OFF = LDSCTL_OFF + 320;
constexpr int RING_OFF = 0;

#define GAS __attribute__((address_space(1)))
#define LAS __attribute__((address_space(3)))
typedef unsigned short bf16;
typedef unsigned v4u __attribute__((ext_vector_type(4)));
typedef unsigned v2u __attribute__((ext_vector_type(2)));
typedef float f32x4 __attribute__((ext_vector_type(4)));
typedef float f32x16 __attribute__((ext_vector_type(16)));
typedef short bf16x8 __attribute__((ext_vector_type(8)));
typedef short s16x4 __attribute__((ext_vector_type(4)));
typedef GAS unsigned gu32;
#define RLX_AGENT __ATOMIC_RELAXED, __HIP_MEMORY_SCOPE_AGENT
#define LDS_WAIT() asm volatile("s_waitcnt lgkmcnt(0)" ::: "memory")
#define VM_WAIT() asm volatile("s_waitcnt vmcnt(0)" ::: "memory")
__device__ __forceinline__ unsigned f2bf(float f) { unsigned u = __builtin_bit_cast(unsigned, f); return (u + 0x7fffu + ((u >> 16) & 1u)) >> 16; }
typedef float f32x2_cv __attribute__((ext_vector_type(2))); typedef __bf16 bf16x2_cv __attribute__((ext_vector_type(2)));
__device__ __forceinline__ unsigned pk2(float lo, float hi) { const f32x2_cv v = {lo, hi}; const bf16x2_cv b = __builtin_convertvector(v, bf16x2_cv); return __builtin_bit_cast(unsigned, b); }
__device__ __forceinline__ float bflo(unsigned w) { return __builtin_bit_cast(float, w << 16); }
__device__ __forceinline__ float bfhi(unsigned w) { return __builtin_bit_cast(float, w & 0xffff0000u); }
#define XB_TMO      128
#define XB_XCNT(j)  (256  + 64 * (j))
#define XB_XSUB(j)  (1280 + 64 * (j))
#define XB_XGEN(j)  (2304 + 64 * (j))
#define XB_TOP      3328
#define XB_TOPGEN   3392
#define XCD_BAR_WORDS 3456
#define XB_SPIN_CAP (1u << 18)

__device__ __forceinline__ unsigned xb_ld(unsigned* p)              { return __hip_atomic_load(p, __ATOMIC_RELAXED, __HIP_MEMORY_SCOPE_AGENT); }
__device__ __forceinline__ unsigned xb_add(unsigned* p, unsigned v) { return __hip_atomic_fetch_add(p, v, __ATOMIC_RELAXED, __HIP_MEMORY_SCOPE_AGENT); }
__device__ __forceinline__ unsigned xb_xcc_id() { return (unsigned)__builtin_amdgcn_s_getreg((3 << 11) | 20) & 0xFu; }
#define XB_SPIN(cond, bar) do { unsigned _sp = 0; while (cond) { __builtin_amdgcn_s_sleep(1); \
    if ((++_sp & 255u) == 0u) { if (xb_ld(&(bar)[XB_TMO])) break; if (_sp > XB_SPIN_CAP) { atomicAdd(&(bar)[XB_TMO], 1u); break; } } } } while (0)

struct XcdBarrier {
    unsigned* bar; unsigned x;
    volatile LAS unsigned* st;
};

__device__ __forceinline__ XcdBarrier xcd_barrier_post(unsigned* bar, volatile LAS unsigned* st) {
    XcdBarrier b; b.bar = bar; b.x = xb_xcc_id(); b.st = st;
    if (threadIdx.x == 0) (void)xb_add(&bar[XB_XCNT(b.x)], 1u);
    return b;
}
__device__ __forceinline__ void xcd_barrier_complete(unsigned* bar, unsigned x, unsigned& nloc, unsigned& nx) {
    const unsigned G = gridDim.x * gridDim.y * gridDim.z;
    unsigned sum, cnt, mine, sp = 0u;
    for (;;) {
        sum = 0u; cnt = 0u; mine = 0u;
#pragma unroll
        for (unsigned j = 0; j < 16; ++j) { const unsigned c = xb_ld(&bar[XB_XCNT(j)]); sum += c; cnt += (c > 0u) ? 1u : 0u; mine = (j == x) ? c : mine; }
        if (sum == G) break;
        __builtin_amdgcn_s_sleep(1);
        if ((++sp & 255u) == 0u) { if (xb_ld(&bar[XB_TMO])) break; if (sp > XB_SPIN_CAP) { atomicAdd(&bar[XB_TMO], 1u); break; } }
    }
    nloc = mine > 0u ? mine : 1u; nx = cnt > 0u ? cnt : 1u;
}

__device__ __forceinline__ void xcd_barrier(const XcdBarrier& b) {
    asm volatile("s_waitcnt vmcnt(0)" ::: "memory");
    __syncthreads();
    if (threadIdx.x == 0) {
        unsigned* bar = b.bar;
        __builtin_amdgcn_s_waitcnt(0);
        unsigned nloc = b.st[0], nx = b.st[1];
        if (nloc == 0u) { xcd_barrier_complete(bar, b.x, nloc, nx); b.st[0] = nloc; b.st[1] = nx; }
        const unsigned old = xb_add(&bar[XB_XSUB(b.x)], 1u);
        const unsigned gen = old / nloc;
        if (old + 1u == (gen + 1u) * nloc) {
            __builtin_amdgcn_fence(__ATOMIC_RELEASE, "agent");
            asm volatile("s_waitcnt vmcnt(0)" ::: "memory");
            const unsigned og = xb_add(&bar[XB_TOP], 1u);
            const unsigned tg = og / nx;
            if (og + 1u == (tg + 1u) * nx) xb_add(&bar[XB_TOPGEN], 1u);
            else XB_SPIN(xb_ld(&bar[XB_TOPGEN]) == tg, bar);
            __builtin_amdgcn_fence(__ATOMIC_ACQUIRE, "agent");
            xb_add(&bar[XB_XGEN(b.x)], 1u);
            asm volatile("s_waitcnt vmcnt(0)" ::: "memory");
        } else {
            XB_SPIN(xb_ld(&bar[XB_XGEN(b.x)]) == gen, bar);
            __builtin_amdgcn_fence(__ATOMIC_ACQUIRE, "agent");
            asm volatile("s_waitcnt vmcnt(0)" ::: "memory");
        }
    }
    __syncthreads();
}

struct Frame {
    LAS unsigned char* lds;
    volatile LAS unsigned* MISC;
    int tid, lane, wave;
    int vcu, G;
    const float *x, *norm_mix, *w_in, *w_pool, *pool_scale, *w_out, *norm_ffn, *w_query, *sub_keys, *expert_u, *expert_v, *norm_final;
    float* out;
    unsigned char* ws;
};

__device__ __forceinline__ float wave_sum(float v) {
#pragma unroll
    for (int o = 1; o < 64; o <<= 1) v += __shfl_xor(v, o);
    return v;
}

__device__ __forceinline__ void p0_transpose_item(const float* W, int N, const float* ks, bf16* WT, int ldo, int col_off, LAS float* scr, int item, int lane) {
    const int nblk = N / 32, kb = item / nblk, nb = item % nblk, k0 = 64 * kb, n0 = 32 * nb;
#pragma unroll 8
    for (int i = 0; i < 32; ++i) { const int kk = 2 * i + (lane >> 5); const float s = ks ? ks[k0 + kk] : 1.f; scr[kk * 33 + (lane & 31)] = W[(size_t)(k0 + kk) * N + n0 + (lane & 31)] * s; }
    LDS_WAIT(); asm volatile("" ::: "memory");
    const int c = lane & 7;
#pragma unroll
    for (int j = 0; j < 4; ++j) { const int n = (lane >> 3) + 8 * j; const LAS float* s = scr + (8 * c) * 33 + n;
        v4u o; o.x = pk2(s[0 * 33], s[1 * 33]); o.y = pk2(s[2 * 33], s[3 * 33]); o.z = pk2(s[4 * 33], s[5 * 33]); o.w = pk2(s[6 * 33], s[7 * 33]);
        *(GAS v4u*)(WT + (size_t)(n0 + n) * ldo + col_off + k0 + 8 * c) = o; }
    LDS_WAIT(); asm volatile("" ::: "memory");
}

__device__ __forceinline__ void p0_prologue(Frame& F) {
    LAS float* scr = (LAS float*)(F.lds + RING_OFF + F.wave * 16384);
    const int gw = F.vcu * NWAVES + F.wave, NGW = F.G * NWAVES;
    bf16* WIN = (bf16*)(F.ws + WS_WIN); bf16* WOUT = (bf16*)(F.ws + WS_WOUT); bf16* WSC = (bf16*)(F.ws + WS_WSC);
    constexpr int I_IN = (D / 64) * (NZ / 32), I_OUT = (DATT / 64) * (D / 32);
    for (int it = gw; it < I_IN + I_OUT; it += NGW) {
        if (it < I_IN) p0_transpose_item(F.w_in, NZ, F.norm_mix, WIN, D, 0, scr, it, F.lane);
        else p0_transpose_item(F.w_out, D, nullptr, WOUT, D, 0, scr, it - I_IN, F.lane);
    }
    const int gt = (F.vcu * NWAVES + F.wave) * 64 + F.lane, NGT = F.G * NWAVES * 64;
    for (int it = gt; it < DPOOL * (D / 4); it += NGT) {
        const int cin = it / (D / 4), n4 = (it % (D / 4)) * 4, g = cin >> 7;
        const float* wp = F.w_pool + (size_t)cin * 128;
        const float* ps = F.pool_scale + g * 128;
        const float* wo = F.w_out + (size_t)(DATT + g * 128) * D + n4;
        f32x4 acc = {0.f, 0.f, 0.f, 0.f};
#pragma unroll 16
        for (int d = 0; d < 128; ++d) { const float a = wp[d] * ps[d]; const f32x4 b = *(const f32x4*)(wo + (size_t)d * D); acc += a * b; }
#pragma unroll
        for (int j = 0; j < 4; ++j) WOUT[(size_t)(n4 + j) * D + DATT + cin] = (bf16)f2bf(acc[j]);
    }
    {
        LAS float* sk = (LAS float*)(F.lds + RING_OFF);
        for (int base = F.vcu * NWAVES; base < 16 * 128; base += F.G * NWAVES) {
            const int blk = base >> 7;
            __syncthreads();
            for (int idx = F.tid; idx < 128 * 32; idx += NWAVES * 64) { const int key = idx >> 5, c4 = (idx & 31) * 4;
                *(LAS f32x4*)(sk + key * 132 + c4) = *(const f32x4*)(F.sub_keys + (size_t)(blk * 128 + key) * 128 + c4); }
            __syncthreads();
            const int d0 = ((base + F.wave) & 127) * 8;
            const float* wq = F.w_query + (size_t)d0 * NSC + blk * 128;
            LAS float* wql = (LAS float*)(F.lds + RING_OFF + 128 * 132 * 4 + F.wave * 4096);
#pragma unroll
            for (int j = 0; j < 4; ++j) { const int r = 2 * j + (F.lane >> 5), cc = (F.lane & 31) * 4; *(LAS f32x4*)(wql + r * 128 + cc) = *(const f32x4*)(wq + (size_t)r * NSC + cc); }
            LDS_WAIT(); asm volatile("" ::: "memory");
            float acc[2][8];
#pragma unroll
            for (int i = 0; i < 2; ++i)
#pragma unroll
                for (int j = 0; j < 8; ++j) acc[i][j] = 0.f;
#pragma unroll 2
            for (int c = 0; c < 128; c += 4) {
                const f32x4 a0 = *(const LAS f32x4*)(sk + (2 * F.lane) * 132 + c), a1 = *(const LAS f32x4*)(sk + (2 * F.lane + 1) * 132 + c);
#pragma unroll
                for (int j = 0; j < 8; ++j) { const f32x4 wv = *(const LAS f32x4*)(wql + j * 128 + c);
                    acc[0][j] += a0[0] * wv[0] + a0[1] * wv[1] + a0[2] * wv[2] + a0[3] * wv[3]; acc[1][j] += a1[0] * wv[0] + a1[1] * wv[1] + a1[2] * wv[2] + a1[3] * wv[3]; }
            }
            const f32x4 g0 = *(const f32x4*)(F.norm_ffn + d0), g1 = *(const f32x4*)(F.norm_ffn + d0 + 4);
#pragma unroll
            for (int i = 0; i < 2; ++i) { v4u o; o.x = pk2(acc[i][0] * g0[0], acc[i][1] * g0[1]); o.y = pk2(acc[i][2] * g0[2], acc[i][3] * g0[3]); o.z = pk2(acc[i][4] * g1[0], acc[i][5] * g1[1]); o.w = pk2(acc[i][6] * g1[2], acc[i][7] * g1[3]);
                *(GAS v4u*)(WSC + (size_t)(blk * 128 + 2 * F.lane + i) * D + d0) = o; }
        }
        __syncthreads();
    }
    {
        bf16* XB = (bf16*)(F.ws + WS_XB); float* R1 = (float*)(F.ws + WS_R1);
        for (int m0 = gw * 4; m0 < M; m0 += NGW * 4) {
            f32x4 a[4][4];
#pragma unroll
            for (int r = 0; r < 4; ++r) { const float* xr = F.x + (size_t)(m0 + r) * D + 8 * F.lane;
                a[r][0] = *(const f32x4*)(xr); a[r][1] = *(const f32x4*)(xr + 4); a[r][2] = *(const f32x4*)(xr + 512); a[r][3] = *(const f32x4*)(xr + 516); }
#pragma unroll
            for (int r = 0; r < 4; ++r) { float s = 0.f;
#pragma unroll
                for (int q = 0; q < 4; ++q) s += (a[r][q][0] * a[r][q][0] + a[r][q][1] * a[r][q][1]) + (a[r][q][2] * a[r][q][2] + a[r][q][3] * a[r][q][3]);
#pragma unroll
                for (int j = 0; j < 2; ++j) { v4u o; o.x = pk2(a[r][2 * j][0], a[r][2 * j][1]); o.y = pk2(a[r][2 * j][2], a[r][2 * j][3]); o.z = pk2(a[r][2 * j + 1][0], a[r][2 * j + 1][1]); o.w = pk2(a[r][2 * j + 1][2], a[r][2 * j + 1][3]);
                    *(GAS v4u*)(XB + (size_t)(m0 + r) * D + 8 * F.lane + 512 * j) = o; }
                s = wave_sum(s);
                if (F.lane == 0) R1[m0 + r] = 1.0f / sqrtf(s * (1.0f / D) + EPS); }
        }
    }
}

constexpr int ATT_KEYS = 384, ATT_KCH = ATT_KEYS * 16 + 16;
constexpr int ATT_K_OFF = 0, ATT_V_OFF = 8 * ATT_KCH;
constexpr int ATT_VDH = 24 * 1024 + 64;
constexpr int ATT_OST_OFF = ATT_V_OFF + 2 * ATT_VDH;
constexpr int ATT_LDS_END = ATT_OST_OFF + NWAVES * 4096;
static_assert(ATT_V_OFF % 16 == 0 && ATT_OST_OFF % 16 == 0 && ATT_LDS_END <= LDSCTL_OFF, "attention LDS map");
constexpr int ATT_UNITS = BATCH * NH * 96;

__device__ __forceinline__ int crow(int r, int hi) { return (r & 3) + 8 * (r >> 2) + 4 * hi; }
__device__ __forceinline__ s16x4 vtr(const LAS unsigned char* p) { return __builtin_bit_cast(s16x4, __builtin_amdgcn_ds_read_tr16_b64_v4i16((LAS s16x4*)p)); }

struct AttnDec { int b, h, br, dsh, pair, s0, res; size_t tokbase; };
__device__ __forceinline__ AttnDec attn_decode(int unit) {
    AttnDec d; const int bh = unit / 96, rem = unit % 96, idx = rem & 31;
    d.br = rem >> 5; d.b = bh >> 3; d.h = bh & 7; d.dsh = 2 * d.br;
    const int ppr = 32 >> d.dsh;
    const int res = idx / ppr; d.res = res; d.pair = idx % ppr; d.s0 = d.pair * 256 - 128;
    d.tokbase = (size_t)d.b * SEQ + res; return d;
}
__device__ __forceinline__ void attn_fetch(Frame& F, int unit, v4u (&kv)[6], v4u (&vv)[6]) {
    const AttnDec d = attn_decode(unit); const bf16* ZHh = (const bf16*)(F.ws + WS_Z) + ((size_t)(d.b * NH + d.h) * SEQ + d.res) * HD;
    int tid = F.tid; asm volatile("" : "+v"(tid));
#pragma unroll
    for (int it = 0; it < 6; ++it) { const int p = tid + 512 * it, key = p >> 3, c = p & 7; int s = d.s0 + key; s = s < 0 ? 0 : s;
        const bf16* row = ZHh + ((size_t)s << d.dsh) * HD + c * 8;
        kv[it] = *(const GAS v4u*)(row + (size_t)M * DATT); vv[it] = *(const GAS v4u*)(row + (size_t)2 * M * DATT); }
}
__device__ __forceinline__ void attn_fetch_q(Frame& F, int unit, bf16x8 (&qr)[4]) {
    const AttnDec d = attn_decode(unit); const bf16* ZHh = (const bf16*)(F.ws + WS_Z) + ((size_t)(d.b * NH + d.h) * SEQ + d.res) * HD;
    int ln = F.lane; asm volatile("" : "+v"(ln));
    const int r32 = ln & 31, hi = ln >> 5, sq0 = d.pair * 256 + 32 * F.wave;
    const bf16* qrow = ZHh + ((size_t)(sq0 + r32) << d.dsh) * HD + hi * 8;
#pragma unroll
    for (int d0 = 0; d0 < 4; ++d0) qr[d0] = *(const GAS bf16x8*)(qrow + d0 * 16);
}
__device__ __forceinline__ void attn_stage(Frame& F, const v4u (&kv)[6], const v4u (&vv)[6]) {
    int tid = F.tid; asm volatile("" : "+v"(tid));
#pragma unroll
    for (int it = 0; it < 6; ++it) { const int p = tid + 512 * it, key = p >> 3, c = p & 7;
        *(LAS v4u*)(F.lds + ATT_K_OFF + c * ATT_KCH + key * 16) = kv[it];
        *(LAS v4u*)(F.lds + ATT_V_OFF + (c >> 2) * ATT_VDH + (key >> 4) * 1024 + (key & 15) * 64 + (c & 3) * 16) = vv[it]; }
}

__device__ __forceinline__ void attn_compute(Frame& F, int unit, const bf16x8 (&qr)[4]) {
    int lane = F.lane; asm volatile("" : "+v"(lane));
    const int w = F.wave, r32 = lane & 31, hi = lane >> 5;
    const AttnDec dd = attn_decode(unit);
    const int h = dd.h, br = dd.br, dsh = dd.dsh, pair = dd.pair; const size_t tokbase = dd.tokbase;
    const int sq0 = pair * 256 + 32 * w;
    f32x16 p[5];
#pragma unroll
    for (int j = 0; j < 5; ++j) {
        p[j] = f32x16{};
        const LAS unsigned char* kb = F.lds + ATT_K_OFF + hi * ATT_KCH + (32 * (w + j) + r32) * 16;
#pragma unroll
        for (int d0 = 0; d0 < 4; ++d0) { const bf16x8 kf = *(const LAS bf16x8*)(kb + 2 * d0 * ATT_KCH); p[j] = __builtin_amdgcn_mfma_f32_32x32x16_bf16(kf, qr[d0], p[j], 0, 0, 0); }
    }
    const float NEGB = -1e30f;
#pragma unroll
    for (int r = 0; r < 16; ++r) { const int kj = crow(r, hi); if (kj < r32) p[0][r] = NEGB; if (kj > r32) p[4][r] = NEGB; }
    if (pair == 0) {
#pragma unroll
        for (int j = 0; j < 4; ++j) if (w + j < 4) {
#pragma unroll
            for (int r = 0; r < 16; ++r) p[j][r] = NEGB; }
    }
    float mx = NEGB;
#pragma unroll
    for (int j = 0; j < 5; ++j)
#pragma unroll
        for (int r = 0; r < 16; ++r) mx = fmaxf(mx, p[j][r]);
    mx = fmaxf(mx, __shfl_xor(mx, 32));
    float l = 0.f;
#pragma unroll
    for (int j = 0; j < 5; ++j)
#pragma unroll
        for (int r = 0; r < 16; ++r) { const float e = __builtin_amdgcn_exp2f(p[j][r] - mx); p[j][r] = e; l += e; }
    l += __shfl_xor(l, 32);
    f32x16 o[2]; o[0] = f32x16{}; o[1] = f32x16{};
    const LAS unsigned char* vb = F.lds + ATT_V_OFF + (4 * hi + ((lane & 15) >> 2)) * 64 + ((lane >> 4) & 1) * 32 + (lane & 3) * 8;
#pragma unroll
    for (int j = 0; j < 5; ++j)
#pragma unroll
        for (int s = 0; s < 2; ++s) {
            v4u pw; pw.x = pk2(p[j][8 * s + 0], p[j][8 * s + 1]); pw.y = pk2(p[j][8 * s + 2], p[j][8 * s + 3]); pw.z = pk2(p[j][8 * s + 4], p[j][8 * s + 5]); pw.w = pk2(p[j][8 * s + 6], p[j][8 * s + 7]);
            const bf16x8 pa = __builtin_bit_cast(bf16x8, pw);
#pragma unroll
            for (int dh = 0; dh < 2; ++dh) {
                const LAS unsigned char* vp = vb + dh * ATT_VDH + (2 * (w + j) + s) * 1024;
                const s16x4 lo = vtr(vp), hh = vtr(vp + 512);
                const bf16x8 vf = (bf16x8){lo[0], lo[1], lo[2], lo[3], hh[0], hh[1], hh[2], hh[3]};
                o[dh] = __builtin_amdgcn_mfma_f32_32x32x16_bf16(pa, vf, o[dh], 0, 0, 0);
            }
        }
    const float rl = 1.0f / l;
    bf16* OB = (bf16*)(F.ws + WS_OB) + (size_t)br * M * DATT;
    float* LSE = (float*)(F.ws + WS_LSE) + (size_t)br * M * NH;
    LAS bf16* stg = (LAS bf16*)(F.lds + ATT_OST_OFF + w * 4096);
#pragma unroll
    for (int r = 0; r < 16; ++r) { const int orow = crow(r, hi); const float rr = __shfl(rl, orow);
        { const unsigned w2 = pk2(o[0][r] * rr, o[1][r] * rr); stg[orow * 64 + r32] = (bf16)(w2 & 0xffffu); stg[orow * 64 + 32 + r32] = (bf16)(w2 >> 16); } }
    if (hi == 0) LSE[(tokbase + ((size_t)(sq0 + r32) << dsh)) * NH + h] = mx + __builtin_amdgcn_logf(l);
    LDS_WAIT();
#pragma unroll
    for (int i = 0; i < 4; ++i) { const int row = i * 8 + (lane >> 3), ch = lane & 7; const v4u v = *(const LAS v4u*)(stg + row * 64 + ch * 8);
        *(GAS v4u*)(OB + (tokbase + ((size_t)(sq0 + row) << dsh)) * DATT + h * HD + ch * 8) = v; }
}


__device__ __forceinline__ void pool_rows(Frame& F) {
    const bf16* ZP = (const bf16*)(F.ws + WS_ZP); bf16* MIX = (bf16*)(F.ws + WS_MIX);
    const int gw = F.vcu * NWAVES + F.wave, NGW = F.G * NWAVES;
    const int win = 2 << (F.lane >> 4);
    constexpr int TPW = 16;
    for (int it = gw; it < M / TPW; it += NGW) {
        const int tb = it * TPW, sb = tb & (SEQ - 1);
        const bf16* zc = ZP + (size_t)tb * DPOOL + 8 * F.lane;
        v4u rows[31];
#pragma unroll
        for (int k = 0; k < 31; ++k) { const int s = sb - 15 + k; rows[k] = (s >= 0) ? *(const GAS v4u*)(zc + (long)(k - 15) * DPOOL) : (v4u){0u, 0u, 0u, 0u}; }
        float ps[8];
#pragma unroll
        for (int e = 0; e < 8; ++e) ps[e] = 0.f;
#pragma unroll
        for (int k = 0; k < 15; ++k) if (k >= 16 - win) { const v4u v = rows[k];
            ps[0] += bflo(v.x); ps[1] += bfhi(v.x); ps[2] += bflo(v.y); ps[3] += bfhi(v.y); ps[4] += bflo(v.z); ps[5] += bfhi(v.z); ps[6] += bflo(v.w); ps[7] += bfhi(v.w); }
#pragma unroll
        for (int i = 0; i < TPW; ++i) {
            const int s = sb + i; const v4u z0 = rows[15 + i];
            ps[0] += bflo(z0.x); ps[1] += bfhi(z0.x); ps[2] += bflo(z0.y); ps[3] += bfhi(z0.y); ps[4] += bflo(z0.z); ps[5] += bfhi(z0.z); ps[6] += bflo(z0.w); ps[7] += bfhi(z0.w);
            const int cnt = (s + 1) < win ? (s + 1) : win; const float inv = 1.0f / (float)cnt;
            v4u o; o.x = pk2(ps[0] * inv - bflo(z0.x), ps[1] * inv - bfhi(z0.x)); o.y = pk2(ps[2] * inv - bflo(z0.y), ps[3] * inv - bfhi(z0.y));
            o.z = pk2(ps[4] * inv - bflo(z0.z), ps[5] * inv - bfhi(z0.z)); o.w = pk2(ps[6] * inv - bflo(z0.w), ps[7] * inv - bfhi(z0.w));
            *(GAS v4u*)(MIX + (size_t)(tb + i) * D + DATT + 8 * F.lane) = o;
            const v4u l2 = rows[15 + i - 1], l4 = rows[15 + i - 3], l8 = rows[15 + i - 7], l16 = rows[15 + i - 15];
            const v4u v = (win == 2) ? l2 : (win == 4) ? l4 : (win == 8) ? l8 : l16;
            ps[0] -= bflo(v.x); ps[1] -= bfhi(v.x); ps[2] -= bflo(v.y); ps[3] -= bfhi(v.y); ps[4] -= bflo(v.z); ps[5] -= bfhi(v.z); ps[6] -= bflo(v.w); ps[7] -= bfhi(v.w);
        }
    }
}

__device__ __forceinline__ void merge_rows(Frame& F) {
    const bf16* OB = (const bf16*)(F.ws + WS_OB); const float* LSE = (const float*)(F.ws + WS_LSE); bf16* MIX = (bf16*)(F.ws + WS_MIX);
    const int gw = F.vcu * NWAVES + F.wave, NGW = F.G * NWAVES;
#pragma unroll 2
    for (int t = gw; t < M; t += NGW) {
        const int h = F.lane >> 3;
        const float l0 = LSE[(size_t)t * NH + h], l1 = LSE[(size_t)(M + t) * NH + h], l2 = LSE[(size_t)(2 * M + t) * NH + h];
        const size_t off = (size_t)t * DATT + 8 * F.lane;
        const v4u a = *(const GAS v4u*)(OB + off), b = *(const GAS v4u*)(OB + (size_t)M * DATT + off), c = *(const GAS v4u*)(OB + (size_t)2 * M * DATT + off);
        const float mx = fmaxf(l0, fmaxf(l1, l2));
        float w0 = __builtin_amdgcn_exp2f(l0 - mx), w1 = __builtin_amdgcn_exp2f(l1 - mx), w2 = __builtin_amdgcn_exp2f(l2 - mx);
        const float inv = 1.0f / (w0 + w1 + w2); w0 *= inv; w1 *= inv; w2 *= inv;
        v4u o;
        o.x = pk2(w0 * bflo(a.x) + w1 * bflo(b.x) + w2 * bflo(c.x), w0 * bfhi(a.x) + w1 * bfhi(b.x) + w2 * bfhi(c.x));
        o.y = pk2(w0 * bflo(a.y) + w1 * bflo(b.y) + w2 * bflo(c.y), w0 * bfhi(a.y) + w1 * bfhi(b.y) + w2 * bfhi(c.y));
        o.z = pk2(w0 * bflo(a.z) + w1 * bflo(b.z) + w2 * bflo(c.z), w0 * bfhi(a.z) + w1 * bfhi(b.z) + w2 * bfhi(c.z));
        o.w = pk2(w0 * bflo(a.w) + w1 * bflo(b.w) + w2 * bflo(c.w), w0 * bfhi(a.w) + w1 * bfhi(b.w) + w2 * bfhi(c.w));
        *(GAS v4u*)(MIX + (size_t)t * D + 8 * F.lane) = o;
    }
}

constexpr int TK_ROW = 68;
constexpr int TK_WAVE_BYTES = 64 * TK_ROW * 4;
static_assert(NWAVES * TK_WAVE_BYTES <= LDSCTL_OFF, "top-k LDS map");

__device__ __forceinline__ unsigned f2ord(float f) { const unsigned u = __builtin_bit_cast(unsigned, f); return (u & 0x80000000u) ? ~u : (u | 0x80000000u); }
__device__ __forceinline__ float ord2f(unsigned k) { const unsigned u = (k & 0x80000000u) ? (k & 0x7fffffffu) : ~k; return __builtin_bit_cast(float, u); }
#define TK_CE(a, b) do { const unsigned hi_ = max(a, b), lo_ = min(a, b); a = hi_; b = lo_; } while (0)
#define TK_SORT16(N) do { TK_CE(N[0], N[1]); TK_CE(N[2], N[3]); TK_CE(N[0], N[2]); TK_CE(N[1], N[3]); TK_CE(N[1], N[2]); TK_CE(N[4], N[5]); TK_CE(N[6], N[7]); TK_CE(N[4], N[6]); TK_CE(N[5], N[7]); TK_CE(N[5], N[6]); TK_CE(N[0], N[4]); TK_CE(N[2], N[6]); TK_CE(N[2], N[4]); TK_CE(N[1], N[5]); TK_CE(N[3], N[7]); TK_CE(N[3], N[5]); TK_CE(N[1], N[2]); TK_CE(N[3], N[4]); TK_CE(N[5], N[6]); TK_CE(N[8], N[9]); TK_CE(N[10], N[11]); TK_CE(N[8], N[10]); TK_CE(N[9], N[11]); TK_CE(N[9], N[10]); TK_CE(N[12], N[13]); TK_CE(N[14], N[15]); TK_CE(N[12], N[14]); TK_CE(N[13], N[15]); TK_CE(N[13], N[14]); TK_CE(N[8], N[12]); TK_CE(N[10], N[14]); TK_CE(N[10], N[12]); TK_CE(N[9], N[13]); TK_CE(N[11], N[15]); TK_CE(N[11], N[13]); TK_CE(N[9], N[10]); TK_CE(N[11], N[12]); TK_CE(N[13], N[14]); TK_CE(N[0], N[8]); TK_CE(N[4], N[12]); TK_CE(N[4], N[8]); TK_CE(N[2], N[10]); TK_CE(N[6], N[14]); TK_CE(N[6], N[10]); TK_CE(N[2], N[4]); TK_CE(N[6], N[8]); TK_CE(N[10], N[12]); TK_CE(N[1], N[9]); TK_CE(N[5], N[13]); TK_CE(N[5], N[9]); TK_CE(N[3], N[11]); TK_CE(N[7], N[15]); TK_CE(N[7], N[11]); TK_CE(N[3], N[5]); TK_CE(N[7], N[9]); TK_CE(N[11], N[13]); TK_CE(N[1], N[2]); TK_CE(N[3], N[4]); TK_CE(N[5], N[6]); TK_CE(N[7], N[8]); TK_CE(N[9], N[10]); TK_CE(N[11], N[12]); TK_CE(N[13], N[14]); } while (0)
#define TK_BMERGE16(L) do { TK_CE(L[0], L[8]); TK_CE(L[1], L[9]); TK_CE(L[2], L[10]); TK_CE(L[3], L[11]); TK_CE(L[4], L[12]); TK_CE(L[5], L[13]); TK_CE(L[6], L[14]); TK_CE(L[7], L[15]); TK_CE(L[0], L[4]); TK_CE(L[1], L[5]); TK_CE(L[2], L[6]); TK_CE(L[3], L[7]); TK_CE(L[8], L[12]); TK_CE(L[9], L[13]); TK_CE(L[10], L[14]); TK_CE(L[11], L[15]); TK_CE(L[0], L[2]); TK_CE(L[1], L[3]); TK_CE(L[4], L[6]); TK_CE(L[5], L[7]); TK_CE(L[8], L[10]); TK_CE(L[9], L[11]); TK_CE(L[12], L[14]); TK_CE(L[13], L[15]); TK_CE(L[0], L[1]); TK_CE(L[2], L[3]); TK_CE(L[4], L[5]); TK_CE(L[6], L[7]); TK_CE(L[8], L[9]); TK_CE(L[10], L[11]); TK_CE(L[12], L[13]); TK_CE(L[14], L[15]); } while (0)
#define TK_INSERT(L, xin) do { unsigned x_ = (xin); _Pragma("unroll") for (int i_ = 0; i_ < 16; ++i_) { const unsigned hi_ = max(L[i_], x_); x_ = min(L[i_], x_); L[i_] = hi_; } } while (0)

constexpr int EXP_NCH = 2 * NEXP;
__device__ __forceinline__ void expcvt_load(Frame& F, int ci, f32x4 (&a)[4], int lane) {
    const float* src = (ci < NEXP ? F.expert_u + (size_t)ci * D : F.expert_v + (size_t)(ci - NEXP) * D) + 16 * lane;
#pragma unroll
    for (int q = 0; q < 4; ++q) a[q] = *(const GAS f32x4*)(src + 4 * q);
}
__device__ __forceinline__ void expcvt_store(Frame& F, int ci, const f32x4 (&a)[4], int lane) {
    const bool isu = ci < NEXP;
    if (isu) {
        f32x4 v[4];
#pragma unroll
        for (int q = 0; q < 4; ++q) { v[q] = a[q] * 56.0f; v[q] = v[q] * *(const GAS f32x4*)(F.norm_ffn + 16 * lane + 4 * q); }
        unsigned w2[2];
        w2[0] = __builtin_amdgcn_cvt_scalef32_pk_fp4_f32(0u, v[0][0], v[0][1], 1.0f, 0); w2[0] = __builtin_amdgcn_cvt_scalef32_pk_fp4_f32(w2[0], v[0][2], v[0][3], 1.0f, 1);
        w2[0] = __builtin_amdgcn_cvt_scalef32_pk_fp4_f32(w2[0], v[1][0], v[1][1], 1.0f, 2); w2[0] = __builtin_amdgcn_cvt_scalef32_pk_fp4_f32(w2[0], v[1][2], v[1][3], 1.0f, 3);
        w2[1] = __builtin_amdgcn_cvt_scalef32_pk_fp4_f32(0u, v[2][0], v[2][1], 1.0f, 0); w2[1] = __builtin_amdgcn_cvt_scalef32_pk_fp4_f32(w2[1], v[2][2], v[2][3], 1.0f, 1);
        w2[1] = __builtin_amdgcn_cvt_scalef32_pk_fp4_f32(w2[1], v[3][0], v[3][1], 1.0f, 2); w2[1] = __builtin_amdgcn_cvt_scalef32_pk_fp4_f32(w2[1], v[3][2], v[3][3], 1.0f, 3);
        *(GAS v2u*)(F.ws + WS_EU + (size_t)ci * (D / 2) + 8 * lane) = (v2u){w2[0], w2[1]};
        return;
    }
    {
        f32x4 v[4];
#pragma unroll
        for (int q = 0; q < 4; ++q) v[q] = a[q] * 7.0f;
        unsigned w2[2];
        w2[0] = __builtin_amdgcn_cvt_scalef32_pk_fp4_f32(0u, v[0][0], v[0][1], 1.0f, 0); w2[0] = __builtin_amdgcn_cvt_scalef32_pk_fp4_f32(w2[0], v[0][2], v[0][3], 1.0f, 1);
        w2[0] = __builtin_amdgcn_cvt_scalef32_pk_fp4_f32(w2[0], v[1][0], v[1][1], 1.0f, 2); w2[0] = __builtin_amdgcn_cvt_scalef32_pk_fp4_f32(w2[0], v[1][2], v[1][3], 1.0f, 3);
        w2[1] = __builtin_amdgcn_cvt_scalef32_pk_fp4_f32(0u, v[2][0], v[2][1], 1.0f, 0); w2[1] = __builtin_amdgcn_cvt_scalef32_pk_fp4_f32(w2[1], v[2][2], v[2][3], 1.0f, 1);
        w2[1] = __builtin_amdgcn_cvt_scalef32_pk_fp4_f32(w2[1], v[3][0], v[3][1], 1.0f, 2); w2[1] = __builtin_amdgcn_cvt_scalef32_pk_fp4_f32(w2[1], v[3][2], v[3][3], 1.0f, 3);
        *(GAS v2u*)(F.ws + WS_EV + (size_t)(ci - NEXP) * (D / 2) + 8 * lane) = (v2u){w2[0], w2[1]};
    }
}
__device__ __forceinline__ void tk_fetch(const unsigned short* SCH, int t0, int rnd, v4u (&sn)[8], int lane) {
    const int p = rnd >> 1, kc = rnd & 1;
#pragma unroll
    for (int i = 0; i < 8; ++i) { const int pr = 8 * i + (lane >> 3), tl = pr >> 3, h = pr & 7;
        sn[i] = *(const GAS v4u*)(SCH + (size_t)(t0 + tl) * NSC + h * 256 + p * 128 + kc * 64 + (lane & 7) * 8); }
}

__device__ __forceinline__ void topk_phase(Frame& F) {
    const unsigned short* SCH = (const unsigned short*)(F.ws + WS_SCH); const float* SS = (const float*)(F.ws + WS_SS);
    int* IDX = (int*)(F.ws + WS_IDX); float* GATE = (float*)(F.ws + WS_GATE);
    const int gw = F.vcu * NWAVES + F.wave, NGW = F.G * NWAVES, lane = F.lane;
    LAS float* st = (LAS float*)(F.lds + F.wave * TK_WAVE_BYTES);
    int cnext = gw;
    v4u sn[8];
    for (int it = gw; it < M / 8; it += NGW) {
        const int t0 = it * 8;
        unsigned L0[16], L1[16];
#pragma unroll
        for (int i = 0; i < 16; ++i) { L0[i] = 0u; L1[i] = 0u; }
        if (it == gw) tk_fetch(SCH, t0, 0, sn, lane);
#pragma unroll
        for (int rnd = 0; rnd < 4; ++rnd) {
            const int p = rnd >> 1, kc = rnd & 1;
            v4u sc[8];
#pragma unroll
            for (int i = 0; i < 8; ++i) sc[i] = sn[i];
            if (rnd < 3) tk_fetch(SCH, t0, rnd + 1, sn, lane); else if (it + NGW < M / 8) tk_fetch(SCH, (it + NGW) * 8, 0, sn, lane);
            f32x4 xa[4], xb[4]; const int c0 = cnext, c1 = cnext + NGW;
            if (c0 < EXP_NCH) expcvt_load(F, c0, xa, lane); if (c1 < EXP_NCH) expcvt_load(F, c1, xb, lane);
#pragma unroll
            for (int i = 0; i < 8; ++i) { const int pr = 8 * i + (lane >> 3);
                const v4u v = sc[i];
                f32x4 lo, hi;
#pragma unroll
                for (int e = 0; e < 2; ++e) { const unsigned wa = v[e], wb = v[2 + e];
                    const pg8::f16x2_t a = __builtin_bit_cast(pg8::f16x2_t, wa), b = __builtin_bit_cast(pg8::f16x2_t, wb);
                    lo[2 * e] = (float)a.x; lo[2 * e + 1] = (float)a.y; hi[2 * e] = (float)b.x; hi[2 * e + 1] = (float)b.y; }
                *(LAS f32x4*)(st + pr * TK_ROW + (lane & 7) * 8) = lo; *(LAS f32x4*)(st + pr * TK_ROW + (lane & 7) * 8 + 4) = hi; }
            LDS_WAIT(); asm volatile("" ::: "memory");
#pragma unroll 1
            for (int q = 0; q < 4; ++q) {
                unsigned N[16];
#pragma unroll
                for (int u = 0; u < 4; ++u) { const f32x4 v = *(const LAS f32x4*)(st + lane * TK_ROW + q * 16 + u * 4);
#pragma unroll
                    for (int e = 0; e < 4; ++e) N[4 * u + e] = (f2ord(v[e]) & ~127u) | (unsigned)(127 - (kc * 64 + q * 16 + u * 4 + e)); }
                TK_SORT16(N);
                if (p == 0) {
#pragma unroll
                    for (int i = 0; i < 16; ++i) L0[i] = max(L0[i], N[15 - i]);
                    TK_BMERGE16(L0);
                } else {
#pragma unroll
                    for (int i = 0; i < 16; ++i) L1[i] = max(L1[i], N[15 - i]);
                    TK_BMERGE16(L1);
                }
            }
            if (c0 < EXP_NCH) expcvt_store(F, c0, xa, lane); if (c1 < EXP_NCH) expcvt_store(F, c1, xb, lane);
            cnext += 2 * NGW;
            LDS_WAIT(); asm volatile("" ::: "memory");
        }
        LAS float* pv0 = st; LAS float* pv1 = st + 16 * 64; LAS int* pi0 = (LAS int*)(st + 32 * 64); LAS int* pi1 = (LAS int*)(st + 48 * 64);
        float v0[16], v1[16];
#pragma unroll
        for (int i = 0; i < 16; ++i) { v0[i] = ord2f(L0[i] & ~127u); v1[i] = ord2f(L1[i] & ~127u);
            pv0[i * 64 + lane] = v0[i]; pv1[i * 64 + lane] = v1[i]; pi0[i * 64 + lane] = 127 - (int)(L0[i] & 127u); pi1[i * 64 + lane] = 127 - (int)(L1[i] & 127u); }
        unsigned T[16];
#pragma unroll
        for (int i = 0; i < 16; ++i) T[i] = 0u;
        {
            unsigned N[16]; int nn = 0;
#pragma unroll
            for (int i = 0; i < 16; ++i)
#pragma unroll
                for (int j = 0; j < 16; ++j) if ((i + 1) * (j + 1) <= 16) {
                    N[nn & 15] = (f2ord(v0[i] + v1[j]) & ~255u) | (unsigned)(255 - (i * 16 + j)); ++nn;
                    if ((nn & 15) == 0 || nn == 50) {
                        if (nn == 50) { N[2] = 0u; N[3] = 0u; N[4] = 0u; N[5] = 0u; N[6] = 0u; N[7] = 0u; N[8] = 0u; N[9] = 0u; N[10] = 0u; N[11] = 0u; N[12] = 0u; N[13] = 0u; N[14] = 0u; N[15] = 0u; }
                        TK_SORT16(N);
#pragma unroll
                        for (int q = 0; q < 16; ++q) T[q] = max(T[q], N[15 - q]);
                        TK_BMERGE16(T);
                    }
                }
        }
        LDS_WAIT(); asm volatile("" ::: "memory");
        const int tl = lane >> 3, h = lane & 7, t = t0 + tl;
        float ssum = 0.f;
        { const float* sp = SS + (size_t)t * 16;
#pragma unroll
          for (int i = 0; i < 4; ++i) { const f32x4 v = *(const GAS f32x4*)(sp + 4 * i); ssum += (v[0] + v[1]) + (v[2] + v[3]); } }
        const float r2 = 1.0f / sqrtf(ssum * (1.0f / D) + EPS);
        float bs[16]; int ex[16]; float mxs = -3.0e38f;
#pragma unroll
        for (int k = 0; k < 16; ++k) { const int pos = 255 - (int)(T[k] & 255u), i = pos >> 4, j = pos & 15;
            bs[k] = (pv0[i * 64 + lane] + pv1[j * 64 + lane]) * r2; ex[k] = pi0[i * 64 + lane] * NKEYS + pi1[j * 64 + lane]; mxs = fmaxf(mxs, bs[k]); }
        float den = 0.f;
#pragma unroll
        for (int k = 0; k < 16; ++k) { bs[k] = __expf(bs[k] - mxs); den += bs[k]; }
        const float inv = 1.0f / den;
        int* ip = IDX + ((size_t)t * PEER_H + h) * TOPK; float* gp = GATE + ((size_t)t * PEER_H + h) * TOPK;
#pragma unroll
        for (int k = 0; k < 16; k += 4) { *(GAS v4u*)(ip + k) = (v4u){(unsigned)ex[k], (unsigned)ex[k + 1], (unsigned)ex[k + 2], (unsigned)ex[k + 3]};
            *(GAS f32x4*)(gp + k) = (f32x4){bs[k] * inv, bs[k + 1] * inv, bs[k + 2] * inv, bs[k + 3] * inv}; }
        LDS_WAIT(); asm volatile("" ::: "memory");
    }
    for (; cnext < EXP_NCH; cnext += NGW) { f32x4 xa[4]; expcvt_load(F, cnext, xa, lane); expcvt_store(F, cnext, xa, lane); }
}

typedef float f32x2 __attribute__((ext_vector_type(2)));
typedef long l64x2 __attribute__((ext_vector_type(2)));
constexpr float EU_SCALE = 56.0f, EV_SCALE = 4.0f;
__device__ __forceinline__ float gelu_erf(float v) {
    const float av = __builtin_fabsf(v), t = __builtin_amdgcn_rcpf(av * 0.2316418882f + 1.0f);
    float q = t * 0.5307027145f + (-0.7265760135f); q = q * t + 0.7107068705f; q = q * t + (-0.142248368f); q = q * t + 0.127414796f; q = q * t;
    const float e = __builtin_amdgcn_exp2f((v * v) * (-0.72134752044f));
    const float m = v * (q * e);
    return v < 0.f ? m : v - m;
}
constexpr int PU_WAVE_LDS = 9216;
constexpr int PU_SL = 0, PU_HIST = 8192, PU_DSCR = 8192;
constexpr int PV_STG_BYTES = 16384, PV_LST = NWAVES * PV_STG_BYTES, PV_SSP = PV_LST + 8192;
static_assert(PV_SSP + 256 <= LDSCTL_OFF && NWAVES * PU_WAVE_LDS <= LDSCTL_OFF, "PEER LDS map");
constexpr float ACT_SCALE = 64.0f, EV4_SCALE = 7.0f;
#ifndef PEER_UACT_EXPR
#define PEER_UACT_EXPR gelu_erf(a * (1.0f / EU_SCALE)) * gt
#endif
#ifndef PEER_ACT_EXPR
#define PEER_ACT_EXPR __builtin_bit_cast(float, itv.y)
#endif
#ifndef PEER_V_ITEMS
#define PEER_V_ITEMS 128
#endif

#ifndef PROBE_NOBPERM
#define PROBE_NOBPERM 0
#endif
typedef int v8i_t __attribute__((ext_vector_type(8)));
__device__ __forceinline__ void peer_u_loadA(v4u (&A)[8], const unsigned char* EU, unsigned e, int lane) {
    int l3 = lane & 3; asm volatile("" : "+v"(l3));
    const GAS unsigned char* rowp = (const GAS unsigned char*)EU + (size_t)e * (D / 2) + 16 * l3;
#pragma unroll
    for (int i = 0; i < 8; ++i) A[i] = *(const GAS v4u*)(rowp + 64 * i);
}
template <unsigned EMASK, bool DUMMY> __device__ __forceinline__ void peer_u_phase(Frame& F, int blk) {
    const int* IDX = (const int*)(F.ws + WS_IDX); const float* GATE = (const float*)(F.ws + WS_GATE); const float* SS = (const float*)(F.ws + WS_SS);
    const unsigned char* EU = F.ws + WS_EU; unsigned char* LG = F.ws + WS_SC + (size_t)(blk * 8 + F.wave) * 8192;
    int lane = F.lane; asm volatile("" : "+v"(lane));
    const int c = lane & 15, g = lane >> 4;
    const int T0 = blk * 128 + F.wave * 16;
    LAS unsigned char* wl = F.lds + F.wave * PU_WAVE_LDS;
    LAS unsigned* SL = (LAS unsigned*)(wl + PU_SL); LAS unsigned* HIST = (LAS unsigned*)(wl + PU_HIST); LAS float* DSCR = (LAS float*)(wl + PU_DSCR);
    *(LAS v4u*)(HIST + 4 * lane) = (v4u){0u, 0u, 0u, 0u};
    LDS_WAIT(); asm volatile("" ::: "memory");
    unsigned ev[32];
#pragma unroll
    for (int q = 0; q < 32; ++q) ev[q] = (unsigned)IDX[(size_t)T0 * 128 + q * 64 + lane];
#pragma unroll
    for (int q = 0; q < 32; ++q) __hip_atomic_fetch_add(HIST + (ev[q] >> 6), 1u, __ATOMIC_RELAXED, __HIP_MEMORY_SCOPE_WAVEFRONT);
    LDS_WAIT(); asm volatile("" ::: "memory");
    {
        const v4u hv = *(const LAS v4u*)(HIST + 4 * lane); const unsigned tot = hv.x + hv.y + hv.z + hv.w; unsigned inc = tot;
#pragma unroll
        for (int o = 1; o < 64; o <<= 1) { const unsigned n = (unsigned)__shfl_up((int)inc, o); if (lane >= o) inc += n; }
        const unsigned ex = inc - tot;
        LDS_WAIT(); asm volatile("" ::: "memory");
        *(LAS v4u*)(HIST + 4 * lane) = (v4u){ex, ex + hv.x, ex + hv.x + hv.y, ex + hv.x + hv.y + hv.z};
    }
    LDS_WAIT(); asm volatile("" ::: "memory");
#pragma unroll
    for (int q = 0; q < 32; ++q) { const unsigned p = (unsigned)(q * 64 + lane); const unsigned e = ev[q];
        const unsigned pos = __hip_atomic_fetch_add(HIST + (e >> 6), 1u, __ATOMIC_RELAXED, __HIP_MEMORY_SCOPE_WAVEFRONT); SL[pos] = (e << 11) | p; }
    LDS_WAIT(); asm volatile("" ::: "memory");
    v8i_t Bop[8];
    {
        const int tB = T0 + c; float s = 0.f;
#pragma unroll
        for (int i = 0; i < 4; ++i) { const f32x4 v = *(const GAS f32x4*)(SS + (size_t)tB * 16 + 4 * i); s += (v[0] + v[1]) + (v[2] + v[3]); }
        const float r2 = 1.0f / sqrtf(s * (1.0f / D) + EPS);
        int gq = g; asm volatile("" : "+v"(gq));
        const bf16* xp = (const bf16*)(F.ws + WS_XB) + (size_t)tB * D + 16 * gq;
#pragma unroll
        for (int i = 0; i < 8; ++i) { v8i_t o;
#pragma unroll
            for (int k = 0; k < 4; ++k) { const v4u xa = *(const GAS v4u*)(xp + 128 * i + 64 * (k >> 1) + 8 * (k & 1));
#pragma unroll
                for (int q = 0; q < 2; ++q) { const unsigned w0 = xa[2 * q], w1 = xa[2 * q + 1];
                    int w = __builtin_amdgcn_cvt_pk_fp8_f32(bflo(w0) * r2, bfhi(w0) * r2, 0, false); w = __builtin_amdgcn_cvt_pk_fp8_f32(bflo(w1) * r2, bfhi(w1) * r2, w, true); o[2 * k + q] = w; } }
            Bop[i] = o; if ((i & 3) == 3) asm volatile("" : "+v"(Bop[i - 3]), "+v"(Bop[i - 2]), "+v"(Bop[i - 1]), "+v"(Bop[i]) :: "memory"); }
    }
#define PU_TAIL(b) *(LAS f32x4*)(DSCR + 4 * lane) = acc; LDS_WAIT(); asm volatile("" ::: "memory"); if (lane < 16) { const unsigned p = itcur & 2047u, cr = p >> 7, e = itcur >> 11; const float a = DSCR[((lane >> 2) * 16 + cr) * 4 + (lane & 3)]; const float sact = (PEER_UACT_EXPR) * ACT_SCALE; const unsigned a8 = (unsigned)__builtin_amdgcn_cvt_pk_fp8_f32(sact, 0.f, 0, false) & 0xffu; if (!DUMMY) { *(GAS unsigned short*)(LG + 2 * (16 * (b) + lane)) = (unsigned short)e; *(GAS unsigned char*)(LG + 4096 + 16 * (b) + lane) = (unsigned char)cr; *(GAS unsigned char*)(LG + 6144 + 16 * (b) + lane) = (unsigned char)a8; } else if (sact == 123.456f) LG[0] = 1; } LDS_WAIT(); asm volatile("" ::: "memory");
    v4u A0[8], A1[8];
    const int psrc = (4 * c + g) * 4;
    { const unsigned i0_ = SL[lane >> 2], i1_ = SL[16 + (lane >> 2)];
      peer_u_loadA(A0, EU, (i0_ >> 11) & EMASK, lane); peer_u_loadA(A1, EU, (i1_ >> 11) & EMASK, lane); }
#define PU_STEP(Acur, b) do { \
        const unsigned itcur = SL[16 * (b) + c]; \
        float gt = 0.f; if (lane < 16) gt = GATE[(size_t)T0 * 128 + (itcur & 2047u)]; \
        const int bn = ((b) + 2 < 128) ? (b) + 2 : (b); \
        const unsigned itl = SL[16 * bn + (lane >> 2)]; \
        int l3 = lane & 3; asm volatile("" : "+v"(l3)); \
        const GAS unsigned char* nrow = (const GAS unsigned char*)EU + (size_t)((itl >> 11) & EMASK) * (D / 2) + 16 * l3; \
        f32x4 acc = {0.f, 0.f, 0.f, 0.f}; \
        _Pragma("unroll") for (int i = 0; i < 8; ++i) { v4u t; \
            _Pragma("unroll") for (int w = 0; w < 4; ++w) t[w] = (DUMMY && PROBE_NOBPERM) ? Acur[i][w] : (unsigned)__builtin_amdgcn_ds_bpermute(psrc, (int)Acur[i][w]); \
            Acur[i] = *(const GAS v4u*)(nrow + 64 * i); \
            const v8i_t a8 = {(int)t[0], (int)t[1], (int)t[2], (int)t[3], 0, 0, 0, 0}; \
            acc = __builtin_amdgcn_mfma_scale_f32_16x16x128_f8f6f4(a8, Bop[i], acc, 4  , 0  , 0, 0x7f7f7f7f, 0, 0x7f7f7f7f); } \
        PU_TAIL(b) \
    } while (0)
#pragma unroll 1
    for (int b = 0; b < 128; b += 2) { PU_STEP(A0, b); PU_STEP(A1, b + 1); }
#undef PU_STEP
#undef PU_TAIL
}

template <unsigned EMASK> __device__ __forceinline__ void peer_v_phase(Frame& F, int blk) {
    typedef int v2i_t __attribute__((ext_vector_type(2)));
    int lane = F.lane; asm volatile("" : "+v"(lane));
    int tid = F.tid; asm volatile("" : "+v"(tid));
    const int w = F.wave, p = w >> 1, hf = w & 1;
    LAS unsigned char* stg = F.lds + w * PV_STG_BYTES;
    LAS unsigned char* lst = F.lds + PV_LST;
    const LAS unsigned short* E16 = (const LAS unsigned short*)lst; const LAS unsigned char* TOK8 = lst + 4096; const LAS unsigned char* ACT8 = lst + 6144;
    LAS float* SSP = (LAS float*)(F.lds + PV_SSP);
    const __amdgpu_buffer_rsrc_t evr = __builtin_amdgcn_make_buffer_rsrc((void*)(F.ws + WS_EV), 0, NEXP * (D / 2), 0x00020000);
    const int t16 = lane & 15, g4 = lane >> 4;
    const unsigned tsplat = (unsigned)t16 * 0x01010101u;
    const int sit = lane >> 3, sc = lane & 7;
    const unsigned coff = 128u * (unsigned)p + 16u * (unsigned)sc;
    const int et = 8 * hf + (lane >> 3), eq = lane & 7;
    const unsigned char* LG = F.ws + WS_SC + (size_t)blk * 65536;
    __syncthreads();
#pragma unroll 1
    for (int g = 0; g < 8; ++g) {
        const int T0 = blk * 128 + g * 16;
        { const v4u t = *(const GAS v4u*)(LG + g * 8192 + 16 * tid); *(LAS v4u*)(lst + 16 * tid) = t; }
        __syncthreads();
        f32x4 acc[16];
#pragma unroll
        for (int j = 0; j < 16; ++j) acc[j] = (f32x4){0.f, 0.f, 0.f, 0.f};
        v4u sv[16];
#pragma unroll
        for (int m = 0; m < 16; ++m) sv[m] = __builtin_amdgcn_raw_buffer_load_b128(evr, (int)(((unsigned)E16[128 * hf + 8 * m + sit] & EMASK) * 512u + coff), 0, 0);
#pragma unroll 1
        for (int b = hf; b < 16; b += 2) {
#pragma unroll
            for (int m = 0; m < 16; ++m) { const int row = 8 * m + sit; *(LAS v4u*)(stg + 128 * row + 16 * (sc ^ ((row ^ (row >> 3)) & 7))) = sv[m]; }
            const int bn = (b + 2 < 16) ? b + 2 : b;
#pragma unroll
            for (int m = 0; m < 16; ++m) sv[m] = __builtin_amdgcn_raw_buffer_load_b128(evr, (int)(((unsigned)E16[128 * bn + 8 * m + sit] & EMASK) * 512u + coff), 0, 0);
            const v4u tk0 = *(const LAS v4u*)(TOK8 + 128 * b + 16 * g4), tk1 = *(const LAS v4u*)(TOK8 + 128 * b + 64 + 16 * g4);
            const v4u ak0 = *(const LAS v4u*)(ACT8 + 128 * b + 16 * g4), ak1 = *(const LAS v4u*)(ACT8 + 128 * b + 64 + 16 * g4);
            v8i_t aop;
#pragma unroll
            for (int h = 0; h < 4; ++h) { const unsigned x0 = tk0[h] ^ tsplat, x1 = tk1[h] ^ tsplat;
                const unsigned z0 = ~((x0 | 0x80808080u) - 0x01010101u) & 0x80808080u, z1 = ~((x1 | 0x80808080u) - 0x01010101u) & 0x80808080u;
                aop[h] = (int)(ak0[h] & ((z0 >> 7) * 0xffu)); aop[4 + h] = (int)(ak1[h] & ((z1 >> 7) * 0xffu)); }
            asm volatile("" ::: "memory");
#pragma unroll
            for (int j = 0; j < 16; ++j) {
                const int r0 = 32 * g4 + t16, r1 = r0 + 16;
                const v2i_t lo = __builtin_amdgcn_ds_read_tr4_b64_v2i32((LAS v2i_t*)(stg + 128 * r0 + 16 * ((j >> 1) ^ ((r0 ^ (r0 >> 3)) & 7)) + 8 * (j & 1)));
                const v2i_t hi = __builtin_amdgcn_ds_read_tr4_b64_v2i32((LAS v2i_t*)(stg + 128 * r1 + 16 * ((j >> 1) ^ ((r1 ^ (r1 >> 3)) & 7)) + 8 * (j & 1)));
                const v8i_t bop = {lo.x, lo.y, hi.x, hi.y, 0, 0, 0, 0};
                acc[j] = __builtin_amdgcn_mfma_scale_f32_16x16x128_f8f6f4(aop, bop, acc[j], 0  , 4  , 0, 0x7f7f7f7f, 0, 0x7f7f7f7f); }
            asm volatile("" ::: "memory");
        }
        LAS float* yt = (LAS float*)stg;
#pragma unroll
        for (int j = 0; j < 16; ++j)
#pragma unroll
            for (int v = 0; v < 4; ++v) yt[(4 * g4 + v) * 256 + ((16 * j + t16) ^ (16 * g4))] = acc[j][v];
        __syncthreads();
        const LAS float* ya = (const LAS float*)(F.lds + (w & ~1) * PV_STG_BYTES) + et * 256; const LAS float* yb = ya + PV_STG_BYTES / 4;
        const bf16* xr = (const bf16*)(F.ws + WS_XB) + (size_t)(T0 + et) * D + 256 * p + 32 * eq;
        f32x4 x2[8]; float ss = 0.f;
#pragma unroll
        for (int k = 0; k < 4; ++k) { const v4u xw = *(const GAS v4u*)(xr + 8 * k); const int ix = (32 * eq + 8 * k) ^ (16 * (et >> 2));
            const f32x4 y0 = *(const LAS f32x4*)(ya + ix) + *(const LAS f32x4*)(yb + ix), y1 = *(const LAS f32x4*)(ya + ix + 4) + *(const LAS f32x4*)(yb + ix + 4);
            const unsigned w0 = xw.x, w1 = xw.y, w2 = xw.z, w3 = xw.w; const float scl = 1.0f / (ACT_SCALE * EV4_SCALE);
            x2[2 * k] = (f32x4){bflo(w0) + y0[0] * scl, bfhi(w0) + y0[1] * scl, bflo(w1) + y0[2] * scl, bfhi(w1) + y0[3] * scl};
            x2[2 * k + 1] = (f32x4){bflo(w2) + y1[0] * scl, bfhi(w2) + y1[1] * scl, bflo(w3) + y1[2] * scl, bfhi(w3) + y1[3] * scl};
            const f32x4 o0 = x2[2 * k], o1 = x2[2 * k + 1];
            ss += (o0[0] * o0[0] + o0[1] * o0[1]) + (o0[2] * o0[2] + o0[3] * o0[3]) + (o1[0] * o1[0] + o1[1] * o1[1]) + (o1[2] * o1[2] + o1[3] * o1[3]); }
        ss += __shfl_xor(ss, 1); ss += __shfl_xor(ss, 2); ss += __shfl_xor(ss, 4);
        if (eq == 0) SSP[et * 4 + p] = ss;
        __syncthreads();
        { const f32x4 s0 = *(const LAS f32x4*)(SSP + et * 4);
          const float tot = (s0[0] + s0[1]) + (s0[2] + s0[3]);
          const float r3 = 1.0f / sqrtf(tot * (1.0f / D) + EPS);
          float* orow = F.out + (size_t)(T0 + et) * D + 256 * p + 32 * eq; const float* gn = F.norm_final + 256 * p + 32 * eq;
#pragma unroll
          for (int k = 0; k < 8; ++k) { const f32x4 gv = *(const GAS f32x4*)(gn + 4 * k); const f32x4 v = x2[k];
              *(GAS f32x4*)(orow + 4 * k) = (f32x4){v[0] * r3 * gv[0], v[1] * r3 * gv[1], v[2] * r3 * gv[2], v[3] * r3 * gv[3]}; } }
    }
}

struct Args { const float* in[12]; float* out; unsigned char* ws; };
__global__ void __launch_bounds__(NWAVES * 64, 2) hymba_fwd(Args args) {
    extern __shared__ __attribute__((aligned(16))) unsigned char lds[];
    Frame F;
    F.lds = (LAS unsigned char*)lds;
    F.MISC = (volatile LAS unsigned*)(F.lds + MISC_OFF);
    F.tid = threadIdx.x; F.lane = F.tid & 63; F.wave = __builtin_amdgcn_readfirstlane(F.tid >> 6);
    F.G = gridDim.x; { const int bx = blockIdx.x; F.vcu = (F.G % 8 == 0) ? (bx % 8) * (F.G / 8) + bx / 8 : bx; }
    F.x = args.in[0]; F.norm_mix = args.in[1]; F.w_in = args.in[2]; F.w_pool = args.in[3]; F.pool_scale = args.in[4]; F.w_out = args.in[5];
    F.norm_ffn = args.in[6]; F.w_query = args.in[7]; F.sub_keys = args.in[8]; F.expert_u = args.in[9]; F.expert_v = args.in[10]; F.norm_final = args.in[11];
    F.out = args.out; F.ws = args.ws;
    for (int u = F.tid; u < (LDS_BYTES - LDSCTL_OFF) / 4; u += NWAVES * 64) ((LAS unsigned*)(F.lds + LDSCTL_OFF))[u] = 0u;
    __syncthreads();
    XcdBarrier bar = xcd_barrier_post((unsigned*)(F.ws + WS_CTL), F.MISC + 8);
#define GRID_BAR() xcd_barrier(bar)
#ifndef PROBE_SPIN
#define PROBE_SPIN -1
#endif
    unsigned long long ps_t0 = 0;
#define PH_BEGIN(k) do { if (PROBE_SPIN == (k)) ps_t0 = __builtin_amdgcn_s_memrealtime(); } while (0)
#define PH_END(k) do { if (PROBE_SPIN == (k)) { const unsigned long long t1 = __builtin_amdgcn_s_memrealtime(), dt = t1 - ps_t0; while (__builtin_amdgcn_s_memrealtime() - t1 < dt) __builtin_amdgcn_s_sleep(8); } } while (0)

#ifndef PROBE_DUP
#define PROBE_DUP -1
#endif
#ifdef TR4TEST
    {
        LAS unsigned char* tb = F.lds + 4096 * F.wave;
        for (int i = F.lane; i < 512; i += 64) { const int grp = i >> 7, r = (i >> 3) & 15, cb = i & 7;
            const unsigned lo = (unsigned)(r + 3 * (2 * cb) + 5 * grp) & 15u, hi = (unsigned)(r + 3 * (2 * cb + 1) + 5 * grp) & 15u; tb[i] = (unsigned char)(lo | (hi << 4)); }
        LDS_WAIT(); asm volatile("" ::: "memory");
        typedef int v2i_t4 __attribute__((ext_vector_type(2)));
        const int l16 = F.lane & 15, grp = F.lane >> 4;
#if TR4TEST == 1
        const int roff = l16 * 8;
#else
        const int roff = ((l16 + 1) & 15) * 8;
#endif
        const v2i_t4 rr = __builtin_amdgcn_ds_read_tr4_b64_v2i32((LAS v2i_t4*)(tb + grp * 128 + roff));
        const unsigned long long got = ((unsigned long long)(unsigned)rr.y << 32) | (unsigned)rr.x; unsigned long long want = 0;
        for (int j = 0; j < 16; ++j) want |= (unsigned long long)((unsigned)(j + 3 * l16 + 5 * grp) & 15u) << (4 * j);
        if (got != want) __hip_atomic_store((unsigned*)(F.ws + WS_CTL) + 8, 1u, RLX_AGENT);
        LDS_WAIT(); asm volatile("" ::: "memory");
        __syncthreads();
    }
#endif
#ifdef DIAGS
    if (blockIdx.x == 0 && F.wave == 0) {
        typedef int v8i_d __attribute__((ext_vector_type(8)));
        const int g0 = (DIAGS) >> 5, j0 = (DIAGS) & 31, r0 = 3;
        const int lg = F.lane >> 4;
        v8i_d A = {0, 0, 0, 0, 0, 0, 0, 0};
        if (F.lane == 16 * g0 + r0) A[j0 >> 3] = 0x2 << (4 * (j0 & 7));
        int P = 0;
        for (int bit = 0; bit < 7; ++bit) {
            v8i_d B;
#pragma unroll
            for (int rg = 0; rg < 8; ++rg) { unsigned w = 0;
#pragma unroll
                for (int by = 0; by < 4; ++by) { const int j = 4 * rg + by; if (((lg * 32 + j) >> bit) & 1) w |= 0x38u << (8 * by); }
                B[rg] = (int)w; }
            f32x4 acc = {0.f, 0.f, 0.f, 0.f};
            acc = __builtin_amdgcn_mfma_scale_f32_16x16x128_f8f6f4(A, B, acc, 4, 0, 0, 0x7f7f7f7f, 0, 0x7f7f7f7f);
            const float dsel = acc[r0 & 3];
            const float d = __builtin_bit_cast(float, __builtin_amdgcn_readlane(__builtin_bit_cast(int, dsel), 16 * (r0 >> 2)));
            if (d > 0.5f) P |= 1 << bit;
        }
        const unsigned long long t1 = __builtin_amdgcn_s_memrealtime();
        while (__builtin_amdgcn_s_memrealtime() - t1 < (unsigned long long)(P + 1) * 10000ull) __builtin_amdgcn_s_sleep(8);
    }
#endif
#ifdef TRTEST
    {
        LAS unsigned char* tb = F.lds + 4096 * F.wave;
        for (int i = F.lane; i < 512; i += 64) tb[i] = (unsigned char)((i & 127) ^ ((i >> 7) * 0x55));
        LDS_WAIT(); asm volatile("" ::: "memory");
        typedef int v2i_t __attribute__((ext_vector_type(2)));
        const int l16 = F.lane & 15, grp = F.lane >> 4;
#if TRTEST == 1
        const int roff = (l16 >> 1) * 16 + (l16 & 1) * 8;
#else
        const int roff = (l16 & 7) * 16 + (l16 >> 3) * 8;
#endif
        const v2i_t rr = __builtin_amdgcn_ds_read_tr8_b64_v2i32((LAS v2i_t*)(tb + grp * 128 + roff));
        unsigned long long got = ((unsigned long long)(unsigned)rr.y << 32) | (unsigned)rr.x, want = 0;
        for (int j = 0; j < 8; ++j) want |= (unsigned long long)(unsigned char)(((j * 16 + l16) & 127) ^ (grp * 0x55)) << (8 * j);
        if (got != want) __hip_atomic_store((unsigned*)(F.ws + WS_CTL) + 8, 1u, RLX_AGENT);
        LDS_WAIT(); asm volatile("" ::: "memory");
        __syncthreads();
    }
#endif
#ifdef UBENCH
    {
        unsigned r0 = F.tid, r1 = F.tid * 3, r2 = F.tid * 5, r3 = F.tid * 7; float f0 = 1.f, f1 = 2.f, f2 = 3.f, f3 = 4.f; f32x2 p0 = {1.f, 2.f}, p1 = {3.f, 4.f}, q0 = {0.f, 0.f}, q1 = {0.f, 0.f}, q2 = {0.f, 0.f}, q3 = {0.f, 0.f};
        for (int it = 0; it < 20000; ++it) {
#pragma unroll
            for (int k = 0; k < 4; ++k) {
#if UBENCH == 1
                asm volatile("v_cvt_pk_f32_fp8_e32 %0, %4\n v_cvt_pk_f32_fp8_e32 %1, %5\n v_cvt_pk_f32_fp8_e32 %2, %6\n v_cvt_pk_f32_fp8_e32 %3, %7" : "=v"(q0), "=v"(q1), "=v"(q2), "=v"(q3) : "v"(r0), "v"(r1), "v"(r2), "v"(r3));
#elif UBENCH == 2
                asm volatile("v_cvt_f32_ubyte0_e32 %0, %4\n v_cvt_f32_ubyte1_e32 %1, %5\n v_cvt_f32_ubyte2_e32 %2, %6\n v_cvt_f32_ubyte3_e32 %3, %7" : "=v"(f0), "=v"(f1), "=v"(f2), "=v"(f3) : "v"(r0), "v"(r1), "v"(r2), "v"(r3));
#elif UBENCH == 3
                asm volatile("v_pk_fma_f32 %0, %4, %5, %0\n v_pk_fma_f32 %1, %4, %5, %1\n v_pk_fma_f32 %2, %4, %5, %2\n v_pk_fma_f32 %3, %4, %5, %3" : "+v"(q0), "+v"(q1), "+v"(q2), "+v"(q3) : "v"(p0), "v"(p1));
#elif UBENCH == 4
                asm volatile("v_dot2_f32_f16 %0, %4, %5, %0\n v_dot2_f32_f16 %1, %4, %6, %1\n v_dot2_f32_f16 %2, %5, %6, %2\n v_dot2_f32_f16 %3, %6, %7, %3" : "+v"(f0), "+v"(f1), "+v"(f2), "+v"(f3) : "v"(r0), "v"(r1), "v"(r2), "v"(r3));
#elif UBENCH == 5
                asm volatile("v_perm_b32 %0, %4, %5, %6\n v_perm_b32 %1, %5, %6, %7\n v_perm_b32 %2, %4, %6, %7\n v_perm_b32 %3, %4, %5, %7" : "=v"(f0), "=v"(f1), "=v"(f2), "=v"(f3) : "v"(r0), "v"(r1), "v"(r2), "v"(r3));
#elif UBENCH == 6
                asm volatile("v_fma_f32 %0, %4, %5, %0\n v_fma_f32 %1, %4, %5, %1\n v_fma_f32 %2, %4, %5, %2\n v_fma_f32 %3, %4, %5, %3" : "+v"(f0), "+v"(f1), "+v"(f2), "+v"(f3) : "v"(p0.x), "v"(p1.y));
#elif UBENCH == 8
                asm volatile("v_pk_fma_f16 %0, %4, %5, %0\n v_pk_fma_f16 %1, %4, %5, %1\n v_pk_fma_f16 %2, %4, %5, %2\n v_pk_fma_f16 %3, %4, %5, %3" : "+v"(f0), "+v"(f1), "+v"(f2), "+v"(f3) : "v"(r0), "v"(r1));
#elif UBENCH == 9
                asm volatile("v_cvt_scalef32_pk_f16_fp8 %0, %4, 1.0\n v_cvt_scalef32_pk_f16_fp8 %1, %5, 1.0\n v_cvt_scalef32_pk_f16_fp8 %2, %6, 1.0\n v_cvt_scalef32_pk_f16_fp8 %3, %7, 1.0" : "=v"(f0), "=v"(f1), "=v"(f2), "=v"(f3) : "v"(r0), "v"(r1), "v"(r2), "v"(r3));
#elif UBENCH == 10
                asm volatile("v_cvt_pk_f32_fp8_sdwa %0, %4 src0_sel:WORD_1\n v_cvt_pk_f32_fp8_sdwa %1, %5 src0_sel:WORD_1\n v_cvt_pk_f32_fp8_sdwa %2, %6 src0_sel:WORD_1\n v_cvt_pk_f32_fp8_sdwa %3, %7 src0_sel:WORD_1" : "=v"(q0), "=v"(q1), "=v"(q2), "=v"(q3) : "v"(r0), "v"(r1), "v"(r2), "v"(r3));
#elif UBENCH == 7
                asm volatile("v_dot4_i32_i8 %0, %4, %5, %0\n v_dot4_i32_i8 %1, %4, %6, %1\n v_dot4_i32_i8 %2, %5, %6, %2\n v_dot4_i32_i8 %3, %6, %7, %3" : "+v"(f0), "+v"(f1), "+v"(f2), "+v"(f3) : "v"(r0), "v"(r1), "v"(r2), "v"(r3));
#endif
            }
        }
        float* dump = (float*)(F.ws + WS_Z);
        dump[(size_t)blockIdx.x * 512 + F.tid] = f0 + f1 + f2 + f3 + q0.x + q1.y + q2.x + q3.y;
    }
#endif
    PH_BEGIN(0); p0_prologue(F); PH_END(0);
    if (PROBE_DUP == 0) { GRID_BAR(); p0_prologue(F); }
    GRID_BAR();
    PH_BEGIN(1);
    {
        pg8::Gemm g{(const pg8::bf16_t*)(F.ws + WS_XB), (const pg8::bf16_t*)(F.ws + WS_WIN), M, NZ, D}; pg8::StaticOrder S; S.init(M, NZ, F.G, (int)blockIdx.x);
        pg8::EpiZ E{(pg8::bf16_t*)(F.ws + WS_Z), (pg8::bf16_t*)(F.ws + WS_ZP), (const float*)(F.ws + WS_R1), DATT, QSCALE, SEQ, NH, M};
        pg8::gemm_phase<pg8::EpiZ, pg8::StaticOrder, PG8_ALIGN, PG8_SP2>(F.lds + RING_OFF, g, S, E);
        if (PROBE_DUP == 1) { GRID_BAR(); pg8::gemm_phase<pg8::EpiZ, pg8::StaticOrder, PG8_ALIGN, PG8_SP2>(F.lds + RING_OFF, g, S, E); }
    }
    PH_END(1);
    GRID_BAR();
    PH_BEGIN(2);
    {
        v4u kv[6], vv[6]; bf16x8 qc[4], qn[4];
        int u = F.vcu;
        if (u < ATT_UNITS) { attn_fetch(F, u, kv, vv); attn_fetch_q(F, u, qn); }
        for (; u < ATT_UNITS; u += F.G) {
#pragma unroll
            for (int d0 = 0; d0 < 4; ++d0) qc[d0] = qn[d0];
            attn_stage(F, kv, vv);
            __syncthreads();
            if (u + F.G < ATT_UNITS) { attn_fetch(F, u + F.G, kv, vv); attn_fetch_q(F, u + F.G, qn); }
            attn_compute(F, u, qc);
            __syncthreads();
        }
    }
    PH_END(2);
    PH_BEGIN(3); pool_rows(F); PH_END(3);
    if (PROBE_DUP == 3) { GRID_BAR(); pool_rows(F); }
    GRID_BAR();
    PH_BEGIN(4); merge_rows(F); PH_END(4);
    if (PROBE_DUP == 4) { GRID_BAR(); merge_rows(F); }
    GRID_BAR();
    PH_BEGIN(5);
    {
        pg8::Gemm g{(const pg8::bf16_t*)(F.ws + WS_MIX), (const pg8::bf16_t*)(F.ws + WS_WOUT), M, D, D}; pg8::StaticOrder S; S.init(M, D, F.G, (int)blockIdx.x);
        pg8::EpiRes E{(pg8::bf16_t*)(F.ws + WS_XB), (float*)(F.ws + WS_SS), D};
        pg8::gemm_phase<pg8::EpiRes, pg8::StaticOrder, PG8_ALIGN, PG8_SP2>(F.lds + RING_OFF, g, S, E);
        if (PROBE_DUP == 5) { GRID_BAR(); pg8::gemm_phase<pg8::EpiRes, pg8::StaticOrder, PG8_ALIGN, PG8_SP2>(F.lds + RING_OFF, g, S, E); }
    }
    PH_END(5);
    GRID_BAR();
    PH_BEGIN(6);
    {
        pg8::Gemm g{(const pg8::bf16_t*)(F.ws + WS_XB), (const pg8::bf16_t*)(F.ws + WS_WSC), M, NSC, D}; pg8::StaticOrder S; S.init(M, NSC, F.G, (int)blockIdx.x);
        pg8::EpiF16 E{(unsigned short*)(F.ws + WS_SCH), NSC};
        pg8::gemm_phase<pg8::EpiF16, pg8::StaticOrder, PG8_ALIGN, PG8_SP2>(F.lds + RING_OFF, g, S, E);
        if (PROBE_DUP == 6) { GRID_BAR(); pg8::gemm_phase<pg8::EpiF16, pg8::StaticOrder, PG8_ALIGN, PG8_SP2>(F.lds + RING_OFF, g, S, E); }
    }
    PH_END(6);
    GRID_BAR();
    PH_BEGIN(7); topk_phase(F); PH_END(7);
    if (PROBE_DUP == 7) { GRID_BAR(); topk_phase(F); }
    GRID_BAR();
#ifndef VSYNC
#define VSYNC 0
#endif
#ifndef PROBE_U2
#define PROBE_U2 0
#endif
#ifndef PROBE_UMASK
#define PROBE_UMASK 0x3fffu
#endif
    for (int blk = F.vcu; blk < M / 128; blk += F.G) { PH_BEGIN(8); peer_u_phase<0x3fffu, false>(F, blk); PH_END(8); PH_BEGIN(9); peer_v_phase<0x3fffu>(F, blk); PH_END(9); }
#if defined(TRTEST) || defined(TR4TEST)
    GRID_BAR();
    if (blockIdx.x == 0 && F.tid == 0 && __hip_atomic_load((unsigned*)(F.ws + WS_CTL) + 8, RLX_AGENT) != 0u) F.out[0] = __builtin_nanf("");
#endif
}

extern "C" void kernel_launch(void* const* d_in, const int* in_sizes, int n_in, void* d_out, int out_size, void* d_ws, size_t ws_size, hipStream_t stream) {
    static int grid = 0;
    if (grid == 0) {
        if (n_in != 12 || in_sizes[0] != M * D || out_size != M * D || ws_size < WS_END) { fprintf(stderr, "kernel_launch: unexpected shapes (n_in %d, in0 %d, out %d, ws %zu); nothing launched\n", n_in, n_in > 0 ? in_sizes[0] : -1, out_size, ws_size); grid = -1; return; }
        int dev = 0, cus = 0, per_cu = 0;
        if (hipGetDevice(&dev) != hipSuccess || hipDeviceGetAttribute(&cus, hipDeviceAttributeMultiprocessorCount, dev) != hipSuccess) { grid = -1; return; }
        if (hipFuncSetAttribute((const void*)hymba_fwd, hipFuncAttributeMaxDynamicSharedMemorySize, LDS_BYTES) != hipSuccess) { fprintf(stderr, "kernel_launch: hipFuncSetAttribute failed\n"); grid = -1; return; }
        if (hipOccupancyMaxActiveBlocksPerMultiprocessor(&per_cu, (const void*)hymba_fwd, NWAVES * 64, LDS_BYTES) != hipSuccess || per_cu < 1)
            fprintf(stderr, "kernel_launch: note: occupancy query reports %d workgroups per CU\n", per_cu);
        (void)hipGetLastError();
        grid = cus;
    }
    if (grid < 0) return;
    if (hipMemsetAsync((char*)d_ws + WS_CTL, 0, CTL_ZERO_BYTES, stream) != hipSuccess) { fprintf(stderr, "kernel_launch: hipMemsetAsync failed\n"); return; }
    Args a{};
    for (int i = 0; i < 12; ++i) a.in[i] = (const float*)d_in[i];
    a.out = (float*)d_out; a.ws = (unsigned char*)d_ws;
    hipLaunchKernelGGL(hymba_fwd, dim3(grid), dim3(NWAVES * 64), LDS_BYTES, stream, a);
    const hipError_t le = hipPeekAtLastError();
    if (le != hipSuccess) fprintf(stderr, "kernel_launch: launch failed: %s\n", hipGetErrorName(le));
}
```
